# Optimizing an MI355X kernel written in HIP

```python
import jax, jax.numpy as jnp
from jax import lax
import numpy as np

D_MODEL = 1024
BATCH = 2
SEQ = 16384
DEPTH = 4

N_MIXERS = 2
ATTN_HEAD_DIM = 64
ATTN_HEADS = D_MODEL // ATTN_HEAD_DIM
DILATION_PAIRS = ((128, 1), (512, 4), (2048, 16))
ATTN_BLOCK = 128
MLSTM_HEADS = 4
MLSTM_V_DIM = D_MODEL // MLSTM_HEADS
MLSTM_QK_DIM = MLSTM_V_DIM // 2
MLSTM_CHUNK = 64
CONV_WIDTH = 4
N_GROUPS = 8
EXPERTS_PER_GROUP = 8
N_EXPERTS = N_GROUPS * EXPERTS_PER_GROUP
TOP_K_IN_GROUP = 2
EXPERT_FF = D_MODEL // 2
MOE_BLOCK = 256
NORM_EPS = 1e-6

kernel_name = "hybrid_dilated_attn_mlstm_hmoe"

F32 = jnp.float32


def rms_norm(x, gain):
    xf = x.astype(F32)
    y = xf * lax.rsqrt(jnp.mean(xf * xf, axis=-1, keepdims=True) + NORM_EPS)
    return (y * gain.astype(F32)).astype(x.dtype)


def rms_norm_f32(x, gain):
    xf = x.astype(F32)
    return xf * lax.rsqrt(jnp.mean(xf * xf, axis=-1, keepdims=True) + NORM_EPS) * gain.astype(F32)


def dilated_branch(q, k, v, window, dilation):
    B_, S_, H_, Dh = q.shape
    n_back = window // dilation
    blk = ATTN_BLOCK
    span = dilation * blk
    S_pad = -(-S_ // span) * span
    nb = S_pad // span
    pad = ((0, 0), (0, S_pad - S_), (0, 0), (0, 0))

    def split(t):
        return jnp.pad(t, pad).reshape(B_, nb, blk, dilation, H_, Dh)

    def band(t):
        prev = jnp.concatenate([jnp.zeros_like(t[:, :1]), t[:, :-1]], axis=1)
        return jnp.concatenate([prev, t], axis=2)

    qb = split(q)
    kband = band(split(k))
    vband = band(split(v))
    s = jnp.einsum('bnqrhd,bnkrhd->bnrhqk', qb, kband) * (Dh ** -0.5)
    qi = jnp.arange(blk)[:, None]
    ki = jnp.arange(2 * blk)[None, :]
    dist = blk + qi - ki
    valid = (dist >= 0) & (dist <= n_back)
    valid = valid[None] & ((jnp.arange(nb)[:, None, None] > 0) | (ki >= blk)[None])
    s = jnp.where(valid[None, :, None, None], s, -jnp.inf)
    mx = jnp.max(s, axis=-1, keepdims=True)
    p = jnp.exp(s - mx)
    l = jnp.sum(p, axis=-1, keepdims=True)
    o = jnp.einsum('bnrhqk,bnkrhd->bnrhqd', p, vband) / l
    o = o.transpose(0, 1, 4, 2, 3, 5).reshape(B_, S_pad, H_, Dh)[:, :S_]
    lse = (mx[..., 0] + jnp.log(l[..., 0])).transpose(0, 1, 4, 2, 3).reshape(B_, S_pad, H_)[:, :S_]
    return o, lse


def dilated_attention_mixer(h, w_in, q_gain, k_gain, w_out):
    B_, S_, _ = h.shape
    qkv = (h @ w_in).reshape(B_, S_, 3, ATTN_HEADS, ATTN_HEAD_DIM).astype(F32)
    q = rms_norm_f32(qkv[:, :, 0], q_gain)
    k = rms_norm_f32(qkv[:, :, 1], k_gain)
    v = qkv[:, :, 2]
    outs, lses = [], []
    for window, dilation in DILATION_PAIRS:
        o, l = dilated_branch(q, k, v, window, dilation)
        outs.append(o)
        lses.append(l)
    wts = jax.nn.softmax(jnp.stack(lses), axis=0)
    o = jnp.einsum('gbsh,gbshd->bshd', wts, jnp.stack(outs))
    return o.reshape(B_, S_, ATTN_HEADS * ATTN_HEAD_DIM).astype(h.dtype) @ w_out


def causal_depthwise_conv(x, w):
    c = x.shape[-1]
    return lax.conv_general_dilated(
        x, w[:, None, :].astype(x.dtype), window_strides=(1,), padding=((CONV_WIDTH - 1, 0),),
        dimension_numbers=('NWC', 'WIO', 'NWC'), feature_group_count=c)


def mlstm_chunkwise(q, k, v, logi, logf):
    B_, S_, NH, DK = q.shape
    DV = v.shape[-1]
    L = MLSTM_CHUNK
    nc = S_ // L

    def chunks4(t):
        return t.reshape(B_, nc, L, NH, t.shape[-1]).transpose(1, 0, 3, 2, 4)

    def chunks3(t):
        return t.reshape(B_, nc, L, NH).transpose(1, 0, 3, 2)

    causal = jnp.tril(jnp.ones((L, L), dtype=bool))

    def step(carry, inp):
        C, n, m = carry
        qc, kc, vc, ic, fc = inp
        b = jnp.cumsum(fc, axis=-1)
        D = jnp.where(causal, b[..., :, None] - b[..., None, :] + ic[..., None, :], -jnp.inf)
        m_inter = b + m[..., None]
        m_t = jnp.maximum(m_inter, jnp.max(D, axis=-1))
        s = jnp.einsum('bhtd,bhsd->bhts', qc, kc) * jnp.exp(D - m_t[..., None])
        w_inter = jnp.exp(m_inter - m_t)
        num = jnp.einsum('bhts,bhsv->bhtv', s, vc) + w_inter[..., None] * jnp.einsum('bhtd,bhdv->bhtv', qc, C)
        den = jnp.sum(s, axis=-1) + w_inter * jnp.einsum('bhtd,bhd->bht', qc, n)
        h = num / jnp.maximum(jnp.abs(den), jnp.exp(-m_t))[..., None]
        bL = b[..., -1]
        g = bL[..., None] - b + ic
        m_new = jnp.maximum(bL + m, jnp.max(g, axis=-1))
        decay = jnp.exp(bL + m - m_new)
        wk = jnp.exp(g - m_new[..., None])[..., None] * kc
        C_new = decay[..., None, None] * C + jnp.einsum('bhsd,bhsv->bhdv', wk, vc)
        n_new = decay[..., None] * n + jnp.sum(wk, axis=-2)
        return (C_new, n_new, m_new), h

    init = (jnp.zeros((B_, NH, DK, DV), F32), jnp.zeros((B_, NH, DK), F32), jnp.zeros((B_, NH), F32))
    _, hs = lax.scan(step, init, (chunks4(q), chunks4(k), chunks4(v), chunks3(logi), chunks3(logf)))
    return hs.transpose(1, 0, 3, 2, 4).reshape(B_, S_, NH, DV)


def mlstm_mixer(h, w_in, conv_w, conv_b, gate_b, h_gain, w_out):
    B_, S_, _ = h.shape
    qk_w = MLSTM_HEADS * MLSTM_QK_DIM
    v_w = MLSTM_HEADS * MLSTM_V_DIM
    proj = h @ w_in
    qk = proj[..., :2 * qk_w]
    v = proj[..., 2 * qk_w:2 * qk_w + v_w]
    og = proj[..., 2 * qk_w + v_w:2 * qk_w + 2 * v_w]
    gates = proj[..., 2 * qk_w + 2 * v_w:].astype(F32) + gate_b.astype(F32)
    qk = jax.nn.silu(causal_depthwise_conv(qk, conv_w) + conv_b.astype(qk.dtype)).astype(F32)
    q = qk[..., :qk_w].reshape(B_, S_, MLSTM_HEADS, MLSTM_QK_DIM)
    k = qk[..., qk_w:].reshape(B_, S_, MLSTM_HEADS, MLSTM_QK_DIM) * (MLSTM_QK_DIM ** -0.5)
    v = v.astype(F32).reshape(B_, S_, MLSTM_HEADS, MLSTM_V_DIM)
    logi = gates[..., :MLSTM_HEADS]
    logf = jax.nn.log_sigmoid(gates[..., MLSTM_HEADS:])
    hs = mlstm_chunkwise(q, k, v, logi, logf)
    hs = rms_norm_f32(hs, h_gain.reshape(MLSTM_HEADS, MLSTM_V_DIM))
    y = hs.reshape(B_, S_, v_w) * jax.nn.sigmoid(og.astype(F32))
    return y.astype(h.dtype) @ w_out


def hierarchical_moe(h, w_group, b_group, w_expert, b_expert, w_gate, w_up, w_down):
    B_, S_, D_ = h.shape
    N = B_ * S_
    xf = h.reshape(N, D_)
    g_logits = (xf @ w_group).astype(F32) + b_group.astype(F32)
    g_prob = jax.nn.softmax(g_logits, axis=-1)
    _, grp = lax.top_k(g_logits, 1)
    grp = grp[:, 0]
    p_grp = jnp.take_along_axis(g_prob, grp[:, None], axis=-1)[:, 0]
    e_logits = ((xf @ w_expert).astype(F32) + b_expert.astype(F32)).reshape(N, N_GROUPS, EXPERTS_PER_GROUP)
    e_in = jnp.take_along_axis(e_logits, grp[:, None, None], axis=1)[:, 0]
    top_v, top_i = lax.top_k(e_in, TOP_K_IN_GROUP)
    gates = p_grp[:, None] * jax.nn.softmax(top_v, axis=-1)
    expert_id = grp[:, None] * EXPERTS_PER_GROUP + top_i

    A = N * TOP_K_IN_GROUP
    e_flat = expert_id.reshape(A).astype(jnp.int32)
    tok_flat = jnp.repeat(jnp.arange(N, dtype=jnp.int32), TOP_K_IN_GROUP)
    g_flat = gates.reshape(A)
    order = jnp.argsort(e_flat)
    e_s, tok_s, g_s = e_flat[order], tok_flat[order], g_flat[order]
    counts = jnp.bincount(e_flat, length=N_EXPERTS)
    padded = ((counts + MOE_BLOCK - 1) // MOE_BLOCK) * MOE_BLOCK
    pad_end = jnp.cumsum(padded)
    pad_start = pad_end - padded
    start = jnp.cumsum(counts) - counts
    dest = pad_start[e_s] + jnp.arange(A, dtype=jnp.int32) - start[e_s]
    P = (A // MOE_BLOCK + N_EXPERTS) * MOE_BLOCK
    nb = P // MOE_BLOCK
    row_tok = jnp.full((P,), N, dtype=jnp.int32).at[dest].set(tok_s)
    row_gate = jnp.zeros((P,), F32).at[dest].set(g_s)
    block_exp = jnp.clip(jnp.searchsorted(pad_end, jnp.arange(nb) * MOE_BLOCK, side='right'), 0, N_EXPERTS - 1)
    x_pad = jnp.concatenate([xf, jnp.zeros((1, D_), xf.dtype)], axis=0)
    xs = x_pad[row_tok].reshape(nb, MOE_BLOCK, D_)

    def expert_block(args):
        xb, e = args
        return (jax.nn.silu(xb @ w_gate[e]) * (xb @ w_up[e])) @ w_down[e]

    ys = lax.map(expert_block, (xs, block_exp)).reshape(P, D_)
    out = jnp.zeros((N + 1, D_), F32).at[row_tok].add(ys.astype(F32) * row_gate[:, None])[:N]
    return out.reshape(B_, S_, D_).astype(h.dtype)


def setup_inputs(seed: int = 0) -> dict:
    key = jax.random.key(seed)
    ks = jax.random.split(key, 24)
    n_attn = (DEPTH + N_MIXERS - 1) // N_MIXERS
    n_mlstm = DEPTH // N_MIXERS
    d = D_MODEL
    attn_w = ATTN_HEADS * ATTN_HEAD_DIM
    qk_w = MLSTM_HEADS * MLSTM_QK_DIM
    v_w = MLSTM_HEADS * MLSTM_V_DIM
    nrm = jax.random.normal
    return {
        "x": nrm(ks[0], (BATCH, SEQ, d), F32),
        "norm_mix": 1.0 + 0.02 * nrm(ks[1], (DEPTH, d), F32),
        "norm_ffn": 1.0 + 0.02 * nrm(ks[2], (DEPTH, d), F32),
        "attn_w_in": nrm(ks[3], (n_attn, d, 3 * attn_w), F32) * d ** -0.5,
        "attn_q_norm": 1.0 + 0.02 * nrm(ks[4], (n_attn, ATTN_HEAD_DIM), F32),
        "attn_k_norm": 1.0 + 0.02 * nrm(ks[5], (n_attn, ATTN_HEAD_DIM), F32),
        "attn_w_out": nrm(ks[6], (n_attn, attn_w, d), F32) * attn_w ** -0.5,
        "mlstm_w_in": nrm(ks[7], (n_mlstm, d, 2 * qk_w + 2 * v_w + 2 * MLSTM_HEADS), F32) * d ** -0.5,
        "mlstm_conv_w": nrm(ks[8], (n_mlstm, CONV_WIDTH, 2 * qk_w), F32) * CONV_WIDTH ** -0.5,
        "mlstm_conv_b": 0.02 * nrm(ks[9], (n_mlstm, 2 * qk_w), F32),
        "mlstm_gate_b": jnp.concatenate([
            0.1 * nrm(ks[10], (n_mlstm, MLSTM_HEADS), F32),
            jax.random.uniform(ks[11], (n_mlstm, MLSTM_HEADS), F32, 3.0, 6.0)], axis=-1),
        "mlstm_h_norm": 1.0 + 0.02 * nrm(ks[12], (n_mlstm, v_w), F32),
        "mlstm_w_out": nrm(ks[13], (n_mlstm, v_w, d), F32) * v_w ** -0.5,
        "moe_w_group": nrm(ks[14], (DEPTH, d, N_GROUPS), F32) * d ** -0.5,
        "moe_b_group": 0.01 * nrm(ks[15], (DEPTH, N_GROUPS), F32),
        "moe_w_expert": nrm(ks[16], (DEPTH, d, N_EXPERTS), F32) * d ** -0.5,
        "moe_b_expert": 0.01 * nrm(ks[17], (DEPTH, N_EXPERTS), F32),
        "moe_w_gate": nrm(ks[18], (DEPTH, N_EXPERTS, d, EXPERT_FF), F32) * d ** -0.5,
        "moe_w_up": nrm(ks[19], (DEPTH, N_EXPERTS, d, EXPERT_FF), F32) * d ** -0.5,
        "moe_w_down": nrm(ks[20], (DEPTH, N_EXPERTS, EXPERT_FF, d), F32) * EXPERT_FF ** -0.5,
    }


def reference(x, norm_mix, norm_ffn, attn_w_in, attn_q_norm, attn_k_norm, attn_w_out,
              mlstm_w_in, mlstm_conv_w, mlstm_conv_b, mlstm_gate_b, mlstm_h_norm, mlstm_w_out,
              moe_w_group, moe_b_group, moe_w_expert, moe_b_expert, moe_w_gate, moe_w_up, moe_w_down):
    for layer in range(DEPTH):
        j = layer // N_MIXERS
        h = rms_norm(x, norm_mix[layer])
        if layer % N_MIXERS == 0:
            x = x + dilated_attention_mixer(h, attn_w_in[j], attn_q_norm[j], attn_k_norm[j], attn_w_out[j])
        else:
            x = x + mlstm_mixer(h, mlstm_w_in[j], mlstm_conv_w[j], mlstm_conv_b[j], mlstm_gate_b[j],
                                mlstm_h_norm[j], mlstm_w_out[j])
        h = rms_norm(x, norm_ffn[layer])
        x = x + hierarchical_moe(h, moe_w_group[layer], moe_b_group[layer], moe_w_expert[layer],
                                 moe_b_expert[layer], moe_w_gate[layer], moe_w_up[layer], moe_w_down[layer])
    return x
```

```cpp
#include <hip/hip_runtime.h>
#include <cstdio>
#include <cstdint>

#ifndef MK_ONE_LAUNCH
#define MK_ONE_LAUNCH 1
#endif

#ifndef PHMASK
#define PHMASK 0xFFFFFFFFu
#endif
#define PHON(n) ((PHMASK >> (n)) & 1u)
#ifndef REPMASK
#define REPMASK 0u
#endif
#define NREP(n) (1 + (int)((REPMASK >> (n)) & 1u))
#ifdef DBG_NOGATES
#define DBGG(x) 0.0f
#else
#define DBGG(x) (x)
#endif

#define LAS __attribute__((address_space(3)))
#define GAS __attribute__((address_space(1)))
typedef unsigned short bf16_t;
typedef short bf16x8 __attribute__((ext_vector_type(8)));
typedef float f32x4 __attribute__((ext_vector_type(4)));
typedef float f32x2 __attribute__((ext_vector_type(2)));
typedef unsigned u32x4 __attribute__((ext_vector_type(4)));
typedef unsigned u32x2 __attribute__((ext_vector_type(2)));

constexpr int NTOK = 32768, SEQ = 16384, DM = 1024, NLAYER = 4;
constexpr int NEXP = 64, FFE = 512;
constexpr int PMAX = 81920;
constexpr float EPS = 1e-6f;
constexpr float LOG2E = 1.4426950408889634f;

constexpr size_t MiB = 1u << 20;
constexpr size_t WS_CTL = 0, CTL_ZERO_BYTES = 1 * MiB;
constexpr size_t WS_WQKV = 2 * MiB, WS_WO = 14 * MiB, WS_WIN = 18 * MiB, WS_WMO = 30 * MiB, WS_WR = 34 * MiB, WS_WG = 36 * MiB;
constexpr size_t WS_SMALL = 37 * MiB;
constexpr size_t SM_RSTD = WS_SMALL, SM_GATES = WS_SMALL + 256 * 1024, SM_TOKE = WS_SMALL + 1280 * 1024, SM_TOKG = WS_SMALL + 1536 * 1024,
                 SM_TOKP = WS_SMALL + 1792 * 1024, SM_ROWTOK = WS_SMALL + 2 * MiB, SM_TILEEXP = WS_SMALL + 2 * MiB + 512 * 1024,
                 SM_MLOC = WS_SMALL + 2 * MiB + 768 * 1024, SM_BL = SM_MLOC + 8192, SM_MPREV = SM_MLOC + 16384,
                 SM_DN = WS_SMALL + 3 * MiB, SM_NS = WS_SMALL + 4 * MiB, SM_L1 = WS_SMALL + 5 * MiB, SM_L2 = WS_SMALL + 7 * MiB;
constexpr size_t WS_WGU = 64 * MiB, WS_WD = 576 * MiB, WS_XB = 832 * MiB, WS_QKV = 898 * MiB, WS_OB = 1090 * MiB,
                 WS_P1 = 1170 * MiB, WS_P2 = 1234 * MiB, WS_CS = 1298 * MiB, WS_QC = 1426 * MiB, WS_KC = 1458 * MiB, WS_END = 1490 * MiB;
constexpr size_t WS_YB = WS_QKV, WS_ACT = WS_OB, WS_DC = WS_P1;
constexpr int CW_BAR = 4096, CW_CNT = 16384;

constexpr int LDS_BYTES = 147456;
constexpr int MISC_OFF = 147456 - 512;

__device__ __forceinline__ unsigned f2bf(float f) { unsigned u = __builtin_bit_cast(unsigned, f); return (u + 0x7fffu + ((u >> 16) & 1u)) >> 16; }
__device__ __forceinline__ float bf2f(unsigned h) { return __builtin_bit_cast(float, h << 16); }
typedef __bf16 bf16x2_t __attribute__((ext_vector_type(2)));
__device__ __forceinline__ unsigned cvt_pk_bf16(float lo, float hi) { f32x2 v = {lo, hi}; bf16x2_t r = __builtin_convertvector(v, bf16x2_t); return __builtin_bit_cast(unsigned, r); }
__device__ __forceinline__ float bflo(unsigned w) { return __builtin_bit_cast(float, w << 16); }
__device__ __forceinline__ float bfhi(unsigned w) { return __builtin_bit_cast(float, w & 0xffff0000u); }
__device__ __forceinline__ float fast_exp2(float x) { return __builtin_amdgcn_exp2f(x); }
__device__ __forceinline__ float fast_rcp(float x) { return __builtin_amdgcn_rcpf(x); }
#define LDS_WAIT() asm volatile("s_waitcnt lgkmcnt(0)" ::: "memory")
#define VM_WAIT() asm volatile("s_waitcnt vmcnt(0)" ::: "memory")

#define XB_TMO      128
#define XB_XCNT(j)  (256  + 64 * (j))
#define XB_XSUB(j)  (1280 + 64 * (j))
#define XB_XGEN(j)  (2304 + 64 * (j))
#define XB_TOP      3328
#define XB_TOPGEN   3392
#define XCD_BAR_WORDS 3456
#define XB_SPIN_CAP (1u << 18)
__device__ __forceinline__ unsigned xb_ld(unsigned* p)              { return __hip_atomic_load(p, __ATOMIC_RELAXED, __HIP_MEMORY_SCOPE_AGENT); }
__device__ __forceinline__ unsigned xb_add(unsigned* p, unsigned v) { return __hip_atomic_fetch_add(p, v, __ATOMIC_RELAXED, __HIP_MEMORY_SCOPE_AGENT); }
__device__ __forceinline__ unsigned xb_xcc_id() { return (unsigned)__builtin_amdgcn_s_getreg((3 << 11) | 20) & 0xFu; }
#define XB_SPIN(cond, bar) do { unsigned _sp = 0; while (cond) { __builtin_amdgcn_s_sleep(1); \
    if ((++_sp & 255u) == 0u) { if (xb_ld(&(bar)[XB_TMO])) break; if (_sp > XB_SPIN_CAP) { atomicAdd(&(bar)[XB_TMO], 1u); break; } } } } while (0)
struct XcdBarrier { unsigned* bar; unsigned x; volatile LAS unsigned* st; };
__device__ __forceinline__ XcdBarrier xcd_barrier_post(unsigned* bar, volatile LAS unsigned* st) {
    XcdBarrier b; b.bar = bar; b.x = xb_xcc_id(); b.st = st;
    if (threadIdx.x == 0) (void)xb_add(&bar[XB_XCNT(b.x)], 1u);
    return b;
}
__device__ __forceinline__ void xcd_barrier_complete(unsigned* bar, unsigned x, unsigned& nloc, unsigned& nx) {
    const unsigned G = gridDim.x * gridDim.y * gridDim.z;
    unsigned sum, cnt, mine, sp = 0u;
    for (;;) {
        sum = 0u; cnt = 0u; mine = 0u;
#pragma unroll
        for (unsigned j = 0; j < 16; ++j) { const unsigned c = xb_ld(&bar[XB_XCNT(j)]); sum += c; cnt += (c > 0u) ? 1u : 0u; mine = (j == x) ? c : mine; }
        if (sum == G) break;
        __builtin_amdgcn_s_sleep(1);
        if ((++sp & 255u) == 0u) { if (xb_ld(&bar[XB_TMO])) break; if (sp > XB_SPIN_CAP) { atomicAdd(&bar[XB_TMO], 1u); break; } }
    }
    nloc = mine > 0u ? mine : 1u; nx = cnt > 0u ? cnt : 1u;
}
__device__ __forceinline__ void xcd_barrier(const XcdBarrier& b) {
    asm volatile("s_waitcnt vmcnt(0)" ::: "memory");
    __syncthreads();
    if (threadIdx.x == 0) {
        unsigned* bar = b.bar;
        __builtin_amdgcn_s_waitcnt(0);
        unsigned nloc = b.st[0], nx = b.st[1];
        if (nloc == 0u) { xcd_barrier_complete(bar, b.x, nloc, nx); b.st[0] = nloc; b.st[1] = nx; }
        const unsigned old = xb_add(&bar[XB_XSUB(b.x)], 1u);
        const unsigned gen = old / nloc;
        if (old + 1u == (gen + 1u) * nloc) {
            __builtin_amdgcn_fence(__ATOMIC_RELEASE, "agent");
            asm volatile("s_waitcnt vmcnt(0)" ::: "memory");
            const unsigned og = xb_add(&bar[XB_TOP], 1u);
            const unsigned tg = og / nx;
            if (og + 1u == (tg + 1u) * nx) xb_add(&bar[XB_TOPGEN], 1u);
            else XB_SPIN(xb_ld(&bar[XB_TOPGEN]) == tg, bar);
            __builtin_amdgcn_fence(__ATOMIC_ACQUIRE, "agent");
            xb_add(&bar[XB_XGEN(b.x)], 1u);
            asm volatile("s_waitcnt vmcnt(0)" ::: "memory");
        } else {
            XB_SPIN(xb_ld(&bar[XB_XGEN(b.x)]) == gen, bar);
            __builtin_amdgcn_fence(__ATOMIC_ACQUIRE, "agent");
            asm volatile("s_waitcnt vmcnt(0)" ::: "memory");
        }
    }
    __syncthreads();
}

namespace pg8 {
constexpr int BM = 256, BK = 64, HALF = 128, HTB = HALF * BK * 2, STAGE_BYTES = 8 * HTB, NXCD = 8, WGM = 8;
__host__ __device__ __forceinline__ int lds_byte(int r, int c) { const int st = (r >> 4) * 2 + (c >> 5), rr = r & 15, cc = c & 31, ob = rr * 64 + cc * 2; return st * 1024 + (ob ^ (((ob >> 9) & 1) << 5)); }
__host__ __device__ __forceinline__ void stage_rc(int b, int& R, int& C) { const int st = b / 1024, sb = b % 1024, swz = sb ^ (((sb >> 9) & 1) << 5); R = (st >> 1) * 16 + swz / 64; C = (st & 1) * 32 + (swz % 64) / 2; }
__host__ __device__ __forceinline__ int perm32(int rho) { const int n = rho >> 4, i = rho & 15; return 8 * (i >> 2) + 4 * n + (i & 3); }

struct Unit { int pm, pn, e; };
struct Gemm { const bf16_t* A; const bf16_t* Bt; int K; size_t b_estride; const int* sparse; const LAS int* pst; const LAS int* cnt; };

struct StaticOrder {
    int nM, nN, nwg, G, c; const LAS int* pst;
    __device__ void init(int nM_, int nN_, int G_, int c_, const LAS int* pst_) { nM = nM_; nN = nN_; nwg = nM * nN; G = G_; c = c_; pst = pst_; }
    __device__ bool next(int i, Unit& u) const {
        const long L = (long)i * G + c; if (L >= nwg) return false;
        int wgid = (int)L; { const int q = nwg / NXCD, r = nwg % NXCD, xcd = wgid % NXCD, off = wgid / NXCD; wgid = (xcd < r ? xcd * (q + 1) : r * (q + 1) + (xcd - r) * q) + off; }
        const int nig = WGM * nN, gid = wgid / nig, fm = gid * WGM, gsz = (nM - fm) < WGM ? (nM - fm) : WGM;
        u.pm = fm + ((wgid % nig) % gsz); u.pn = (wgid % nig) / gsz;
        u.e = pst ? __builtin_amdgcn_readfirstlane(pst[256 + u.pm]) : 0;
        return true;
    }
};

template <class Epi, bool ALIGN_EPI, bool GATHER, bool A_HM = false>
__device__ __forceinline__ void gemm_phase(LAS unsigned char* lds, const int tid, const Gemm g, const StaticOrder& S, const Epi& E) {
    const int wid = __builtin_amdgcn_readfirstlane(tid >> 6), lane = tid & 63, wr = wid >> 2, wc = wid & 3, fr = lane & 15, fq = lane >> 4;
    const int K = g.K, nt = K / BK;
    int RA[2], CA[2]; unsigned voffB[2];
#pragma unroll
    for (int i = 0; i < 2; ++i) { int R, C; stage_rc(tid * 16 + i * 8192, R, C); const int Rb = Epi::PERM ? ((R & ~31) + perm32(R & 31)) : R;
        RA[i] = R; CA[i] = C; voffB[i] = (unsigned)(Rb * K + C) * 2u; }
    const size_t kstep = (size_t)(BK * 2);
    const size_t hstep = (size_t)HALF * K * 2;
    const size_t tstep = 2 * hstep;
    const size_t akstep = A_HM ? (size_t)16384 * 128 : kstep, ahstep = A_HM ? (size_t)HALF * 128 : hstep;
#define PG8_ABASE(pm_) (A_HM ? ((size_t)((pm_) >> 6) * 16 * 16384 + (size_t)((pm_) & 63) * 256) * 128 : (size_t)(pm_) * tstep)
    const unsigned ldsw = (unsigned)wid * 1024u;
    const int aoff = lds_byte(wr * 64 + fr, fq * 8), boff = lds_byte(wc * 32 + fr, fq * 8);
#define PG8_SA(b, h) (((b) * 2 + (h)) * HTB)
#define PG8_SB(b, h) ((4 + (b) * 2 + (h)) * HTB)
#define PG8_STAGE(bufoff, gbase, voff) do { _Pragma("unroll") for (int _i = 0; _i < 2; ++_i) \
        __builtin_amdgcn_global_load_lds((const unsigned*)((const char*)(gbase) + (voff)[_i]), (LAS unsigned*)(lds + (bufoff) + ldsw + _i * 8192), 16, 0, 0); } while (0)
#define PG8_LDA(dst, b, h) do { _Pragma("unroll") for (int m = 0; m < 4; ++m) _Pragma("unroll") for (int k = 0; k < 2; ++k) dst[m][k] = *(const LAS bf16x8*)(lds + PG8_SA(b, h) + aoff + m * 2048 + k * 1024); } while (0)
#define PG8_LDB(dst, b, h) do { _Pragma("unroll") for (int n = 0; n < 2; ++n) _Pragma("unroll") for (int k = 0; k < 2; ++k) dst[n][k] = *(const LAS bf16x8*)(lds + PG8_SB(b, h) + boff + n * 2048 + k * 1024); } while (0)
#define PG8_MMA(ai, bj, At, Bt) do { __builtin_amdgcn_s_setprio(1); _Pragma("unroll") for (int m = 0; m < 4; ++m) _Pragma("unroll") for (int n = 0; n < 2; ++n) _Pragma("unroll") for (int k = 0; k < 2; ++k) \
        acc[ai][bj][m][n] = __builtin_amdgcn_mfma_f32_16x16x32_bf16(Bt[n][k], At[m][k], acc[ai][bj][m][n], 0, 0, 0); __builtin_amdgcn_s_setprio(0); } while (0)
#define PG8_WAIT_V(n) asm volatile("s_waitcnt vmcnt(" #n ")" ::: "memory")
#define PG8_WAIT_L(n) asm volatile("s_waitcnt lgkmcnt(" #n ")" ::: "memory")
#define PG8_BAR __builtin_amdgcn_s_barrier()
#define PG8_SCHED __builtin_amdgcn_sched_barrier(0)
#define PG8_AOFFS(dst, unit) do { _Pragma("unroll") for (int _h = 0; _h < 2; ++_h) _Pragma("unroll") for (int _i = 0; _i < 2; ++_i) { \
        const int _j = (unit).pm * BM + _h * HALF + RA[_i] - g.pst[(unit).e]; const int _src = (_j < g.cnt[(unit).e]) ? g.sparse[(unit).e * 32768 + _j] : NTOK; dst[_h][_i] = (unsigned)(_src * K + CA[_i]) * 2u; } } while (0)
    Unit cur, nxt; int ui = 0;
    if (!S.next(0, cur)) return;
    f32x4 acc[2][2][4][2];
#pragma unroll
    for (int a = 0; a < 2; ++a)
#pragma unroll
        for (int b = 0; b < 2; ++b)
#pragma unroll
            for (int m = 0; m < 4; ++m)
#pragma unroll
                for (int n = 0; n < 2; ++n) acc[a][b][m][n] = (f32x4){0.f, 0.f, 0.f, 0.f};
    bf16x8 At[4][2], B0[2][2], B1[2][2];
    unsigned voffA[2]; unsigned cAo[2][2], nAo[2][2];
#pragma unroll
    for (int i = 0; i < 2; ++i) voffA[i] = (unsigned)(RA[i] * (A_HM ? 64 : K) + CA[i]) * 2u;
    const char* cA = (const char*)g.A;
    if constexpr (GATHER) { PG8_AOFFS(cAo, cur); } else { cA += PG8_ABASE(cur.pm); }
    const char* cB = (const char*)g.Bt + (size_t)cur.e * g.b_estride + (size_t)cur.pn * tstep;
#define PG8_STAGE_A(bufoff, base, h, nx) do { if constexpr (GATHER) { _Pragma("unroll") for (int _i = 0; _i < 2; ++_i) { const unsigned _o = (nx) ? nAo[h][_i] : cAo[h][_i]; \
            __builtin_amdgcn_global_load_lds((const unsigned*)((const char*)(base) + _o), (LAS unsigned*)(lds + (bufoff) + ldsw + _i * 8192), 16, 0, 0); } } \
        else { PG8_STAGE(bufoff, (base) + (h) * ahstep, voffA); } } while (0)
    PG8_STAGE(PG8_SB(0, 0), cB, voffB); PG8_STAGE(PG8_SB(0, 1), cB + hstep, voffB); PG8_STAGE_A(PG8_SA(0, 0), cA, 0, false); PG8_STAGE_A(PG8_SA(0, 1), cA, 1, false);
    if (wr == 1) PG8_BAR;
    PG8_WAIT_V(2); PG8_BAR;
    PG8_STAGE(PG8_SB(1, 0), cB + kstep, voffB); PG8_STAGE_A(PG8_SA(1, 0), cA + akstep, 0, false); PG8_STAGE(PG8_SB(1, 1), cB + hstep + kstep, voffB);
    PG8_WAIT_V(6); PG8_BAR;
    for (;;) {
        const bool has_next = S.next(ui + 1, nxt);
        const char* nA = cA;
        if constexpr (GATHER) { if (has_next) { PG8_AOFFS(nAo, nxt); } else {
#pragma unroll
            for (int h = 0; h < 2; ++h)
#pragma unroll
                for (int i = 0; i < 2; ++i) nAo[h][i] = cAo[h][i]; } }
        else { if (has_next) nA = (const char*)g.A + PG8_ABASE(nxt.pm); }
        const char* nB = has_next ? (const char*)g.Bt + (size_t)nxt.e * g.b_estride + (size_t)nxt.pn * tstep : cB;
        for (int t = 0; t < nt; t += 2) {
            const bool last = (t == nt - 2);
            const char* a1 = cA + (size_t)(t + 1) * akstep;
            const char* a2 = last ? nA : cA + (size_t)(t + 2) * akstep; const char* b2 = last ? nB : cB + (size_t)(t + 2) * kstep;
            const char* a3 = a2 + akstep; const char* b3 = b2 + kstep;
            PG8_LDB(B0, 0, 0); PG8_LDB(B1, 0, 1); PG8_SCHED; PG8_LDA(At, 0, 0); PG8_STAGE_A(PG8_SA(1, 1), a1, 1, false);
            PG8_WAIT_V(8); PG8_WAIT_L(0); PG8_BAR; PG8_MMA(0, 0, At, B0); PG8_MMA(0, 1, At, B1); PG8_BAR; PG8_SCHED;
            PG8_LDA(At, 0, 1); PG8_STAGE(PG8_SB(0, 0), b2, voffB); PG8_STAGE(PG8_SB(0, 1), b2 + hstep, voffB); PG8_STAGE_A(PG8_SA(0, 0), a2, 0, last);
            PG8_WAIT_V(8); PG8_WAIT_L(0); PG8_BAR; PG8_MMA(1, 0, At, B0); PG8_MMA(1, 1, At, B1); PG8_BAR; PG8_SCHED;
            PG8_LDB(B0, 1, 0); PG8_LDB(B1, 1, 1); PG8_SCHED; PG8_LDA(At, 1, 0); PG8_STAGE_A(PG8_SA(0, 1), a2, 1, last);
            PG8_WAIT_V(8); PG8_WAIT_L(0); PG8_BAR; PG8_MMA(0, 0, At, B0); PG8_MMA(0, 1, At, B1); PG8_BAR; PG8_SCHED;
            PG8_LDA(At, 1, 1); PG8_STAGE(PG8_SB(1, 0), b3, voffB); PG8_STAGE(PG8_SB(1, 1), b3 + hstep, voffB); PG8_STAGE_A(PG8_SA(1, 0), a3, 0, last);
            PG8_WAIT_V(8); PG8_WAIT_L(0); PG8_BAR; PG8_MMA(1, 0, At, B0); PG8_MMA(1, 1, At, B1); PG8_BAR; PG8_SCHED;
        }
        if constexpr (ALIGN_EPI) { if (wr == 0) PG8_BAR; }
        E(acc, cur, wr, wc, fr, fq);
        if (!has_next) break;
#pragma unroll
        for (int a = 0; a < 2; ++a)
#pragma unroll
            for (int b = 0; b < 2; ++b)
#pragma unroll
                for (int m = 0; m < 4; ++m)
#pragma unroll
                    for (int n = 0; n < 2; ++n) acc[a][b][m][n] = (f32x4){0.f, 0.f, 0.f, 0.f};
        cur = nxt; cB = nB; cA = nA; ++ui;
        if constexpr (GATHER) {
#pragma unroll
        for (int h = 0; h < 2; ++h)
#pragma unroll
            for (int i = 0; i < 2; ++i) cAo[h][i] = nAo[h][i]; }
        if constexpr (ALIGN_EPI) { if (wr == 1) PG8_BAR; }
    }
    PG8_WAIT_V(0);
    if constexpr (!ALIGN_EPI) { if (wr == 0) PG8_BAR; }
    PG8_BAR;
#undef PG8_SA
#undef PG8_SB
#undef PG8_STAGE
#undef PG8_LDA
#undef PG8_LDB
#undef PG8_MMA
#undef PG8_WAIT_V
#undef PG8_WAIT_L
#undef PG8_BAR
#undef PG8_SCHED
#undef PG8_AOFFS
#undef PG8_STAGE_A
#undef PG8_ABASE
}


struct EpiQKV {
    static constexpr bool PERM = true;
    bf16_t* O; const float* rstd; const float* qg; const float* kg; float qscale;
    __device__ __forceinline__ void operator()(const f32x4 (&acc)[2][2][4][2], const Unit& u, int wr, int wc, int fr, int fq) const {
        const int part = u.pn >> 2, head = 4 * (u.pn & 3) + wc;
        f32x4 gv[2][2];
#pragma unroll
        for (int bj = 0; bj < 2; ++bj)
#pragma unroll
            for (int n = 0; n < 2; ++n) { const int dim = 32 * bj + 8 * fq + 4 * n;
                if (part == 0) gv[bj][n] = *(const f32x4*)(qg + dim) * qscale; else if (part == 1) gv[bj][n] = *(const f32x4*)(kg + dim); else gv[bj][n] = (f32x4){1.f, 1.f, 1.f, 1.f}; }
#pragma unroll
        for (int ai = 0; ai < 2; ++ai)
#pragma unroll
            for (int m = 0; m < 4; ++m) {
                const int row = u.pm * BM + ai * HALF + wr * 64 + m * 16 + fr; const float rs = rstd[row];
                f32x4 v[2][2]; float ss = 0.f;
#pragma unroll
                for (int bj = 0; bj < 2; ++bj)
#pragma unroll
                    for (int n = 0; n < 2; ++n) { v[bj][n] = acc[ai][bj][m][n] * rs; const f32x4 q = v[bj][n] * v[bj][n]; ss += (q[0] + q[1]) + (q[2] + q[3]); }
                float sc = 1.f;
                if (part < 2) { ss += __shfl_xor(ss, 16); ss += __shfl_xor(ss, 32); sc = 1.0f / sqrtf(ss * (1.0f / 64.0f) + EPS); }
                bf16_t* rowp = O + ((size_t)(part * 32 + (row / SEQ) * 16 + head) * SEQ + (row % SEQ)) * 64 + 8 * fq;
#pragma unroll
                for (int bj = 0; bj < 2; ++bj) { const f32x4 v0 = v[bj][0] * gv[bj][0] * sc, v1 = v[bj][1] * gv[bj][1] * sc;
                    u32x4 w; w.x = cvt_pk_bf16(v0[0], v0[1]); w.y = cvt_pk_bf16(v0[2], v0[3]); w.z = cvt_pk_bf16(v1[0], v1[1]); w.w = cvt_pk_bf16(v1[2], v1[3]);
                    *(u32x4*)(rowp + 32 * bj) = w; }
            }
    }
};
struct EpiBf16 {
    static constexpr bool PERM = true;
    bf16_t* O; int ldc; const float* rscale;
    __device__ __forceinline__ void operator()(const f32x4 (&acc)[2][2][4][2], const Unit& u, int wr, int wc, int fr, int fq) const {
        const int col0 = u.pn * BM + wc * 32 + 8 * fq;
#pragma unroll
        for (int ai = 0; ai < 2; ++ai)
#pragma unroll
            for (int m = 0; m < 4; ++m) { const int row = u.pm * BM + ai * HALF + wr * 64 + m * 16 + fr; const float rs = rscale ? rscale[row] : 1.f;
                bf16_t* rowp = O + (size_t)row * ldc + col0;
#pragma unroll
                for (int bj = 0; bj < 2; ++bj) { const f32x4 v0 = acc[ai][bj][m][0] * rs, v1 = acc[ai][bj][m][1] * rs;
                    u32x4 w; w.x = cvt_pk_bf16(v0[0], v0[1]); w.y = cvt_pk_bf16(v0[2], v0[3]); w.z = cvt_pk_bf16(v1[0], v1[1]); w.w = cvt_pk_bf16(v1[2], v1[3]);
                    *(u32x4*)(rowp + bj * HALF) = w; } }
    }
};
struct EpiResid {
    static constexpr bool PERM = false;
    const float* xin; float* out;
    __device__ __forceinline__ void operator()(const f32x4 (&acc)[2][2][4][2], const Unit& u, int wr, int wc, int fr, int fq) const {
        const int col0 = u.pn * BM + wc * 32 + 4 * fq;
#pragma unroll
        for (int ai = 0; ai < 2; ++ai)
#pragma unroll
            for (int m = 0; m < 4; ++m) { const size_t off = (size_t)(u.pm * BM + ai * HALF + wr * 64 + m * 16 + fr) * DM + col0;
#pragma unroll
                for (int bj = 0; bj < 2; ++bj)
#pragma unroll
                    for (int n = 0; n < 2; ++n) { const f32x4 b = *(const f32x4*)(xin + off + bj * HALF + n * 16); *(f32x4*)(out + off + bj * HALF + n * 16) = b + acc[ai][bj][m][n]; } }
    }
};
struct EpiResidB {
    static constexpr bool PERM = true;
    bf16_t* X;
    __device__ __forceinline__ void operator()(const f32x4 (&acc)[2][2][4][2], const Unit& u, int wr, int wc, int fr, int fq) const {
        const int col0 = u.pn * BM + wc * 32 + 8 * fq;
#pragma unroll
        for (int ai = 0; ai < 2; ++ai)
#pragma unroll
            for (int m = 0; m < 4; ++m) { bf16_t* rowp = X + (size_t)(u.pm * BM + ai * HALF + wr * 64 + m * 16 + fr) * DM + col0;
#pragma unroll
                for (int bj = 0; bj < 2; ++bj) { const u32x4 x = *(const u32x4*)(rowp + bj * HALF); const f32x4 a0 = acc[ai][bj][m][0], a1 = acc[ai][bj][m][1];
                    u32x4 w; w.x = cvt_pk_bf16(bflo(x.x) + a0[0], bfhi(x.x) + a0[1]); w.y = cvt_pk_bf16(bflo(x.y) + a0[2], bfhi(x.y) + a0[3]);
                    w.z = cvt_pk_bf16(bflo(x.z) + a1[0], bfhi(x.z) + a1[1]); w.w = cvt_pk_bf16(bflo(x.w) + a1[2], bfhi(x.w) + a1[3]);
                    *(u32x4*)(rowp + bj * HALF) = w; } }
    }
};
struct EpiGU {
    static constexpr bool PERM = true;
    bf16_t* O; const float* rstd; const int* sparse; const LAS int* pst; const LAS int* cnt;
    __device__ __forceinline__ void operator()(const f32x4 (&acc)[2][2][4][2], const Unit& u, int wr, int wc, int fr, int fq) const {
        const int col0 = u.pn * HALF + wc * 32 + 8 * fq;
#pragma unroll
        for (int ai = 0; ai < 2; ++ai)
#pragma unroll
            for (int m = 0; m < 4; ++m) { const int row = u.pm * BM + ai * HALF + wr * 64 + m * 16 + fr; const int jj = row - pst[u.e]; const float rs = (jj < cnt[u.e]) ? rstd[sparse[u.e * 32768 + jj]] : 0.f;
                float o[8];
#pragma unroll
                for (int n = 0; n < 2; ++n)
#pragma unroll
                    for (int i = 0; i < 4; ++i) { const float gg = acc[ai][0][m][n][i] * rs, uu = acc[ai][1][m][n][i] * rs;
                        o[n * 4 + i] = gg * fast_rcp(1.0f + fast_exp2(-gg * LOG2E)) * uu; }
                u32x4 w; w.x = cvt_pk_bf16(o[0], o[1]); w.y = cvt_pk_bf16(o[2], o[3]); w.z = cvt_pk_bf16(o[4], o[5]); w.w = cvt_pk_bf16(o[6], o[7]);
                *(u32x4*)(O + (size_t)row * FFE + col0) = w; }
    }
};
}

struct Frame {
    LAS unsigned char* lds;
    int tid, lane, wave, vcu, G;
};
struct Args { const float* in[20]; float* out; unsigned char* ws; int ph_lo, ph_hi; };
__device__ __forceinline__ Frame make_frame(LAS unsigned char* lds) {
    Frame F; int t = threadIdx.x; asm volatile("" : "+v"(t));
    F.lds = lds; F.tid = t; F.lane = t & 63; F.wave = __builtin_amdgcn_readfirstlane(t >> 6);
    F.G = gridDim.x; { const int bx = blockIdx.x; F.vcu = (F.G % 8 == 0) ? (bx % 8) * (F.G / 8) + bx / 8 : bx; }
    return F;
}

__device__ __forceinline__ bf16x8 ld_frag_lds(const LAS unsigned char* p) { return *(const LAS bf16x8*)p; }
__device__ __forceinline__ bf16x8 mk_frag(unsigned a, unsigned b, unsigned c, unsigned d) { u32x4 w = {a, b, c, d}; return __builtin_bit_cast(bf16x8, w); }
#define MFMA16(a, b, c) __builtin_amdgcn_mfma_f32_16x16x32_bf16(a, b, c, 0, 0, 0)

struct CvtDesc { const float* src; int ldsrc, k0, scol; const float* kscale; bf16_t* dst; int K, drow; };
__device__ __forceinline__ void cvt_load(const CvtDesc& d, int lane, f32x4 (&v)[8]) {
#pragma unroll
    for (int i = 0; i < 8; ++i) v[i] = __builtin_nontemporal_load((const GAS f32x4*)(d.src + (size_t)(d.k0 + 8 * i + (lane >> 3)) * d.ldsrc + d.scol + 4 * (lane & 7)));
}
__device__ __forceinline__ void cvt_finish(const CvtDesc& d, int lane, const f32x4 (&v)[8], LAS float* scr) {
#pragma unroll
    for (int i = 0; i < 8; ++i) { const int kk = 8 * i + (lane >> 3); const float s = d.kscale ? d.kscale[d.k0 + kk] : 1.f; LAS float* p = scr + kk * 33 + 4 * (lane & 7);
        p[0] = v[i][0] * s; p[1] = v[i][1] * s; p[2] = v[i][2] * s; p[3] = v[i][3] * s; }
    LDS_WAIT(); asm volatile("" ::: "memory");
    const int c = lane & 7;
#pragma unroll
    for (int j = 0; j < 4; ++j) { const int n = (lane >> 3) + 8 * j; const LAS float* s = scr + (8 * c) * 33 + n;
        u32x4 o; o.x = cvt_pk_bf16(s[0 * 33], s[1 * 33]); o.y = cvt_pk_bf16(s[2 * 33], s[3 * 33]); o.z = cvt_pk_bf16(s[4 * 33], s[5 * 33]); o.w = cvt_pk_bf16(s[6 * 33], s[7 * 33]);
        __builtin_nontemporal_store(o, (GAS u32x4*)(d.dst + (size_t)(d.drow + n) * d.K + d.k0 + 8 * c)); }
    LDS_WAIT(); asm volatile("" ::: "memory");
}
__device__ __forceinline__ void cvt_item(const float* src, int ldsrc, int k0, int scol, const float* kscale, bf16_t* dst, int K, int drow, LAS float* scr, int lane) {
    const CvtDesc d{src, ldsrc, k0, scol, kscale, dst, K, drow}; f32x4 v[8]; cvt_load(d, lane, v); cvt_finish(d, lane, v, scr);
}
constexpr int MOE_ITEMS = 64 * 16 * 32 + 64 * 8 * 32;
__device__ __forceinline__ CvtDesc cvt_moe_desc(const Args& a, int l, int it) {
    constexpr int I_GU = 64 * 16 * 32;
    unsigned char* ws = a.ws; CvtDesc d;
    if (it < I_GU) { const int e = it / (16 * 32), q = it % (16 * 32), kb = q / 32, nb = q % 32;
        const int pn = nb >> 3, bj = (nb >> 2) & 1, c32 = nb & 3; const int le = l * 64 + e;
        d.src = (bj ? a.in[18] : a.in[17]) + (size_t)le * DM * FFE; d.ldsrc = FFE; d.k0 = kb * 64; d.scol = 128 * pn + 32 * c32; d.kscale = a.in[2] + (size_t)l * DM;
        d.dst = (bf16_t*)(ws + WS_WGU) + (size_t)le * DM * DM; d.K = DM; d.drow = nb * 32; }
    else { const int r = it - I_GU; const int e = r / (8 * 32), q = r % (8 * 32), kb = q / 32, nb = q % 32; const int le = l * 64 + e;
        d.src = a.in[19] + (size_t)le * FFE * DM; d.ldsrc = DM; d.k0 = kb * 64; d.scol = nb * 32; d.kscale = nullptr;
        d.dst = (bf16_t*)(ws + WS_WD) + (size_t)le * DM * FFE; d.K = FFE; d.drow = nb * 32; }
    return d;
}

__device__ __forceinline__ void p0_weights(const Frame& F, const Args& a) {
    LAS float* scr = (LAS float*)(F.lds + F.wave * 16384);
    const int gw = F.vcu * 8 + F.wave, NGW = F.G * 8;
    unsigned char* ws = a.ws;
    constexpr int I_QKV = 2 * 16 * 96, I_O = 2 * 16 * 32, I_IN = 2 * 16 * 96, I_MO = 2 * 16 * 32;
    constexpr int NITEMS = I_QKV + I_O + I_IN + I_MO;
    for (int it = gw; it < NITEMS; it += NGW) {
        int r = it;
        if (r < I_QKV) { const int j = r / (16 * 96), q = r % (16 * 96), kb = q / 96, nb = q % 96;
            const int pn = nb >> 3, bj = (nb >> 2) & 1, wc = nb & 3, part = pn >> 2, head = 4 * (pn & 3) + wc;
            cvt_item(a.in[3] + (size_t)j * DM * 3072, 3072, kb * 64, part * 1024 + head * 64 + 32 * bj, a.in[1] + (size_t)(2 * j) * DM, (bf16_t*)(ws + WS_WQKV) + (size_t)j * 3072 * DM, DM, nb * 32, scr, F.lane); continue; }
        r -= I_QKV;
        if (r < I_O) { const int j = r / (16 * 32), q = r % (16 * 32), kb = q / 32, nb = q % 32;
            cvt_item(a.in[6] + (size_t)j * DM * DM, DM, kb * 64, nb * 32, nullptr, (bf16_t*)(ws + WS_WO) + (size_t)j * DM * DM, DM, nb * 32, scr, F.lane); continue; }
        r -= I_O;
        if (r < I_IN) { const int j = r / (16 * 96), q = r % (16 * 96), kb = q / 96, nb = q % 96;
            cvt_item(a.in[7] + (size_t)j * DM * 3080, 3080, kb * 64, nb * 32, a.in[1] + (size_t)(2 * j + 1) * DM, (bf16_t*)(ws + WS_WIN) + (size_t)j * 3072 * DM, DM, nb * 32, scr, F.lane); continue; }
        r -= I_IN;
        { const int j = r / (16 * 32), q = r % (16 * 32), kb = q / 32, nb = q % 32;
            cvt_item(a.in[12] + (size_t)j * DM * DM, DM, kb * 64, nb * 32, nullptr, (bf16_t*)(ws + WS_WMO) + (size_t)j * DM * DM, DM, nb * 32, scr, F.lane); }
    }
    {
        const int gt = F.vcu * 512 + F.tid, NT = F.G * 512;
        for (int i = gt; i < 4 * 80 * 1024; i += NT) { const int l = i / (80 * 1024), c = (i / 1024) % 80, k = i % 1024;
            float w = 0.f;
            if (c < 8) w = a.in[13][((size_t)l * DM + k) * 8 + c]; else if (c < 72) w = a.in[15][((size_t)l * DM + k) * 64 + (c - 8)];
            w *= a.in[2][l * DM + k];
            const unsigned hi = f2bf(w); const unsigned lo = f2bf(w - bf2f(hi));
            bf16_t* base = (bf16_t*)(ws + WS_WR) + (size_t)l * 2 * 80 * 1024;
            base[c * 1024 + k] = (bf16_t)hi; base[80 * 1024 + c * 1024 + k] = (bf16_t)lo; }
        for (int i = gt; i < 2 * 16 * 1024; i += NT) { const int j = i / (16 * 1024), c = (i / 1024) % 16, k = i % 1024;
            float w = 0.f; if (c < 8) w = a.in[7][((size_t)j * DM + k) * 3080 + 3072 + c] * a.in[1][(2 * j + 1) * DM + k];
            const unsigned hi = f2bf(w); const unsigned lo = f2bf(w - bf2f(hi));
            bf16_t* base = (bf16_t*)(ws + WS_WG) + (size_t)j * 2 * 16 * 1024;
            base[c * 1024 + k] = (bf16_t)hi; base[16 * 1024 + c * 1024 + k] = (bf16_t)lo; }
        if (F.vcu == 0) { for (int i = F.tid; i < DM / 2; i += 512) ((unsigned*)((bf16_t*)(ws + WS_XB) + (size_t)NTOK * DM))[i] = 0u;
            if (F.tid == 0) ((float*)(ws + SM_RSTD))[NTOK] = 0.f; }
    }
}

template <int MODE, int NT, bool WLO = false>
__device__ __forceinline__ void rowpass_wave(const Frame& F, const float* xsrc, float* xdst, bf16_t* xb, float* rstd_out,
                                             const bf16_t* yb, const int* tokp, const float* tokg, const int* toke, const LAS int* pst,
                                             const bf16_t* whi, const bf16_t* wlo, int tok0, f32x4 (&acc)[NT > 0 ? NT : 1], float& rstd_lane) {
    const int lane = F.lane, t = lane & 15, fq = lane >> 4, tok = tok0 + t;
    const float* xr = xsrc + (size_t)tok * DM + 8 * fq;
    bf16_t* xbr = xb + (size_t)tok * DM + 8 * fq;
    const bf16_t *y0 = nullptr, *y1 = nullptr; float g0 = 0.f, g1 = 0.f;
    if (MODE == 2) { const int p0 = pst[toke[2 * tok]] + tokp[2 * tok], p1 = pst[toke[2 * tok + 1]] + tokp[2 * tok + 1]; g0 = tokg[2 * tok]; g1 = tokg[2 * tok + 1];
        y0 = yb + (size_t)p0 * DM + 8 * fq; y1 = yb + (size_t)p1 * DM + 8 * fq; }
    float* xw = (MODE == 2) ? xdst + (size_t)tok * DM + 8 * fq : nullptr;
#pragma unroll
    for (int c = 0; c < (NT > 0 ? NT : 1); ++c) acc[c] = (f32x4){0.f, 0.f, 0.f, 0.f};
    float ss = 0.f;
#pragma unroll 4
    for (int s = 0; s < 32; ++s) {
        f32x4 a0 = __builtin_nontemporal_load((const GAS f32x4*)(xr + 32 * s)), a1 = __builtin_nontemporal_load((const GAS f32x4*)(xr + 32 * s + 4));
        if (MODE == 2) {
            const u32x4 w0 = *(const GAS u32x4*)(y0 + 32 * s), w1 = *(const GAS u32x4*)(y1 + 32 * s);
            a0[0] += g0 * bflo(w0.x) + g1 * bflo(w1.x); a0[1] += g0 * bfhi(w0.x) + g1 * bfhi(w1.x);
            a0[2] += g0 * bflo(w0.y) + g1 * bflo(w1.y); a0[3] += g0 * bfhi(w0.y) + g1 * bfhi(w1.y);
            a1[0] += g0 * bflo(w0.z) + g1 * bflo(w1.z); a1[1] += g0 * bfhi(w0.z) + g1 * bfhi(w1.z);
            a1[2] += g0 * bflo(w0.w) + g1 * bflo(w1.w); a1[3] += g0 * bfhi(w0.w) + g1 * bfhi(w1.w);
            *(GAS f32x4*)(xw + 32 * s) = a0; *(GAS f32x4*)(xw + 32 * s + 4) = a1;
        }
        ss += (a0[0] * a0[0] + a0[1] * a0[1]) + (a0[2] * a0[2] + a0[3] * a0[3]) + (a1[0] * a1[0] + a1[1] * a1[1]) + (a1[2] * a1[2] + a1[3] * a1[3]);
        u32x4 hi; hi.x = cvt_pk_bf16(a0[0], a0[1]); hi.y = cvt_pk_bf16(a0[2], a0[3]); hi.z = cvt_pk_bf16(a1[0], a1[1]); hi.w = cvt_pk_bf16(a1[2], a1[3]);
        *(GAS u32x4*)(xbr + 32 * s) = hi;
        if (NT > 0) {
            u32x4 lo;
            lo.x = cvt_pk_bf16(a0[0] - bflo(hi.x), a0[1] - bfhi(hi.x)); lo.y = cvt_pk_bf16(a0[2] - bflo(hi.y), a0[3] - bfhi(hi.y));
            lo.z = cvt_pk_bf16(a1[0] - bflo(hi.z), a1[1] - bfhi(hi.z)); lo.w = cvt_pk_bf16(a1[2] - bflo(hi.w), a1[3] - bfhi(hi.w));
            const bf16x8 Ah = __builtin_bit_cast(bf16x8, hi), Al = __builtin_bit_cast(bf16x8, lo);
#pragma unroll
            for (int c = 0; c < NT; ++c) {
                const bf16x8 Bh = *(const GAS bf16x8*)(whi + (size_t)(16 * c + t) * DM + 32 * s + 8 * fq);
                acc[c] = MFMA16(Ah, Bh, acc[c]); acc[c] = MFMA16(Al, Bh, acc[c]);
                if (WLO) { const bf16x8 Bl = *(const GAS bf16x8*)(wlo + (size_t)(16 * c + t) * DM + 32 * s + 8 * fq); acc[c] = MFMA16(Ah, Bl, acc[c]); }
            }
        }
    }
    ss += __shfl_xor(ss, 16); ss += __shfl_xor(ss, 32);
    rstd_lane = 1.0f / sqrtf(ss * (1.0f / DM) + EPS);
    if (fq == 0) rstd_out[tok] = rstd_lane;
}

__device__ __forceinline__ void phase_x0(const Frame& F, const Args& a) {
    f32x4 dummy[1]; float rs;
    for (int tb = F.vcu; tb < NTOK / 128; tb += F.G)
        rowpass_wave<0, 0>(F, a.in[0], nullptr, (bf16_t*)(a.ws + WS_XB), (float*)(a.ws + SM_RSTD), nullptr, nullptr, nullptr, nullptr, nullptr, nullptr, nullptr, tb * 128 + F.wave * 16, dummy, rs);
}


constexpr int RT_WB = 73728, RT_WBUF = 21760;
__device__ __forceinline__ void router_pass(const Frame& F, const bf16_t* xb, float* rstd_out, const bf16_t* whi, int tok0, f32x4 (&acc)[5], float& rstd_lane) {
    const int lane = F.lane, t = lane & 15, fq = lane >> 4, tok = tok0 + t;
    const bf16_t* xbr = xb + (size_t)tok * DM + 8 * fq;
    LAS unsigned char* WB = F.lds + RT_WB;
    u32x4 wr[3];
#define RT_LOAD(chunk) do { _Pragma("unroll") for (int i = 0; i < 3; ++i) { const int p = F.tid + 512 * i; if (p < 1280) wr[i] = *(const GAS u32x4*)(whi + (size_t)(p >> 4) * DM + (chunk) * 128 + (p & 15) * 8); } } while (0)
#define RT_STORE(buf) do { _Pragma("unroll") for (int i = 0; i < 3; ++i) { const int p = F.tid + 512 * i; if (p < 1280) *(LAS u32x4*)(WB + (buf) * RT_WBUF + (p >> 4) * 272 + (p & 15) * 16) = wr[i]; } } while (0)
    __syncthreads();
    RT_LOAD(0); RT_STORE(0);
    __syncthreads();
#pragma unroll
    for (int c = 0; c < 5; ++c) acc[c] = (f32x4){0.f, 0.f, 0.f, 0.f};
    float ss = 0.f;
    u32x4 xc[4], xn[4];
#pragma unroll
    for (int s4 = 0; s4 < 4; ++s4) xc[s4] = *(const GAS u32x4*)(xbr + 32 * s4);
    for (int chunk = 0; chunk < 8; ++chunk) {
        if (chunk + 1 < 8) { RT_LOAD(chunk + 1);
#pragma unroll
            for (int s4 = 0; s4 < 4; ++s4) xn[s4] = *(const GAS u32x4*)(xbr + 32 * ((chunk + 1) * 4 + s4)); }
        const LAS unsigned char* wb = WB + (chunk & 1) * RT_WBUF + t * 272 + fq * 16;
#pragma unroll
        for (int s4 = 0; s4 < 4; ++s4) {
            const u32x4 hi = xc[s4];
            { const float x0 = bflo(hi.x), x1 = bfhi(hi.x), x2 = bflo(hi.y), x3 = bfhi(hi.y), x4 = bflo(hi.z), x5 = bfhi(hi.z), x6 = bflo(hi.w), x7 = bfhi(hi.w);
              ss += (x0 * x0 + x1 * x1) + (x2 * x2 + x3 * x3) + (x4 * x4 + x5 * x5) + (x6 * x6 + x7 * x7); }
            const bf16x8 Ah = __builtin_bit_cast(bf16x8, hi);
#pragma unroll
            for (int c = 0; c < 5; ++c) { const bf16x8 Bh = *(const LAS bf16x8*)(wb + c * (16 * 272) + s4 * 64); acc[c] = MFMA16(Ah, Bh, acc[c]); } }
        if (chunk + 1 < 8) { RT_STORE((chunk + 1) & 1);
#pragma unroll
            for (int s4 = 0; s4 < 4; ++s4) xc[s4] = xn[s4]; }
        __syncthreads();
    }
#undef RT_LOAD
#undef RT_STORE
    ss += __shfl_xor(ss, 16); ss += __shfl_xor(ss, 32);
    rstd_lane = 1.0f / sqrtf(ss * (1.0f / DM) + EPS);
    if (fq == 0) rstd_out[tok] = rstd_lane;
}

__device__ __forceinline__ void phase_router(const Frame& F, const Args& a, int l, bool dry = false) {
    unsigned char* ws = a.ws;
    int* sparse = (int*)(ws + WS_QC);
    LAS float* lg = (LAS float*)(F.lds) + F.wave * (16 * 81);
    LAS float* rsl = (LAS float*)(F.lds + 65536) + F.wave * 16;
    LAS int* hist = (LAS int*)(F.lds + 70000);
    LAS int* bbase = (LAS int*)(F.lds + 70000 + 256);
    LAS int* a_e = (LAS int*)(F.lds + 71000);
    LAS int* a_r = (LAS int*)(F.lds + 72100);
    const bf16_t* whi = (const bf16_t*)(ws + WS_WR) + (size_t)l * 2 * 80 * 1024; const bf16_t* wlo = whi + 80 * 1024;
    unsigned* counts = (unsigned*)(ws + WS_CTL) + CW_CNT + l * 64 + (dry ? 4096 : 0);
    int* toke = (int*)(ws + SM_TOKE); float* tokg = (float*)(ws + SM_TOKG); int* tokp = (int*)(ws + SM_TOKP);
    const float* bg = a.in[14] + l * 8; const float* be = a.in[16] + l * 64;
    for (int tb = F.vcu; tb < NTOK / 128; tb += F.G) {
        __syncthreads();
        if (F.tid < 64) hist[F.tid] = 0;
        __syncthreads();
        f32x4 acc[5]; float rs;
        const int tok0 = tb * 128 + F.wave * 16;
        router_pass(F, (const bf16_t*)(ws + WS_XB), (float*)(ws + SM_RSTD), whi, tok0, acc, rs);
        const int t = F.lane & 15, fq = F.lane >> 4;
        if (fq == 0) rsl[t] = rs;
        LDS_WAIT();
#pragma unroll
        for (int c = 0; c < 5; ++c)
#pragma unroll
            for (int i = 0; i < 4; ++i) { const int tt = 4 * fq + i, col = 16 * c + t; const float bias = col < 8 ? bg[col] : (col < 72 ? be[col - 8] : 0.f);
                lg[tt * 81 + col] = acc[c][i] * rsl[tt] + bias; }
        LDS_WAIT();
        if (F.lane < 16) {
            const LAS float* L = lg + F.lane * 81;
            int grp = 0; float gm = L[0];
#pragma unroll
            for (int j = 1; j < 8; ++j) { const float v = L[j]; if (v > gm) { gm = v; grp = j; } }
            float den = 0.f;
#pragma unroll
            for (int j = 0; j < 8; ++j) den += __expf(L[j] - gm);
            const float pg = 1.0f / den;
            const LAS float* E = L + 8 + grp * 8;
            int i1 = 0; float v1 = E[0];
#pragma unroll
            for (int j = 1; j < 8; ++j) { const float v = E[j]; if (v > v1) { v1 = v; i1 = j; } }
            int i2 = (i1 == 0) ? 1 : 0; float v2 = -3.0e38f;
#pragma unroll
            for (int j = 0; j < 8; ++j) { const float v = E[j]; if (j != i1 && v > v2) { v2 = v; i2 = j; } }
            const float e2 = __expf(v2 - v1), s1 = 1.0f / (1.0f + e2);
            const int tok = tok0 + F.lane, e_a = grp * 8 + i1, e_b = grp * 8 + i2;
            toke[2 * tok] = e_a; toke[2 * tok + 1] = e_b; tokg[2 * tok] = pg * s1; tokg[2 * tok + 1] = pg * e2 * s1;
            const int la = (F.wave * 16 + F.lane) * 2;
            a_e[la] = e_a; a_e[la + 1] = e_b;
            a_r[la] = atomicAdd((int*)(hist + e_a), 1); a_r[la + 1] = atomicAdd((int*)(hist + e_b), 1);
        }
        __syncthreads();
        if (F.tid < 64) bbase[F.tid] = (int)atomicAdd(counts + F.tid, (unsigned)hist[F.tid]);
        __syncthreads();
        if (F.tid < 256) { const int tok = tb * 128 + (F.tid >> 1); const int e = a_e[F.tid], idx = bbase[e] + a_r[F.tid]; tokp[2 * tok + (F.tid & 1)] = idx; if (!dry) sparse[e * 32768 + idx] = tok; }
    }
}

__device__ __forceinline__ int moe_tables(const Frame& F, const unsigned* counts, LAS int* pst, LAS int* cnt) {
    __syncthreads();
    if (F.tid < 64) {
        const int c = (int)counts[F.tid]; const int pc = (c + 255) & ~255;
        int incl = pc;
#pragma unroll
        for (int o = 1; o < 64; o <<= 1) { const int t = __shfl_up(incl, o); if (F.lane >= o) incl += t; }
        const int start = incl - pc;
        cnt[F.tid] = c; pst[F.tid] = start; if (F.tid == 63) pst[64] = incl;
        for (int t = start >> 8; t < (incl >> 8); ++t) pst[256 + t] = F.tid;
    }
    __syncthreads();
    return pst[64] >> 8;
}
constexpr int MOE_TAB_OFF = 131072;
struct TokRec { int e0, e1, q0, q1; float g0, g1; };
__device__ __forceinline__ TokRec tok_rec(const int* toke, const int* tokp, const float* tokg, int tok) { TokRec r; r.e0 = toke[2 * tok]; r.e1 = toke[2 * tok + 1]; r.q0 = tokp[2 * tok]; r.q1 = tokp[2 * tok + 1]; r.g0 = tokg[2 * tok]; r.g1 = tokg[2 * tok + 1]; return r; }
template <bool GATES, bool FINAL>
__device__ __forceinline__ void combine_wave(const Frame& F, bf16_t* xb, float* rstd_out, float* fout, const bf16_t* yb, const TokRec tr, const LAS int* pst,
                                             const bf16_t* whi, const bf16_t* wlo, int tok0, f32x4& acc, float& rstd_lane) {
    const int lane = F.lane, t = lane & 15, fq = lane >> 4, tok = tok0 + t;
    bf16_t* xr = xb + (size_t)tok * DM + 8 * fq;
    const int p0 = pst[tr.e0] + tr.q0, p1 = pst[tr.e1] + tr.q1; const float g0 = tr.g0, g1 = tr.g1;
    const bf16_t* y0 = yb + (size_t)p0 * DM + 8 * fq; const bf16_t* y1 = yb + (size_t)p1 * DM + 8 * fq;
    float* fo = FINAL ? fout + (size_t)tok * DM + 8 * fq : nullptr;
    acc = (f32x4){0.f, 0.f, 0.f, 0.f};
    float ss = 0.f;
#pragma unroll 4
    for (int s = 0; s < 32; ++s) {
        const u32x4 x = *(const GAS u32x4*)(xr + 32 * s), w0 = *(const GAS u32x4*)(y0 + 32 * s), w1 = *(const GAS u32x4*)(y1 + 32 * s);
        float v[8];
        v[0] = bflo(x.x) + g0 * bflo(w0.x) + g1 * bflo(w1.x); v[1] = bfhi(x.x) + g0 * bfhi(w0.x) + g1 * bfhi(w1.x);
        v[2] = bflo(x.y) + g0 * bflo(w0.y) + g1 * bflo(w1.y); v[3] = bfhi(x.y) + g0 * bfhi(w0.y) + g1 * bfhi(w1.y);
        v[4] = bflo(x.z) + g0 * bflo(w0.z) + g1 * bflo(w1.z); v[5] = bfhi(x.z) + g0 * bfhi(w0.z) + g1 * bfhi(w1.z);
        v[6] = bflo(x.w) + g0 * bflo(w0.w) + g1 * bflo(w1.w); v[7] = bfhi(x.w) + g0 * bfhi(w0.w) + g1 * bfhi(w1.w);
        if (FINAL) { __builtin_nontemporal_store((f32x4){v[0], v[1], v[2], v[3]}, (GAS f32x4*)(fo + 32 * s)); __builtin_nontemporal_store((f32x4){v[4], v[5], v[6], v[7]}, (GAS f32x4*)(fo + 32 * s + 4)); }
        u32x4 hi; hi.x = cvt_pk_bf16(v[0], v[1]); hi.y = cvt_pk_bf16(v[2], v[3]); hi.z = cvt_pk_bf16(v[4], v[5]); hi.w = cvt_pk_bf16(v[6], v[7]);
        if (!FINAL) *(GAS u32x4*)(xr + 32 * s) = hi;
        { const float r0 = bflo(hi.x), r1 = bfhi(hi.x), r2 = bflo(hi.y), r3 = bfhi(hi.y), r4 = bflo(hi.z), r5 = bfhi(hi.z), r6 = bflo(hi.w), r7 = bfhi(hi.w);
          ss += (r0 * r0 + r1 * r1) + (r2 * r2 + r3 * r3) + (r4 * r4 + r5 * r5) + (r6 * r6 + r7 * r7); }
        if (GATES) { const bf16x8 Ah = __builtin_bit_cast(bf16x8, hi);
            const bf16x8 Bh = *(const GAS bf16x8*)(whi + (size_t)t * DM + 32 * s + 8 * fq), Bl = *(const GAS bf16x8*)(wlo + (size_t)t * DM + 32 * s + 8 * fq);
            acc = MFMA16(Ah, Bh, acc); acc = MFMA16(Ah, Bl, acc); }
    }
    ss += __shfl_xor(ss, 16); ss += __shfl_xor(ss, 32);
    rstd_lane = 1.0f / sqrtf(ss * (1.0f / DM) + EPS);
    if (!FINAL && fq == 0) rstd_out[tok] = rstd_lane;
}
template <bool FINAL>
__device__ __forceinline__ void combine_rows(const Frame& F, bf16_t* xb, float* rstd_out, float* fout, const bf16_t* yb, const int* toke, const int* tokp, const float* tokg, const LAS int* pst, int tok0) {
    const int lane = F.lane;
#pragma unroll 1
    for (int bt = 0; bt < 4; ++bt) {
        u32x4 xv[4][2], y0v[4][2], y1v[4][2]; float g0[4], g1[4];
#pragma unroll
        for (int t4 = 0; t4 < 4; ++t4) { const int tok = __builtin_amdgcn_readfirstlane(tok0 + 4 * bt + t4);
            const int p0 = __builtin_amdgcn_readfirstlane(pst[toke[2 * tok]] + tokp[2 * tok]), p1 = __builtin_amdgcn_readfirstlane(pst[toke[2 * tok + 1]] + tokp[2 * tok + 1]);
            g0[t4] = tokg[2 * tok]; g1[t4] = tokg[2 * tok + 1];
            const bf16_t* xr = xb + (size_t)tok * DM + 8 * lane; const bf16_t* r0 = yb + (size_t)p0 * DM + 8 * lane; const bf16_t* r1 = yb + (size_t)p1 * DM + 8 * lane;
#pragma unroll
            for (int j = 0; j < 2; ++j) { xv[t4][j] = *(const GAS u32x4*)(xr + 512 * j); y0v[t4][j] = *(const GAS u32x4*)(r0 + 512 * j); y1v[t4][j] = *(const GAS u32x4*)(r1 + 512 * j); } }
#pragma unroll
        for (int t4 = 0; t4 < 4; ++t4) { const int tok = tok0 + 4 * bt + t4; float ss = 0.f;
#pragma unroll
            for (int j = 0; j < 2; ++j) { const u32x4 x = xv[t4][j], w0 = y0v[t4][j], w1 = y1v[t4][j]; const float a0 = g0[t4], a1 = g1[t4];
                float v[8];
                v[0] = bflo(x.x) + a0 * bflo(w0.x) + a1 * bflo(w1.x); v[1] = bfhi(x.x) + a0 * bfhi(w0.x) + a1 * bfhi(w1.x);
                v[2] = bflo(x.y) + a0 * bflo(w0.y) + a1 * bflo(w1.y); v[3] = bfhi(x.y) + a0 * bfhi(w0.y) + a1 * bfhi(w1.y);
                v[4] = bflo(x.z) + a0 * bflo(w0.z) + a1 * bflo(w1.z); v[5] = bfhi(x.z) + a0 * bfhi(w0.z) + a1 * bfhi(w1.z);
                v[6] = bflo(x.w) + a0 * bflo(w0.w) + a1 * bflo(w1.w); v[7] = bfhi(x.w) + a0 * bfhi(w0.w) + a1 * bfhi(w1.w);
                if (FINAL) { float* fo = fout + (size_t)tok * DM + 512 * j + 8 * lane;
                    __builtin_nontemporal_store((f32x4){v[0], v[1], v[2], v[3]}, (GAS f32x4*)fo); __builtin_nontemporal_store((f32x4){v[4], v[5], v[6], v[7]}, (GAS f32x4*)(fo + 4)); }
                else { u32x4 hi; hi.x = cvt_pk_bf16(v[0], v[1]); hi.y = cvt_pk_bf16(v[2], v[3]); hi.z = cvt_pk_bf16(v[4], v[5]); hi.w = cvt_pk_bf16(v[6], v[7]);
                    *(GAS u32x4*)(xb + (size_t)tok * DM + 512 * j + 8 * lane) = hi;
                    const float r0 = bflo(hi.x), r1 = bfhi(hi.x), r2 = bflo(hi.y), r3 = bfhi(hi.y), r4 = bflo(hi.z), r5 = bfhi(hi.z), r6 = bflo(hi.w), r7 = bfhi(hi.w);
                    ss += (r0 * r0 + r1 * r1) + (r2 * r2 + r3 * r3) + (r4 * r4 + r5 * r5) + (r6 * r6 + r7 * r7); } }
            if (!FINAL) {
#pragma unroll
                for (int o = 1; o < 64; o <<= 1) ss += __shfl_xor(ss, o);
                if (lane == 0) rstd_out[tok] = 1.0f / sqrtf(ss * (1.0f / DM) + EPS); } }
    }
}
__device__ __forceinline__ void combine_rows_gates(const Frame& F, bf16_t* xb, float* rstd_out, float* gout, const bf16_t* yb, const int* toke, const int* tokp, const float* tokg, const LAS int* pst, int tok0,
                                                   const float* win  , const float* gain  ) {
    const int lane = F.lane;
    float wg[2][8][8];
#pragma unroll
    for (int j = 0; j < 2; ++j)
#pragma unroll
        for (int i = 0; i < 8; ++i) { const int k = 512 * j + 8 * lane + i; const float gk = gain[k]; const f32x4 a = *(const GAS f32x4*)(win + (size_t)k * 3080 + 3072), b = *(const GAS f32x4*)(win + (size_t)k * 3080 + 3076);
            wg[j][i][0] = a[0] * gk; wg[j][i][1] = a[1] * gk; wg[j][i][2] = a[2] * gk; wg[j][i][3] = a[3] * gk; wg[j][i][4] = b[0] * gk; wg[j][i][5] = b[1] * gk; wg[j][i][6] = b[2] * gk; wg[j][i][7] = b[3] * gk; }
#pragma unroll 1
    for (int bt = 0; bt < 8; ++bt) {
        u32x4 xv[2][2], y0v[2][2], y1v[2][2]; float g0[2], g1[2];
#pragma unroll
        for (int t2 = 0; t2 < 2; ++t2) { const int tok = __builtin_amdgcn_readfirstlane(tok0 + 2 * bt + t2);
            const int p0 = __builtin_amdgcn_readfirstlane(pst[toke[2 * tok]] + tokp[2 * tok]), p1 = __builtin_amdgcn_readfirstlane(pst[toke[2 * tok + 1]] + tokp[2 * tok + 1]);
            g0[t2] = tokg[2 * tok]; g1[t2] = tokg[2 * tok + 1];
            const bf16_t* xr = xb + (size_t)tok * DM + 8 * lane; const bf16_t* r0 = yb + (size_t)p0 * DM + 8 * lane; const bf16_t* r1 = yb + (size_t)p1 * DM + 8 * lane;
#pragma unroll
            for (int j = 0; j < 2; ++j) { xv[t2][j] = *(const GAS u32x4*)(xr + 512 * j); y0v[t2][j] = *(const GAS u32x4*)(r0 + 512 * j); y1v[t2][j] = *(const GAS u32x4*)(r1 + 512 * j); } }
#pragma unroll
        for (int t2 = 0; t2 < 2; ++t2) { const int tok = tok0 + 2 * bt + t2; float ss = 0.f, gs[8];
#pragma unroll
            for (int c = 0; c < 8; ++c) gs[c] = 0.f;
#pragma unroll
            for (int j = 0; j < 2; ++j) { const u32x4 x = xv[t2][j], w0 = y0v[t2][j], w1 = y1v[t2][j]; const float a0 = g0[t2], a1 = g1[t2];
                float v[8];
                v[0] = bflo(x.x) + a0 * bflo(w0.x) + a1 * bflo(w1.x); v[1] = bfhi(x.x) + a0 * bfhi(w0.x) + a1 * bfhi(w1.x);
                v[2] = bflo(x.y) + a0 * bflo(w0.y) + a1 * bflo(w1.y); v[3] = bfhi(x.y) + a0 * bfhi(w0.y) + a1 * bfhi(w1.y);
                v[4] = bflo(x.z) + a0 * bflo(w0.z) + a1 * bflo(w1.z); v[5] = bfhi(x.z) + a0 * bfhi(w0.z) + a1 * bfhi(w1.z);
                v[6] = bflo(x.w) + a0 * bflo(w0.w) + a1 * bflo(w1.w); v[7] = bfhi(x.w) + a0 * bfhi(w0.w) + a1 * bfhi(w1.w);
                u32x4 hi; hi.x = cvt_pk_bf16(v[0], v[1]); hi.y = cvt_pk_bf16(v[2], v[3]); hi.z = cvt_pk_bf16(v[4], v[5]); hi.w = cvt_pk_bf16(v[6], v[7]);
                *(GAS u32x4*)(xb + (size_t)tok * DM + 512 * j + 8 * lane) = hi;
                const float r[8] = {bflo(hi.x), bfhi(hi.x), bflo(hi.y), bfhi(hi.y), bflo(hi.z), bfhi(hi.z), bflo(hi.w), bfhi(hi.w)};
#pragma unroll
                for (int i = 0; i < 8; ++i) { ss += r[i] * r[i];
#pragma unroll
                    for (int c = 0; c < 8; ++c) gs[c] += r[i] * wg[j][i][c]; } }
#pragma unroll
            for (int o = 1; o < 64; o <<= 1) { ss += __shfl_xor(ss, o);
#pragma unroll
                for (int c = 0; c < 8; ++c) gs[c] += __shfl_xor(gs[c], o); }
            const float rs = 1.0f / sqrtf(ss * (1.0f / DM) + EPS);
            if (lane == 0) rstd_out[tok] = rs;
            if (lane < 8) { float gv = gs[0];
#pragma unroll
                for (int c = 1; c < 8; ++c) gv = (lane == c) ? gs[c] : gv;
                gout[(size_t)tok * 8 + lane] = gv * rs; } }
    }
}
__device__ __forceinline__ void phase_combine(const Frame& F, const Args& a, int l) {
    unsigned char* ws = a.ws;
    const bool gates = (l + 1 < NLAYER) && ((l + 1) & 1);
    const int j = (l + 1) >> 1;
    const bf16_t* whi = (const bf16_t*)(ws + WS_WG) + (size_t)j * 2 * 16 * 1024; const bf16_t* wlo = whi + 16 * 1024;
    float* gout = (float*)(ws + SM_GATES);
    LAS float* rsl = (LAS float*)(F.lds) + F.wave * 16;
    LAS int* pst = (LAS int*)(F.lds + MOE_TAB_OFF); LAS int* cnt = (LAS int*)(F.lds + MOE_TAB_OFF + 512);
    const int* tokp = (const int*)(ws + SM_TOKP); const float* tokg = (const float*)(ws + SM_TOKG); const int* toke = (const int*)(ws + SM_TOKE);
    TokRec tr = tok_rec(toke, tokp, tokg, F.vcu * 128 + F.wave * 16 + (F.lane & 15));
    (void)moe_tables(F, (const unsigned*)(ws + WS_CTL) + CW_CNT + l * 64, pst, cnt);
    bf16_t* xb = (bf16_t*)(ws + WS_XB); float* rstd = (float*)(ws + SM_RSTD); const bf16_t* yb = (const bf16_t*)(ws + WS_YB);
    for (int tb = F.vcu; tb < NTOK / 128; tb += F.G) {
        f32x4 acc; float rs; const int tok0 = tb * 128 + F.wave * 16;
        if (tb != F.vcu) tr = tok_rec(toke, tokp, tokg, tok0 + (F.lane & 15));
        if (l + 1 == NLAYER) combine_rows<true>(F, xb, rstd, a.out, yb, toke, tokp, tokg, pst, tok0);
        else if (gates) { combine_rows_gates(F, xb, rstd, gout, yb, toke, tokp, tokg, pst, tok0, a.in[7] + (size_t)j * DM * 3080, a.in[1] + (size_t)(2 * j + 1) * DM);
        } else combine_rows<false>(F, xb, rstd, nullptr, yb, toke, tokp, tokg, pst, tok0);
    }
}

constexpr int ATT_KB = 0, ATT_VT = 36864;
struct AttnRegs { u32x4 k[2]; u32x4 v0, v1; bf16x8 q0, q1; };
struct AttnStep { int d, b, h, r, blk; bool prime; };
__device__ __forceinline__ void attn_fetch(const Frame& F, const bf16_t* QKV, const AttnStep& u, AttnRegs& R) {
    const int tid = F.tid, fr = F.lane & 15, fq = F.lane >> 4; const bool valid = u.blk >= 0; const int s0 = u.blk * 128;
#pragma unroll
    for (int i = 0; i < 2; ++i) { const int id = tid + 512 * i, row = id >> 3, ch = id & 7;
        R.k[i] = (u32x4){0u, 0u, 0u, 0u};
        if (valid) R.k[i] = *(const GAS u32x4*)(QKV + ((size_t)(32 + u.b * 16 + u.h) * SEQ + (s0 + row) * u.d + u.r) * 64 + 8 * ch); }
    { const int pair = tid >> 3, ch = tid & 7;
        R.v0 = (u32x4){0u, 0u, 0u, 0u}; R.v1 = (u32x4){0u, 0u, 0u, 0u};
        if (valid) { const bf16_t* p = QKV + ((size_t)(64 + u.b * 16 + u.h) * SEQ + (s0 + 2 * pair) * u.d + u.r) * 64 + 8 * ch; R.v0 = *(const GAS u32x4*)p; R.v1 = *(const GAS u32x4*)(p + (size_t)u.d * 64); } }
    if (!u.prime) { const size_t qrow = (size_t)(u.b * 16 + u.h) * SEQ + (s0 + 16 * F.wave + fr) * u.d + u.r;
        R.q0 = *(const GAS bf16x8*)(QKV + qrow * 64 + 8 * fq); R.q1 = *(const GAS bf16x8*)(QKV + qrow * 64 + 32 + 8 * fq); }
}
__device__ __forceinline__ void attn_stage(const Frame& F, const AttnRegs& R, int slot) {
    LAS unsigned char* Kb = F.lds + ATT_KB; LAS unsigned* VT = (LAS unsigned*)(F.lds + ATT_VT);
#pragma unroll
    for (int i = 0; i < 2; ++i) { const int id = F.tid + 512 * i, row = id >> 3, ch = id & 7; *(LAS u32x4*)(Kb + (slot * 128 + row) * 144 + ch * 16) = R.k[i]; }
    { const int pair = F.tid >> 3, ch = F.tid & 7; const u32x4 v0 = R.v0, v1 = R.v1;
        LAS unsigned* o = VT + (8 * ch) * 129 + slot * 64 + pair;
        o[0 * 129] = (v0.x & 0xffffu) | (v1.x << 16); o[1 * 129] = (v0.x >> 16) | (v1.x & 0xffff0000u);
        o[2 * 129] = (v0.y & 0xffffu) | (v1.y << 16); o[3 * 129] = (v0.y >> 16) | (v1.y & 0xffff0000u);
        o[4 * 129] = (v0.z & 0xffffu) | (v1.z << 16); o[5 * 129] = (v0.z >> 16) | (v1.z & 0xffff0000u);
        o[6 * 129] = (v0.w & 0xffffu) | (v1.w << 16); o[7 * 129] = (v0.w >> 16) | (v1.w & 0xffff0000u); }
}
template <int MODE, bool FIRST>
__device__ __forceinline__ void attn_compute(const Frame& F, const AttnStep& u, const int par, const bf16x8 Q0, const bf16x8 Q1, float off2, bf16_t* part_out, float* l_out, bf16_t* OB, const bf16_t* PP1, const bf16_t* PP2, const float* PL1, const float* PL2) {
    const int lane = F.lane, w = F.wave, fr = lane & 15, fq = lane >> 4;
    const int si0 = u.blk * 128;
    const LAS unsigned char* Kb = F.lds + ATT_KB; const LAS unsigned* VT = (const LAS unsigned*)(F.lds + ATT_VT);
    const int iq = 16 * w + fr; const size_t qrow = (size_t)(u.b * SEQ + (si0 + iq) * u.d + u.r), hrow = (size_t)(u.b * 16 + u.h) * SEQ + (si0 + iq) * u.d + u.r;
    f32x4 O[4];
#pragma unroll
    for (int dt = 0; dt < 4; ++dt) O[dt] = (f32x4){0.f, 0.f, 0.f, 0.f};
    float lsum = 0.f;
#pragma unroll
    for (int up = 0; up < 5; ++up) {
        unsigned pk[4];
#pragma unroll
        for (int hh = 0; hh < 2; ++hh) {
            const int tt = 2 * up + hh;
            if (tt < 9) {
                const int kt = w + tt;
                const int prow = ((kt < 8) ? (par ^ 1) : par) * 128 + 16 * (kt & 7);
                const LAS unsigned char* kp = Kb + (prow + fr) * 144 + fq * 16;
                f32x4 s = (f32x4){0.f, 0.f, 0.f, 0.f};
                s = MFMA16(ld_frag_lds(kp), Q0, s); s = MFMA16(ld_frag_lds(kp + 64), Q1, s);
                float p[4];
                if (FIRST || tt == 0 || tt == 8) {
#pragma unroll
                    for (int i = 0; i < 4; ++i) { const int jk = 16 * kt + 4 * fq + i; const bool ok = (jk >= iq) && (jk <= iq + 128) && (!FIRST || jk >= 128);
                        p[i] = ok ? fast_exp2(s[i] - off2) : 0.f; }
                } else {
#pragma unroll
                    for (int i = 0; i < 4; ++i) p[i] = fast_exp2(s[i] - off2);
                }
                lsum += (p[0] + p[1]) + (p[2] + p[3]);
                pk[2 * hh] = cvt_pk_bf16(p[0], p[1]); pk[2 * hh + 1] = cvt_pk_bf16(p[2], p[3]);
            } else { pk[2 * hh] = 0u; pk[2 * hh + 1] = 0u; }
        }
        const bf16x8 Pf = mk_frag(pk[0], pk[1], pk[2], pk[3]);
        const int kt0 = w + 2 * up, kt1 = (2 * up + 1 < 9) ? kt0 + 1 : kt0;
        const int pb0 = ((kt0 < 8) ? (par ^ 1) : par) * 64 + 8 * (kt0 & 7), pb1 = ((kt1 < 8) ? (par ^ 1) : par) * 64 + 8 * (kt1 & 7);
#pragma unroll
        for (int dt = 0; dt < 4; ++dt) { const LAS unsigned* vp = VT + (16 * dt + fr) * 129 + 2 * fq;
            const bf16x8 V = mk_frag(vp[pb0], vp[pb0 + 1], vp[pb1], vp[pb1 + 1]);
            O[dt] = MFMA16(V, Pf, O[dt]); }
    }
    lsum += __shfl_xor(lsum, 16); lsum += __shfl_xor(lsum, 32);
    if (MODE == 0) {
        bf16_t* o = part_out + hrow * 64 + 4 * fq;
#pragma unroll
        for (int dt = 0; dt < 4; ++dt) { u32x2 wv; wv.x = cvt_pk_bf16(O[dt][0], O[dt][1]); wv.y = cvt_pk_bf16(O[dt][2], O[dt][3]); *(GAS u32x2*)(o + 16 * dt) = wv; }
        if (fq == 0) l_out[hrow] = lsum;
    } else {
        const float inv = 1.0f / (lsum + PL1[hrow] + PL2[hrow]);
        bf16_t* o = OB + hrow * 64 + 4 * fq;
#pragma unroll
        for (int dt = 0; dt < 4; ++dt) { const u32x2 x1 = *(const GAS u32x2*)(PP1 + hrow * 64 + 4 * fq + 16 * dt), x2 = *(const GAS u32x2*)(PP2 + hrow * 64 + 4 * fq + 16 * dt);
            const float o0 = (O[dt][0] + bflo(x1.x) + bflo(x2.x)) * inv, o1 = (O[dt][1] + bfhi(x1.x) + bfhi(x2.x)) * inv;
            const float o2 = (O[dt][2] + bflo(x1.y) + bflo(x2.y)) * inv, o3 = (O[dt][3] + bfhi(x1.y) + bfhi(x2.y)) * inv;
            u32x2 wv; wv.x = cvt_pk_bf16(o0, o1); wv.y = cvt_pk_bf16(o2, o3); *(GAS u32x2*)(o + 16 * dt) = wv; }
    }
}
__device__ __forceinline__ float attn_off2(const float* qg, const float* kg) {
    const int i = threadIdx.x & 63; float mx = fabsf(qg[i] * kg[i]);
#pragma unroll
    for (int o = 1; o < 64; o <<= 1) mx = fmaxf(mx, __shfl_xor(mx, o));
    return 8.0f * mx * LOG2E * 1.02f;
}
template <int MODE>
__device__ __forceinline__ AttnStep attn_step(int s, int vcu, int& br) {
    const int xcd = vcu >> 5, jb = vcu & 31; AttnStep u; int bhl, nblk0, o;
    if (MODE == 0) {
        if (s < 18) { const int ci = 2 * jb + (s >= 9 ? 1 : 0); o = s >= 9 ? s - 9 : s; u.d = 16; bhl = ci >> 4; u.r = ci & 15; nblk0 = 0; br = 0; }
        else { o = s - 18; u.d = 4; bhl = jb >> 3; u.r = (jb & 7) >> 1; nblk0 = 16 * (jb & 1); br = 1; }
    } else { o = s; u.d = 1; bhl = jb >> 3; u.r = 0; nblk0 = 16 * (jb & 7); br = 0; }
    const int bh = xcd + 8 * bhl; u.b = bh >> 4; u.h = bh & 15; u.blk = nblk0 + o - 1; u.prime = (o == 0);
    return u;
}
template <int MODE>
__device__ __forceinline__ void phase_attn(const Frame& F, const Args& a, int j) {
    unsigned char* ws = a.ws; const bf16_t* QKV = (const bf16_t*)(ws + WS_QKV);
    const float off2 = attn_off2(a.in[4] + j * 64, a.in[5] + j * 64);
    constexpr int NSTEP = (MODE == 0) ? 35 : 17;
    if (F.G != 256) return;
    AttnRegs R; R.q0 = (bf16x8){0, 0, 0, 0, 0, 0, 0, 0}; R.q1 = R.q0; int br = 0, ucount = 0;
    AttnStep st = attn_step<MODE>(0, F.vcu, br);
    attn_fetch(F, QKV, st, R);
    const bf16_t* P1 = (const bf16_t*)(ws + WS_P1); const bf16_t* P2 = (const bf16_t*)(ws + WS_P2); const float* L1 = (const float*)(ws + SM_L1); const float* L2 = (const float*)(ws + SM_L2);
    for (int s = 0; s < NSTEP; ++s) {
        __syncthreads();
        attn_stage(F, R, s & 1);
        const bf16x8 Q0 = R.q0, Q1 = R.q1;
        const AttnStep cur = st; const int cbr = br;
        if (s + 1 < NSTEP) { st = attn_step<MODE>(s + 1, F.vcu, br); attn_fetch(F, QKV, st, R); }
        __syncthreads();
        if (cur.prime) continue;
        const int slot = (MODE == 0 ? 0 : 32) + ucount; ++ucount; const int cl = 2 * j + (slot >= 24 ? 1 : 0); const int cit = (F.vcu * 8 + F.wave) + 2048 * (slot % 24);
        const bool do_cvt = (slot < 48) && (cit < MOE_ITEMS);
        CvtDesc cd = cvt_moe_desc(a, cl, do_cvt ? cit : 0); f32x4 cv[8];
        if (do_cvt) cvt_load(cd, F.lane, cv);
        if (cur.blk == 0) attn_compute<MODE, true>(F, cur, s & 1, Q0, Q1, off2, (bf16_t*)(ws + (cbr == 0 ? WS_P1 : WS_P2)), (float*)(ws + (cbr == 0 ? SM_L1 : SM_L2)), (bf16_t*)(ws + WS_OB), P1, P2, L1, L2);
        else attn_compute<MODE, false>(F, cur, s & 1, Q0, Q1, off2, (bf16_t*)(ws + (cbr == 0 ? WS_P1 : WS_P2)), (float*)(ws + (cbr == 0 ? SM_L1 : SM_L2)), (bf16_t*)(ws + WS_OB), P1, P2, L1, L2);
        if (do_cvt) cvt_finish(cd, F.lane, cv, (LAS float*)(F.lds + 71680 + F.wave * 8448));
    }
}
__device__ __forceinline__ void phase_attn_a(const Frame& F, const Args& a, int j) { phase_attn<0>(F, a, j); }
__device__ __forceinline__ void phase_attn_b(const Frame& F, const Args& a, int j) { phase_attn<1>(F, a, j); }

__device__ __forceinline__ float log_sigmoid(float x) { return fminf(x, 0.f) - __logf(1.0f + __expf(-fabsf(x))); }
__device__ __forceinline__ float wave_incl_scan_add(float v, int lane) {
#pragma unroll
    for (int o = 1; o < 64; o <<= 1) { const float t = __shfl_up(v, o); if (lane >= o) v += t; }
    return v;
}
__device__ __forceinline__ float wave_incl_scan_max(float v, int lane) {
#pragma unroll
    for (int o = 1; o < 64; o <<= 1) { const float t = __shfl_up(v, o); if (lane >= o) v = fmaxf(v, t); }
    return v;
}
__device__ __forceinline__ float wave_max(float v) {
#pragma unroll
    for (int o = 1; o < 64; o <<= 1) v = fmaxf(v, __shfl_xor(v, o));
    return v;
}
constexpr int B2_KWT = 0, B2_VT = 18432, B2_WS = 52224, B2_RAW = 56320, B2_OUT = 91904;
__device__ __forceinline__ int vt_col(int dv, int pair) { return (pair + (dv >> 5)) & 31; }
__device__ __forceinline__ void mlstm_fetch_v(const Frame& F, const bf16_t* QKV, int n0, int h, u32x4 (&v0)[2], u32x4 (&v1)[2]) {
#pragma unroll
    for (int i = 0; i < 2; ++i) { const int id = F.tid + 512 * i, ch = id & 31, pair = id >> 5;
        const bf16_t* p = QKV + (size_t)(n0 + 2 * pair) * 3072 + 1024 + h * 256 + 8 * ch;
        v0[i] = *(const GAS u32x4*)p; v1[i] = *(const GAS u32x4*)(p + 3072); }
}
__device__ __forceinline__ void mlstm_write_vT(const Frame& F, const u32x4 (&v0a)[2], const u32x4 (&v1a)[2], LAS unsigned* VT) {
#pragma unroll
    for (int i = 0; i < 2; ++i) { const int id = F.tid + 512 * i, ch = id & 31, pair = id >> 5; const u32x4 v0 = v0a[i], v1 = v1a[i];
        LAS unsigned* o = VT + (8 * ch) * 33 + ((pair + (ch >> 2)) & 31);
        o[0 * 33] = (v0.x & 0xffffu) | (v1.x << 16); o[1 * 33] = (v0.x >> 16) | (v1.x & 0xffff0000u);
        o[2 * 33] = (v0.y & 0xffffu) | (v1.y << 16); o[3 * 33] = (v0.y >> 16) | (v1.y & 0xffff0000u);
        o[4 * 33] = (v0.z & 0xffffu) | (v1.z << 16); o[5 * 33] = (v0.z >> 16) | (v1.z & 0xffff0000u);
        o[6 * 33] = (v0.w & 0xffffu) | (v1.w << 16); o[7 * 33] = (v0.w >> 16) | (v1.w & 0xffff0000u); }
}
__device__ __forceinline__ void mlstm_stage_vT(const Frame& F, const bf16_t* QKV, int n0, int h, LAS unsigned* VT) {
    u32x4 v0[2], v1[2]; mlstm_fetch_v(F, QKV, n0, h, v0, v1); mlstm_write_vT(F, v0, v1, VT);
}
__device__ __forceinline__ void phase_mlstm_local(const Frame& F, const Args& a, int j) {
    unsigned char* ws = a.ws; const bf16_t* QKV = (const bf16_t*)(ws + WS_QKV);
    const float* gates = (const float*)(ws + SM_GATES); const float* gb = a.in[10] + j * 8;
    const float* cw = a.in[8] + (size_t)j * 4 * 1024; const float* cb = a.in[9] + j * 1024;
    bf16_t* QC = (bf16_t*)(ws + WS_QC); bf16_t* KC = (bf16_t*)(ws + WS_KC);
    bf16_t* DC = (bf16_t*)(ws + WS_DC); float* DN = (float*)(ws + SM_DN); float* MLOC = (float*)(ws + SM_MLOC); float* BL = (float*)(ws + SM_BL);
    LAS unsigned char* KwT = F.lds + B2_KWT; LAS unsigned* VT = (LAS unsigned*)(F.lds + B2_VT); LAS float* wsm = (LAS float*)(F.lds + B2_WS);
    if (F.vcu >= 256) return;
    const int bh = F.vcu >> 5, sc = F.vcu & 31, b = bh >> 2, h = bh & 3, us = bh * 32 + sc;
    f32x4 Dacc[2][8], an = (f32x4){0.f, 0.f, 0.f, 0.f};
#pragma unroll
    for (int bt = 0; bt < 2; ++bt)
#pragma unroll
        for (int at = 0; at < 8; ++at) Dacc[bt][at] = (f32x4){0.f, 0.f, 0.f, 0.f};
    float mq = -__builtin_inff(), blsum = 0.f;
    LAS float* G2 = (LAS float*)(F.lds + B2_WS + 512);
    { const int w_ = F.wave, lane_ = F.lane; const int n0w = b * SEQ + (sc * 8 + w_) * 64;
        const float ipre = DBGG(gates[(size_t)(n0w + lane_) * 8 + h]) + gb[h]; const float fpre = DBGG(gates[(size_t)(n0w + lane_) * 8 + 4 + h]) + gb[4 + h];
        const float bs = wave_incl_scan_add(log_sigmoid(fpre), lane_); const float bL = __shfl(bs, 63);
        const float gs = bL - bs + ipre; const float ml = wave_max(gs);
        G2[w_ * 64 + lane_] = __expf(gs - ml);
        if (lane_ == 0) { G2[512 + 2 * w_] = bL; G2[512 + 2 * w_ + 1] = ml; } }
    u32x4 Rv0[2], Rv1[2], Rr[5];
    LAS unsigned char* raw = F.lds + B2_RAW;
#define B2_FETCH(FR, c_) do { _Pragma("unroll") for (int i = 0; i < 5; ++i) { const int p = FR.tid + 512 * i, r = p >> 5, hf = (p >> 4) & 1, c16 = p & 15; const int pos = (c_) * 64 - 3 + r; \
            Rr[i] = (u32x4){0u, 0u, 0u, 0u}; if (p < 67 * 32 && pos >= 0) Rr[i] = *(const GAS u32x4*)(QKV + (size_t)(b * SEQ + pos) * 3072 + hf * 512 + h * 128 + 8 * c16); } } while (0)
    B2_FETCH(F, sc * 8); mlstm_fetch_v(F, QKV, b * SEQ + sc * 8 * 64, h, Rv0, Rv1);
    for (int jc = 0; jc < 8; ++jc) {
        const Frame Fi = make_frame(F.lds);
        const int lane = Fi.lane, fr = lane & 15, fq = lane >> 4, w = Fi.wave;
        const int c = sc * 8 + jc, n0 = b * SEQ + c * 64;
        __syncthreads();
        if (Fi.tid < 64) { const int s = Fi.tid; const float bL = G2[512 + 2 * jc], ml = G2[512 + 2 * jc + 1];
            const float mn = fmaxf(bL + mq, ml); const float aa = __expf(bL + mq - mn), bb = __expf(ml - mn);
            wsm[s] = G2[jc * 64 + s] * bb;
            if (s == 0) wsm[64] = aa;
            mq = mn; blsum += bL; }
        mlstm_write_vT(Fi, Rv0, Rv1, VT);
#pragma unroll
        for (int i = 0; i < 5; ++i) { const int p = Fi.tid + 512 * i, r = p >> 5, hf = (p >> 4) & 1, c16 = p & 15; if (p < 67 * 32) *(LAS u32x4*)(raw + r * 528 + hf * 256 + c16 * 16) = Rr[i]; }
        if (jc + 1 < 8) { mlstm_fetch_v(Fi, QKV, b * SEQ + (c + 1) * 64, h, Rv0, Rv1); B2_FETCH(Fi, c + 1); }
        __syncthreads();
#pragma unroll
        for (int i = 0; i < 4; ++i) { const int id = Fi.tid + 512 * i, s = id & 63, ch = (id >> 6) & 15, isk = id >> 10;
            const int col = (isk ? 512 : 0) + h * 128 + 8 * ch;
            float accv[8];
#pragma unroll
            for (int e = 0; e < 8; ++e) accv[e] = cb[col + e];
#pragma unroll
            for (int jj = 0; jj < 4; ++jj) { const u32x4 x = *(const LAS u32x4*)(raw + (s + jj) * 528 + isk * 256 + ch * 16); const float* wj = cw + jj * 1024 + col;
                accv[0] += wj[0] * bflo(x.x); accv[1] += wj[1] * bfhi(x.x); accv[2] += wj[2] * bflo(x.y); accv[3] += wj[3] * bfhi(x.y);
                accv[4] += wj[4] * bflo(x.z); accv[5] += wj[5] * bfhi(x.z); accv[6] += wj[6] * bflo(x.w); accv[7] += wj[7] * bfhi(x.w); }
            const float scq = isk ? 0.08838834764831845f : 1.0f;
#pragma unroll
            for (int e = 0; e < 8; ++e) { const float v = accv[e]; accv[e] = v * fast_rcp(1.0f + __expf(-v)) * scq; }
            u32x4 o; o.x = cvt_pk_bf16(accv[0], accv[1]); o.y = cvt_pk_bf16(accv[2], accv[3]); o.z = cvt_pk_bf16(accv[4], accv[5]); o.w = cvt_pk_bf16(accv[6], accv[7]);
            *(LAS u32x4*)(F.lds + B2_OUT + isk * 17408 + s * 272 + ch * 16) = o;
            if (isk) { const float wv = wsm[s];
#pragma unroll
                for (int e = 0; e < 8; ++e) *(LAS bf16_t*)(KwT + (8 * ch + e) * 144 + 2 * s) = (bf16_t)f2bf(accv[e] * wv); } }
        __syncthreads();
#pragma unroll
        for (int i = 0; i < 4; ++i) { const int id = Fi.tid + 512 * i, c16 = id & 15, s = (id >> 4) & 63, isk = id >> 10;
            *(GAS u32x4*)((isk ? KC : QC) + ((size_t)(b * 4 + h) * SEQ + c * 64 + s) * 128 + 8 * c16) = *(const LAS u32x4*)(F.lds + B2_OUT + isk * 17408 + s * 272 + c16 * 16); }
        const float aa = wsm[64];
        bf16x8 Bv[2][2];
#pragma unroll
        for (int bt = 0; bt < 2; ++bt)
#pragma unroll
            for (int kk = 0; kk < 2; ++kk) { const int dvr = 16 * (2 * w + bt) + fr; const LAS unsigned* vp = VT + dvr * 33; const int p0 = 4 * fq + 16 * kk; Bv[bt][kk] = mk_frag(vp[vt_col(dvr, p0)], vp[vt_col(dvr, p0 + 1)], vp[vt_col(dvr, p0 + 2)], vp[vt_col(dvr, p0 + 3)]); }
        an *= aa;
#pragma unroll
        for (int at = 0; at < 8; ++at) {
            const LAS unsigned char* kp = KwT + (16 * at + fr) * 144 + 16 * fq;
            const bf16x8 A0 = ld_frag_lds(kp), A1 = ld_frag_lds(kp + 64);
#pragma unroll
            for (int bt = 0; bt < 2; ++bt) { f32x4 d = Dacc[bt][at] * aa; d = MFMA16(A0, Bv[bt][0], d); d = MFMA16(A1, Bv[bt][1], d); Dacc[bt][at] = d; }
            if (at == w) {
                const bf16x8 ones = mk_frag(0x3f803f80u, 0x3f803f80u, 0x3f803f80u, 0x3f803f80u);
                an = MFMA16(A0, ones, an); an = MFMA16(A1, ones, an); }
        }
    }
    { const int lane = F.lane, fr = lane & 15, fq = lane >> 4, w = F.wave;
        bf16_t* dcu = DC + (size_t)us * 32768;
#pragma unroll
        for (int bt = 0; bt < 2; ++bt)
#pragma unroll
            for (int at = 0; at < 8; ++at) { const f32x4 d = Dacc[bt][at]; u32x2 wv; wv.x = cvt_pk_bf16(d[0], d[1]); wv.y = cvt_pk_bf16(d[2], d[3]);
                *(GAS u32x2*)(dcu + (size_t)(16 * (2 * w + bt) + fr) * 128 + 16 * at + 4 * fq) = wv; }
        if (fr == 0) *(GAS f32x4*)(DN + (size_t)us * 128 + 16 * w + 4 * fq) = an;
        if (F.tid == 0) { MLOC[us] = mq; BL[us] = blsum; } }
#undef B2_FETCH
}
__device__ __forceinline__ void phase_mlstm_scan(const Frame& F, const Args& a) {
    unsigned char* ws = a.ws;
    if (F.vcu >= 256 || F.tid >= 256) return;
    const int bh = F.vcu >> 5, part = F.vcu & 31; const size_t eoff = (size_t)part * 1024 + F.tid * 4;
    const bf16_t* DC = (const bf16_t*)(ws + WS_DC); bf16_t* CS = (bf16_t*)(ws + WS_CS);
    const float* DN = (const float*)(ws + SM_DN); float* NS = (float*)(ws + SM_NS);
    const float* MLOC = (const float*)(ws + SM_MLOC); const float* BL = (const float*)(ws + SM_BL); float* MPREV = (float*)(ws + SM_MPREV);
    const bool doN = (part == 0) && (F.tid < 128);
    float st[4] = {0.f, 0.f, 0.f, 0.f}, nst = 0.f, m = 0.f;
    u32x2 dcA[8], dcB[8]; float blA[8], mlA[8], dnA[8], blB[8], mlB[8], dnB[8];
#define B3_LOAD(dc, bl, ml, dn, c0) do { _Pragma("unroll") for (int i = 0; i < 8; ++i) { const int u = bh * 32 + (c0) + i; dc[i] = *(const GAS u32x2*)(DC + (size_t)u * 32768 + eoff); bl[i] = BL[u]; ml[i] = MLOC[u]; dn[i] = doN ? DN[(size_t)u * 128 + F.tid] : 0.f; } } while (0)
#define B3_STEP(dc, bl, ml, dn, c0) do { _Pragma("unroll") for (int i = 0; i < 8; ++i) { const int u = bh * 32 + (c0) + i; \
            u32x2 o; o.x = cvt_pk_bf16(st[0], st[1]); o.y = cvt_pk_bf16(st[2], st[3]); \
            *(GAS u32x2*)(CS + (size_t)u * 32768 + eoff) = o; \
            if (doN) NS[(size_t)u * 128 + F.tid] = nst; \
            if (part == 0 && F.tid == 0) MPREV[u] = m; \
            const float mn = fmaxf(bl[i] + m, ml[i]); const float aa = __expf(bl[i] + m - mn), bb = __expf(ml[i] - mn); \
            st[0] = aa * st[0] + bb * bflo(dc[i].x); st[1] = aa * st[1] + bb * bfhi(dc[i].x); st[2] = aa * st[2] + bb * bflo(dc[i].y); st[3] = aa * st[3] + bb * bfhi(dc[i].y); \
            nst = aa * nst + bb * dn[i]; m = mn; } } while (0)
    B3_LOAD(dcA, blA, mlA, dnA, 0);
    for (int c0 = 0; c0 < 32; c0 += 16) {
        B3_LOAD(dcB, blB, mlB, dnB, c0 + 8);
        B3_STEP(dcA, blA, mlA, dnA, c0);
        if (c0 + 16 < 32) B3_LOAD(dcA, blA, mlA, dnA, c0 + 16);
        B3_STEP(dcB, blB, mlB, dnB, c0 + 8);
    }
#undef B3_LOAD
#undef B3_STEP
}
constexpr int B4_QS = 0, B4_KS = 17408, B4_VT = 34816, B4_SS = 68608, B4_SC = 77824, B4_KWT = 86016, B4_G = 104448, B4_OG = 112768;
__device__ __forceinline__ void phase_mlstm_out(const Frame& F, const Args& a, int j) {
    unsigned char* ws = a.ws; const bf16_t* QKV = (const bf16_t*)(ws + WS_QKV);
    const float* gates = (const float*)(ws + SM_GATES); const float* gb = a.in[10] + j * 8; const float* hg = a.in[11] + (size_t)j * 1024;
    const bf16_t* QC = (const bf16_t*)(ws + WS_QC); const bf16_t* KC = (const bf16_t*)(ws + WS_KC);
    const bf16_t* CS = (const bf16_t*)(ws + WS_CS); const float* NS = (const float*)(ws + SM_NS); const float* MPREV = (const float*)(ws + SM_MPREV);
    bf16_t* OB = (bf16_t*)(ws + WS_OB);
    LAS unsigned char* Qs = F.lds + B4_QS; LAS unsigned char* Ks = F.lds + B4_KS; LAS unsigned* VT = (LAS unsigned*)(F.lds + B4_VT); LAS unsigned char* Ss = F.lds + B4_SS; LAS unsigned char* KwT = F.lds + B4_KWT;
    LAS float* us = (LAS float*)(F.lds + B4_SC); LAS float* Ms = us + 64; LAS float* wint = us + 128; LAS float* eneg = us + 192; LAS float* npv = us + 256; LAS float* den = us + 384  ; LAS float* qn = us + 640  ; LAS float* hss = us + 1152  ;
    LAS float* wk = us + 1664  ; LAS float* scal = us + 1728;
    const int lane = F.lane, fr = lane & 15, fq = lane >> 4, w = F.wave;
    if (F.vcu >= 256) return;
    const int bh = F.vcu >> 5, sc = F.vcu & 31, b = bh >> 2, h = bh & 3;
    const int us0 = bh * 32 + sc;
    f32x4 Cst[2][8];
#pragma unroll
    for (int bt = 0; bt < 2; ++bt)
#pragma unroll
        for (int at = 0; at < 8; ++at) { const u32x2 x = *(const GAS u32x2*)(CS + (size_t)us0 * 32768 + (size_t)(16 * (2 * w + bt) + fr) * 128 + 16 * at + 4 * fq);
            Cst[bt][at] = (f32x4){bflo(x.x), bfhi(x.x), bflo(x.y), bfhi(x.y)}; }
    float mcur = MPREV[us0];
    LAS float* G4 = (LAS float*)(F.lds + B4_G);
    { const int n0w = b * SEQ + (sc * 8 + w) * 64;
        const float ipre = DBGG(gates[(size_t)(n0w + lane) * 8 + h]) + gb[h]; const float fpre = DBGG(gates[(size_t)(n0w + lane) * 8 + 4 + h]) + gb[4 + h];
        const float bs = wave_incl_scan_add(log_sigmoid(fpre), lane); const float uu = ipre - bs; const float pm = wave_incl_scan_max(uu, lane);
        const float bL = __shfl(bs, 63); const float gs = bL - bs + ipre; const float ml = wave_max(gs);
        G4[(w * 4 + 0) * 64 + lane] = bs; G4[(w * 4 + 1) * 64 + lane] = uu; G4[(w * 4 + 2) * 64 + lane] = pm; G4[(w * 4 + 3) * 64 + lane] = __expf(gs - ml);
        if (lane == 0) { G4[2048 + 2 * w] = bL; G4[2048 + 2 * w + 1] = ml; } }
    if (F.tid >= 64 && F.tid < 192) npv[F.tid - 64] = NS[(size_t)us0 * 128 + F.tid - 64];
    u32x4 Rqk[4], Rv0[2], Rv1[2], Rog[4];
#define B4_FETCH(FR, c_) do { const int n0_ = b * SEQ + (c_) * 64; \
        _Pragma("unroll") for (int i = 0; i < 4; ++i) { const int id = FR.tid + 512 * i, c32 = id & 31, s = id >> 5; Rog[i] = *(const GAS u32x4*)(QKV + (size_t)(n0_ + s) * 3072 + 2048 + h * 256 + 8 * c32); } \
        _Pragma("unroll") for (int i = 0; i < 4; ++i) { const int id = FR.tid + 512 * i, ch = id & 15, s = (id >> 4) & 63, isk = id >> 10; \
            Rqk[i] = *(const GAS u32x4*)((isk ? KC : QC) + ((size_t)(b * 4 + h) * SEQ + (c_) * 64 + s) * 128 + 8 * ch); } \
        mlstm_fetch_v(FR, QKV, n0_, h, Rv0, Rv1); } while (0)
    B4_FETCH(F, sc * 8);
    for (int jc = 0; jc < 8; ++jc) {
        const Frame Fi = make_frame(F.lds);
        const int lane = Fi.lane, fr = lane & 15, fq = lane >> 4, w = Fi.wave;
        const int c = sc * 8 + jc, n0 = b * SEQ + c * 64;
        __syncthreads();
        if (Fi.tid < 64) { const int s = Fi.tid; const float bs = G4[(jc * 4 + 0) * 64 + s], uu = G4[(jc * 4 + 1) * 64 + s], pm = G4[(jc * 4 + 2) * 64 + s];
            const float mp = mcur; const float M = fmaxf(mp, pm);
            us[s] = uu; Ms[s] = M; wint[s] = __expf(mp - M); eneg[s] = __expf(-(bs + M));
            const float bL = G4[2048 + 2 * jc], ml = G4[2048 + 2 * jc + 1];
            const float mn = fmaxf(bL + mp, ml); const float aa = __expf(bL + mp - mn), bb = __expf(ml - mn);
            wk[s] = G4[(jc * 4 + 3) * 64 + s] * bb;
            if (s == 0) scal[0] = aa;
            mcur = mn; }
#pragma unroll
        for (int i = 0; i < 4; ++i) { const int id = Fi.tid + 512 * i, ch = id & 15, s = (id >> 4) & 63, isk = id >> 10;
            *(LAS u32x4*)((isk ? Ks : Qs) + s * 272 + ch * 16) = Rqk[i]; }
        mlstm_write_vT(Fi, Rv0, Rv1, VT);
#pragma unroll
        for (int i = 0; i < 4; ++i) { const int id = Fi.tid + 512 * i, c32 = id & 31, s = id >> 5; *(LAS u32x4*)(F.lds + B4_OG + s * 528 + c32 * 16) = Rog[i]; }
        if (jc + 1 < 8) B4_FETCH(Fi, c + 1);
        __syncthreads();
        f32x4 hgv[2];
#pragma unroll
        for (int dv = 0; dv < 2; ++dv) hgv[dv] = *(const GAS f32x4*)(hg + h * 256 + 16 * (2 * w + dv) + 4 * fq);
#pragma unroll
        for (int i = 0; i < 2; ++i) { const int id = Fi.tid + 512 * i, s = id & 63, ch = id >> 6; const u32x4 kx = *(const LAS u32x4*)(Ks + s * 272 + ch * 16); const float wv = wk[s];
            LAS unsigned char* o = KwT + (8 * ch) * 144 + 2 * s;
            *(LAS bf16_t*)(o + 0 * 144) = (bf16_t)f2bf(bflo(kx.x) * wv); *(LAS bf16_t*)(o + 1 * 144) = (bf16_t)f2bf(bfhi(kx.x) * wv);
            *(LAS bf16_t*)(o + 2 * 144) = (bf16_t)f2bf(bflo(kx.y) * wv); *(LAS bf16_t*)(o + 3 * 144) = (bf16_t)f2bf(bfhi(kx.y) * wv);
            *(LAS bf16_t*)(o + 4 * 144) = (bf16_t)f2bf(bflo(kx.z) * wv); *(LAS bf16_t*)(o + 5 * 144) = (bf16_t)f2bf(bfhi(kx.z) * wv);
            *(LAS bf16_t*)(o + 6 * 144) = (bf16_t)f2bf(bflo(kx.w) * wv); *(LAS bf16_t*)(o + 7 * 144) = (bf16_t)f2bf(bfhi(kx.w) * wv); }
#pragma unroll
        for (int q2 = 0; q2 < 2; ++q2) { const int idx = 2 * w + q2, st = idx >> 2, tt = idx & 3;
            f32x4 sacc = (f32x4){0.f, 0.f, 0.f, 0.f};
            if (st <= tt) {
#pragma unroll
                for (int kk = 0; kk < 4; ++kk) sacc = MFMA16(ld_frag_lds(Ks + (16 * st + fr) * 272 + 16 * fq + 64 * kk), ld_frag_lds(Qs + (16 * tt + fr) * 272 + 16 * fq + 64 * kk), sacc);
            }
            const int t = 16 * tt + fr; const float Mt = Ms[t]; float p[4], rsum = 0.f;
#pragma unroll
            for (int i = 0; i < 4; ++i) { const int s = 16 * st + 4 * fq + i; p[i] = (s <= t) ? sacc[i] * __expf(us[s] - Mt) : 0.f; rsum += p[i]; }
            u32x2 wv; wv.x = cvt_pk_bf16(p[0], p[1]); wv.y = cvt_pk_bf16(p[2], p[3]);
            *(LAS u32x2*)(Ss + t * 144 + (16 * st + 4 * fq) * 2) = wv;
            rsum += __shfl_xor(rsum, 16); rsum += __shfl_xor(rsum, 32);
            if (fq == 0) den[st * 64 + t] = rsum; }
        { const int t = Fi.tid & 63, pp = Fi.tid >> 6; const LAS bf16_t* qr = (const LAS bf16_t*)(Qs + t * 272) + 16 * pp; float sacc = 0.f;
#pragma unroll
            for (int e = 0; e < 16; ++e) sacc += bf2f(qr[e]) * npv[16 * pp + e];
            qn[pp * 64 + t] = sacc; }
        __syncthreads();
        f32x4 acc[2][4];
#pragma unroll
        for (int dv = 0; dv < 2; ++dv)
#pragma unroll
            for (int tt = 0; tt < 4; ++tt) acc[dv][tt] = (f32x4){0.f, 0.f, 0.f, 0.f};
#pragma unroll
        for (int kk = 0; kk < 4; ++kk) {
            bf16x8 Bq[4];
#pragma unroll
            for (int tt = 0; tt < 4; ++tt) { const LAS unsigned char* qp = Qs + (16 * tt + fr) * 272 + 64 * kk + 8 * fq; const u32x2 lo = *(const LAS u32x2*)qp, hi = *(const LAS u32x2*)(qp + 32); Bq[tt] = mk_frag(lo.x, lo.y, hi.x, hi.y); }
#pragma unroll
            for (int dv = 0; dv < 2; ++dv) { const f32x4 c0 = Cst[dv][2 * kk], c1 = Cst[dv][2 * kk + 1];
                const bf16x8 Ac = mk_frag(cvt_pk_bf16(c0[0], c0[1]), cvt_pk_bf16(c0[2], c0[3]), cvt_pk_bf16(c1[0], c1[1]), cvt_pk_bf16(c1[2], c1[3]));
#pragma unroll
                for (int tt = 0; tt < 4; ++tt) acc[dv][tt] = MFMA16(Ac, Bq[tt], acc[dv][tt]); }
            __builtin_amdgcn_sched_barrier(0);
        }
#pragma unroll
        for (int tt = 0; tt < 4; ++tt) { const float wi = wint[16 * tt + fr];
#pragma unroll
            for (int dv = 0; dv < 2; ++dv) acc[dv][tt] *= wi; }
#pragma unroll
        for (int kk = 0; kk < 2; ++kk) {
            bf16x8 Bs[4], Avk[2];
#pragma unroll
            for (int dv = 0; dv < 2; ++dv) { const int dvr = 16 * (2 * w + dv) + fr; const LAS unsigned* vp = VT + dvr * 33; const int p0 = 4 * fq + 16 * kk; Avk[dv] = mk_frag(vp[vt_col(dvr, p0)], vp[vt_col(dvr, p0 + 1)], vp[vt_col(dvr, p0 + 2)], vp[vt_col(dvr, p0 + 3)]); }
#pragma unroll
            for (int tt = 0; tt < 4; ++tt) Bs[tt] = ld_frag_lds(Ss + (16 * tt + fr) * 144 + 16 * fq + 64 * kk);
#pragma unroll
            for (int dv = 0; dv < 2; ++dv)
#pragma unroll
                for (int tt = 0; tt < 4; ++tt) acc[dv][tt] = MFMA16(Avk[dv], Bs[tt], acc[dv][tt]);
            __builtin_amdgcn_sched_barrier(0);
        }
#pragma unroll
        for (int tt = 0; tt < 4; ++tt) { const int t = 16 * tt + fr; const float qnt = ((qn[t] + qn[64 + t]) + (qn[128 + t] + qn[192 + t])) + ((qn[256 + t] + qn[320 + t]) + (qn[384 + t] + qn[448 + t]));
            const float dn = ((den[t] + den[64 + t]) + (den[128 + t] + den[192 + t])) + wint[t] * qnt; const float inv = 1.0f / fmaxf(fabsf(dn), eneg[t]);
            float q = 0.f;
#pragma unroll
            for (int dv = 0; dv < 2; ++dv) { acc[dv][tt] *= inv; const f32x4 v = acc[dv][tt] * acc[dv][tt]; q += (v[0] + v[1]) + (v[2] + v[3]); }
            q += __shfl_xor(q, 16); q += __shfl_xor(q, 32);
            if (fq == 0) hss[w * 64 + t] = q; }
        __syncthreads();
#pragma unroll
        for (int tt = 0; tt < 4; ++tt) { const int t = 16 * tt + fr; const float hs = ((hss[t] + hss[64 + t]) + (hss[128 + t] + hss[192 + t])) + ((hss[256 + t] + hss[320 + t]) + (hss[384 + t] + hss[448 + t]));
            const float rst = 1.0f / sqrtf(hs * (1.0f / 256.0f) + EPS);
#pragma unroll
            for (int dv = 0; dv < 2; ++dv) { const int col = h * 256 + 16 * (2 * w + dv) + 4 * fq;
                const u32x2 og = *(const LAS u32x2*)(F.lds + B4_OG + t * 528 + (16 * (2 * w + dv) + 4 * fq) * 2); const f32x4 g4 = hgv[dv];
                const float o0 = acc[dv][tt][0] * rst * g4[0] * fast_rcp(1.0f + __expf(-bflo(og.x))), o1 = acc[dv][tt][1] * rst * g4[1] * fast_rcp(1.0f + __expf(-bfhi(og.x)));
                const float o2 = acc[dv][tt][2] * rst * g4[2] * fast_rcp(1.0f + __expf(-bflo(og.y))), o3 = acc[dv][tt][3] * rst * g4[3] * fast_rcp(1.0f + __expf(-bfhi(og.y)));
                u32x2 wv; wv.x = cvt_pk_bf16(o0, o1); wv.y = cvt_pk_bf16(o2, o3);
                *(GAS u32x2*)(OB + (size_t)(n0 + t) * DM + col) = wv; } }
        { const float aa = scal[0];
            bf16x8 Avk[2][2];
#pragma unroll
            for (int kk = 0; kk < 2; ++kk)
#pragma unroll
                for (int dv = 0; dv < 2; ++dv) { const int dvr = 16 * (2 * w + dv) + fr; const LAS unsigned* vp = VT + dvr * 33; const int p0 = 4 * fq + 16 * kk; Avk[kk][dv] = mk_frag(vp[vt_col(dvr, p0)], vp[vt_col(dvr, p0 + 1)], vp[vt_col(dvr, p0 + 2)], vp[vt_col(dvr, p0 + 3)]); }
#pragma unroll
            for (int bt = 0; bt < 2; ++bt)
#pragma unroll
                for (int at = 0; at < 8; ++at) Cst[bt][at] *= aa;
#pragma unroll
            for (int at = 0; at < 8; ++at) { const LAS unsigned char* kp = KwT + (16 * at + fr) * 144 + 16 * fq; const bf16x8 A0 = ld_frag_lds(kp), A1 = ld_frag_lds(kp + 64);
#pragma unroll
                for (int bt = 0; bt < 2; ++bt) { Cst[bt][at] = MFMA16(A0, Avk[0][bt], Cst[bt][at]); Cst[bt][at] = MFMA16(A1, Avk[1][bt], Cst[bt][at]); } }
            if (Fi.tid >= 64 && Fi.tid < 192) { const int dk = Fi.tid - 64; const LAS unsigned char* kr = KwT + dk * 144; float sum = 0.f;
#pragma unroll
                for (int q8 = 0; q8 < 8; ++q8) { const u32x4 x = *(const LAS u32x4*)(kr + 16 * q8); sum += ((bflo(x.x) + bfhi(x.x)) + (bflo(x.y) + bfhi(x.y))) + ((bflo(x.z) + bfhi(x.z)) + (bflo(x.w) + bfhi(x.w))); }
                npv[dk] = aa * npv[dk] + sum; } }
    }
#undef B4_FETCH
}


#ifdef PROBE_BUF
__device__ __forceinline__ void probe_scan(const Frame& F, const Args& a) {
    unsigned* ctl = (unsigned*)(a.ws + WS_CTL);
    unsigned bad = 0; float ms = 0.f;
    for (size_t i = (size_t)F.vcu * 512 + F.tid; i < (size_t)(PROBE_N); i += (size_t)F.G * 512) {
        float v;
        if (PROBE_KIND == 0) v = bf2f(((const bf16_t*)(a.ws + PROBE_BUF))[i]); else v = ((const float*)(a.ws + PROBE_BUF))[i];
        if (fabsf(v) < 1e30f) ms += v * v; else ++bad;
    }
    if (PROBE_STAT == 2) { bad = 0; ms = 0.f;
        for (int u = F.vcu * 8 + F.wave; u < (int)((PROBE_N) / 32768); u += F.G * 8) { unsigned b2 = 0;
            for (int i = F.lane; i < 32768; i += 64) { const float v = bf2f(((const bf16_t*)(a.ws + PROBE_BUF))[(size_t)u * 32768 + i]); if (!(fabsf(v) < 1e30f)) b2 = 1; }
            b2 = __any(b2) ? 1u : 0u; if (F.lane == 0) bad += b2 * 32768u; } }
    atomicAdd(ctl + 20000, bad); atomicAdd((float*)(ctl + 20064), ms);
}
__device__ __forceinline__ void probe_fill(const Frame& F, const Args& a) {
    const unsigned* ctl = (const unsigned*)(a.ws + WS_CTL);
    const float f = (float)ctl[20000] / (float)(PROBE_N), msq = ((const float*)ctl)[20064] / (float)(PROBE_N);
    const float c = sqrtf(PROBE_STAT != 1 ? 10.0f * f : msq);
    for (size_t i = (size_t)F.vcu * 512 + F.tid; i < (size_t)NTOK * DM; i += (size_t)F.G * 512) a.out[i] = c;
}
#endif
constexpr int NPHASE = 1 + NLAYER * 10;

typedef const __attribute__((address_space(4))) Args* KArgsPtr;
__device__ __forceinline__ Args opaque_args() {
#if defined(__HIP_DEVICE_COMPILE__)
    KArgsPtr p = (KArgsPtr)__builtin_amdgcn_kernarg_segment_ptr(); asm volatile("" : "+s"(p)); return *p;
#else
    return Args{};
#endif
}
#define SITE() const Frame FP = make_frame(lds); const Args A = opaque_args(); unsigned char* const ws = A.ws; (void)ws
__global__ void __launch_bounds__(512, 2) mk_fwd(Args args) {
    extern __shared__ __attribute__((aligned(16))) unsigned char lds_raw[];
    LAS unsigned char* const lds = (LAS unsigned char*)lds_raw;
    volatile LAS unsigned* MISC = (volatile LAS unsigned*)(lds + MISC_OFF);
    if (threadIdx.x < 32) MISC[threadIdx.x] = 0u;
    __syncthreads();
    const int lo = args.ph_lo, hi = args.ph_hi;
    XcdBarrier bar; bar.bar = (unsigned*)(args.ws + WS_CTL) + CW_BAR; bar.x = 0; bar.st = nullptr;
    if (hi - lo > 1) bar = xcd_barrier_post((unsigned*)(args.ws + WS_CTL) + CW_BAR, MISC + 8);
#define IN(k) (lo <= (k) && (k) < hi)
#ifdef XBAR_EXTRA
#define SEAM(k) do { if (IN(k) && IN((k) + 1)) { xcd_barrier(bar); xcd_barrier(bar); } } while (0)
#else
#define SEAM(k) do { if (IN(k) && IN((k) + 1)) xcd_barrier(bar); } while (0)
#endif
    if (PHON(0) && IN(0)) for (int rep_ = 0; rep_ < NREP(0); ++rep_) { SITE(); p0_weights(FP, A); phase_x0(FP, A); }
    SEAM(0);
    for (int l = 0; l < NLAYER; ++l) {
        const int pb = 1 + l * 10, j = l >> 1;
        if ((l & 1) == 0) {
            if (PHON(1) && IN(pb)) for (int rep_ = 0; rep_ < NREP(1); ++rep_) { SITE(); pg8::Gemm g{(const bf16_t*)(ws + WS_XB), (const bf16_t*)(ws + WS_WQKV) + (size_t)j * 3072 * DM, DM, 0, nullptr, nullptr, nullptr};
                pg8::StaticOrder S; S.init(NTOK / 256, 12, FP.G, (int)blockIdx.x, nullptr);
                pg8::EpiQKV E{(bf16_t*)(ws + WS_QKV), (const float*)(ws + SM_RSTD), A.in[4] + j * 64, A.in[5] + j * 64, 0.125f * LOG2E};
                pg8::gemm_phase<pg8::EpiQKV, true, false>(lds, FP.tid, g, S, E); }
            SEAM(pb);
            if (PHON(2) && IN(pb + 1)) for (int rep_ = 0; rep_ < NREP(2); ++rep_) { SITE(); phase_attn_a(FP, A, j); }
            SEAM(pb + 1);
            if (PHON(3) && IN(pb + 2)) for (int rep_ = 0; rep_ < NREP(3); ++rep_) { SITE(); phase_attn_b(FP, A, j); }
            if (IN(pb + 2) && IN(pb + 4)) xcd_barrier(bar);
            if (PHON(4) && IN(pb + 4)) { SITE(); pg8::Gemm g{(const bf16_t*)(ws + WS_OB), (const bf16_t*)(ws + WS_WO) + (size_t)j * DM * DM, DM, 0, nullptr, nullptr, nullptr};
                pg8::StaticOrder S; S.init(NTOK / 256, 4, FP.G, (int)blockIdx.x, nullptr);
                pg8::EpiResidB E{(bf16_t*)(ws + WS_XB)};
                pg8::gemm_phase<pg8::EpiResidB, true, false, true>(lds, FP.tid, g, S, E); }
            SEAM(pb + 4);
        } else {
            if (PHON(5) && IN(pb)) for (int rep_ = 0; rep_ < NREP(5); ++rep_) { SITE(); pg8::Gemm g{(const bf16_t*)(ws + WS_XB), (const bf16_t*)(ws + WS_WIN) + (size_t)j * 3072 * DM, DM, 0, nullptr, nullptr, nullptr};
                pg8::StaticOrder S; S.init(NTOK / 256, 12, FP.G, (int)blockIdx.x, nullptr);
                pg8::EpiBf16 E{(bf16_t*)(ws + WS_QKV), 3072, (const float*)(ws + SM_RSTD)};
                pg8::gemm_phase<pg8::EpiBf16, true, false>(lds, FP.tid, g, S, E); }
            SEAM(pb);
            if (PHON(6) && IN(pb + 1)) for (int rep_ = 0; rep_ < NREP(6); ++rep_) { SITE(); phase_mlstm_local(FP, A, j); }
            SEAM(pb + 1);
            if (PHON(7) && IN(pb + 2)) for (int rep_ = 0; rep_ < NREP(7); ++rep_) { SITE(); phase_mlstm_scan(FP, A); }
            SEAM(pb + 2);
            if (PHON(8) && IN(pb + 3)) for (int rep_ = 0; rep_ < NREP(8); ++rep_) { SITE(); phase_mlstm_out(FP, A, j); }
            SEAM(pb + 3);
            if (PHON(9) && IN(pb + 4)) { SITE(); pg8::Gemm g{(const bf16_t*)(ws + WS_OB), (const bf16_t*)(ws + WS_WMO) + (size_t)j * DM * DM, DM, 0, nullptr, nullptr, nullptr};
                pg8::StaticOrder S; S.init(NTOK / 256, 4, FP.G, (int)blockIdx.x, nullptr);
                pg8::EpiResidB E{(bf16_t*)(ws + WS_XB)};
                pg8::gemm_phase<pg8::EpiResidB, true, false>(lds, FP.tid, g, S, E); }
            SEAM(pb + 4);
        }
        if (PHON(10) && IN(pb + 5)) for (int rep_ = 0; rep_ < NREP(10); ++rep_) { SITE(); phase_router(FP, A, l, rep_ + 1 < NREP(10)); }
        if (IN(pb + 5) && IN(pb + 7)) xcd_barrier(bar);
        if (PHON(12) && IN(pb + 7)) for (int rep_ = 0; rep_ < NREP(12); ++rep_) { SITE();
            LAS int* pst = (LAS int*)(lds + MOE_TAB_OFF); LAS int* cnt = (LAS int*)(lds + MOE_TAB_OFF + 512);
            const int ntiles = __builtin_amdgcn_readfirstlane(moe_tables(FP, (const unsigned*)(ws + WS_CTL) + CW_CNT + l * 64, pst, cnt));
            pg8::Gemm g{(const bf16_t*)(ws + WS_XB), (const bf16_t*)(ws + WS_WGU) + (size_t)l * 64 * DM * DM, DM, (size_t)DM * DM * 2, (const int*)(ws + WS_QC), pst, cnt};
            pg8::StaticOrder S; S.init(ntiles, 4, FP.G, (int)blockIdx.x, pst);
            pg8::EpiGU E{(bf16_t*)(ws + WS_ACT), (const float*)(ws + SM_RSTD), (const int*)(ws + WS_QC), pst, cnt};
            pg8::gemm_phase<pg8::EpiGU, true, true>(lds, FP.tid, g, S, E); }
        SEAM(pb + 7);
        if (PHON(13) && IN(pb + 8)) for (int rep_ = 0; rep_ < NREP(13); ++rep_) { SITE();
            LAS int* pst = (LAS int*)(lds + MOE_TAB_OFF); LAS int* cnt = (LAS int*)(lds + MOE_TAB_OFF + 512);
            const int ntiles = __builtin_amdgcn_readfirstlane(moe_tables(FP, (const unsigned*)(ws + WS_CTL) + CW_CNT + l * 64, pst, cnt));
            pg8::Gemm g{(const bf16_t*)(ws + WS_ACT), (const bf16_t*)(ws + WS_WD) + (size_t)l * 64 * DM * FFE, FFE, (size_t)DM * FFE * 2, nullptr, pst, cnt};
            pg8::StaticOrder S; S.init(ntiles, 4, FP.G, (int)blockIdx.x, pst);
            pg8::EpiBf16 E{(bf16_t*)(ws + WS_YB), DM, nullptr};
            pg8::gemm_phase<pg8::EpiBf16, true, false>(lds, FP.tid, g, S, E); }
        SEAM(pb + 8);
        if (PHON(14) && IN(pb + 9)) { SITE(); phase_combine(FP, A, l); }
        SEAM(pb + 9);
    }
#ifdef PROBE_BUF
    if (IN(NPHASE)) { SITE(); probe_scan(FP, A); }
    if (IN(NPHASE + 1)) { SITE(); probe_fill(FP, A); }
#endif
#undef IN
#undef SEAM
}

extern "C" void kernel_launch(void* const* d_in, const int* in_sizes, int n_in, void* d_out, int out_size, void* d_ws, size_t ws_size, hipStream_t stream) {
    static int grid = 0;
    if (grid == 0) {
        if (n_in != 20 || out_size != NTOK * DM || ws_size < WS_END) { fprintf(stderr, "kernel_launch: unexpected shapes (n_in %d, out %d, ws %zu < %zu); nothing launched\n", n_in, out_size, ws_size, (size_t)WS_END); grid = -1; return; }
        int dev = 0, cus = 0, per_cu = 0;
        if (hipGetDevice(&dev) != hipSuccess || hipDeviceGetAttribute(&cus, hipDeviceAttributeMultiprocessorCount, dev) != hipSuccess) { grid = -1; return; }
        if (hipFuncSetAttribute((const void*)mk_fwd, hipFuncAttributeMaxDynamicSharedMemorySize, LDS_BYTES) != hipSuccess) { fprintf(stderr, "kernel_launch: hipFuncSetAttribute failed\n"); grid = -1; return; }
        if (hipOccupancyMaxActiveBlocksPerMultiprocessor(&per_cu, (const void*)mk_fwd, 512, LDS_BYTES) != hipSuccess || per_cu < 1) { fprintf(stderr, "kernel_launch: occupancy query says %d\n", per_cu); }
        (void)hipGetLastError();
        grid = cus;
        if (grid != 256) { fprintf(stderr, "kernel_launch: built for a 256-CU device, found %d CUs; nothing launched\n", cus); grid = -1; return; }
    }
    if (grid < 0) return;
    if (hipMemsetAsync((char*)d_ws + WS_CTL, 0, CTL_ZERO_BYTES, stream) != hipSuccess) return;
    Args a{};
    for (int i = 0; i < 20; ++i) a.in[i] = (const float*)d_in[i];
    a.out = (float*)d_out; a.ws = (unsigned char*)d_ws;
#if MK_ONE_LAUNCH
    a.ph_lo = 0; a.ph_hi = NPHASE;
    hipLaunchKernelGGL(mk_fwd, dim3(grid), dim3(512), LDS_BYTES, stream, a);
#else
    int np = NPHASE;
#ifdef PROBE_BUF
    np += 2;
#endif
    for (int p = 0; p < np; ++p) { a.ph_lo = p; a.ph_hi = p + 1; hipLaunchKernelGGL(mk_fwd, dim3(grid), dim3(512), LDS_BYTES, stream, a); }
#endif
}
```

```cpp
#include <hip/hip_runtime.h>
#include <cstdio>
#include <cstdint>

#ifndef MK_ONE_LAUNCH
#define MK_ONE_LAUNCH 1
#endif

#ifndef PHMASK
#define PHMASK 0xFFFFFFFFu
#endif
#define PHON(n) ((PHMASK >> (n)) & 1u)
#ifndef REPMASK
#define REPMASK 0u
#endif
#define NREP(n) (1 + (int)((REPMASK >> (n)) & 1u))
#ifdef DBG_NOGATES
#define DBGG(x) 0.0f
#else
#define DBGG(x) (x)
#endif

#define LAS __attribute__((address_space(3)))
#define GAS __attribute__((address_space(1)))
typedef unsigned short bf16_t;
typedef short bf16x8 __attribute__((ext_vector_type(8)));
typedef float f32x4 __attribute__((ext_vector_type(4)));
typedef float f32x2 __attribute__((ext_vector_type(2)));
typedef unsigned u32x4 __attribute__((ext_vector_type(4)));
typedef unsigned u32x2 __attribute__((ext_vector_type(2)));

constexpr int NTOK = 32768, SEQ = 16384, DM = 1024, NLAYER = 4;
constexpr int NEXP = 64, FFE = 512;
constexpr int PMAX = 81920;
constexpr float EPS = 1e-6f;
constexpr float LOG2E = 1.4426950408889634f;

constexpr size_t MiB = 1u << 20;
constexpr size_t WS_CTL = 0, CTL_ZERO_BYTES = 1 * MiB;
constexpr size_t WS_WQKV = 2 * MiB, WS_WO = 14 * MiB, WS_WIN = 18 * MiB, WS_WMO = 30 * MiB, WS_WR = 34 * MiB, WS_WG = 36 * MiB;
constexpr size_t WS_SMALL = 37 * MiB;
constexpr size_t SM_RSTD = WS_SMALL, SM_GATES = WS_SMALL + 256 * 1024, SM_TOKE = WS_SMALL + 1280 * 1024, SM_TOKG = WS_SMALL + 1536 * 1024,
                 SM_TOKP = WS_SMALL + 1792 * 1024, SM_ROWTOK = WS_SMALL + 2 * MiB, SM_TILEEXP = WS_SMALL + 2 * MiB + 512 * 1024,
                 SM_MLOC = WS_SMALL + 2 * MiB + 768 * 1024, SM_BL = SM_MLOC + 8192, SM_MPREV = SM_MLOC + 16384,
                 SM_DN = WS_SMALL + 3 * MiB, SM_NS = WS_SMALL + 4 * MiB, SM_L1 = WS_SMALL + 5 * MiB, SM_L2 = WS_SMALL + 7 * MiB;
constexpr size_t WS_WGU = 64 * MiB, WS_WD = 576 * MiB, WS_XB = 832 * MiB, WS_QKV = 898 * MiB, WS_OB = 1090 * MiB,
                 WS_P1 = 1170 * MiB, WS_P2 = 1234 * MiB, WS_CS = 1298 * MiB, WS_QC = 1426 * MiB, WS_KC = 1458 * MiB, WS_END = 1490 * MiB;
constexpr size_t WS_YB = WS_QKV, WS_ACT = WS_OB, WS_DC = WS_P1;
constexpr int CW_BAR = 4096, CW_CNT = 16384;

constexpr int LDS_BYTES = 147456;
constexpr int MISC_OFF = 147456 - 512;

__device__ __forceinline__ unsigned f2bf(float f) { unsigned u = __builtin_bit_cast(unsigned, f); return (u + 0x7fffu + ((u >> 16) & 1u)) >> 16; }
__device__ __forceinline__ float bf2f(unsigned h) { return __builtin_bit_cast(float, h << 16); }
typedef __bf16 bf16x2_t __attribute__((ext_vector_type(2)));
__device__ __forceinline__ unsigned cvt_pk_bf16(float lo, float hi) { f32x2 v = {lo, hi}; bf16x2_t r = __builtin_convertvector(v, bf16x2_t); return __builtin_bit_cast(unsigned, r); }
__device__ __forceinline__ float bflo(unsigned w) { return __builtin_bit_cast(float, w << 16); }
__device__ __forceinline__ float bfhi(unsigned w) { return __builtin_bit_cast(float, w & 0xffff0000u); }
__device__ __forceinline__ float fast_exp2(float x) { return __builtin_amdgcn_exp2f(x); }
__device__ __forceinline__ float fast_rcp(float x) { return __builtin_amdgcn_rcpf(x); }
#define LDS_WAIT() asm volatile("s_waitcnt lgkmcnt(0)" ::: "memory")
#define VM_WAIT() asm volatile("s_waitcnt vmcnt(0)" ::: "memory")

#define XB_TMO      128
#define XB_XCNT(j)  (256  + 64 * (j))
#define XB_XSUB(j)  (1280 + 64 * (j))
#define XB_XGEN(j)  (2304 + 64 * (j))
#define XB_TOP      3328
#define XB_TOPGEN   3392
#define XCD_BAR_WORDS 3456
#define XB_SPIN_CAP (1u << 18)
__device__ __forceinline__ unsigned xb_ld(unsigned* p)              { return __hip_atomic_load(p, __ATOMIC_RELAXED, __HIP_MEMORY_SCOPE_AGENT); }
__device__ __forceinline__ unsigned xb_add(unsigned* p, unsigned v) { return __hip_atomic_fetch_add(p, v, __ATOMIC_RELAXED, __HIP_MEMORY_SCOPE_AGENT); }
__device__ __forceinline__ unsigned xb_xcc_id() { return (unsigned)__builtin_amdgcn_s_getreg((3 << 11) | 20) & 0xFu; }
#define XB_SPIN(cond, bar) do { unsigned _sp = 0; while (cond) { __builtin_amdgcn_s_sleep(1); \
    if ((++_sp & 255u) == 0u) { if (xb_ld(&(bar)[XB_TMO])) break; if (_sp > XB_SPIN_CAP) { atomicAdd(&(bar)[XB_TMO], 1u); break; } } } } while (0)
struct XcdBarrier { unsigned* bar; unsigned x; volatile LAS unsigned* st; };
__device__ __forceinline__ XcdBarrier xcd_barrier_post(unsigned* bar, volatile LAS unsigned* st) {
    XcdBarrier b; b.bar = bar; b.x = xb_xcc_id(); b.st = st;
    if (threadIdx.x == 0) (void)xb_add(&bar[XB_XCNT(b.x)], 1u);
    return b;
}
__device__ __forceinline__ void xcd_barrier_complete(unsigned* bar, unsigned x, unsigned& nloc, unsigned& nx) {
    const unsigned G = gridDim.x * gridDim.y * gridDim.z;
    unsigned sum, cnt, mine, sp = 0u;
    for (;;) {
        sum = 0u; cnt = 0u; mine = 0u;
#pragma unroll
        for (unsigned j = 0; j < 16; ++j) { const unsigned c = xb_ld(&bar[XB_XCNT(j)]); sum += c; cnt += (c > 0u) ? 1u : 0u; mine = (j == x) ? c : mine; }
        if (sum == G) break;
        __builtin_amdgcn_s_sleep(1);
        if ((++sp & 255u) == 0u) { if (xb_ld(&bar[XB_TMO])) break; if (sp > XB_SPIN_CAP) { atomicAdd(&bar[XB_TMO], 1u); break; } }
    }
    nloc = mine > 0u ? mine : 1u; nx = cnt > 0u ? cnt : 1u;
}
__device__ __forceinline__ void xcd_barrier(const XcdBarrier& b) {
    asm volatile("s_waitcnt vmcnt(0)" ::: "memory");
    __syncthreads();
    if (threadIdx.x == 0) {
        unsigned* bar = b.bar;
        __builtin_amdgcn_s_waitcnt(0);
        unsigned nloc = b.st[0], nx = b.st[1];
        if (nloc == 0u) { xcd_barrier_complete(bar, b.x, nloc, nx); b.st[0] = nloc; b.st[1] = nx; }
        const unsigned old = xb_add(&bar[XB_XSUB(b.x)], 1u);
        const unsigned gen = old / nloc;
        if (old + 1u == (gen + 1u) * nloc) {
            __builtin_amdgcn_fence(__ATOMIC_RELEASE, "agent");
            asm volatile("s_waitcnt vmcnt(0)" ::: "memory");
            const unsigned og = xb_add(&bar[XB_TOP], 1u);
            const unsigned tg = og / nx;
            if (og + 1u == (tg + 1u) * nx) xb_add(&bar[XB_TOPGEN], 1u);
            else XB_SPIN(xb_ld(&bar[XB_TOPGEN]) == tg, bar);
            __builtin_amdgcn_fence(__ATOMIC_ACQUIRE, "agent");
            xb_add(&bar[XB_XGEN(b.x)], 1u);
            asm volatile("s_waitcnt vmcnt(0)" ::: "memory");
        } else {
            XB_SPIN(xb_ld(&bar[XB_XGEN(b.x)]) == gen, bar);
            __builtin_amdgcn_fence(__ATOMIC_ACQUIRE, "agent");
            asm volatile("s_waitcnt vmcnt(0)" ::: "memory");
        }
    }
    __syncthreads();
}

namespace pg8 {
constexpr int BM = 256, BK = 64, HALF = 128, HTB = HALF * BK * 2, STAGE_BYTES = 8 * HTB, NXCD = 8, WGM = 8;
__host__ __device__ __forceinline__ int lds_byte(int r, int c) { const int st = (r >> 4) * 2 + (c >> 5), rr = r & 15, cc = c & 31, ob = rr * 64 + cc * 2; return st * 1024 + (ob ^ (((ob >> 9) & 1) << 5)); }
__host__ __device__ __forceinline__ void stage_rc(int b, int& R, int& C) { const int st = b / 1024, sb = b % 1024, swz = sb ^ (((sb >> 9) & 1) << 5); R = (st >> 1) * 16 + swz / 64; C = (st & 1) * 32 + (swz % 64) / 2; }
__host__ __device__ __forceinline__ int perm32(int rho) { const int n = rho >> 4, i = rho & 15; return 8 * (i >> 2) + 4 * n + (i & 3); }

struct Unit { int pm, pn, e; };
struct Gemm { const bf16_t* A; const bf16_t* Bt; int K; size_t b_estride; const int* sparse; const LAS int* pst; const LAS int* cnt; };

struct StaticOrder {
    int nM, nN, nwg, G, c; const LAS int* pst;
    __device__ void init(int nM_, int nN_, int G_, int c_, const LAS int* pst_) { nM = nM_; nN = nN_; nwg = nM * nN; G = G_; c = c_; pst = pst_; }
    __device__ bool next(int i, Unit& u) const {
        const long L = (long)i * G + c; if (L >= nwg) return false;
        int wgid = (int)L; { const int q = nwg / NXCD, r = nwg % NXCD, xcd = wgid % NXCD, off = wgid / NXCD; wgid = (xcd < r ? xcd * (q + 1) : r * (q + 1) + (xcd - r) * q) + off; }
        const int nig = WGM * nN, gid = wgid / nig, fm = gid * WGM, gsz = (nM - fm) < WGM ? (nM - fm) : WGM;
        u.pm = fm + ((wgid % nig) % gsz); u.pn = (wgid % nig) / gsz;
        u.e = pst ? __builtin_amdgcn_readfirstlane(pst[256 + u.pm]) : 0;
        return true;
    }
};

template <class Epi, bool ALIGN_EPI, bool GATHER, bool A_HM = false>
__device__ __forceinline__ void gemm_phase(LAS unsigned char* lds, const int tid, const Gemm g, const StaticOrder& S, const Epi& E) {
    const int wid = __builtin_amdgcn_readfirstlane(tid >> 6), lane = tid & 63, wr = wid >> 2, wc = wid & 3, fr = lane & 15, fq = lane >> 4;
    const int K = g.K, nt = K / BK;
    int RA[2], CA[2]; unsigned voffB[2];
#pragma unroll
    for (int i = 0; i < 2; ++i) { int R, C; stage_rc(tid * 16 + i * 8192, R, C); const int Rb = Epi::PERM ? ((R & ~31) + perm32(R & 31)) : R;
        RA[i] = R; CA[i] = C; voffB[i] = (unsigned)(Rb * K + C) * 2u; }
    const size_t kstep = (size_t)(BK * 2);
    const size_t hstep = (size_t)HALF * K * 2;
    const size_t tstep = 2 * hstep;
    const size_t akstep = A_HM ? (size_t)16384 * 128 : kstep, ahstep = A_HM ? (size_t)HALF * 128 : hstep;
#define PG8_ABASE(pm_) (A_HM ? ((size_t)((pm_) >> 6) * 16 * 16384 + (size_t)((pm_) & 63) * 256) * 128 : (size_t)(pm_) * tstep)
    const unsigned ldsw = (unsigned)wid * 1024u;
    const int aoff = lds_byte(wr * 64 + fr, fq * 8), boff = lds_byte(wc * 32 + fr, fq * 8);
#define PG8_SA(b, h) (((b) * 2 + (h)) * HTB)
#define PG8_SB(b, h) ((4 + (b) * 2 + (h)) * HTB)
#define PG8_STAGE(bufoff, gbase, voff) do { _Pragma("unroll") for (int _i = 0; _i < 2; ++_i) \
        __builtin_amdgcn_global_load_lds((const unsigned*)((const char*)(gbase) + (voff)[_i]), (LAS unsigned*)(lds + (bufoff) + ldsw + _i * 8192), 16, 0, 0); } while (0)
#define PG8_LDA(dst, b, h) do { _Pragma("unroll") for (int m = 0; m < 4; ++m) _Pragma("unroll") for (int k = 0; k < 2; ++k) dst[m][k] = *(const LAS bf16x8*)(lds + PG8_SA(b, h) + aoff + m * 2048 + k * 1024); } while (0)
#define PG8_LDB(dst, b, h) do { _Pragma("unroll") for (int n = 0; n < 2; ++n) _Pragma("unroll") for (int k = 0; k < 2; ++k) dst[n][k] = *(const LAS bf16x8*)(lds + PG8_SB(b, h) + boff + n * 2048 + k * 1024); } while (0)
#define PG8_MMA(ai, bj, At, Bt) do { __builtin_amdgcn_s_setprio(1); _Pragma("unroll") for (int m = 0; m < 4; ++m) _Pragma("unroll") for (int n = 0; n < 2; ++n) _Pragma("unroll") for (int k = 0; k < 2; ++k) \
        acc[ai][bj][m][n] = __builtin_amdgcn_mfma_f32_16x16x32_bf16(Bt[n][k], At[m][k], acc[ai][bj][m][n], 0, 0, 0); __builtin_amdgcn_s_setprio(0); } while (0)
#define PG8_WAIT_V(n) asm volatile("s_waitcnt vmcnt(" #n ")" ::: "memory")
#define PG8_WAIT_L(n) asm volatile("s_waitcnt lgkmcnt(" #n ")" ::: "memory")
#define PG8_BAR __builtin_amdgcn_s_barrier()
#define PG8_SCHED __builtin_amdgcn_sched_barrier(0)
#define PG8_AOFFS(dst, unit) do { _Pragma("unroll") for (int _h = 0; _h < 2; ++_h) _Pragma("unroll") for (int _i = 0; _i < 2; ++_i) { \
        const int _j = (unit).pm * BM + _h * HALF + RA[_i] - g.pst[(unit).e]; const int _src = (_j < g.cnt[(unit).e]) ? g.sparse[(unit).e * 32768 + _j] : NTOK; dst[_h][_i] = (unsigned)(_src * K + CA[_i]) * 2u; } } while (0)
    Unit cur, nxt; int ui = 0;
    if (!S.next(0, cur)) return;
    f32x4 acc[2][2][4][2];
#pragma unroll
    for (int a = 0; a < 2; ++a)
#pragma unroll
        for (int b = 0; b < 2; ++b)
#pragma unroll
            for (int m = 0; m < 4; ++m)
#pragma unroll
                for (int n = 0; n < 2; ++n) acc[a][b][m][n] = (f32x4){0.f, 0.f, 0.f, 0.f};
    bf16x8 At[4][2], B0[2][2], B1[2][2];
    unsigned voffA[2]; unsigned cAo[2][2], nAo[2][2];
#pragma unroll
    for (int i = 0; i < 2; ++i) voffA[i] = (unsigned)(RA[i] * (A_HM ? 64 : K) + CA[i]) * 2u;
    const char* cA = (const char*)g.A;
    if constexpr (GATHER) { PG8_AOFFS(cAo, cur); } else { cA += PG8_ABASE(cur.pm); }
    const char* cB = (const char*)g.Bt + (size_t)cur.e * g.b_estride + (size_t)cur.pn * tstep;
#define PG8_STAGE_A(bufoff, base, h, nx) do { if constexpr (GATHER) { _Pragma("unroll") for (int _i = 0; _i < 2; ++_i) { const unsigned _o = (nx) ? nAo[h][_i] : cAo[h][_i]; \
            __builtin_amdgcn_global_load_lds((const unsigned*)((const char*)(base) + _o), (LAS unsigned*)(lds + (bufoff) + ldsw + _i * 8192), 16, 0, 0); } } \
        else { PG8_STAGE(bufoff, (base) + (h) * ahstep, voffA); } } while (0)
    PG8_STAGE(PG8_SB(0, 0), cB, voffB); PG8_STAGE(PG8_SB(0, 1), cB + hstep, voffB); PG8_STAGE_A(PG8_SA(0, 0), cA, 0, false); PG8_STAGE_A(PG8_SA(0, 1), cA, 1, false);
    if (wr == 1) PG8_BAR;
    PG8_WAIT_V(2); PG8_BAR;
    PG8_STAGE(PG8_SB(1, 0), cB + kstep, voffB); PG8_STAGE_A(PG8_SA(1, 0), cA + akstep, 0, false); PG8_STAGE(PG8_SB(1, 1), cB + hstep + kstep, voffB);
    PG8_WAIT_V(6); PG8_BAR;
    for (;;) {
        const bool has_next = S.next(ui + 1, nxt);
        const char* nA = cA;
        if constexpr (GATHER) { if (has_next) { PG8_AOFFS(nAo, nxt); } else {
#pragma unroll
            for (int h = 0; h < 2; ++h)
#pragma unroll
                for (int i = 0; i < 2; ++i) nAo[h][i] = cAo[h][i]; } }
        else { if (has_next) nA = (const char*)g.A + PG8_ABASE(nxt.pm); }
        const char* nB = has_next ? (const char*)g.Bt + (size_t)nxt.e * g.b_estride + (size_t)nxt.pn * tstep : cB;
        for (int t = 0; t < nt; t += 2) {
            const bool last = (t == nt - 2);
            const char* a1 = cA + (size_t)(t + 1) * akstep;
            const char* a2 = last ? nA : cA + (size_t)(t + 2) * akstep; const char* b2 = last ? nB : cB + (size_t)(t + 2) * kstep;
            const char* a3 = a2 + akstep; const char* b3 = b2 + kstep;
            PG8_LDB(B0, 0, 0); PG8_LDB(B1, 0, 1); PG8_SCHED; PG8_LDA(At, 0, 0); PG8_STAGE_A(PG8_SA(1, 1), a1, 1, false);
            PG8_WAIT_V(8); PG8_WAIT_L(0); PG8_BAR; PG8_MMA(0, 0, At, B0); PG8_MMA(0, 1, At, B1); PG8_BAR; PG8_SCHED;
            PG8_LDA(At, 0, 1); PG8_STAGE(PG8_SB(0, 0), b2, voffB); PG8_STAGE(PG8_SB(0, 1), b2 + hstep, voffB); PG8_STAGE_A(PG8_SA(0, 0), a2, 0, last);
            PG8_WAIT_V(8); PG8_WAIT_L(0); PG8_BAR; PG8_MMA(1, 0, At, B0); PG8_MMA(1, 1, At, B1); PG8_BAR; PG8_SCHED;
            PG8_LDB(B0, 1, 0); PG8_LDB(B1, 1, 1); PG8_SCHED; PG8_LDA(At, 1, 0); PG8_STAGE_A(PG8_SA(0, 1), a2, 1, last);
            PG8_WAIT_V(8); PG8_WAIT_L(0); PG8_BAR; PG8_MMA(0, 0, At, B0); PG8_MMA(0, 1, At, B1); PG8_BAR; PG8_SCHED;
            PG8_LDA(At, 1, 1); PG8_STAGE(PG8_SB(1, 0), b3, voffB); PG8_STAGE(PG8_SB(1, 1), b3 + hstep, voffB); PG8_STAGE_A(PG8_SA(1, 0), a3, 0, last);
            PG8_WAIT_V(8); PG8_WAIT_L(0); PG8_BAR; PG8_MMA(1, 0, At, B0); PG8_MMA(1, 1, At, B1); PG8_BAR; PG8_SCHED;
        }
        if constexpr (ALIGN_EPI) { if (wr == 0) PG8_BAR; }
        E(acc, cur, wr, wc, fr, fq);
        if (!has_next) break;
#pragma unroll
        for (int a = 0; a < 2; ++a)
#pragma unroll
            for (int b = 0; b < 2; ++b)
#pragma unroll
                for (int m = 0; m < 4; ++m)
#pragma unroll
                    for (int n = 0; n < 2; ++n) acc[a][b][m][n] = (f32x4){0.f, 0.f, 0.f, 0.f};
        cur = nxt; cB = nB; cA = nA; ++ui;
        if constexpr (GATHER) {
#pragma unroll
        for (int h = 0; h < 2; ++h)
#pragma unroll
            for (int i = 0; i < 2; ++i) cAo[h][i] = nAo[h][i]; }
        if constexpr (ALIGN_EPI) { if (wr == 1) PG8_BAR; }
    }
    PG8_WAIT_V(0);
    if constexpr (!ALIGN_EPI) { if (wr == 0) PG8_BAR; }
    PG8_BAR;
#undef PG8_SA
#undef PG8_SB
#undef PG8_STAGE
#undef PG8_LDA
#undef PG8_LDB
#undef PG8_MMA
#undef PG8_WAIT_V
#undef PG8_WAIT_L
#undef PG8_BAR
#undef PG8_SCHED
#undef PG8_AOFFS
#undef PG8_STAGE_A
#undef PG8_ABASE
}


struct EpiQKV {
    static constexpr bool PERM = true;
    bf16_t* O; const float* rstd; const float* qg; const float* kg; float qscale;
    __device__ __forceinline__ void operator()(const f32x4 (&acc)[2][2][4][2], const Unit& u, int wr, int wc, int fr, int fq) const {
        const int part = u.pn >> 2, head = 4 * (u.pn & 3) + wc;
        f32x4 gv[2][2];
#pragma unroll
        for (int bj = 0; bj < 2; ++bj)
#pragma unroll
            for (int n = 0; n < 2; ++n) { const int dim = 32 * bj + 8 * fq + 4 * n;
                if (part == 0) gv[bj][n] = *(const f32x4*)(qg + dim) * qscale; else if (part == 1) gv[bj][n] = *(const f32x4*)(kg + dim); else gv[bj][n] = (f32x4){1.f, 1.f, 1.f, 1.f}; }
#pragma unroll
        for (int ai = 0; ai < 2; ++ai)
#pragma unroll
            for (int m = 0; m < 4; ++m) {
                const int row = u.pm * BM + ai * HALF + wr * 64 + m * 16 + fr; const float rs = rstd[row];
                f32x4 v[2][2]; float ss = 0.f;
#pragma unroll
                for (int bj = 0; bj < 2; ++bj)
#pragma unroll
                    for (int n = 0; n < 2; ++n) { v[bj][n] = acc[ai][bj][m][n] * rs; const f32x4 q = v[bj][n] * v[bj][n]; ss += (q[0] + q[1]) + (q[2] + q[3]); }
                float sc = 1.f;
                if (part < 2) { ss += __shfl_xor(ss, 16); ss += __shfl_xor(ss, 32); sc = 1.0f / sqrtf(ss * (1.0f / 64.0f) + EPS); }
                bf16_t* rowp = O + ((size_t)(part * 32 + (row / SEQ) * 16 + head) * SEQ + (row % SEQ)) * 64 + 8 * fq;
#pragma unroll
                for (int bj = 0; bj < 2; ++bj) { const f32x4 v0 = v[bj][0] * gv[bj][0] * sc, v1 = v[bj][1] * gv[bj][1] * sc;
                    u32x4 w; w.x = cvt_pk_bf16(v0[0], v0[1]); w.y = cvt_pk_bf16(v0[2], v0[3]); w.z = cvt_pk_bf16(v1[0], v1[1]); w.w = cvt_pk_bf16(v1[2], v1[3]);
                    *(u32x4*)(rowp + 32 * bj) = w; }
            }
    }
};
struct EpiBf16 {
    static constexpr bool PERM = true;
    bf16_t* O; int ldc; const float* rscale;
    __device__ __forceinline__ void operator()(const f32x4 (&acc)[2][2][4][2], const Unit& u, int wr, int wc, int fr, int fq) const {
        const int col0 = u.pn * BM + wc * 32 + 8 * fq;
#pragma unroll
        for (int ai = 0; ai < 2; ++ai)
#pragma unroll
            for (int m = 0; m < 4; ++m) { const int row = u.pm * BM + ai * HALF + wr * 64 + m * 16 + fr; const float rs = rscale ? rscale[row] : 1.f;
                bf16_t* rowp = O + (size_t)row * ldc + col0;
#pragma unroll
                for (int bj = 0; bj < 2; ++bj) { const f32x4 v0 = acc[ai][bj][m][0] * rs, v1 = acc[ai][bj][m][1] * rs;
                    u32x4 w; w.x = cvt_pk_bf16(v0[0], v0[1]); w.y = cvt_pk_bf16(v0[2], v0[3]); w.z = cvt_pk_bf16(v1[0], v1[1]); w.w = cvt_pk_bf16(v1[2], v1[3]);
                    *(u32x4*)(rowp + bj * HALF) = w; } }
    }
};
struct EpiResid {
    static constexpr bool PERM = false;
    const float* xin; float* out;
    __device__ __forceinline__ void operator()(const f32x4 (&acc)[2][2][4][2], const Unit& u, int wr, int wc, int fr, int fq) const {
        const int col0 = u.pn * BM + wc * 32 + 4 * fq;
#pragma unroll
        for (int ai = 0; ai < 2; ++ai)
#pragma unroll
            for (int m = 0; m < 4; ++m) { const size_t off = (size_t)(u.pm * BM + ai * HALF + wr * 64 + m * 16 + fr) * DM + col0;
#pragma unroll
                for (int bj = 0; bj < 2; ++bj)
#pragma unroll
                    for (int n = 0; n < 2; ++n) { const f32x4 b = *(const f32x4*)(xin + off + bj * HALF + n * 16); *(f32x4*)(out + off + bj * HALF + n * 16) = b + acc[ai][bj][m][n]; } }
    }
};
struct EpiResidB {
    static constexpr bool PERM = true;
    bf16_t* X;
    __device__ __forceinline__ void operator()(const f32x4 (&acc)[2][2][4][2], const Unit& u, int wr, int wc, int fr, int fq) const {
        const int col0 = u.pn * BM + wc * 32 + 8 * fq;
#pragma unroll
        for (int ai = 0; ai < 2; ++ai)
#pragma unroll
            for (int m = 0; m < 4; ++m) { bf16_t* rowp = X + (size_t)(u.pm * BM + ai * HALF + wr * 64 + m * 16 + fr) * DM + col0;
#pragma unroll
                for (int bj = 0; bj < 2; ++bj) { const u32x4 x = *(const u32x4*)(rowp + bj * HALF); const f32x4 a0 = acc[ai][bj][m][0], a1 = acc[ai][bj][m][1];
                    u32x4 w; w.x = cvt_pk_bf16(bflo(x.x) + a0[0], bfhi(x.x) + a0[1]); w.y = cvt_pk_bf16(bflo(x.y) + a0[2], bfhi(x.y) + a0[3]);
                    w.z = cvt_pk_bf16(bflo(x.z) + a1[0], bfhi(x.z) + a1[1]); w.w = cvt_pk_bf16(bflo(x.w) + a1[2], bfhi(x.w) + a1[3]);
                    *(u32x4*)(rowp + bj * HALF) = w; } }
    }
};
struct EpiGU {
    static constexpr bool PERM = true;
    bf16_t* O; const float* rstd; const int* sparse; const LAS int* pst; const LAS int* cnt;
    __device__ __forceinline__ void operator()(const f32x4 (&acc)[2][2][4][2], const Unit& u, int wr, int wc, int fr, int fq) const {
        const int col0 = u.pn * HALF + wc * 32 + 8 * fq;
#pragma unroll
        for (int ai = 0; ai < 2; ++ai)
#pragma unroll
            for (int m = 0; m < 4; ++m) { const int row = u.pm * BM + ai * HALF + wr * 64 + m * 16 + fr; const int jj = row - pst[u.e]; const float rs = (jj < cnt[u.e]) ? rstd[sparse[u.e * 32768 + jj]] : 0.f;
                float o[8];
#pragma unroll
                for (int n = 0; n < 2; ++n)
#pragma unroll
                    for (int i = 0; i < 4; ++i) { const float gg = acc[ai][0][m][n][i] * rs, uu = acc[ai][1][m][n][i] * rs;
                        o[n * 4 + i] = gg * fast_rcp(1.0f + fast_exp2(-gg * LOG2E)) * uu; }
                u32x4 w; w.x = cvt_pk_bf16(o[0], o[1]); w.y = cvt_pk_bf16(o[2], o[3]); w.z = cvt_pk_bf16(o[4], o[5]); w.w = cvt_pk_bf16(o[6], o[7]);
                *(u32x4*)(O + (size_t)row * FFE + col0) = w; }
    }
};
}

struct Frame {
    LAS unsigned char* lds;
    int tid, lane, wave, vcu, G;
};
struct Args { const float* in[20]; float* out; unsigned char* ws; int ph_lo, ph_hi; };
__device__ __forceinline__ Frame make_frame(LAS unsigned char* lds) {
    Frame F; int t = threadIdx.x; asm volatile("" : "+v"(t));
    F.lds = lds; F.tid = t; F.lane = t & 63; F.wave = __builtin_amdgcn_readfirstlane(t >> 6);
    F.G = gridDim.x; { const int bx = blockIdx.x; F.vcu = (F.G % 8 == 0) ? (bx % 8) * (F.G / 8) + bx / 8 : bx; }
    return F;
}

__device__ __forceinline__ bf16x8 ld_frag_lds(const LAS unsigned char* p) { return *(const LAS bf16x8*)p; }
__device__ __forceinline__ bf16x8 mk_frag(unsigned a, unsigned b, unsigned c, unsigned d) { u32x4 w = {a, b, c, d}; return __builtin_bit_cast(bf16x8, w); }
#define MFMA16(a, b, c) __builtin_amdgcn_mfma_f32_16x16x32_bf16(a, b, c, 0, 0, 0)

struct CvtDesc { const float* src; int ldsrc, k0, scol; const float* kscale; bf16_t* dst; int K, drow; };
__device__ __forceinline__ void cvt_load(const CvtDesc& d, int lane, f32x4 (&v)[8]) {
#pragma unroll
    for (int i = 0; i < 8; ++i) v[i] = __builtin_nontemporal_load((const GAS f32x4*)(d.src + (size_t)(d.k0 + 8 * i + (lane >> 3)) * d.ldsrc + d.scol + 4 * (lane & 7)));
}
__device__ __forceinline__ void cvt_finish(const CvtDesc& d, int lane, const f32x4 (&v)[8], LAS float* scr) {
#pragma unroll
    for (int i = 0; i < 8; ++i) { const int kk = 8 * i + (lane >> 3); const float s = d.kscale ? d.kscale[d.k0 + kk] : 1.f; LAS float* p = scr + kk * 33 + 4 * (lane & 7);
        p[0] = v[i][0] * s; p[1] = v[i][1] * s; p[2] = v[i][2] * s; p[3] = v[i][3] * s; }
    LDS_WAIT(); asm volatile("" ::: "memory");
    const int c = lane & 7;
#pragma unroll
    for (int j = 0; j < 4; ++j) { const int n = (lane >> 3) + 8 * j; const LAS float* s = scr + (8 * c) * 33 + n;
        u32x4 o; o.x = cvt_pk_bf16(s[0 * 33], s[1 * 33]); o.y = cvt_pk_bf16(s[2 * 33], s[3 * 33]); o.z = cvt_pk_bf16(s[4 * 33], s[5 * 33]); o.w = cvt_pk_bf16(s[6 * 33], s[7 * 33]);
        __builtin_nontemporal_store(o, (GAS u32x4*)(d.dst + (size_t)(d.drow + n) * d.K + d.k0 + 8 * c)); }
    LDS_WAIT(); asm volatile("" ::: "memory");
}
__device__ __forceinline__ void cvt_item(const float* src, int ldsrc, int k0, int scol, const float* kscale, bf16_t* dst, int K, int drow, LAS float* scr, int lane) {
    const CvtDesc d{src, ldsrc, k0, scol, kscale, dst, K, drow}; f32x4 v[8]; cvt_load(d, lane, v); cvt_finish(d, lane, v, scr);
}
constexpr int MOE_ITEMS = 64 * 16 * 32 + 64 * 8 * 32;
__device__ __forceinline__ CvtDesc cvt_moe_desc(const Args& a, int l, int it) {
    constexpr int I_GU = 64 * 16 * 32;
    unsigned char* ws = a.ws; CvtDesc d;
    if (it < I_GU) { const int e = it / (16 * 32), q = it % (16 * 32), kb = q / 32, nb = q % 32;
        const int pn = nb >> 3, bj = (nb >> 2) & 1, c32 = nb & 3; const int le = l * 64 + e;
        d.src = (bj ? a.in[18] : a.in[17]) + (size_t)le * DM * FFE; d.ldsrc = FFE; d.k0 = kb * 64; d.scol = 128 * pn + 32 * c32; d.kscale = a.in[2] + (size_t)l * DM;
        d.dst = (bf16_t*)(ws + WS_WGU) + (size_t)le * DM * DM; d.K = DM; d.drow = nb * 32; }
    else { const int r = it - I_GU; const int e = r / (8 * 32), q = r % (8 * 32), kb = q / 32, nb = q % 32; const int le = l * 64 + e;
        d.src = a.in[19] + (size_t)le * FFE * DM; d.ldsrc = DM; d.k0 = kb * 64; d.scol = nb * 32; d.kscale = nullptr;
        d.dst = (bf16_t*)(ws + WS_WD) + (size_t)le * DM * FFE; d.K = FFE; d.drow = nb * 32; }
    return d;
}

__device__ __forceinline__ void p0_weights(const Frame& F, const Args& a) {
    LAS float* scr = (LAS float*)(F.lds + F.wave * 16384);
    const int gw = F.vcu * 8 + F.wave, NGW = F.G * 8;
    unsigned char* ws = a.ws;
    constexpr int I_QKV = 2 * 16 * 96, I_O = 2 * 16 * 32, I_IN = 2 * 16 * 96, I_MO = 2 * 16 * 32;
    constexpr int NITEMS = I_QKV + I_O + I_IN + I_MO;
    for (int it = gw; it < NITEMS; it += NGW) {
        int r = it;
        if (r < I_QKV) { const int j = r / (16 * 96), q = r % (16 * 96), kb = q / 96, nb = q % 96;
            const int pn = nb >> 3, bj = (nb >> 2) & 1, wc = nb & 3, part = pn >> 2, head = 4 * (pn & 3) + wc;
            cvt_item(a.in[3] + (size_t)j * DM * 3072, 3072, kb * 64, part * 1024 + head * 64 + 32 * bj, a.in[1] + (size_t)(2 * j) * DM, (bf16_t*)(ws + WS_WQKV) + (size_t)j * 3072 * DM, DM, nb * 32, scr, F.lane); continue; }
        r -= I_QKV;
        if (r < I_O) { const int j = r / (16 * 32), q = r % (16 * 32), kb = q / 32, nb = q % 32;
            cvt_item(a.in[6] + (size_t)j * DM * DM, DM, kb * 64, nb * 32, nullptr, (bf16_t*)(ws + WS_WO) + (size_t)j * DM * DM, DM, nb * 32, scr, F.lane); continue; }
        r -= I_O;
        if (r < I_IN) { const int j = r / (16 * 96), q = r % (16 * 96), kb = q / 96, nb = q % 96;
            cvt_item(a.in[7] + (size_t)j * DM * 3080, 3080, kb * 64, nb * 32, a.in[1] + (size_t)(2 * j + 1) * DM, (bf16_t*)(ws + WS_WIN) + (size_t)j * 3072 * DM, DM, nb * 32, scr, F.lane); continue; }
        r -= I_IN;
        { const int j = r / (16 * 32), q = r % (16 * 32), kb = q / 32, nb = q % 32;
            cvt_item(a.in[12] + (size_t)j * DM * DM, DM, kb * 64, nb * 32, nullptr, (bf16_t*)(ws + WS_WMO) + (size_t)j * DM * DM, DM, nb * 32, scr, F.lane); }
    }
    {
        const int gt = F.vcu * 512 + F.tid, NT = F.G * 512;
        for (int i = gt; i < 4 * 80 * 1024; i += NT) { const int l = i / (80 * 1024), c = (i / 1024) % 80, k = i % 1024;
            float w = 0.f;
            if (c < 8) w = a.in[13][((size_t)l * DM + k) * 8 + c]; else if (c < 72) w = a.in[15][((size_t)l * DM + k) * 64 + (c - 8)];
            w *= a.in[2][l * DM + k];
            const unsigned hi = f2bf(w); const unsigned lo = f2bf(w - bf2f(hi));
            bf16_t* base = (bf16_t*)(ws + WS_WR) + (size_t)l * 2 * 80 * 1024;
            base[c * 1024 + k] = (bf16_t)hi; base[80 * 1024 + c * 1024 + k] = (bf16_t)lo; }
        for (int i = gt; i < 2 * 16 * 1024; i += NT) { const int j = i / (16 * 1024), c = (i / 1024) % 16, k = i % 1024;
            float w = 0.f; if (c < 8) w = a.in[7][((size_t)j * DM + k) * 3080 + 3072 + c] * a.in[1][(2 * j + 1) * DM + k];
            const unsigned hi = f2bf(w); const unsigned lo = f2bf(w - bf2f(hi));
            bf16_t* base = (bf16_t*)(ws + WS_WG) + (size_t)j * 2 * 16 * 1024;
            base[c * 1024 + k] = (bf16_t)hi; base[16 * 1024 + c * 1024 + k] = (bf16_t)lo;
            if (c < 8) ((float*)(ws + WS_WG + 512 * 1024))[(size_t)(j * 8 + c) * 1024 + k] = w; }
        if (F.vcu == 0) { for (int i = F.tid; i < DM / 2; i += 512) ((unsigned*)((bf16_t*)(ws + WS_XB) + (size_t)NTOK * DM))[i] = 0u;
            if (F.tid == 0) ((float*)(ws + SM_RSTD))[NTOK] = 0.f; }
    }
}

template <int MODE, int NT, bool WLO = false>
__device__ __forceinline__ void rowpass_wave(const Frame& F, const float* xsrc, float* xdst, bf16_t* xb, float* rstd_out,
                                             const bf16_t* yb, const int* tokp, const float* tokg, const int* toke, const LAS int* pst,
                                             const bf16_t* whi, const bf16_t* wlo, int tok0, f32x4 (&acc)[NT > 0 ? NT : 1], float& rstd_lane) {
    const int lane = F.lane, t = lane & 15, fq = lane >> 4, tok = tok0 + t;
    const float* xr = xsrc + (size_t)tok * DM + 8 * fq;
    bf16_t* xbr = xb + (size_t)tok * DM + 8 * fq;
    const bf16_t *y0 = nullptr, *y1 = nullptr; float g0 = 0.f, g1 = 0.f;
    if (MODE == 2) { const int p0 = pst[toke[2 * tok]] + tokp[2 * tok], p1 = pst[toke[2 * tok + 1]] + tokp[2 * tok + 1]; g0 = tokg[2 * tok]; g1 = tokg[2 * tok + 1];
        y0 = yb + (size_t)p0 * DM + 8 * fq; y1 = yb + (size_t)p1 * DM + 8 * fq; }
    float* xw = (MODE == 2) ? xdst + (size_t)tok * DM + 8 * fq : nullptr;
#pragma unroll
    for (int c = 0; c < (NT > 0 ? NT : 1); ++c) acc[c] = (f32x4){0.f, 0.f, 0.f, 0.f};
    float ss = 0.f;
#pragma unroll 4
    for (int s = 0; s < 32; ++s) {
        f32x4 a0 = __builtin_nontemporal_load((const GAS f32x4*)(xr + 32 * s)), a1 = __builtin_nontemporal_load((const GAS f32x4*)(xr + 32 * s + 4));
        if (MODE == 2) {
            const u32x4 w0 = *(const GAS u32x4*)(y0 + 32 * s), w1 = *(const GAS u32x4*)(y1 + 32 * s);
            a0[0] += g0 * bflo(w0.x) + g1 * bflo(w1.x); a0[1] += g0 * bfhi(w0.x) + g1 * bfhi(w1.x);
            a0[2] += g0 * bflo(w0.y) + g1 * bflo(w1.y); a0[3] += g0 * bfhi(w0.y) + g1 * bfhi(w1.y);
            a1[0] += g0 * bflo(w0.z) + g1 * bflo(w1.z); a1[1] += g0 * bfhi(w0.z) + g1 * bfhi(w1.z);
            a1[2] += g0 * bflo(w0.w) + g1 * bflo(w1.w); a1[3] += g0 * bfhi(w0.w) + g1 * bfhi(w1.w);
            *(GAS f32x4*)(xw + 32 * s) = a0; *(GAS f32x4*)(xw + 32 * s + 4) = a1;
        }
        ss += (a0[0] * a0[0] + a0[1] * a0[1]) + (a0[2] * a0[2] + a0[3] * a0[3]) + (a1[0] * a1[0] + a1[1] * a1[1]) + (a1[2] * a1[2] + a1[3] * a1[3]);
        u32x4 hi; hi.x = cvt_pk_bf16(a0[0], a0[1]); hi.y = cvt_pk_bf16(a0[2], a0[3]); hi.z = cvt_pk_bf16(a1[0], a1[1]); hi.w = cvt_pk_bf16(a1[2], a1[3]);
        *(GAS u32x4*)(xbr + 32 * s) = hi;
        if (NT > 0) {
            u32x4 lo;
            lo.x = cvt_pk_bf16(a0[0] - bflo(hi.x), a0[1] - bfhi(hi.x)); lo.y = cvt_pk_bf16(a0[2] - bflo(hi.y), a0[3] - bfhi(hi.y));
            lo.z = cvt_pk_bf16(a1[0] - bflo(hi.z), a1[1] - bfhi(hi.z)); lo.w = cvt_pk_bf16(a1[2] - bflo(hi.w), a1[3] - bfhi(hi.w));
            const bf16x8 Ah = __builtin_bit_cast(bf16x8, hi), Al = __builtin_bit_cast(bf16x8, lo);
#pragma unroll
            for (int c = 0; c < NT; ++c) {
                const bf16x8 Bh = *(const GAS bf16x8*)(whi + (size_t)(16 * c + t) * DM + 32 * s + 8 * fq);
                acc[c] = MFMA16(Ah, Bh, acc[c]); acc[c] = MFMA16(Al, Bh, acc[c]);
                if (WLO) { const bf16x8 Bl = *(const GAS bf16x8*)(wlo + (size_t)(16 * c + t) * DM + 32 * s + 8 * fq); acc[c] = MFMA16(Ah, Bl, acc[c]); }
            }
        }
    }
    ss += __shfl_xor(ss, 16); ss += __shfl_xor(ss, 32);
    rstd_lane = 1.0f / sqrtf(ss * (1.0f / DM) + EPS);
    if (fq == 0) rstd_out[tok] = rstd_lane;
}

__device__ __forceinline__ void phase_x0(const Frame& F, const Args& a) {
    f32x4 dummy[1]; float rs;
    for (int tb = F.vcu; tb < NTOK / 128; tb += F.G)
        rowpass_wave<0, 0>(F, a.in[0], nullptr, (bf16_t*)(a.ws + WS_XB), (float*)(a.ws + SM_RSTD), nullptr, nullptr, nullptr, nullptr, nullptr, nullptr, nullptr, tb * 128 + F.wave * 16, dummy, rs);
}


constexpr int RT_WB = 73728, RT_WBUF = 21760;
__device__ __forceinline__ void router_pass(const Frame& F, const bf16_t* xb, float* rstd_out, const bf16_t* whi, int tok0, f32x4 (&acc)[5], float& rstd_lane) {
    const int lane = F.lane, t = lane & 15, fq = lane >> 4, tok = tok0 + t;
    const bf16_t* xbr = xb + (size_t)tok * DM + 8 * fq;
    LAS unsigned char* WB = F.lds + RT_WB;
    u32x4 wr[3];
#define RT_LOAD(chunk) do { _Pragma("unroll") for (int i = 0; i < 3; ++i) { const int p = F.tid + 512 * i; if (p < 1280) wr[i] = *(const GAS u32x4*)(whi + (size_t)(p >> 4) * DM + (chunk) * 128 + (p & 15) * 8); } } while (0)
#define RT_STORE(buf) do { _Pragma("unroll") for (int i = 0; i < 3; ++i) { const int p = F.tid + 512 * i; if (p < 1280) *(LAS u32x4*)(WB + (buf) * RT_WBUF + (p >> 4) * 272 + (p & 15) * 16) = wr[i]; } } while (0)
    __syncthreads();
    RT_LOAD(0); RT_STORE(0);
    __syncthreads();
#pragma unroll
    for (int c = 0; c < 5; ++c) acc[c] = (f32x4){0.f, 0.f, 0.f, 0.f};
    float ss = 0.f;
    u32x4 xc[4], xn[4];
#pragma unroll
    for (int s4 = 0; s4 < 4; ++s4) xc[s4] = *(const GAS u32x4*)(xbr + 32 * s4);
    for (int chunk = 0; chunk < 8; ++chunk) {
        if (chunk + 1 < 8) { RT_LOAD(chunk + 1);
#pragma unroll
            for (int s4 = 0; s4 < 4; ++s4) xn[s4] = *(const GAS u32x4*)(xbr + 32 * ((chunk + 1) * 4 + s4)); }
        const LAS unsigned char* wb = WB + (chunk & 1) * RT_WBUF + t * 272 + fq * 16;
#pragma unroll
        for (int s4 = 0; s4 < 4; ++s4) {
            const u32x4 hi = xc[s4];
            { const float x0 = bflo(hi.x), x1 = bfhi(hi.x), x2 = bflo(hi.y), x3 = bfhi(hi.y), x4 = bflo(hi.z), x5 = bfhi(hi.z), x6 = bflo(hi.w), x7 = bfhi(hi.w);
              ss += (x0 * x0 + x1 * x1) + (x2 * x2 + x3 * x3) + (x4 * x4 + x5 * x5) + (x6 * x6 + x7 * x7); }
            const bf16x8 Ah = __builtin_bit_cast(bf16x8, hi);
#pragma unroll
            for (int c = 0; c < 5; ++c) { const bf16x8 Bh = *(const LAS bf16x8*)(wb + c * (16 * 272) + s4 * 64); acc[c] = MFMA16(Ah, Bh, acc[c]); } }
        if (chunk + 1 < 8) { RT_STORE((chunk + 1) & 1);
#pragma unroll
            for (int s4 = 0; s4 < 4; ++s4) xc[s4] = xn[s4]; }
        __syncthreads();
    }
#undef RT_LOAD
#undef RT_STORE
    ss += __shfl_xor(ss, 16); ss += __shfl_xor(ss, 32);
    rstd_lane = 1.0f / sqrtf(ss * (1.0f / DM) + EPS);
    if (fq == 0) rstd_out[tok] = rstd_lane;
}

__device__ __forceinline__ void phase_router(const Frame& F, const Args& a, int l, bool dry = false) {
    unsigned char* ws = a.ws;
    int* sparse = (int*)(ws + WS_QC);
    LAS float* lg = (LAS float*)(F.lds) + F.wave * (16 * 81);
    LAS float* rsl = (LAS float*)(F.lds + 65536) + F.wave * 16;
    LAS int* hist = (LAS int*)(F.lds + 70000);
    LAS int* bbase = (LAS int*)(F.lds + 70000 + 256);
    LAS int* a_e = (LAS int*)(F.lds + 71000);
    LAS int* a_r = (LAS int*)(F.lds + 72100);
    const bf16_t* whi = (const bf16_t*)(ws + WS_WR) + (size_t)l * 2 * 80 * 1024; const bf16_t* wlo = whi + 80 * 1024;
    unsigned* counts = (unsigned*)(ws + WS_CTL) + CW_CNT + l * 64 + (dry ? 4096 : 0);
    int* toke = (int*)(ws + SM_TOKE); float* tokg = (float*)(ws + SM_TOKG); int* tokp = (int*)(ws + SM_TOKP);
    const float* bg = a.in[14] + l * 8; const float* be = a.in[16] + l * 64;
    for (int tb = F.vcu; tb < NTOK / 128; tb += F.G) {
        __syncthreads();
        if (F.tid < 64) hist[F.tid] = 0;
        __syncthreads();
        f32x4 acc[5]; float rs;
        const int tok0 = tb * 128 + F.wave * 16;
        router_pass(F, (const bf16_t*)(ws + WS_XB), (float*)(ws + SM_RSTD), whi, tok0, acc, rs);
        const int t = F.lane & 15, fq = F.lane >> 4;
        if (fq == 0) rsl[t] = rs;
        LDS_WAIT();
#pragma unroll
        for (int c = 0; c < 5; ++c)
#pragma unroll
            for (int i = 0; i < 4; ++i) { const int tt = 4 * fq + i, col = 16 * c + t; const float bias = col < 8 ? bg[col] : (col < 72 ? be[col - 8] : 0.f);
                lg[tt * 81 + col] = acc[c][i] * rsl[tt] + bias; }
        LDS_WAIT();
        if (F.lane < 16) {
            const LAS float* L = lg + F.lane * 81;
            int grp = 0; float gm = L[0];
#pragma unroll
            for (int j = 1; j < 8; ++j) { const float v = L[j]; if (v > gm) { gm = v; grp = j; } }
            float den = 0.f;
#pragma unroll
            for (int j = 0; j < 8; ++j) den += __expf(L[j] - gm);
            const float pg = 1.0f / den;
            const LAS float* E = L + 8 + grp * 8;
            int i1 = 0; float v1 = E[0];
#pragma unroll
            for (int j = 1; j < 8; ++j) { const float v = E[j]; if (v > v1) { v1 = v; i1 = j; } }
            int i2 = (i1 == 0) ? 1 : 0; float v2 = -3.0e38f;
#pragma unroll
            for (int j = 0; j < 8; ++j) { const float v = E[j]; if (j != i1 && v > v2) { v2 = v; i2 = j; } }
            const float e2 = __expf(v2 - v1), s1 = 1.0f / (1.0f + e2);
            const int tok = tok0 + F.lane, e_a = grp * 8 + i1, e_b = grp * 8 + i2;
            toke[2 * tok] = e_a; toke[2 * tok + 1] = e_b; tokg[2 * tok] = pg * s1; tokg[2 * tok + 1] = pg * e2 * s1;
            const int la = (F.wave * 16 + F.lane) * 2;
            a_e[la] = e_a; a_e[la + 1] = e_b;
            a_r[la] = atomicAdd((int*)(hist + e_a), 1); a_r[la + 1] = atomicAdd((int*)(hist + e_b), 1);
        }
        __syncthreads();
        if (F.tid < 64) bbase[F.tid] = (int)atomicAdd(counts + F.tid, (unsigned)hist[F.tid]);
        __syncthreads();
        if (F.tid < 256) { const int tok = tb * 128 + (F.tid >> 1); const int e = a_e[F.tid], idx = bbase[e] + a_r[F.tid]; tokp[2 * tok + (F.tid & 1)] = idx; if (!dry) sparse[e * 32768 + idx] = tok; }
    }
}

__device__ __forceinline__ int moe_tables(const Frame& F, const unsigned* counts, LAS int* pst, LAS int* cnt) {
    __syncthreads();
    if (F.tid < 64) {
        const int c = (int)counts[F.tid]; const int pc = (c + 255) & ~255;
        int incl = pc;
#pragma unroll
        for (int o = 1; o < 64; o <<= 1) { const int t = __shfl_up(incl, o); if (F.lane >= o) incl += t; }
        const int start = incl - pc;
        cnt[F.tid] = c; pst[F.tid] = start; if (F.tid == 63) pst[64] = incl;
        for (int t = start >> 8; t < (incl >> 8); ++t) pst[256 + t] = F.tid;
    }
    __syncthreads();
    return pst[64] >> 8;
}
constexpr int MOE_TAB_OFF = 131072;
struct TokRec { int e0, e1, q0, q1; float g0, g1; };
__device__ __forceinline__ TokRec tok_rec(const int* toke, const int* tokp, const float* tokg, int tok) { TokRec r; r.e0 = toke[2 * tok]; r.e1 = toke[2 * tok + 1]; r.q0 = tokp[2 * tok]; r.q1 = tokp[2 * tok + 1]; r.g0 = tokg[2 * tok]; r.g1 = tokg[2 * tok + 1]; return r; }
template <bool GATES, bool FINAL>
__device__ __forceinline__ void combine_wave(const Frame& F, bf16_t* xb, float* rstd_out, float* fout, const bf16_t* yb, const TokRec tr, const LAS int* pst,
                                             const bf16_t* whi, const bf16_t* wlo, int tok0, f32x4& acc, float& rstd_lane) {
    const int lane = F.lane, t = lane & 15, fq = lane >> 4, tok = tok0 + t;
    bf16_t* xr = xb + (size_t)tok * DM + 8 * fq;
    const int p0 = pst[tr.e0] + tr.q0, p1 = pst[tr.e1] + tr.q1; const float g0 = tr.g0, g1 = tr.g1;
    const bf16_t* y0 = yb + (size_t)p0 * DM + 8 * fq; const bf16_t* y1 = yb + (size_t)p1 * DM + 8 * fq;
    float* fo = FINAL ? fout + (size_t)tok * DM + 8 * fq : nullptr;
    acc = (f32x4){0.f, 0.f, 0.f, 0.f};
    float ss = 0.f;
#pragma unroll 4
    for (int s = 0; s < 32; ++s) {
        const u32x4 x = *(const GAS u32x4*)(xr + 32 * s), w0 = *(const GAS u32x4*)(y0 + 32 * s), w1 = *(const GAS u32x4*)(y1 + 32 * s);
        float v[8];
        v[0] = bflo(x.x) + g0 * bflo(w0.x) + g1 * bflo(w1.x); v[1] = bfhi(x.x) + g0 * bfhi(w0.x) + g1 * bfhi(w1.x);
        v[2] = bflo(x.y) + g0 * bflo(w0.y) + g1 * bflo(w1.y); v[3] = bfhi(x.y) + g0 * bfhi(w0.y) + g1 * bfhi(w1.y);
        v[4] = bflo(x.z) + g0 * bflo(w0.z) + g1 * bflo(w1.z); v[5] = bfhi(x.z) + g0 * bfhi(w0.z) + g1 * bfhi(w1.z);
        v[6] = bflo(x.w) + g0 * bflo(w0.w) + g1 * bflo(w1.w); v[7] = bfhi(x.w) + g0 * bfhi(w0.w) + g1 * bfhi(w1.w);
        if (FINAL) { __builtin_nontemporal_store((f32x4){v[0], v[1], v[2], v[3]}, (GAS f32x4*)(fo + 32 * s)); __builtin_nontemporal_store((f32x4){v[4], v[5], v[6], v[7]}, (GAS f32x4*)(fo + 32 * s + 4)); }
        u32x4 hi; hi.x = cvt_pk_bf16(v[0], v[1]); hi.y = cvt_pk_bf16(v[2], v[3]); hi.z = cvt_pk_bf16(v[4], v[5]); hi.w = cvt_pk_bf16(v[6], v[7]);
        if (!FINAL) *(GAS u32x4*)(xr + 32 * s) = hi;
        { const float r0 = bflo(hi.x), r1 = bfhi(hi.x), r2 = bflo(hi.y), r3 = bfhi(hi.y), r4 = bflo(hi.z), r5 = bfhi(hi.z), r6 = bflo(hi.w), r7 = bfhi(hi.w);
          ss += (r0 * r0 + r1 * r1) + (r2 * r2 + r3 * r3) + (r4 * r4 + r5 * r5) + (r6 * r6 + r7 * r7); }
        if (GATES) { const bf16x8 Ah = __builtin_bit_cast(bf16x8, hi);
            const bf16x8 Bh = *(const GAS bf16x8*)(whi + (size_t)t * DM + 32 * s + 8 * fq), Bl = *(const GAS bf16x8*)(wlo + (size_t)t * DM + 32 * s + 8 * fq);
            acc = MFMA16(Ah, Bh, acc); acc = MFMA16(Ah, Bl, acc); }
    }
    ss += __shfl_xor(ss, 16); ss += __shfl_xor(ss, 32);
    rstd_lane = 1.0f / sqrtf(ss * (1.0f / DM) + EPS);
    if (!FINAL && fq == 0) rstd_out[tok] = rstd_lane;
}
template <bool FINAL>
__device__ __forceinline__ void combine_rows(const Frame& F, bf16_t* xb, float* rstd_out, float* fout, const bf16_t* yb, const int* toke, const int* tokp, const float* tokg, const LAS int* pst, int tok0) {
    const int lane = F.lane;
#pragma unroll 1
    for (int bt = 0; bt < 4; ++bt) {
        u32x4 xv[4][2], y0v[4][2], y1v[4][2]; float g0[4], g1[4];
#pragma unroll
        for (int t4 = 0; t4 < 4; ++t4) { const int tok = __builtin_amdgcn_readfirstlane(tok0 + 4 * bt + t4);
            const int p0 = __builtin_amdgcn_readfirstlane(pst[toke[2 * tok]] + tokp[2 * tok]), p1 = __builtin_amdgcn_readfirstlane(pst[toke[2 * tok + 1]] + tokp[2 * tok + 1]);
            g0[t4] = tokg[2 * tok]; g1[t4] = tokg[2 * tok + 1];
            const bf16_t* xr = xb + (size_t)tok * DM + 8 * lane; const bf16_t* r0 = yb + (size_t)p0 * DM + 8 * lane; const bf16_t* r1 = yb + (size_t)p1 * DM + 8 * lane;
#pragma unroll
            for (int j = 0; j < 2; ++j) { xv[t4][j] = *(const GAS u32x4*)(xr + 512 * j); y0v[t4][j] = *(const GAS u32x4*)(r0 + 512 * j); y1v[t4][j] = *(const GAS u32x4*)(r1 + 512 * j); } }
#pragma unroll
        for (int t4 = 0; t4 < 4; ++t4) { const int tok = tok0 + 4 * bt + t4; float ss = 0.f;
#pragma unroll
            for (int j = 0; j < 2; ++j) { const u32x4 x = xv[t4][j], w0 = y0v[t4][j], w1 = y1v[t4][j]; const float a0 = g0[t4], a1 = g1[t4];
                float v[8];
                v[0] = bflo(x.x) + a0 * bflo(w0.x) + a1 * bflo(w1.x); v[1] = bfhi(x.x) + a0 * bfhi(w0.x) + a1 * bfhi(w1.x);
                v[2] = bflo(x.y) + a0 * bflo(w0.y) + a1 * bflo(w1.y); v[3] = bfhi(x.y) + a0 * bfhi(w0.y) + a1 * bfhi(w1.y);
                v[4] = bflo(x.z) + a0 * bflo(w0.z) + a1 * bflo(w1.z); v[5] = bfhi(x.z) + a0 * bfhi(w0.z) + a1 * bfhi(w1.z);
                v[6] = bflo(x.w) + a0 * bflo(w0.w) + a1 * bflo(w1.w); v[7] = bfhi(x.w) + a0 * bfhi(w0.w) + a1 * bfhi(w1.w);
                if (FINAL) { float* fo = fout + (size_t)tok * DM + 512 * j + 8 * lane;
                    __builtin_nontemporal_store((f32x4){v[0], v[1], v[2], v[3]}, (GAS f32x4*)fo); __builtin_nontemporal_store((f32x4){v[4], v[5], v[6], v[7]}, (GAS f32x4*)(fo + 4)); }
                else { u32x4 hi; hi.x = cvt_pk_bf16(v[0], v[1]); hi.y = cvt_pk_bf16(v[2], v[3]); hi.z = cvt_pk_bf16(v[4], v[5]); hi.w = cvt_pk_bf16(v[6], v[7]);
                    *(GAS u32x4*)(xb + (size_t)tok * DM + 512 * j + 8 * lane) = hi;
                    const float r0 = bflo(hi.x), r1 = bfhi(hi.x), r2 = bflo(hi.y), r3 = bfhi(hi.y), r4 = bflo(hi.z), r5 = bfhi(hi.z), r6 = bflo(hi.w), r7 = bfhi(hi.w);
                    ss += (r0 * r0 + r1 * r1) + (r2 * r2 + r3 * r3) + (r4 * r4 + r5 * r5) + (r6 * r6 + r7 * r7); } }
            if (!FINAL) {
#pragma unroll
                for (int o = 1; o < 64; o <<= 1) ss += __shfl_xor(ss, o);
                if (lane == 0) rstd_out[tok] = 1.0f / sqrtf(ss * (1.0f / DM) + EPS); } }
    }
}
__device__ __forceinline__ void combine_rows_gates(const Frame& F, bf16_t* xb, float* rstd_out, float* gout, const bf16_t* yb, const int* toke, const int* tokp, const float* tokg, const LAS int* pst, int tok0,
                                                   const float* wf  ) {
    const int lane = F.lane;
    float wg[2][8][8];
#pragma unroll
    for (int j = 0; j < 2; ++j)
#pragma unroll
        for (int c = 0; c < 8; ++c) { const f32x4 a = *(const GAS f32x4*)(wf + (size_t)c * DM + 512 * j + 8 * lane), b = *(const GAS f32x4*)(wf + (size_t)c * DM + 512 * j + 8 * lane + 4);
            wg[j][0][c] = a[0]; wg[j][1][c] = a[1]; wg[j][2][c] = a[2]; wg[j][3][c] = a[3]; wg[j][4][c] = b[0]; wg[j][5][c] = b[1]; wg[j][6][c] = b[2]; wg[j][7][c] = b[3]; }
#pragma unroll 1
    for (int bt = 0; bt < 8; ++bt) {
        u32x4 xv[2][2], y0v[2][2], y1v[2][2]; float g0[2], g1[2];
#pragma unroll
        for (int t2 = 0; t2 < 2; ++t2) { const int tok = __builtin_amdgcn_readfirstlane(tok0 + 2 * bt + t2);
            const int p0 = __builtin_amdgcn_readfirstlane(pst[toke[2 * tok]] + tokp[2 * tok]), p1 = __builtin_amdgcn_readfirstlane(pst[toke[2 * tok + 1]] + tokp[2 * tok + 1]);
            g0[t2] = tokg[2 * tok]; g1[t2] = tokg[2 * tok + 1];
            const bf16_t* xr = xb + (size_t)tok * DM + 8 * lane; const bf16_t* r0 = yb + (size_t)p0 * DM + 8 * lane; const bf16_t* r1 = yb + (size_t)p1 * DM + 8 * lane;
#pragma unroll
            for (int j = 0; j < 2; ++j) { xv[t2][j] = *(const GAS u32x4*)(xr + 512 * j); y0v[t2][j] = *(const GAS u32x4*)(r0 + 512 * j); y1v[t2][j] = *(const GAS u32x4*)(r1 + 512 * j); } }
#pragma unroll
        for (int t2 = 0; t2 < 2; ++t2) { const int tok = tok0 + 2 * bt + t2; float ss = 0.f, gs[8];
#pragma unroll
            for (int c = 0; c < 8; ++c) gs[c] = 0.f;
#pragma unroll
            for (int j = 0; j < 2; ++j) { const u32x4 x = xv[t2][j], w0 = y0v[t2][j], w1 = y1v[t2][j]; const float a0 = g0[t2], a1 = g1[t2];
                float v[8];
                v[0] = bflo(x.x) + a0 * bflo(w0.x) + a1 * bflo(w1.x); v[1] = bfhi(x.x) + a0 * bfhi(w0.x) + a1 * bfhi(w1.x);
                v[2] = bflo(x.y) + a0 * bflo(w0.y) + a1 * bflo(w1.y); v[3] = bfhi(x.y) + a0 * bfhi(w0.y) + a1 * bfhi(w1.y);
                v[4] = bflo(x.z) + a0 * bflo(w0.z) + a1 * bflo(w1.z); v[5] = bfhi(x.z) + a0 * bfhi(w0.z) + a1 * bfhi(w1.z);
                v[6] = bflo(x.w) + a0 * bflo(w0.w) + a1 * bflo(w1.w); v[7] = bfhi(x.w) + a0 * bfhi(w0.w) + a1 * bfhi(w1.w);
                u32x4 hi; hi.x = cvt_pk_bf16(v[0], v[1]); hi.y = cvt_pk_bf16(v[2], v[3]); hi.z = cvt_pk_bf16(v[4], v[5]); hi.w = cvt_pk_bf16(v[6], v[7]);
                *(GAS u32x4*)(xb + (size_t)tok * DM + 512 * j + 8 * lane) = hi;
                const float r[8] = {bflo(hi.x), bfhi(hi.x), bflo(hi.y), bfhi(hi.y), bflo(hi.z), bfhi(hi.z), bflo(hi.w), bfhi(hi.w)};
#pragma unroll
                for (int i = 0; i < 8; ++i) { ss += r[i] * r[i];
#pragma unroll
                    for (int c = 0; c < 8; ++c) gs[c] += r[i] * wg[j][i][c]; } }
#pragma unroll
            for (int o = 1; o < 64; o <<= 1) { ss += __shfl_xor(ss, o);
#pragma unroll
                for (int c = 0; c < 8; ++c) gs[c] += __shfl_xor(gs[c], o); }
            const float rs = 1.0f / sqrtf(ss * (1.0f / DM) + EPS);
            if (lane == 0) rstd_out[tok] = rs;
            if (lane < 8) { float gv = gs[0];
#pragma unroll
                for (int c = 1; c < 8; ++c) gv = (lane == c) ? gs[c] : gv;
                gout[(size_t)tok * 8 + lane] = gv * rs; } }
    }
}
__device__ __forceinline__ void phase_combine(const Frame& F, const Args& a, int l) {
    unsigned char* ws = a.ws;
    const bool gates = (l + 1 < NLAYER) && ((l + 1) & 1);
    const int j = (l + 1) >> 1;
    const bf16_t* whi = (const bf16_t*)(ws + WS_WG) + (size_t)j * 2 * 16 * 1024; const bf16_t* wlo = whi + 16 * 1024;
    float* gout = (float*)(ws + SM_GATES);
    LAS float* rsl = (LAS float*)(F.lds) + F.wave * 16;
    LAS int* pst = (LAS int*)(F.lds + MOE_TAB_OFF); LAS int* cnt = (LAS int*)(F.lds + MOE_TAB_OFF + 512);
    const int* tokp = (const int*)(ws + SM_TOKP); const float* tokg = (const float*)(ws + SM_TOKG); const int* toke = (const int*)(ws + SM_TOKE);
    TokRec tr = tok_rec(toke, tokp, tokg, F.vcu * 128 + F.wave * 16 + (F.lane & 15));
    (void)moe_tables(F, (const unsigned*)(ws + WS_CTL) + CW_CNT + l * 64, pst, cnt);
    bf16_t* xb = (bf16_t*)(ws + WS_XB); float* rstd = (float*)(ws + SM_RSTD); const bf16_t* yb = (const bf16_t*)(ws + WS_YB);
    for (int tb = F.vcu; tb < NTOK / 128; tb += F.G) {
        f32x4 acc; float rs; const int tok0 = tb * 128 + F.wave * 16;
        if (tb != F.vcu) tr = tok_rec(toke, tokp, tokg, tok0 + (F.lane & 15));
        if (l + 1 == NLAYER) combine_rows<true>(F, xb, rstd, a.out, yb, toke, tokp, tokg, pst, tok0);
        else if (gates) { combine_rows_gates(F, xb, rstd, gout, yb, toke, tokp, tokg, pst, tok0, (const float*)(ws + WS_WG + 512 * 1024) + (size_t)j * 8 * 1024);
        } else combine_rows<false>(F, xb, rstd, nullptr, yb, toke, tokp, tokg, pst, tok0);
    }
}

constexpr int ATT_KB = 0, ATT_VT = 36864;
struct AttnRegs { u32x4 k[2]; u32x4 v0, v1; bf16x8 q0, q1; };
struct AttnStep { int d, b, h, r, blk; bool prime; };
__device__ __forceinline__ void attn_fetch(const Frame& F, const bf16_t* QKV, const AttnStep& u, AttnRegs& R) {
    const int tid = F.tid, fr = F.lane & 15, fq = F.lane >> 4; const bool valid = u.blk >= 0; const int s0 = u.blk * 128;
#pragma unroll
    for (int i = 0; i < 2; ++i) { const int id = tid + 512 * i, row = id >> 3, ch = id & 7;
        R.k[i] = (u32x4){0u, 0u, 0u, 0u};
        if (valid) R.k[i] = *(const GAS u32x4*)(QKV + ((size_t)(32 + u.b * 16 + u.h) * SEQ + (s0 + row) * u.d + u.r) * 64 + 8 * ch); }
    { const int pair = tid >> 3, ch = tid & 7;
        R.v0 = (u32x4){0u, 0u, 0u, 0u}; R.v1 = (u32x4){0u, 0u, 0u, 0u};
        if (valid) { const bf16_t* p = QKV + ((size_t)(64 + u.b * 16 + u.h) * SEQ + (s0 + 2 * pair) * u.d + u.r) * 64 + 8 * ch; R.v0 = *(const GAS u32x4*)p; R.v1 = *(const GAS u32x4*)(p + (size_t)u.d * 64); } }
    if (!u.prime) { const size_t qrow = (size_t)(u.b * 16 + u.h) * SEQ + (s0 + 16 * F.wave + fr) * u.d + u.r;
        R.q0 = *(const GAS bf16x8*)(QKV + qrow * 64 + 8 * fq); R.q1 = *(const GAS bf16x8*)(QKV + qrow * 64 + 32 + 8 * fq); }
}
__device__ __forceinline__ void attn_stage(const Frame& F, const AttnRegs& R, int slot) {
    LAS unsigned char* Kb = F.lds + ATT_KB; LAS unsigned* VT = (LAS unsigned*)(F.lds + ATT_VT);
#pragma unroll
    for (int i = 0; i < 2; ++i) { const int id = F.tid + 512 * i, row = id >> 3, ch = id & 7; *(LAS u32x4*)(Kb + (slot * 128 + row) * 144 + ch * 16) = R.k[i]; }
    { const int pair = F.tid >> 3, ch = F.tid & 7; const u32x4 v0 = R.v0, v1 = R.v1;
        LAS unsigned* o = VT + (8 * ch) * 129 + slot * 64 + pair;
        o[0 * 129] = (v0.x & 0xffffu) | (v1.x << 16); o[1 * 129] = (v0.x >> 16) | (v1.x & 0xffff0000u);
        o[2 * 129] = (v0.y & 0xffffu) | (v1.y << 16); o[3 * 129] = (v0.y >> 16) | (v1.y & 0xffff0000u);
        o[4 * 129] = (v0.z & 0xffffu) | (v1.z << 16); o[5 * 129] = (v0.z >> 16) | (v1.z & 0xffff0000u);
        o[6 * 129] = (v0.w & 0xffffu) | (v1.w << 16); o[7 * 129] = (v0.w >> 16) | (v1.w & 0xffff0000u); }
}
template <int MODE, bool FIRST>
__device__ __forceinline__ void attn_compute(const Frame& F, const AttnStep& u, const int par, const bf16x8 Q0, const bf16x8 Q1, float off2, bf16_t* part_out, float* l_out, bf16_t* OB, const bf16_t* PP1, const bf16_t* PP2, const float* PL1, const float* PL2) {
    const int lane = F.lane, w = F.wave, fr = lane & 15, fq = lane >> 4;
    const int si0 = u.blk * 128;
    const LAS unsigned char* Kb = F.lds + ATT_KB; const LAS unsigned* VT = (const LAS unsigned*)(F.lds + ATT_VT);
    const int iq = 16 * w + fr; const size_t qrow = (size_t)(u.b * SEQ + (si0 + iq) * u.d + u.r), hrow = (size_t)(u.b * 16 + u.h) * SEQ + (si0 + iq) * u.d + u.r;
    f32x4 O[4];
#pragma unroll
    for (int dt = 0; dt < 4; ++dt) O[dt] = (f32x4){0.f, 0.f, 0.f, 0.f};
    float lsum = 0.f;
#pragma unroll
    for (int up = 0; up < 5; ++up) {
        unsigned pk[4];
#pragma unroll
        for (int hh = 0; hh < 2; ++hh) {
            const int tt = 2 * up + hh;
            if (tt < 9) {
                const int kt = w + tt;
                const int prow = ((kt < 8) ? (par ^ 1) : par) * 128 + 16 * (kt & 7);
                const LAS unsigned char* kp = Kb + (prow + fr) * 144 + fq * 16;
                f32x4 s = (f32x4){0.f, 0.f, 0.f, 0.f};
                s = MFMA16(ld_frag_lds(kp), Q0, s); s = MFMA16(ld_frag_lds(kp + 64), Q1, s);
                float p[4];
                if (FIRST || tt == 0 || tt == 8) {
#pragma unroll
                    for (int i = 0; i < 4; ++i) { const int jk = 16 * kt + 4 * fq + i; const bool ok = (jk >= iq) && (jk <= iq + 128) && (!FIRST || jk >= 128);
                        p[i] = ok ? fast_exp2(s[i] - off2) : 0.f; }
                } else {
#pragma unroll
                    for (int i = 0; i < 4; ++i) p[i] = fast_exp2(s[i] - off2);
                }
                lsum += (p[0] + p[1]) + (p[2] + p[3]);
                pk[2 * hh] = cvt_pk_bf16(p[0], p[1]); pk[2 * hh + 1] = cvt_pk_bf16(p[2], p[3]);
            } else { pk[2 * hh] = 0u; pk[2 * hh + 1] = 0u; }
        }
        const bf16x8 Pf = mk_frag(pk[0], pk[1], pk[2], pk[3]);
        const int kt0 = w + 2 * up, kt1 = (2 * up + 1 < 9) ? kt0 + 1 : kt0;
        const int pb0 = ((kt0 < 8) ? (par ^ 1) : par) * 64 + 8 * (kt0 & 7), pb1 = ((kt1 < 8) ? (par ^ 1) : par) * 64 + 8 * (kt1 & 7);
#pragma unroll
        for (int dt = 0; dt < 4; ++dt) { const LAS unsigned* vp = VT + (16 * dt + fr) * 129 + 2 * fq;
            const bf16x8 V = mk_frag(vp[pb0], vp[pb0 + 1], vp[pb1], vp[pb1 + 1]);
            O[dt] = MFMA16(V, Pf, O[dt]); }
    }
    lsum += __shfl_xor(lsum, 16); lsum += __shfl_xor(lsum, 32);
    if (MODE == 0) {
        bf16_t* o = part_out + hrow * 64 + 4 * fq;
#pragma unroll
        for (int dt = 0; dt < 4; ++dt) { u32x2 wv; wv.x = cvt_pk_bf16(O[dt][0], O[dt][1]); wv.y = cvt_pk_bf16(O[dt][2], O[dt][3]); *(GAS u32x2*)(o + 16 * dt) = wv; }
        if (fq == 0) l_out[hrow] = lsum;
    } else {
        const float inv = 1.0f / (lsum + PL1[hrow] + PL2[hrow]);
        bf16_t* o = OB + hrow * 64 + 4 * fq;
#pragma unroll
        for (int dt = 0; dt < 4; ++dt) { const u32x2 x1 = *(const GAS u32x2*)(PP1 + hrow * 64 + 4 * fq + 16 * dt), x2 = *(const GAS u32x2*)(PP2 + hrow * 64 + 4 * fq + 16 * dt);
            const float o0 = (O[dt][0] + bflo(x1.x) + bflo(x2.x)) * inv, o1 = (O[dt][1] + bfhi(x1.x) + bfhi(x2.x)) * inv;
            const float o2 = (O[dt][2] + bflo(x1.y) + bflo(x2.y)) * inv, o3 = (O[dt][3] + bfhi(x1.y) + bfhi(x2.y)) * inv;
            u32x2 wv; wv.x = cvt_pk_bf16(o0, o1); wv.y = cvt_pk_bf16(o2, o3); *(GAS u32x2*)(o + 16 * dt) = wv; }
    }
}
__device__ __forceinline__ float attn_off2(const float* qg, const float* kg) {
    const int i = threadIdx.x & 63; float mx = fabsf(qg[i] * kg[i]);
#pragma unroll
    for (int o = 1; o < 64; o <<= 1) mx = fmaxf(mx, __shfl_xor(mx, o));
    return 8.0f * mx * LOG2E * 1.02f;
}
template <int MODE>
__device__ __forceinline__ AttnStep attn_step(int s, int vcu, int& br) {
    const int xcd = vcu >> 5, jb = vcu & 31; AttnStep u; int bhl, nblk0, o;
    if (MODE == 0) {
        if (s < 18) { const int ci = 2 * jb + (s >= 9 ? 1 : 0); o = s >= 9 ? s - 9 : s; u.d = 16; bhl = ci >> 4; u.r = ci & 15; nblk0 = 0; br = 0; }
        else { o = s - 18; u.d = 4; bhl = jb >> 3; u.r = (jb & 7) >> 1; nblk0 = 16 * (jb & 1); br = 1; }
    } else { o = s; u.d = 1; bhl = jb >> 3; u.r = 0; nblk0 = 16 * (jb & 7); br = 0; }
    const int bh = xcd + 8 * bhl; u.b = bh >> 4; u.h = bh & 15; u.blk = nblk0 + o - 1; u.prime = (o == 0);
    return u;
}
template <int MODE>
__device__ __forceinline__ void phase_attn(const Frame& F, const Args& a, int j) {
    unsigned char* ws = a.ws; const bf16_t* QKV = (const bf16_t*)(ws + WS_QKV);
    const float off2 = attn_off2(a.in[4] + j * 64, a.in[5] + j * 64);
    constexpr int NSTEP = (MODE == 0) ? 35 : 17;
    if (F.G != 256) return;
    AttnRegs R; R.q0 = (bf16x8){0, 0, 0, 0, 0, 0, 0, 0}; R.q1 = R.q0; int br = 0, ucount = 0;
    AttnStep st = attn_step<MODE>(0, F.vcu, br);
    attn_fetch(F, QKV, st, R);
    const bf16_t* P1 = (const bf16_t*)(ws + WS_P1); const bf16_t* P2 = (const bf16_t*)(ws + WS_P2); const float* L1 = (const float*)(ws + SM_L1); const float* L2 = (const float*)(ws + SM_L2);
    for (int s = 0; s < NSTEP; ++s) {
        __syncthreads();
        attn_stage(F, R, s & 1);
        const bf16x8 Q0 = R.q0, Q1 = R.q1;
        const AttnStep cur = st; const int cbr = br;
        if (s + 1 < NSTEP) { st = attn_step<MODE>(s + 1, F.vcu, br); attn_fetch(F, QKV, st, R); }
        __syncthreads();
        if (cur.prime) continue;
        const int slot = (MODE == 0 ? 0 : 32) + ucount; ++ucount; const int cl = 2 * j + (slot >= 24 ? 1 : 0); const int cit = (F.vcu * 8 + F.wave) + 2048 * (slot % 24);
        const bool do_cvt = (slot < 48) && (cit < MOE_ITEMS);
        CvtDesc cd = cvt_moe_desc(a, cl, do_cvt ? cit : 0); f32x4 cv[8];
        if (do_cvt) cvt_load(cd, F.lane, cv);
        if (cur.blk == 0) attn_compute<MODE, true>(F, cur, s & 1, Q0, Q1, off2, (bf16_t*)(ws + (cbr == 0 ? WS_P1 : WS_P2)), (float*)(ws + (cbr == 0 ? SM_L1 : SM_L2)), (bf16_t*)(ws + WS_OB), P1, P2, L1, L2);
        else attn_compute<MODE, false>(F, cur, s & 1, Q0, Q1, off2, (bf16_t*)(ws + (cbr == 0 ? WS_P1 : WS_P2)), (float*)(ws + (cbr == 0 ? SM_L1 : SM_L2)), (bf16_t*)(ws + WS_OB), P1, P2, L1, L2);
        if (do_cvt) cvt_finish(cd, F.lane, cv, (LAS float*)(F.lds + 71680 + F.wave * 8448));
    }
}
__device__ __forceinline__ void phase_attn_a(const Frame& F, const Args& a, int j) { phase_attn<0>(F, a, j); }
__device__ __forceinline__ void phase_attn_b(const Frame& F, const Args& a, int j) { phase_attn<1>(F, a, j); }

__device__ __forceinline__ float log_sigmoid(float x) { return fminf(x, 0.f) - __logf(1.0f + __expf(-fabsf(x))); }
__device__ __forceinline__ float wave_incl_scan_add(float v, int lane) {
#pragma unroll
    for (int o = 1; o < 64; o <<= 1) { const float t = __shfl_up(v, o); if (lane >= o) v += t; }
    return v;
}
__device__ __forceinline__ float wave_incl_scan_max(float v, int lane) {
#pragma unroll
    for (int o = 1; o < 64; o <<= 1) { const float t = __shfl_up(v, o); if (lane >= o) v = fmaxf(v, t); }
    return v;
}
__device__ __forceinline__ float wave_max(float v) {
#pragma unroll
    for (int o = 1; o < 64; o <<= 1) v = fmaxf(v, __shfl_xor(v, o));
    return v;
}
constexpr int B2_KWT = 0, B2_VT = 18432, B2_WS = 52224, B2_RAW = 56320, B2_OUT = 91904;
__device__ __forceinline__ int vt_col(int dv, int pair) { return (pair + (dv >> 5)) & 31; }
__device__ __forceinline__ void mlstm_fetch_v(const Frame& F, const bf16_t* QKV, int n0, int h, u32x4 (&v0)[2], u32x4 (&v1)[2]) {
#pragma unroll
    for (int i = 0; i < 2; ++i) { const int id = F.tid + 512 * i, ch = id & 31, pair = id >> 5;
        const bf16_t* p = QKV + (size_t)(n0 + 2 * pair) * 3072 + 1024 + h * 256 + 8 * ch;
        v0[i] = *(const GAS u32x4*)p; v1[i] = *(const GAS u32x4*)(p + 3072); }
}
__device__ __forceinline__ void mlstm_write_vT(const Frame& F, const u32x4 (&v0a)[2], const u32x4 (&v1a)[2], LAS unsigned* VT) {
#pragma unroll
    for (int i = 0; i < 2; ++i) { const int id = F.tid + 512 * i, ch = id & 31, pair = id >> 5; const u32x4 v0 = v0a[i], v1 = v1a[i];
        LAS unsigned* o = VT + (8 * ch) * 33 + ((pair + (ch >> 2)) & 31);
        o[0 * 33] = (v0.x & 0xffffu) | (v1.x << 16); o[1 * 33] = (v0.x >> 16) | (v1.x & 0xffff0000u);
        o[2 * 33] = (v0.y & 0xffffu) | (v1.y << 16); o[3 * 33] = (v0.y >> 16) | (v1.y & 0xffff0000u);
        o[4 * 33] = (v0.z & 0xffffu) | (v1.z << 16); o[5 * 33] = (v0.z >> 16) | (v1.z & 0xffff0000u);
        o[6 * 33] = (v0.w & 0xffffu) | (v1.w << 16); o[7 * 33] = (v0.w >> 16) | (v1.w & 0xffff0000u); }
}
__device__ __forceinline__ void mlstm_stage_vT(const Frame& F, const bf16_t* QKV, int n0, int h, LAS unsigned* VT) {
    u32x4 v0[2], v1[2]; mlstm_fetch_v(F, QKV, n0, h, v0, v1); mlstm_write_vT(F, v0, v1, VT);
}
__device__ __forceinline__ void phase_mlstm_local(const Frame& F, const Args& a, int j) {
    unsigned char* ws = a.ws; const bf16_t* QKV = (const bf16_t*)(ws + WS_QKV);
    const float* gates = (const float*)(ws + SM_GATES); const float* gb = a.in[10] + j * 8;
    const float* cw = a.in[8] + (size_t)j * 4 * 1024; const float* cb = a.in[9] + j * 1024;
    bf16_t* QC = (bf16_t*)(ws + WS_QC); bf16_t* KC = (bf16_t*)(ws + WS_KC);
    bf16_t* DC = (bf16_t*)(ws + WS_DC); float* DN = (float*)(ws + SM_DN); float* MLOC = (float*)(ws + SM_MLOC); float* BL = (float*)(ws + SM_BL);
    LAS unsigned char* KwT = F.lds + B2_KWT; LAS unsigned* VT = (LAS unsigned*)(F.lds + B2_VT); LAS float* wsm = (LAS float*)(F.lds + B2_WS);
    if (F.vcu >= 256) return;
    const int bh = F.vcu >> 5, sc = F.vcu & 31, b = bh >> 2, h = bh & 3, us = bh * 32 + sc;
    f32x4 Dacc[2][8], an = (f32x4){0.f, 0.f, 0.f, 0.f};
#pragma unroll
    for (int bt = 0; bt < 2; ++bt)
#pragma unroll
        for (int at = 0; at < 8; ++at) Dacc[bt][at] = (f32x4){0.f, 0.f, 0.f, 0.f};
    float mq = -__builtin_inff(), blsum = 0.f;
    LAS float* G2 = (LAS float*)(F.lds + B2_WS + 512);
    { const int w_ = F.wave, lane_ = F.lane; const int n0w = b * SEQ + (sc * 8 + w_) * 64;
        const float ipre = DBGG(gates[(size_t)(n0w + lane_) * 8 + h]) + gb[h]; const float fpre = DBGG(gates[(size_t)(n0w + lane_) * 8 + 4 + h]) + gb[4 + h];
        const float bs = wave_incl_scan_add(log_sigmoid(fpre), lane_); const float bL = __shfl(bs, 63);
        const float gs = bL - bs + ipre; const float ml = wave_max(gs);
        G2[w_ * 64 + lane_] = __expf(gs - ml);
        if (lane_ == 0) { G2[512 + 2 * w_] = bL; G2[512 + 2 * w_ + 1] = ml; } }
    u32x4 Rv0[2], Rv1[2], Rr[5];
    LAS unsigned char* raw = F.lds + B2_RAW;
#define B2_FETCH(FR, c_) do { _Pragma("unroll") for (int i = 0; i < 5; ++i) { const int p = FR.tid + 512 * i, r = p >> 5, hf = (p >> 4) & 1, c16 = p & 15; const int pos = (c_) * 64 - 3 + r; \
            Rr[i] = (u32x4){0u, 0u, 0u, 0u}; if (p < 67 * 32 && pos >= 0) Rr[i] = *(const GAS u32x4*)(QKV + (size_t)(b * SEQ + pos) * 3072 + hf * 512 + h * 128 + 8 * c16); } } while (0)
    B2_FETCH(F, sc * 8); mlstm_fetch_v(F, QKV, b * SEQ + sc * 8 * 64, h, Rv0, Rv1);
    for (int jc = 0; jc < 8; ++jc) {
        const Frame Fi = make_frame(F.lds);
        const int lane = Fi.lane, fr = lane & 15, fq = lane >> 4, w = Fi.wave;
        const int c = sc * 8 + jc, n0 = b * SEQ + c * 64;
        __syncthreads();
        if (Fi.tid < 64) { const int s = Fi.tid; const float bL = G2[512 + 2 * jc], ml = G2[512 + 2 * jc + 1];
            const float mn = fmaxf(bL + mq, ml); const float aa = __expf(bL + mq - mn), bb = __expf(ml - mn);
            wsm[s] = G2[jc * 64 + s] * bb;
            if (s == 0) wsm[64] = aa;
            mq = mn; blsum += bL; }
        mlstm_write_vT(Fi, Rv0, Rv1, VT);
#pragma unroll
        for (int i = 0; i < 5; ++i) { const int p = Fi.tid + 512 * i, r = p >> 5, hf = (p >> 4) & 1, c16 = p & 15; if (p < 67 * 32) *(LAS u32x4*)(raw + r * 528 + hf * 256 + c16 * 16) = Rr[i]; }
        if (jc + 1 < 8) { mlstm_fetch_v(Fi, QKV, b * SEQ + (c + 1) * 64, h, Rv0, Rv1); B2_FETCH(Fi, c + 1); }
        __syncthreads();
#pragma unroll
        for (int i = 0; i < 4; ++i) { const int id = Fi.tid + 512 * i, s = id & 63, ch = (id >> 6) & 15, isk = id >> 10;
            const int col = (isk ? 512 : 0) + h * 128 + 8 * ch;
            float accv[8];
#pragma unroll
            for (int e = 0; e < 8; ++e) accv[e] = cb[col + e];
#pragma unroll
            for (int jj = 0; jj < 4; ++jj) { const u32x4 x = *(const LAS u32x4*)(raw + (s + jj) * 528 + isk * 256 + ch * 16); const float* wj = cw + jj * 1024 + col;
                accv[0] += wj[0] * bflo(x.x); accv[1] += wj[1] * bfhi(x.x); accv[2] += wj[2] * bflo(x.y); accv[3] += wj[3] * bfhi(x.y);
                accv[4] += wj[4] * bflo(x.z); accv[5] += wj[5] * bfhi(x.z); accv[6] += wj[6] * bflo(x.w); accv[7] += wj[7] * bfhi(x.w); }
            const float scq = isk ? 0.08838834764831845f : 1.0f;
#pragma unroll
            for (int e = 0; e < 8; ++e) { const float v = accv[e]; accv[e] = v * fast_rcp(1.0f + __expf(-v)) * scq; }
            u32x4 o; o.x = cvt_pk_bf16(accv[0], accv[1]); o.y = cvt_pk_bf16(accv[2], accv[3]); o.z = cvt_pk_bf16(accv[4], accv[5]); o.w = cvt_pk_bf16(accv[6], accv[7]);
            *(LAS u32x4*)(F.lds + B2_OUT + isk * 17408 + s * 272 + ch * 16) = o;
            if (isk) { const float wv = wsm[s];
#pragma unroll
                for (int e = 0; e < 8; ++e) *(LAS bf16_t*)(KwT + (8 * ch + e) * 144 + 2 * s) = (bf16_t)f2bf(accv[e] * wv); } }
        __syncthreads();
#pragma unroll
        for (int i = 0; i < 4; ++i) { const int id = Fi.tid + 512 * i, c16 = id & 15, s = (id >> 4) & 63, isk = id >> 10;
            *(GAS u32x4*)((isk ? KC : QC) + ((size_t)(b * 4 + h) * SEQ + c * 64 + s) * 128 + 8 * c16) = *(const LAS u32x4*)(F.lds + B2_OUT + isk * 17408 + s * 272 + c16 * 16); }
        const float aa = wsm[64];
        bf16x8 Bv[2][2];
#pragma unroll
        for (int bt = 0; bt < 2; ++bt)
#pragma unroll
            for (int kk = 0; kk < 2; ++kk) { const int dvr = 16 * (2 * w + bt) + fr; const LAS unsigned* vp = VT + dvr * 33; const int p0 = 4 * fq + 16 * kk; Bv[bt][kk] = mk_frag(vp[vt_col(dvr, p0)], vp[vt_col(dvr, p0 + 1)], vp[vt_col(dvr, p0 + 2)], vp[vt_col(dvr, p0 + 3)]); }
        an *= aa;
#pragma unroll
        for (int at = 0; at < 8; ++at) {
            const LAS unsigned char* kp = KwT + (16 * at + fr) * 144 + 16 * fq;
            const bf16x8 A0 = ld_frag_lds(kp), A1 = ld_frag_lds(kp + 64);
#pragma unroll
            for (int bt = 0; bt < 2; ++bt) { f32x4 d = Dacc[bt][at] * aa; d = MFMA16(A0, Bv[bt][0], d); d = MFMA16(A1, Bv[bt][1], d); Dacc[bt][at] = d; }
            if (at == w) {
                const bf16x8 ones = mk_frag(0x3f803f80u, 0x3f803f80u, 0x3f803f80u, 0x3f803f80u);
                an = MFMA16(A0, ones, an); an = MFMA16(A1, ones, an); }
        }
    }
    { const int lane = F.lane, fr = lane & 15, fq = lane >> 4, w = F.wave;
        bf16_t* dcu = DC + (size_t)us * 32768;
#pragma unroll
        for (int bt = 0; bt < 2; ++bt)
#pragma unroll
            for (int at = 0; at < 8; ++at) { const f32x4 d = Dacc[bt][at]; u32x2 wv; wv.x = cvt_pk_bf16(d[0], d[1]); wv.y = cvt_pk_bf16(d[2], d[3]);
                *(GAS u32x2*)(dcu + (size_t)(16 * (2 * w + bt) + fr) * 128 + 16 * at + 4 * fq) = wv; }
        if (fr == 0) *(GAS f32x4*)(DN + (size_t)us * 128 + 16 * w + 4 * fq) = an;
        if (F.tid == 0) { MLOC[us] = mq; BL[us] = blsum; } }
#undef B2_FETCH
}
__device__ __forceinline__ void phase_mlstm_scan(const Frame& F, const Args& a) {
    unsigned char* ws = a.ws;
    if (F.vcu >= 256 || F.tid >= 256) return;
    const int bh = F.vcu >> 5, part = F.vcu & 31; const size_t eoff = (size_t)part * 1024 + F.tid * 4;
    const bf16_t* DC = (const bf16_t*)(ws + WS_DC); bf16_t* CS = (bf16_t*)(ws + WS_CS);
    const float* DN = (const float*)(ws + SM_DN); float* NS = (float*)(ws + SM_NS);
    const float* MLOC = (const float*)(ws + SM_MLOC); const float* BL = (const float*)(ws + SM_BL); float* MPREV = (float*)(ws + SM_MPREV);
    const bool doN = (part == 0) && (F.tid < 128);
    float st[4] = {0.f, 0.f, 0.f, 0.f}, nst = 0.f, m = 0.f;
    u32x2 dcA[8], dcB[8]; float blA[8], mlA[8], dnA[8], blB[8], mlB[8], dnB[8];
#define B3_LOAD(dc, bl, ml, dn, c0) do { _Pragma("unroll") for (int i = 0; i < 8; ++i) { const int u = bh * 32 + (c0) + i; dc[i] = *(const GAS u32x2*)(DC + (size_t)u * 32768 + eoff); bl[i] = BL[u]; ml[i] = MLOC[u]; dn[i] = doN ? DN[(size_t)u * 128 + F.tid] : 0.f; } } while (0)
#define B3_STEP(dc, bl, ml, dn, c0) do { _Pragma("unroll") for (int i = 0; i < 8; ++i) { const int u = bh * 32 + (c0) + i; \
            u32x2 o; o.x = cvt_pk_bf16(st[0], st[1]); o.y = cvt_pk_bf16(st[2], st[3]); \
            *(GAS u32x2*)(CS + (size_t)u * 32768 + eoff) = o; \
            if (doN) NS[(size_t)u * 128 + F.tid] = nst; \
            if (part == 0 && F.tid == 0) MPREV[u] = m; \
            const float mn = fmaxf(bl[i] + m, ml[i]); const float aa = __expf(bl[i] + m - mn), bb = __expf(ml[i] - mn); \
            st[0] = aa * st[0] + bb * bflo(dc[i].x); st[1] = aa * st[1] + bb * bfhi(dc[i].x); st[2] = aa * st[2] + bb * bflo(dc[i].y); st[3] = aa * st[3] + bb * bfhi(dc[i].y); \
            nst = aa * nst + bb * dn[i]; m = mn; } } while (0)
    B3_LOAD(dcA, blA, mlA, dnA, 0);
    for (int c0 = 0; c0 < 32; c0 += 16) {
        B3_LOAD(dcB, blB, mlB, dnB, c0 + 8);
        B3_STEP(dcA, blA, mlA, dnA, c0);
        if (c0 + 16 < 32) B3_LOAD(dcA, blA, mlA, dnA, c0 + 16);
        B3_STEP(dcB, blB, mlB, dnB, c0 + 8);
    }
#undef B3_LOAD
#undef B3_STEP
}
constexpr int B4_QS = 0, B4_KS = 17408, B4_VT = 34816, B4_SS = 68608, B4_SC = 77824, B4_KWT = 86016, B4_G = 104448;
__device__ __forceinline__ void phase_mlstm_out(const Frame& F, const Args& a, int j) {
    unsigned char* ws = a.ws; const bf16_t* QKV = (const bf16_t*)(ws + WS_QKV);
    const float* gates = (const float*)(ws + SM_GATES); const float* gb = a.in[10] + j * 8; const float* hg = a.in[11] + (size_t)j * 1024;
    const bf16_t* QC = (const bf16_t*)(ws + WS_QC); const bf16_t* KC = (const bf16_t*)(ws + WS_KC);
    const bf16_t* CS = (const bf16_t*)(ws + WS_CS); const float* NS = (const float*)(ws + SM_NS); const float* MPREV = (const float*)(ws + SM_MPREV);
    bf16_t* OB = (bf16_t*)(ws + WS_OB);
    LAS unsigned char* Qs = F.lds + B4_QS; LAS unsigned char* Ks = F.lds + B4_KS; LAS unsigned* VT = (LAS unsigned*)(F.lds + B4_VT); LAS unsigned char* Ss = F.lds + B4_SS; LAS unsigned char* KwT = F.lds + B4_KWT;
    LAS float* us = (LAS float*)(F.lds + B4_SC); LAS float* Ms = us + 64; LAS float* wint = us + 128; LAS float* eneg = us + 192; LAS float* npv = us + 256; LAS float* den = us + 384  ; LAS float* qn = us + 640  ; LAS float* hss = us + 1152  ;
    LAS float* wk = us + 1664  ; LAS float* scal = us + 1728;
    const int lane = F.lane, fr = lane & 15, fq = lane >> 4, w = F.wave;
    if (F.vcu >= 256) return;
    const int bh = F.vcu >> 5, sc = F.vcu & 31, b = bh >> 2, h = bh & 3;
    const int us0 = bh * 32 + sc;
    f32x4 Cst[2][8];
#pragma unroll
    for (int bt = 0; bt < 2; ++bt)
#pragma unroll
        for (int at = 0; at < 8; ++at) { const u32x2 x = *(const GAS u32x2*)(CS + (size_t)us0 * 32768 + (size_t)(16 * (2 * w + bt) + fr) * 128 + 16 * at + 4 * fq);
            Cst[bt][at] = (f32x4){bflo(x.x), bfhi(x.x), bflo(x.y), bfhi(x.y)}; }
    float mcur = MPREV[us0];
    LAS float* G4 = (LAS float*)(F.lds + B4_G);
    { const int n0w = b * SEQ + (sc * 8 + w) * 64;
        const float ipre = DBGG(gates[(size_t)(n0w + lane) * 8 + h]) + gb[h]; const float fpre = DBGG(gates[(size_t)(n0w + lane) * 8 + 4 + h]) + gb[4 + h];
        const float bs = wave_incl_scan_add(log_sigmoid(fpre), lane); const float uu = ipre - bs; const float pm = wave_incl_scan_max(uu, lane);
        const float bL = __shfl(bs, 63); const float gs = bL - bs + ipre; const float ml = wave_max(gs);
        G4[(w * 4 + 0) * 64 + lane] = bs; G4[(w * 4 + 1) * 64 + lane] = uu; G4[(w * 4 + 2) * 64 + lane] = pm; G4[(w * 4 + 3) * 64 + lane] = __expf(gs - ml);
        if (lane == 0) { G4[2048 + 2 * w] = bL; G4[2048 + 2 * w + 1] = ml; } }
    if (F.tid >= 64 && F.tid < 192) npv[F.tid - 64] = NS[(size_t)us0 * 128 + F.tid - 64];
    u32x4 Rqk[4], Rv0[2], Rv1[2];
#define B4_FETCH(FR, c_) do { const int n0_ = b * SEQ + (c_) * 64; \
        _Pragma("unroll") for (int i = 0; i < 4; ++i) { const int id = FR.tid + 512 * i, ch = id & 15, s = (id >> 4) & 63, isk = id >> 10; \
            Rqk[i] = *(const GAS u32x4*)((isk ? KC : QC) + ((size_t)(b * 4 + h) * SEQ + (c_) * 64 + s) * 128 + 8 * ch); } \
        mlstm_fetch_v(FR, QKV, n0_, h, Rv0, Rv1); } while (0)
    B4_FETCH(F, sc * 8);
    for (int jc = 0; jc < 8; ++jc) {
        const Frame Fi = make_frame(F.lds);
        const int lane = Fi.lane, fr = lane & 15, fq = lane >> 4, w = Fi.wave;
        const int c = sc * 8 + jc, n0 = b * SEQ + c * 64;
        __syncthreads();
        if (Fi.tid < 64) { const int s = Fi.tid; const float bs = G4[(jc * 4 + 0) * 64 + s], uu = G4[(jc * 4 + 1) * 64 + s], pm = G4[(jc * 4 + 2) * 64 + s];
            const float mp = mcur; const float M = fmaxf(mp, pm);
            us[s] = uu; Ms[s] = M; wint[s] = __expf(mp - M); eneg[s] = __expf(-(bs + M));
            const float bL = G4[2048 + 2 * jc], ml = G4[2048 + 2 * jc + 1];
            const float mn = fmaxf(bL + mp, ml); const float aa = __expf(bL + mp - mn), bb = __expf(ml - mn);
            wk[s] = G4[(jc * 4 + 3) * 64 + s] * bb;
            if (s == 0) scal[0] = aa;
            mcur = mn; }
#pragma unroll
        for (int i = 0; i < 4; ++i) { const int id = Fi.tid + 512 * i, ch = id & 15, s = (id >> 4) & 63, isk = id >> 10;
            *(LAS u32x4*)((isk ? Ks : Qs) + s * 272 + ch * 16) = Rqk[i]; }
        mlstm_write_vT(Fi, Rv0, Rv1, VT);
        if (jc + 1 < 8) B4_FETCH(Fi, c + 1);
        __syncthreads();
        u32x2 ogv[4][2]; f32x4 hgv[2];
#pragma unroll
        for (int dv = 0; dv < 2; ++dv) { const int col = h * 256 + 16 * (2 * w + dv) + 4 * fq; hgv[dv] = *(const GAS f32x4*)(hg + col);
#pragma unroll
            for (int tt = 0; tt < 4; ++tt) ogv[tt][dv] = *(const GAS u32x2*)(QKV + (size_t)(n0 + 16 * tt + fr) * 3072 + 2048 + col); }
#pragma unroll
        for (int i = 0; i < 2; ++i) { const int id = Fi.tid + 512 * i, s = id & 63, ch = id >> 6; const u32x4 kx = *(const LAS u32x4*)(Ks + s * 272 + ch * 16); const float wv = wk[s];
            LAS unsigned char* o = KwT + (8 * ch) * 144 + 2 * s;
            *(LAS bf16_t*)(o + 0 * 144) = (bf16_t)f2bf(bflo(kx.x) * wv); *(LAS bf16_t*)(o + 1 * 144) = (bf16_t)f2bf(bfhi(kx.x) * wv);
            *(LAS bf16_t*)(o + 2 * 144) = (bf16_t)f2bf(bflo(kx.y) * wv); *(LAS bf16_t*)(o + 3 * 144) = (bf16_t)f2bf(bfhi(kx.y) * wv);
            *(LAS bf16_t*)(o + 4 * 144) = (bf16_t)f2bf(bflo(kx.z) * wv); *(LAS bf16_t*)(o + 5 * 144) = (bf16_t)f2bf(bfhi(kx.z) * wv);
            *(LAS bf16_t*)(o + 6 * 144) = (bf16_t)f2bf(bflo(kx.w) * wv); *(LAS bf16_t*)(o + 7 * 144) = (bf16_t)f2bf(bfhi(kx.w) * wv); }
#pragma unroll
        for (int q2 = 0; q2 < 2; ++q2) { const int idx = 2 * w + q2, st = idx >> 2, tt = idx & 3;
            f32x4 sacc = (f32x4){0.f, 0.f, 0.f, 0.f};
            if (st <= tt) {
#pragma unroll
                for (int kk = 0; kk < 4; ++kk) sacc = MFMA16(ld_frag_lds(Ks + (16 * st + fr) * 272 + 16 * fq + 64 * kk), ld_frag_lds(Qs + (16 * tt + fr) * 272 + 16 * fq + 64 * kk), sacc);
            }
            const int t = 16 * tt + fr; const float Mt = Ms[t]; float p[4], rsum = 0.f;
#pragma unroll
            for (int i = 0; i < 4; ++i) { const int s = 16 * st + 4 * fq + i; p[i] = (s <= t) ? sacc[i] * __expf(us[s] - Mt) : 0.f; rsum += p[i]; }
            u32x2 wv; wv.x = cvt_pk_bf16(p[0], p[1]); wv.y = cvt_pk_bf16(p[2], p[3]);
            *(LAS u32x2*)(Ss + t * 144 + (16 * st + 4 * fq) * 2) = wv;
            rsum += __shfl_xor(rsum, 16); rsum += __shfl_xor(rsum, 32);
            if (fq == 0) den[st * 64 + t] = rsum; }
        { const int t = Fi.tid & 63, pp = Fi.tid >> 6; const LAS bf16_t* qr = (const LAS bf16_t*)(Qs + t * 272) + 16 * pp; float sacc = 0.f;
#pragma unroll
            for (int e = 0; e < 16; ++e) sacc += bf2f(qr[e]) * npv[16 * pp + e];
            qn[pp * 64 + t] = sacc; }
        __syncthreads();
        f32x4 acc[2][4];
#pragma unroll
        for (int dv = 0; dv < 2; ++dv)
#pragma unroll
            for (int tt = 0; tt < 4; ++tt) acc[dv][tt] = (f32x4){0.f, 0.f, 0.f, 0.f};
#pragma unroll
        for (int kk = 0; kk < 4; ++kk) {
            bf16x8 Bq[4];
#pragma unroll
            for (int tt = 0; tt < 4; ++tt) { const LAS unsigned char* qp = Qs + (16 * tt + fr) * 272 + 64 * kk + 8 * fq; const u32x2 lo = *(const LAS u32x2*)qp, hi = *(const LAS u32x2*)(qp + 32); Bq[tt] = mk_frag(lo.x, lo.y, hi.x, hi.y); }
#pragma unroll
            for (int dv = 0; dv < 2; ++dv) { const f32x4 c0 = Cst[dv][2 * kk], c1 = Cst[dv][2 * kk + 1];
                const bf16x8 Ac = mk_frag(cvt_pk_bf16(c0[0], c0[1]), cvt_pk_bf16(c0[2], c0[3]), cvt_pk_bf16(c1[0], c1[1]), cvt_pk_bf16(c1[2], c1[3]));
#pragma unroll
                for (int tt = 0; tt < 4; ++tt) acc[dv][tt] = MFMA16(Ac, Bq[tt], acc[dv][tt]); }
            __builtin_amdgcn_sched_barrier(0);
        }
#pragma unroll
        for (int tt = 0; tt < 4; ++tt) { const float wi = wint[16 * tt + fr];
#pragma unroll
            for (int dv = 0; dv < 2; ++dv) acc[dv][tt] *= wi; }
#pragma unroll
        for (int kk = 0; kk < 2; ++kk) {
            bf16x8 Bs[4], Avk[2];
#pragma unroll
            for (int dv = 0; dv < 2; ++dv) { const int dvr = 16 * (2 * w + dv) + fr; const LAS unsigned* vp = VT + dvr * 33; const int p0 = 4 * fq + 16 * kk; Avk[dv] = mk_frag(vp[vt_col(dvr, p0)], vp[vt_col(dvr, p0 + 1)], vp[vt_col(dvr, p0 + 2)], vp[vt_col(dvr, p0 + 3)]); }
#pragma unroll
            for (int tt = 0; tt < 4; ++tt) Bs[tt] = ld_frag_lds(Ss + (16 * tt + fr) * 144 + 16 * fq + 64 * kk);
#pragma unroll
            for (int dv = 0; dv < 2; ++dv)
#pragma unroll
                for (int tt = 0; tt < 4; ++tt) acc[dv][tt] = MFMA16(Avk[dv], Bs[tt], acc[dv][tt]);
            __builtin_amdgcn_sched_barrier(0);
        }
#pragma unroll
        for (int tt = 0; tt < 4; ++tt) { const int t = 16 * tt + fr; const float qnt = ((qn[t] + qn[64 + t]) + (qn[128 + t] + qn[192 + t])) + ((qn[256 + t] + qn[320 + t]) + (qn[384 + t] + qn[448 + t]));
            const float dn = ((den[t] + den[64 + t]) + (den[128 + t] + den[192 + t])) + wint[t] * qnt; const float inv = 1.0f / fmaxf(fabsf(dn), eneg[t]);
            float q = 0.f;
#pragma unroll
            for (int dv = 0; dv < 2; ++dv) { acc[dv][tt] *= inv; const f32x4 v = acc[dv][tt] * acc[dv][tt]; q += (v[0] + v[1]) + (v[2] + v[3]); }
            q += __shfl_xor(q, 16); q += __shfl_xor(q, 32);
            if (fq == 0) hss[w * 64 + t] = q; }
        __syncthreads();
#pragma unroll
        for (int tt = 0; tt < 4; ++tt) { const int t = 16 * tt + fr; const float hs = ((hss[t] + hss[64 + t]) + (hss[128 + t] + hss[192 + t])) + ((hss[256 + t] + hss[320 + t]) + (hss[384 + t] + hss[448 + t]));
            const float rst = 1.0f / sqrtf(hs * (1.0f / 256.0f) + EPS);
#pragma unroll
            for (int dv = 0; dv < 2; ++dv) { const int col = h * 256 + 16 * (2 * w + dv) + 4 * fq;
                const u32x2 og = ogv[tt][dv]; const f32x4 g4 = hgv[dv];
                const float o0 = acc[dv][tt][0] * rst * g4[0] * fast_rcp(1.0f + __expf(-bflo(og.x))), o1 = acc[dv][tt][1] * rst * g4[1] * fast_rcp(1.0f + __expf(-bfhi(og.x)));
                const float o2 = acc[dv][tt][2] * rst * g4[2] * fast_rcp(1.0f + __expf(-bflo(og.y))), o3 = acc[dv][tt][3] * rst * g4[3] * fast_rcp(1.0f + __expf(-bfhi(og.y)));
                u32x2 wv; wv.x = cvt_pk_bf16(o0, o1); wv.y = cvt_pk_bf16(o2, o3);
                *(GAS u32x2*)(OB + (size_t)(n0 + t) * DM + col) = wv; } }
        { const float aa = scal[0];
            bf16x8 Avk[2][2];
#pragma unroll
            for (int kk = 0; kk < 2; ++kk)
#pragma unroll
                for (int dv = 0; dv < 2; ++dv) { const int dvr = 16 * (2 * w + dv) + fr; const LAS unsigned* vp = VT + dvr * 33; const int p0 = 4 * fq + 16 * kk; Avk[kk][dv] = mk_frag(vp[vt_col(dvr, p0)], vp[vt_col(dvr, p0 + 1)], vp[vt_col(dvr, p0 + 2)], vp[vt_col(dvr, p0 + 3)]); }
#pragma unroll
            for (int bt = 0; bt < 2; ++bt)
#pragma unroll
                for (int at = 0; at < 8; ++at) Cst[bt][at] *= aa;
#pragma unroll
            for (int at = 0; at < 8; ++at) { const LAS unsigned char* kp = KwT + (16 * at + fr) * 144 + 16 * fq; const bf16x8 A0 = ld_frag_lds(kp), A1 = ld_frag_lds(kp + 64);
#pragma unroll
                for (int bt = 0; bt < 2; ++bt) { Cst[bt][at] = MFMA16(A0, Avk[0][bt], Cst[bt][at]); Cst[bt][at] = MFMA16(A1, Avk[1][bt], Cst[bt][at]); } }
            if (Fi.tid >= 64 && Fi.tid < 192) { const int dk = Fi.tid - 64; const LAS unsigned char* kr = KwT + dk * 144; float sum = 0.f;
#pragma unroll
                for (int q8 = 0; q8 < 8; ++q8) { const u32x4 x = *(const LAS u32x4*)(kr + 16 * q8); sum += ((bflo(x.x) + bfhi(x.x)) + (bflo(x.y) + bfhi(x.y))) + ((bflo(x.z) + bfhi(x.z)) + (bflo(x.w) + bfhi(x.w))); }
                npv[dk] = aa * npv[dk] + sum; } }
    }
#undef B4_FETCH
}


#ifdef PROBE_BUF
__device__ __forceinline__ void probe_scan(const Frame& F, const Args& a) {
    unsigned* ctl = (unsigned*)(a.ws + WS_CTL);
    unsigned bad = 0; float ms = 0.f;
    for (size_t i = (size_t)F.vcu * 512 + F.tid; i < (size_t)(PROBE_N); i += (size_t)F.G * 512) {
        float v;
        if (PROBE_KIND == 0) v = bf2f(((const bf16_t*)(a.ws + PROBE_BUF))[i]); else v = ((const float*)(a.ws + PROBE_BUF))[i];
        if (fabsf(v) < 1e30f) ms += v * v; else ++bad;
    }
    if (PROBE_STAT == 2) { bad = 0; ms = 0.f;
        for (int u = F.vcu * 8 + F.wave; u < (int)((PROBE_N) / 32768); u += F.G * 8) { unsigned b2 = 0;
            for (int i = F.lane; i < 32768; i += 64) { const float v = bf2f(((const bf16_t*)(a.ws + PROBE_BUF))[(size_t)u * 32768 + i]); if (!(fabsf(v) < 1e30f)) b2 = 1; }
            b2 = __any(b2) ? 1u : 0u; if (F.lane == 0) bad += b2 * 32768u; } }
    atomicAdd(ctl + 20000, bad); atomicAdd((float*)(ctl + 20064), ms);
}
__device__ __forceinline__ void probe_fill(const Frame& F, const Args& a) {
    const unsigned* ctl = (const unsigned*)(a.ws + WS_CTL);
    const float f = (float)ctl[20000] / (float)(PROBE_N), msq = ((const float*)ctl)[20064] / (float)(PROBE_N);
    const float c = sqrtf(PROBE_STAT != 1 ? 10.0f * f : msq);
    for (size_t i = (size_t)F.vcu * 512 + F.tid; i < (size_t)NTOK * DM; i += (size_t)F.G * 512) a.out[i] = c;
}
#endif
constexpr int NPHASE = 1 + NLAYER * 10;

typedef const __attribute__((address_space(4))) Args* KArgsPtr;
__device__ __forceinline__ Args opaque_args() {
#if defined(__HIP_DEVICE_COMPILE__)
    KArgsPtr p = (KArgsPtr)__builtin_amdgcn_kernarg_segment_ptr(); asm volatile("" : "+s"(p)); return *p;
#else
    return Args{};
#endif
}
#define SITE() const Frame FP = make_frame(lds); const Args A = opaque_args(); unsigned char* const ws = A.ws; (void)ws
__global__ void __launch_bounds__(512, 2) mk_fwd(Args args) {
    extern __shared__ __attribute__((aligned(16))) unsigned char lds_raw[];
    LAS unsigned char* const lds = (LAS unsigned char*)lds_raw;
    volatile LAS unsigned* MISC = (volatile LAS unsigned*)(lds + MISC_OFF);
    if (threadIdx.x < 32) MISC[threadIdx.x] = 0u;
    __syncthreads();
    const int lo = args.ph_lo, hi = args.ph_hi;
    XcdBarrier bar; bar.bar = (unsigned*)(args.ws + WS_CTL) + CW_BAR; bar.x = 0; bar.st = nullptr;
    if (hi - lo > 1) bar = xcd_barrier_post((unsigned*)(args.ws + WS_CTL) + CW_BAR, MISC + 8);
#define IN(k) (lo <= (k) && (k) < hi)
#ifdef XBAR_EXTRA
#define SEAM(k) do { if (IN(k) && IN((k) + 1)) { xcd_barrier(bar); xcd_barrier(bar); } } while (0)
#else
#define SEAM(k) do { if (IN(k) && IN((k) + 1)) xcd_barrier(bar); } while (0)
#endif
    if (PHON(0) && IN(0)) for (int rep_ = 0; rep_ < NREP(0); ++rep_) { SITE(); p0_weights(FP, A); phase_x0(FP, A); }
    SEAM(0);
    for (int l = 0; l < NLAYER; ++l) {
        const int pb = 1 + l * 10, j = l >> 1;
        if ((l & 1) == 0) {
            if (PHON(1) && IN(pb)) for (int rep_ = 0; rep_ < NREP(1); ++rep_) { SITE(); pg8::Gemm g{(const bf16_t*)(ws + WS_XB), (const bf16_t*)(ws + WS_WQKV) + (size_t)j * 3072 * DM, DM, 0, nullptr, nullptr, nullptr};
                pg8::StaticOrder S; S.init(NTOK / 256, 12, FP.G, (int)blockIdx.x, nullptr);
                pg8::EpiQKV E{(bf16_t*)(ws + WS_QKV), (const float*)(ws + SM_RSTD), A.in[4] + j * 64, A.in[5] + j * 64, 0.125f * LOG2E};
                pg8::gemm_phase<pg8::EpiQKV, true, false>(lds, FP.tid, g, S, E); }
            SEAM(pb);
            if (PHON(2) && IN(pb + 1)) for (int rep_ = 0; rep_ < NREP(2); ++rep_) { SITE(); phase_attn_a(FP, A, j); }
            SEAM(pb + 1);
            if (PHON(3) && IN(pb + 2)) for (int rep_ = 0; rep_ < NREP(3); ++rep_) { SITE(); phase_attn_b(FP, A, j); }
            if (IN(pb + 2) && IN(pb + 4)) xcd_barrier(bar);
            if (PHON(4) && IN(pb + 4)) { SITE(); pg8::Gemm g{(const bf16_t*)(ws + WS_OB), (const bf16_t*)(ws + WS_WO) + (size_t)j * DM * DM, DM, 0, nullptr, nullptr, nullptr};
                pg8::StaticOrder S; S.init(NTOK / 256, 4, FP.G, (int)blockIdx.x, nullptr);
                pg8::EpiResidB E{(bf16_t*)(ws + WS_XB)};
                pg8::gemm_phase<pg8::EpiResidB, true, false, true>(lds, FP.tid, g, S, E); }
            SEAM(pb + 4);
        } else {
            if (PHON(5) && IN(pb)) for (int rep_ = 0; rep_ < NREP(5); ++rep_) { SITE(); pg8::Gemm g{(const bf16_t*)(ws + WS_XB), (const bf16_t*)(ws + WS_WIN) + (size_t)j * 3072 * DM, DM, 0, nullptr, nullptr, nullptr};
                pg8::StaticOrder S; S.init(NTOK / 256, 12, FP.G, (int)blockIdx.x, nullptr);
                pg8::EpiBf16 E{(bf16_t*)(ws + WS_QKV), 3072, (const float*)(ws + SM_RSTD)};
                pg8::gemm_phase<pg8::EpiBf16, true, false>(lds, FP.tid, g, S, E); }
            SEAM(pb);
            if (PHON(6) && IN(pb + 1)) for (int rep_ = 0; rep_ < NREP(6); ++rep_) { SITE(); phase_mlstm_local(FP, A, j); }
            SEAM(pb + 1);
            if (PHON(7) && IN(pb + 2)) for (int rep_ = 0; rep_ < NREP(7); ++rep_) { SITE(); phase_mlstm_scan(FP, A); }
            SEAM(pb + 2);
            if (PHON(8) && IN(pb + 3)) for (int rep_ = 0; rep_ < NREP(8); ++rep_) { SITE(); phase_mlstm_out(FP, A, j); }
            SEAM(pb + 3);
            if (PHON(9) && IN(pb + 4)) { SITE(); pg8::Gemm g{(const bf16_t*)(ws + WS_OB), (const bf16_t*)(ws + WS_WMO) + (size_t)j * DM * DM, DM, 0, nullptr, nullptr, nullptr};
                pg8::StaticOrder S; S.init(NTOK / 256, 4, FP.G, (int)blockIdx.x, nullptr);
                pg8::EpiResidB E{(bf16_t*)(ws + WS_XB)};
                pg8::gemm_phase<pg8::EpiResidB, true, false>(lds, FP.tid, g, S, E); }
            SEAM(pb + 4);
        }
        if (PHON(10) && IN(pb + 5)) for (int rep_ = 0; rep_ < NREP(10); ++rep_) { SITE(); phase_router(FP, A, l, rep_ + 1 < NREP(10)); }
        if (IN(pb + 5) && IN(pb + 7)) xcd_barrier(bar);
        if (PHON(12) && IN(pb + 7)) for (int rep_ = 0; rep_ < NREP(12); ++rep_) { SITE();
            LAS int* pst = (LAS int*)(lds + MOE_TAB_OFF); LAS int* cnt = (LAS int*)(lds + MOE_TAB_OFF + 512);
            const int ntiles = __builtin_amdgcn_readfirstlane(moe_tables(FP, (const unsigned*)(ws + WS_CTL) + CW_CNT + l * 64, pst, cnt));
            pg8::Gemm g{(const bf16_t*)(ws + WS_XB), (const bf16_t*)(ws + WS_WGU) + (size_t)l * 64 * DM * DM, DM, (size_t)DM * DM * 2, (const int*)(ws + WS_QC), pst, cnt};
            pg8::StaticOrder S; S.init(ntiles, 4, FP.G, (int)blockIdx.x, pst);
            pg8::EpiGU E{(bf16_t*)(ws + WS_ACT), (const float*)(ws + SM_RSTD), (const int*)(ws + WS_QC), pst, cnt};
            pg8::gemm_phase<pg8::EpiGU, true, true>(lds, FP.tid, g, S, E); }
        SEAM(pb + 7);
        if (PHON(13) && IN(pb + 8)) for (int rep_ = 0; rep_ < NREP(13); ++rep_) { SITE();
            LAS int* pst = (LAS int*)(lds + MOE_TAB_OFF); LAS int* cnt = (LAS int*)(lds + MOE_TAB_OFF + 512);
            const int ntiles = __builtin_amdgcn_readfirstlane(moe_tables(FP, (const unsigned*)(ws + WS_CTL) + CW_CNT + l * 64, pst, cnt));
            pg8::Gemm g{(const bf16_t*)(ws + WS_ACT), (const bf16_t*)(ws + WS_WD) + (size_t)l * 64 * DM * FFE, FFE, (size_t)DM * FFE * 2, nullptr, pst, cnt};
            pg8::StaticOrder S; S.init(ntiles, 4, FP.G, (int)blockIdx.x, pst);
            pg8::EpiBf16 E{(bf16_t*)(ws + WS_YB), DM, nullptr};
            pg8::gemm_phase<pg8::EpiBf16, true, false>(lds, FP.tid, g, S, E); }
        SEAM(pb + 8);
        if (PHON(14) && IN(pb + 9)) { SITE(); phase_combine(FP, A, l); }
        SEAM(pb + 9);
    }
#ifdef PROBE_BUF
    if (IN(NPHASE)) { SITE(); probe_scan(FP, A); }
    if (IN(NPHASE + 1)) { SITE(); probe_fill(FP, A); }
#endif
#undef IN
#undef SEAM
}

extern "C" void kernel_launch(void* const* d_in, const int* in_sizes, int n_in, void* d_out, int out_size, void* d_ws, size_t ws_size, hipStream_t stream) {
    static int grid = 0;
    if (grid == 0) {
        if (n_in != 20 || out_size != NTOK * DM || ws_size < WS_END) { fprintf(stderr, "kernel_launch: unexpected shapes (n_in %d, out %d, ws %zu < %zu); nothing launched\n", n_in, out_size, ws_size, (size_t)WS_END); grid = -1; return; }
        int dev = 0, cus = 0, per_cu = 0;
        if (hipGetDevice(&dev) != hipSuccess || hipDeviceGetAttribute(&cus, hipDeviceAttributeMultiprocessorCount, dev) != hipSuccess) { grid = -1; return; }
        if (hipFuncSetAttribute((const void*)mk_fwd, hipFuncAttributeMaxDynamicSharedMemorySize, LDS_BYTES) != hipSuccess) { fprintf(stderr, "kernel_launch: hipFuncSetAttribute failed\n"); grid = -1; return; }
        if (hipOccupancyMaxActiveBlocksPerMultiprocessor(&per_cu, (const void*)mk_fwd, 512, LDS_BYTES) != hipSuccess || per_cu < 1) { fprintf(stderr, "kernel_launch: occupancy query says %d\n", per_cu); }
        (void)hipGetLastError();
        grid = cus;
        if (grid != 256) { fprintf(stderr, "kernel_launch: built for a 256-CU device, found %d CUs; nothing launched\n", cus); grid = -1; return; }
    }
    if (grid < 0) return;
    if (hipMemsetAsync((char*)d_ws + WS_CTL, 0, CTL_ZERO_BYTES, stream) != hipSuccess) return;
    Args a{};
    for (int i = 0; i < 20; ++i) a.in[i] = (const float*)d_in[i];
    a.out = (float*)d_out; a.ws = (unsigned char*)d_ws;
#if MK_ONE_LAUNCH
    a.ph_lo = 0; a.ph_hi = NPHASE;
    hipLaunchKernelGGL(mk_fwd, dim3(grid), dim3(512), LDS_BYTES, stream, a);
#else
    int np = NPHASE;
#ifdef PROBE_BUF
    np += 2;
#endif
    for (int p = 0; p < np; ++p) { a.ph_lo = p; a.ph_hi = p + 1; hipLaunchKernelGGL(mk_fwd, dim3(grid), dim3(512), LDS_BYTES, stream, a); }
#endif
}
```

```cpp
#include <hip/hip_runtime.h>
#include <cstdio>
#include <cstdint>

#ifndef MK_ONE_LAUNCH
#define MK_ONE_LAUNCH 1
#endif

#ifndef PHMASK
#define PHMASK 0xFFFFFFFFu
#endif
#define PHON(n) ((PHMASK >> (n)) & 1u)
#ifndef REPMASK
#define REPMASK 0u
#endif
#define NREP(n) (1 + (int)((REPMASK >> (n)) & 1u))
#ifdef DBG_NOGATES
#define DBGG(x) 0.0f
#else
#define DBGG(x) (x)
#endif

#define LAS __attribute__((address_space(3)))
#define GAS __attribute__((address_space(1)))
typedef unsigned short bf16_t;
typedef short bf16x8 __attribute__((ext_vector_type(8)));
typedef float f32x4 __attribute__((ext_vector_type(4)));
typedef float f32x2 __attribute__((ext_vector_type(2)));
typedef unsigned u32x4 __attribute__((ext_vector_type(4)));
typedef unsigned u32x2 __attribute__((ext_vector_type(2)));

constexpr int NTOK = 32768, SEQ = 16384, DM = 1024, NLAYER = 4;
constexpr int NEXP = 64, FFE = 512;
constexpr int PMAX = 81920;
constexpr float EPS = 1e-6f;
constexpr float LOG2E = 1.4426950408889634f;

constexpr size_t MiB = 1u << 20;
constexpr size_t WS_CTL = 0, CTL_ZERO_BYTES = 128 * 1024;
constexpr size_t WS_WQKV = 2 * MiB, WS_WO = 14 * MiB, WS_WIN = 18 * MiB, WS_WMO = 30 * MiB, WS_WR = 34 * MiB, WS_WG = 36 * MiB;
constexpr size_t WS_SMALL = 37 * MiB;
constexpr size_t SM_RSTD = WS_SMALL, SM_GATES = WS_SMALL + 256 * 1024, SM_TOKE = WS_SMALL + 1280 * 1024, SM_TOKG = WS_SMALL + 1536 * 1024,
                 SM_TOKP = WS_SMALL + 1792 * 1024, SM_ROWTOK = WS_SMALL + 2 * MiB, SM_TILEEXP = WS_SMALL + 2 * MiB + 512 * 1024,
                 SM_MLOC = WS_SMALL + 2 * MiB + 768 * 1024, SM_BL = SM_MLOC + 8192, SM_MPREV = SM_MLOC + 16384,
                 SM_DN = WS_SMALL + 3 * MiB, SM_NS = WS_SMALL + 4 * MiB, SM_L1 = WS_SMALL + 5 * MiB, SM_L2 = WS_SMALL + 7 * MiB;
constexpr size_t WS_WGU = 64 * MiB, WS_WD = 576 * MiB, WS_XB = 832 * MiB, WS_QKV = 898 * MiB, WS_OB = 1090 * MiB,
                 WS_P1 = 1170 * MiB, WS_P2 = 1234 * MiB, WS_CS = 1298 * MiB, WS_QC = 1426 * MiB, WS_KC = 1458 * MiB, WS_END = 1490 * MiB;
constexpr size_t WS_YB = WS_QKV, WS_ACT = WS_OB, WS_DC = WS_P1;
constexpr int CW_BAR = 4096, CW_CNT = 16384;

constexpr int LDS_BYTES = 147456;
constexpr int MISC_OFF = 147456 - 512;

__device__ __forceinline__ unsigned f2bf(float f) { unsigned u = __builtin_bit_cast(unsigned, f); return (u + 0x7fffu + ((u >> 16) & 1u)) >> 16; }
__device__ __forceinline__ float bf2f(unsigned h) { return __builtin_bit_cast(float, h << 16); }
typedef __bf16 bf16x2_t __attribute__((ext_vector_type(2)));
__device__ __forceinline__ unsigned cvt_pk_bf16(float lo, float hi) { f32x2 v = {lo, hi}; bf16x2_t r = __builtin_convertvector(v, bf16x2_t); return __builtin_bit_cast(unsigned, r); }
__device__ __forceinline__ float bflo(unsigned w) { return __builtin_bit_cast(float, w << 16); }
__device__ __forceinline__ float bfhi(unsigned w) { return __builtin_bit_cast(float, w & 0xffff0000u); }
__device__ __forceinline__ float fast_exp2(float x) { return __builtin_amdgcn_exp2f(x); }
__device__ __forceinline__ float fast_rcp(float x) { return __builtin_amdgcn_rcpf(x); }
#define LDS_WAIT() asm volatile("s_waitcnt lgkmcnt(0)" ::: "memory")
#define VM_WAIT() asm volatile("s_waitcnt vmcnt(0)" ::: "memory")

#define XB_TMO      128
#define XB_XCNT(j)  (256  + 64 * (j))
#define XB_XSUB(j)  (1280 + 64 * (j))
#define XB_XGEN(j)  (2304 + 64 * (j))
#define XB_TOP      3328
#define XB_TOPGEN   3392
#define XCD_BAR_WORDS 3456
#define XB_SPIN_CAP (1u << 18)
__device__ __forceinline__ unsigned xb_ld(unsigned* p)              { return __hip_atomic_load(p, __ATOMIC_RELAXED, __HIP_MEMORY_SCOPE_AGENT); }
__device__ __forceinline__ unsigned xb_add(unsigned* p, unsigned v) { return __hip_atomic_fetch_add(p, v, __ATOMIC_RELAXED, __HIP_MEMORY_SCOPE_AGENT); }
__device__ __forceinline__ unsigned xb_xcc_id() { return (unsigned)__builtin_amdgcn_s_getreg((3 << 11) | 20) & 0xFu; }
#define XB_SPIN(cond, bar) do { unsigned _sp = 0; while (cond) { __builtin_amdgcn_s_sleep(1); \
    if ((++_sp & 255u) == 0u) { if (xb_ld(&(bar)[XB_TMO])) break; if (_sp > XB_SPIN_CAP) { atomicAdd(&(bar)[XB_TMO], 1u); break; } } } } while (0)
struct XcdBarrier { unsigned* bar; unsigned x; volatile LAS unsigned* st; };
__device__ __forceinline__ XcdBarrier xcd_barrier_post(unsigned* bar, volatile LAS unsigned* st) {
    XcdBarrier b; b.bar = bar; b.x = xb_xcc_id(); b.st = st;
    if (threadIdx.x == 0) (void)xb_add(&bar[XB_XCNT(b.x)], 1u);
    return b;
}
__device__ __forceinline__ void xcd_barrier_complete(unsigned* bar, unsigned x, unsigned& nloc, unsigned& nx) {
    const unsigned G = gridDim.x * gridDim.y * gridDim.z;
    unsigned sum, cnt, mine, sp = 0u;
    for (;;) {
        sum = 0u; cnt = 0u; mine = 0u;
#pragma unroll
        for (unsigned j = 0; j < 16; ++j) { const unsigned c = xb_ld(&bar[XB_XCNT(j)]); sum += c; cnt += (c > 0u) ? 1u : 0u; mine = (j == x) ? c : mine; }
        if (sum == G) break;
        __builtin_amdgcn_s_sleep(1);
        if ((++sp & 255u) == 0u) { if (xb_ld(&bar[XB_TMO])) break; if (sp > XB_SPIN_CAP) { atomicAdd(&bar[XB_TMO], 1u); break; } }
    }
    nloc = mine > 0u ? mine : 1u; nx = cnt > 0u ? cnt : 1u;
}
__device__ __forceinline__ void xcd_barrier(const XcdBarrier& b) {
    asm volatile("s_waitcnt vmcnt(0)" ::: "memory");
    __syncthreads();
    if (threadIdx.x == 0) {
        unsigned* bar = b.bar;
        __builtin_amdgcn_s_waitcnt(0);
        unsigned nloc = b.st[0], nx = b.st[1];
        if (nloc == 0u) { xcd_barrier_complete(bar, b.x, nloc, nx); b.st[0] = nloc; b.st[1] = nx; }
        const unsigned old = xb_add(&bar[XB_XSUB(b.x)], 1u);
        const unsigned gen = old / nloc;
        if (old + 1u == (gen + 1u) * nloc) {
            __builtin_amdgcn_fence(__ATOMIC_RELEASE, "agent");
            asm volatile("s_waitcnt vmcnt(0)" ::: "memory");
            const unsigned og = xb_add(&bar[XB_TOP], 1u);
            const unsigned tg = og / nx;
            if (og + 1u == (tg + 1u) * nx) xb_add(&bar[XB_TOPGEN], 1u);
            else XB_SPIN(xb_ld(&bar[XB_TOPGEN]) == tg, bar);
            __builtin_amdgcn_fence(__ATOMIC_ACQUIRE, "agent");
            xb_add(&bar[XB_XGEN(b.x)], 1u);
            asm volatile("s_waitcnt vmcnt(0)" ::: "memory");
        } else {
            XB_SPIN(xb_ld(&bar[XB_XGEN(b.x)]) == gen, bar);
            __builtin_amdgcn_fence(__ATOMIC_ACQUIRE, "agent");
            asm volatile("s_waitcnt vmcnt(0)" ::: "memory");
        }
    }
    __syncthreads();
}

namespace pg8 {
constexpr int BM = 256, BK = 64, HALF = 128, HTB = HALF * BK * 2, STAGE_BYTES = 8 * HTB, NXCD = 8, WGM = 8;
__host__ __device__ __forceinline__ int lds_byte(int r, int c) { const int st = (r >> 4) * 2 + (c >> 5), rr = r & 15, cc = c & 31, ob = rr * 64 + cc * 2; return st * 1024 + (ob ^ (((ob >> 9) & 1) << 5)); }
__host__ __device__ __forceinline__ void stage_rc(int b, int& R, int& C) { const int st = b / 1024, sb = b % 1024, swz = sb ^ (((sb >> 9) & 1) << 5); R = (st >> 1) * 16 + swz / 64; C = (st & 1) * 32 + (swz % 64) / 2; }
__host__ __device__ __forceinline__ int perm32(int rho) { const int n = rho >> 4, i = rho & 15; return 8 * (i >> 2) + 4 * n + (i & 3); }

struct Unit { int pm, pn, e; };
struct Gemm { const bf16_t* A; const bf16_t* Bt; int K; size_t b_estride; const int* sparse; const LAS int* pst; const LAS int* cnt; };

struct StaticOrder {
    int nM, nN, nwg, G, c; const LAS int* pst;
    __device__ void init(int nM_, int nN_, int G_, int c_, const LAS int* pst_) { nM = nM_; nN = nN_; nwg = nM * nN; G = G_; c = c_; pst = pst_; }
    __device__ bool next(int i, Unit& u) const {
        const long L = (long)i * G + c; if (L >= nwg) return false;
        int wgid = (int)L; { const int q = nwg / NXCD, r = nwg % NXCD, xcd = wgid % NXCD, off = wgid / NXCD; wgid = (xcd < r ? xcd * (q + 1) : r * (q + 1) + (xcd - r) * q) + off; }
        const int nig = WGM * nN, gid = wgid / nig, fm = gid * WGM, gsz = (nM - fm) < WGM ? (nM - fm) : WGM;
        u.pm = fm + ((wgid % nig) % gsz); u.pn = (wgid % nig) / gsz;
        u.e = pst ? __builtin_amdgcn_readfirstlane(pst[256 + u.pm]) : 0;
        return true;
    }
};

template <class Epi, bool ALIGN_EPI, bool GATHER, bool A_HM = false>
__device__ __forceinline__ void gemm_phase(LAS unsigned char* lds, const int tid, const Gemm g, const StaticOrder& S, const Epi& E) {
    const int wid = __builtin_amdgcn_readfirstlane(tid >> 6), lane = tid & 63, wr = wid >> 2, wc = wid & 3, fr = lane & 15, fq = lane >> 4;
    const int K = g.K, nt = K / BK;
    int RA[2], CA[2]; unsigned voffB[2];
#pragma unroll
    for (int i = 0; i < 2; ++i) { int R, C; stage_rc(tid * 16 + i * 8192, R, C); const int Rb = Epi::PERM ? ((R & ~31) + perm32(R & 31)) : R;
        RA[i] = R; CA[i] = C; voffB[i] = (unsigned)(Rb * K + C) * 2u; }
    const size_t kstep = (size_t)(BK * 2);
    const size_t hstep = (size_t)HALF * K * 2;
    const size_t tstep = 2 * hstep;
    const size_t akstep = A_HM ? (size_t)16384 * 128 : kstep, ahstep = A_HM ? (size_t)HALF * 128 : hstep;
#define PG8_ABASE(pm_) (A_HM ? ((size_t)((pm_) >> 6) * 16 * 16384 + (size_t)((pm_) & 63) * 256) * 128 : (size_t)(pm_) * tstep)
    const unsigned ldsw = (unsigned)wid * 1024u;
    const int aoff = lds_byte(wr * 64 + fr, fq * 8), boff = lds_byte(wc * 32 + fr, fq * 8);
#define PG8_SA(b, h) (((b) * 2 + (h)) * HTB)
#define PG8_SB(b, h) ((4 + (b) * 2 + (h)) * HTB)
#define PG8_STAGE(bufoff, gbase, voff) do { _Pragma("unroll") for (int _i = 0; _i < 2; ++_i) \
        __builtin_amdgcn_global_load_lds((const unsigned*)((const char*)(gbase) + (voff)[_i]), (LAS unsigned*)(lds + (bufoff) + ldsw + _i * 8192), 16, 0, 0); } while (0)
#define PG8_LDA(dst, b, h) do { _Pragma("unroll") for (int m = 0; m < 4; ++m) _Pragma("unroll") for (int k = 0; k < 2; ++k) dst[m][k] = *(const LAS bf16x8*)(lds + PG8_SA(b, h) + aoff + m * 2048 + k * 1024); } while (0)
#define PG8_LDB(dst, b, h) do { _Pragma("unroll") for (int n = 0; n < 2; ++n) _Pragma("unroll") for (int k = 0; k < 2; ++k) dst[n][k] = *(const LAS bf16x8*)(lds + PG8_SB(b, h) + boff + n * 2048 + k * 1024); } while (0)
#define PG8_MMA(ai, bj, At, Bt) do { __builtin_amdgcn_s_setprio(1); _Pragma("unroll") for (int m = 0; m < 4; ++m) _Pragma("unroll") for (int n = 0; n < 2; ++n) _Pragma("unroll") for (int k = 0; k < 2; ++k) \
        acc[ai][bj][m][n] = __builtin_amdgcn_mfma_f32_16x16x32_bf16(Bt[n][k], At[m][k], acc[ai][bj][m][n], 0, 0, 0); __builtin_amdgcn_s_setprio(0); } while (0)
#define PG8_WAIT_V(n) asm volatile("s_waitcnt vmcnt(" #n ")" ::: "memory")
#define PG8_WAIT_L(n) asm volatile("s_waitcnt lgkmcnt(" #n ")" ::: "memory")
#define PG8_BAR __builtin_amdgcn_s_barrier()
#define PG8_SCHED __builtin_amdgcn_sched_barrier(0)
#define PG8_AOFFS(dst, unit) do { _Pragma("unroll") for (int _h = 0; _h < 2; ++_h) _Pragma("unroll") for (int _i = 0; _i < 2; ++_i) { \
        const int _j = (unit).pm * BM + _h * HALF + RA[_i] - g.pst[(unit).e]; const int _src = (_j < g.cnt[(unit).e]) ? g.sparse[(unit).e * 32768 + _j] : NTOK; dst[_h][_i] = (unsigned)(_src * K + CA[_i]) * 2u; } } while (0)
    Unit cur, nxt; int ui = 0;
    if (!S.next(0, cur)) return;
    f32x4 acc[2][2][4][2];
#pragma unroll
    for (int a = 0; a < 2; ++a)
#pragma unroll
        for (int b = 0; b < 2; ++b)
#pragma unroll
            for (int m = 0; m < 4; ++m)
#pragma unroll
                for (int n = 0; n < 2; ++n) acc[a][b][m][n] = (f32x4){0.f, 0.f, 0.f, 0.f};
    bf16x8 At[4][2], B0[2][2], B1[2][2];
    unsigned voffA[2]; unsigned cAo[2][2], nAo[2][2];
#pragma unroll
    for (int i = 0; i < 2; ++i) voffA[i] = (unsigned)(RA[i] * (A_HM ? 64 : K) + CA[i]) * 2u;
    const char* cA = (const char*)g.A;
    if constexpr (GATHER) { PG8_AOFFS(cAo, cur); } else { cA += PG8_ABASE(cur.pm); }
    const char* cB = (const char*)g.Bt + (size_t)cur.e * g.b_estride + (size_t)cur.pn * tstep;
#define PG8_STAGE_A(bufoff, base, h, nx) do { if constexpr (GATHER) { _Pragma("unroll") for (int _i = 0; _i < 2; ++_i) { const unsigned _o = (nx) ? nAo[h][_i] : cAo[h][_i]; \
            __builtin_amdgcn_global_load_lds((const unsigned*)((const char*)(base) + _o), (LAS unsigned*)(lds + (bufoff) + ldsw + _i * 8192), 16, 0, 0); } } \
        else { PG8_STAGE(bufoff, (base) + (h) * ahstep, voffA); } } while (0)
    PG8_STAGE(PG8_SB(0, 0), cB, voffB); PG8_STAGE(PG8_SB(0, 1), cB + hstep, voffB); PG8_STAGE_A(PG8_SA(0, 0), cA, 0, false); PG8_STAGE_A(PG8_SA(0, 1), cA, 1, false);
    if (wr == 1) PG8_BAR;
    PG8_WAIT_V(2); PG8_BAR;
    PG8_STAGE(PG8_SB(1, 0), cB + kstep, voffB); PG8_STAGE_A(PG8_SA(1, 0), cA + akstep, 0, false); PG8_STAGE(PG8_SB(1, 1), cB + hstep + kstep, voffB);
    PG8_WAIT_V(6); PG8_BAR;
    for (;;) {
        const bool has_next = S.next(ui + 1, nxt);
        const char* nA = cA;
        if constexpr (GATHER) { if (has_next) { PG8_AOFFS(nAo, nxt); } else {
#pragma unroll
            for (int h = 0; h < 2; ++h)
#pragma unroll
                for (int i = 0; i < 2; ++i) nAo[h][i] = cAo[h][i]; } }
        else { if (has_next) nA = (const char*)g.A + PG8_ABASE(nxt.pm); }
        const char* nB = has_next ? (const char*)g.Bt + (size_t)nxt.e * g.b_estride + (size_t)nxt.pn * tstep : cB;
        for (int t = 0; t < nt; t += 2) {
            const bool last = (t == nt - 2);
            const char* a1 = cA + (size_t)(t + 1) * akstep;
            const char* a2 = last ? nA : cA + (size_t)(t + 2) * akstep; const char* b2 = last ? nB : cB + (size_t)(t + 2) * kstep;
            const char* a3 = a2 + akstep; const char* b3 = b2 + kstep;
            PG8_LDB(B0, 0, 0); PG8_LDB(B1, 0, 1); PG8_SCHED; PG8_LDA(At, 0, 0); PG8_STAGE_A(PG8_SA(1, 1), a1, 1, false);
            PG8_WAIT_V(8); PG8_WAIT_L(0); PG8_BAR; PG8_MMA(0, 0, At, B0); PG8_MMA(0, 1, At, B1); PG8_BAR; PG8_SCHED;
            PG8_LDA(At, 0, 1); PG8_STAGE(PG8_SB(0, 0), b2, voffB); PG8_STAGE(PG8_SB(0, 1), b2 + hstep, voffB); PG8_STAGE_A(PG8_SA(0, 0), a2, 0, last);
            PG8_WAIT_V(8); PG8_WAIT_L(0); PG8_BAR; PG8_MMA(1, 0, At, B0); PG8_MMA(1, 1, At, B1); PG8_BAR; PG8_SCHED;
            PG8_LDB(B0, 1, 0); PG8_LDB(B1, 1, 1); PG8_SCHED; PG8_LDA(At, 1, 0); PG8_STAGE_A(PG8_SA(0, 1), a2, 1, last);
            PG8_WAIT_V(8); PG8_WAIT_L(0); PG8_BAR; PG8_MMA(0, 0, At, B0); PG8_MMA(0, 1, At, B1); PG8_BAR; PG8_SCHED;
            PG8_LDA(At, 1, 1); PG8_STAGE(PG8_SB(1, 0), b3, voffB); PG8_STAGE(PG8_SB(1, 1), b3 + hstep, voffB); PG8_STAGE_A(PG8_SA(1, 0), a3, 0, last);
            PG8_WAIT_V(8); PG8_WAIT_L(0); PG8_BAR; PG8_MMA(1, 0, At, B0); PG8_MMA(1, 1, At, B1); PG8_BAR; PG8_SCHED;
        }
        if constexpr (ALIGN_EPI) { if (wr == 0) PG8_BAR; }
        E(acc, cur, wr, wc, fr, fq);
        if (!has_next) break;
#pragma unroll
        for (int a = 0; a < 2; ++a)
#pragma unroll
            for (int b = 0; b < 2; ++b)
#pragma unroll
                for (int m = 0; m < 4; ++m)
#pragma unroll
                    for (int n = 0; n < 2; ++n) acc[a][b][m][n] = (f32x4){0.f, 0.f, 0.f, 0.f};
        cur = nxt; cB = nB; cA = nA; ++ui;
        if constexpr (GATHER) {
#pragma unroll
        for (int h = 0; h < 2; ++h)
#pragma unroll
            for (int i = 0; i < 2; ++i) cAo[h][i] = nAo[h][i]; }
        if constexpr (ALIGN_EPI) { if (wr == 1) PG8_BAR; }
    }
    PG8_WAIT_V(0);
    if constexpr (!ALIGN_EPI) { if (wr == 0) PG8_BAR; }
    PG8_BAR;
#undef PG8_SA
#undef PG8_SB
#undef PG8_STAGE
#undef PG8_LDA
#undef PG8_LDB
#undef PG8_MMA
#undef PG8_WAIT_V
#undef PG8_WAIT_L
#undef PG8_BAR
#undef PG8_SCHED
#undef PG8_AOFFS
#undef PG8_STAGE_A
#undef PG8_ABASE
}


struct EpiQKV {
    static constexpr bool PERM = true;
    bf16_t* O; const float* rstd; const float* qg; const float* kg; float qscale;
    __device__ __forceinline__ void operator()(const f32x4 (&acc)[2][2][4][2], const Unit& u, int wr, int wc, int fr, int fq) const {
        const int part = u.pn >> 2, head = 4 * (u.pn & 3) + wc;
        f32x4 gv[2][2];
#pragma unroll
        for (int bj = 0; bj < 2; ++bj)
#pragma unroll
            for (int n = 0; n < 2; ++n) { const int dim = 32 * bj + 8 * fq + 4 * n;
                if (part == 0) gv[bj][n] = *(const f32x4*)(qg + dim) * qscale; else if (part == 1) gv[bj][n] = *(const f32x4*)(kg + dim); else gv[bj][n] = (f32x4){1.f, 1.f, 1.f, 1.f}; }
#pragma unroll
        for (int ai = 0; ai < 2; ++ai)
#pragma unroll
            for (int m = 0; m < 4; ++m) {
                const int row = u.pm * BM + ai * HALF + wr * 64 + m * 16 + fr; const float rs = rstd[row];
                f32x4 v[2][2]; float ss = 0.f;
#pragma unroll
                for (int bj = 0; bj < 2; ++bj)
#pragma unroll
                    for (int n = 0; n < 2; ++n) { v[bj][n] = acc[ai][bj][m][n] * rs; const f32x4 q = v[bj][n] * v[bj][n]; ss += (q[0] + q[1]) + (q[2] + q[3]); }
                float sc = 1.f;
                if (part < 2) { ss += __shfl_xor(ss, 16); ss += __shfl_xor(ss, 32); sc = 1.0f / sqrtf(ss * (1.0f / 64.0f) + EPS); }
                bf16_t* rowp = O + ((size_t)(part * 32 + (row / SEQ) * 16 + head) * SEQ + (row % SEQ)) * 64 + 8 * fq;
#pragma unroll
                for (int bj = 0; bj < 2; ++bj) { const f32x4 v0 = v[bj][0] * gv[bj][0] * sc, v1 = v[bj][1] * gv[bj][1] * sc;
                    u32x4 w; w.x = cvt_pk_bf16(v0[0], v0[1]); w.y = cvt_pk_bf16(v0[2], v0[3]); w.z = cvt_pk_bf16(v1[0], v1[1]); w.w = cvt_pk_bf16(v1[2], v1[3]);
                    *(u32x4*)(rowp + 32 * bj) = w; }
            }
    }
};
struct EpiBf16 {
    static constexpr bool PERM = true;
    bf16_t* O; int ldc; const float* rscale;
    __device__ __forceinline__ void operator()(const f32x4 (&acc)[2][2][4][2], const Unit& u, int wr, int wc, int fr, int fq) const {
        const int col0 = u.pn * BM + wc * 32 + 8 * fq;
#pragma unroll
        for (int ai = 0; ai < 2; ++ai)
#pragma unroll
            for (int m = 0; m < 4; ++m) { const int row = u.pm * BM + ai * HALF + wr * 64 + m * 16 + fr; const float rs = rscale ? rscale[row] : 1.f;
                bf16_t* rowp = O + (size_t)row * ldc + col0;
#pragma unroll
                for (int bj = 0; bj < 2; ++bj) { const f32x4 v0 = acc[ai][bj][m][0] * rs, v1 = acc[ai][bj][m][1] * rs;
                    u32x4 w; w.x = cvt_pk_bf16(v0[0], v0[1]); w.y = cvt_pk_bf16(v0[2], v0[3]); w.z = cvt_pk_bf16(v1[0], v1[1]); w.w = cvt_pk_bf16(v1[2], v1[3]);
                    *(u32x4*)(rowp + bj * HALF) = w; } }
    }
};
struct EpiResid {
    static constexpr bool PERM = false;
    const float* xin; float* out;
    __device__ __forceinline__ void operator()(const f32x4 (&acc)[2][2][4][2], const Unit& u, int wr, int wc, int fr, int fq) const {
        const int col0 = u.pn * BM + wc * 32 + 4 * fq;
#pragma unroll
        for (int ai = 0; ai < 2; ++ai)
#pragma unroll
            for (int m = 0; m < 4; ++m) { const size_t off = (size_t)(u.pm * BM + ai * HALF + wr * 64 + m * 16 + fr) * DM + col0;
#pragma unroll
                for (int bj = 0; bj < 2; ++bj)
#pragma unroll
                    for (int n = 0; n < 2; ++n) { const f32x4 b = *(const f32x4*)(xin + off + bj * HALF + n * 16); *(f32x4*)(out + off + bj * HALF + n * 16) = b + acc[ai][bj][m][n]; } }
    }
};
struct EpiResidB {
    static constexpr bool PERM = true;
    bf16_t* X;
    __device__ __forceinline__ void operator()(const f32x4 (&acc)[2][2][4][2], const Unit& u, int wr, int wc, int fr, int fq) const {
        const int col0 = u.pn * BM + wc * 32 + 8 * fq;
#pragma unroll
        for (int ai = 0; ai < 2; ++ai)
#pragma unroll
            for (int m = 0; m < 4; ++m) { bf16_t* rowp = X + (size_t)(u.pm * BM + ai * HALF + wr * 64 + m * 16 + fr) * DM + col0;
#pragma unroll
                for (int bj = 0; bj < 2; ++bj) { const u32x4 x = *(const u32x4*)(rowp + bj * HALF); const f32x4 a0 = acc[ai][bj][m][0], a1 = acc[ai][bj][m][1];
                    u32x4 w; w.x = cvt_pk_bf16(bflo(x.x) + a0[0], bfhi(x.x) + a0[1]); w.y = cvt_pk_bf16(bflo(x.y) + a0[2], bfhi(x.y) + a0[3]);
                    w.z = cvt_pk_bf16(bflo(x.z) + a1[0], bfhi(x.z) + a1[1]); w.w = cvt_pk_bf16(bflo(x.w) + a1[2], bfhi(x.w) + a1[3]);
                    *(u32x4*)(rowp + bj * HALF) = w; } }
    }
};
struct EpiGU {
    static constexpr bool PERM = true;
    bf16_t* O; const float* rstd; const int* sparse; const LAS int* pst; const LAS int* cnt;
    __device__ __forceinline__ void operator()(const f32x4 (&acc)[2][2][4][2], const Unit& u, int wr, int wc, int fr, int fq) const {
        const int col0 = u.pn * HALF + wc * 32 + 8 * fq;
#pragma unroll
        for (int ai = 0; ai < 2; ++ai)
#pragma unroll
            for (int m = 0; m < 4; ++m) { const int row = u.pm * BM + ai * HALF + wr * 64 + m * 16 + fr; const int jj = row - pst[u.e]; const float rs = (jj < cnt[u.e]) ? rstd[sparse[u.e * 32768 + jj]] : 0.f;
                float o[8];
#pragma unroll
                for (int n = 0; n < 2; ++n)
#pragma unroll
                    for (int i = 0; i < 4; ++i) { const float gg = acc[ai][0][m][n][i] * rs, uu = acc[ai][1][m][n][i] * rs;
                        o[n * 4 + i] = gg * fast_rcp(1.0f + fast_exp2(-gg * LOG2E)) * uu; }
                u32x4 w; w.x = cvt_pk_bf16(o[0], o[1]); w.y = cvt_pk_bf16(o[2], o[3]); w.z = cvt_pk_bf16(o[4], o[5]); w.w = cvt_pk_bf16(o[6], o[7]);
                *(u32x4*)(O + (size_t)row * FFE + col0) = w; }
    }
};
}

struct Frame {
    LAS unsigned char* lds;
    int tid, lane, wave, vcu, G;
};
struct Args { const float* in[20]; float* out; unsigned char* ws; int ph_lo, ph_hi; };
__device__ __forceinline__ Frame make_frame(LAS unsigned char* lds) {
    Frame F; int t = threadIdx.x; asm volatile("" : "+v"(t));
    F.lds = lds; F.tid = t; F.lane = t & 63; F.wave = __builtin_amdgcn_readfirstlane(t >> 6);
    F.G = gridDim.x; { const int bx = blockIdx.x; F.vcu = (F.G % 8 == 0) ? (bx % 8) * (F.G / 8) + bx / 8 : bx; }
    return F;
}

__device__ __forceinline__ bf16x8 ld_frag_lds(const LAS unsigned char* p) { return *(const LAS bf16x8*)p; }
__device__ __forceinline__ bf16x8 mk_frag(unsigned a, unsigned b, unsigned c, unsigned d) { u32x4 w = {a, b, c, d}; return __builtin_bit_cast(bf16x8, w); }
#define MFMA16(a, b, c) __builtin_amdgcn_mfma_f32_16x16x32_bf16(a, b, c, 0, 0, 0)

struct CvtDesc { const float* src; int ldsrc, k0, scol; const float* kscale; bf16_t* dst; int K, drow; };
__device__ __forceinline__ void cvt_load(const CvtDesc& d, int lane, f32x4 (&v)[8]) {
#pragma unroll
    for (int i = 0; i < 8; ++i) v[i] = __builtin_nontemporal_load((const GAS f32x4*)(d.src + (size_t)(d.k0 + 8 * i + (lane >> 3)) * d.ldsrc + d.scol + 4 * (lane & 7)));
}
__device__ __forceinline__ void cvt_finish(const CvtDesc& d, int lane, const f32x4 (&v)[8], LAS float* scr) {
#pragma unroll
    for (int i = 0; i < 8; ++i) { const int kk = 8 * i + (lane >> 3); const float s = d.kscale ? d.kscale[d.k0 + kk] : 1.f; LAS float* p = scr + kk * 33 + 4 * (lane & 7);
        p[0] = v[i][0] * s; p[1] = v[i][1] * s; p[2] = v[i][2] * s; p[3] = v[i][3] * s; }
    LDS_WAIT(); asm volatile("" ::: "memory");
    const int c = lane & 7;
#pragma unroll
    for (int j = 0; j < 4; ++j) { const int n = (lane >> 3) + 8 * j; const LAS float* s = scr + (8 * c) * 33 + n;
        u32x4 o; o.x = cvt_pk_bf16(s[0 * 33], s[1 * 33]); o.y = cvt_pk_bf16(s[2 * 33], s[3 * 33]); o.z = cvt_pk_bf16(s[4 * 33], s[5 * 33]); o.w = cvt_pk_bf16(s[6 * 33], s[7 * 33]);
        __builtin_nontemporal_store(o, (GAS u32x4*)(d.dst + (size_t)(d.drow + n) * d.K + d.k0 + 8 * c)); }
    LDS_WAIT(); asm volatile("" ::: "memory");
}
__device__ __forceinline__ void cvt_item(const float* src, int ldsrc, int k0, int scol, const float* kscale, bf16_t* dst, int K, int drow, LAS float* scr, int lane) {
    const CvtDesc d{src, ldsrc, k0, scol, kscale, dst, K, drow}; f32x4 v[8]; cvt_load(d, lane, v); cvt_finish(d, lane, v, scr);
}
constexpr int MOE_ITEMS = 64 * 16 * 32 + 64 * 8 * 32;
__device__ __forceinline__ CvtDesc cvt_moe_desc(const Args& a, int l, int it) {
    constexpr int I_GU = 64 * 16 * 32;
    unsigned char* ws = a.ws; CvtDesc d;
    if (it < I_GU) { const int e = it / (16 * 32), q = it % (16 * 32), kb = q / 32, nb = q % 32;
        const int pn = nb >> 3, bj = (nb >> 2) & 1, c32 = nb & 3; const int le = l * 64 + e;
        d.src = (bj ? a.in[18] : a.in[17]) + (size_t)le * DM * FFE; d.ldsrc = FFE; d.k0 = kb * 64; d.scol = 128 * pn + 32 * c32; d.kscale = a.in[2] + (size_t)l * DM;
        d.dst = (bf16_t*)(ws + WS_WGU) + (size_t)le * DM * DM; d.K = DM; d.drow = nb * 32; }
    else { const int r = it - I_GU; const int e = r / (8 * 32), q = r % (8 * 32), kb = q / 32, nb = q % 32; const int le = l * 64 + e;
        d.src = a.in[19] + (size_t)le * FFE * DM; d.ldsrc = DM; d.k0 = kb * 64; d.scol = nb * 32; d.kscale = nullptr;
        d.dst = (bf16_t*)(ws + WS_WD) + (size_t)le * DM * FFE; d.K = FFE; d.drow = nb * 32; }
    return d;
}

__device__ __forceinline__ void p0_weights(const Frame& F, const Args& a) {
    LAS float* scr = (LAS float*)(F.lds + F.wave * 16384);
    const int gw = F.vcu * 8 + F.wave, NGW = F.G * 8;
    unsigned char* ws = a.ws;
    constexpr int I_QKV = 2 * 16 * 96, I_O = 2 * 16 * 32, I_IN = 2 * 16 * 96, I_MO = 2 * 16 * 32;
    constexpr int NITEMS = I_QKV + I_O + I_IN + I_MO;
    for (int it = gw; it < NITEMS; it += NGW) {
        int r = it;
        if (r < I_QKV) { const int j = r / (16 * 96), q = r % (16 * 96), kb = q / 96, nb = q % 96;
            const int pn = nb >> 3, bj = (nb >> 2) & 1, wc = nb & 3, part = pn >> 2, head = 4 * (pn & 3) + wc;
            cvt_item(a.in[3] + (size_t)j * DM * 3072, 3072, kb * 64, part * 1024 + head * 64 + 32 * bj, a.in[1] + (size_t)(2 * j) * DM, (bf16_t*)(ws + WS_WQKV) + (size_t)j * 3072 * DM, DM, nb * 32, scr, F.lane); continue; }
        r -= I_QKV;
        if (r < I_O) { const int j = r / (16 * 32), q = r % (16 * 32), kb = q / 32, nb = q % 32;
            cvt_item(a.in[6] + (size_t)j * DM * DM, DM, kb * 64, nb * 32, nullptr, (bf16_t*)(ws + WS_WO) + (size_t)j * DM * DM, DM, nb * 32, scr, F.lane); continue; }
        r -= I_O;
        if (r < I_IN) { const int j = r / (16 * 96), q = r % (16 * 96), kb = q / 96, nb = q % 96;
            cvt_item(a.in[7] + (size_t)j * DM * 3080, 3080, kb * 64, nb * 32, a.in[1] + (size_t)(2 * j + 1) * DM, (bf16_t*)(ws + WS_WIN) + (size_t)j * 3072 * DM, DM, nb * 32, scr, F.lane); continue; }
        r -= I_IN;
        { const int j = r / (16 * 32), q = r % (16 * 32), kb = q / 32, nb = q % 32;
            cvt_item(a.in[12] + (size_t)j * DM * DM, DM, kb * 64, nb * 32, nullptr, (bf16_t*)(ws + WS_WMO) + (size_t)j * DM * DM, DM, nb * 32, scr, F.lane); }
    }
    {
        const int gt = F.vcu * 512 + F.tid, NT = F.G * 512;
        for (int i = gt; i < 4 * 80 * 1024; i += NT) { const int l = i / (80 * 1024), c = (i / 1024) % 80, k = i % 1024;
            float w = 0.f;
            if (c < 8) w = a.in[13][((size_t)l * DM + k) * 8 + c]; else if (c < 72) w = a.in[15][((size_t)l * DM + k) * 64 + (c - 8)];
            w *= a.in[2][l * DM + k];
            const unsigned hi = f2bf(w); const unsigned lo = f2bf(w - bf2f(hi));
            bf16_t* base = (bf16_t*)(ws + WS_WR) + (size_t)l * 2 * 80 * 1024;
            base[c * 1024 + k] = (bf16_t)hi; base[80 * 1024 + c * 1024 + k] = (bf16_t)lo; }
        for (int i = gt; i < 2 * 16 * 1024; i += NT) { const int j = i / (16 * 1024), c = (i / 1024) % 16, k = i % 1024;
            float w = 0.f; if (c < 8) w = a.in[7][((size_t)j * DM + k) * 3080 + 3072 + c] * a.in[1][(2 * j + 1) * DM + k];
            const unsigned hi = f2bf(w); const unsigned lo = f2bf(w - bf2f(hi));
            bf16_t* base = (bf16_t*)(ws + WS_WG) + (size_t)j * 2 * 16 * 1024;
            base[c * 1024 + k] = (bf16_t)hi; base[16 * 1024 + c * 1024 + k] = (bf16_t)lo; }
        if (F.vcu == 0) { for (int i = F.tid; i < DM / 2; i += 512) ((unsigned*)((bf16_t*)(ws + WS_XB) + (size_t)NTOK * DM))[i] = 0u;
            if (F.tid == 0) ((float*)(ws + SM_RSTD))[NTOK] = 0.f; }
    }
}

template <int MODE, int NT, bool WLO = false>
__device__ __forceinline__ void rowpass_wave(const Frame& F, const float* xsrc, float* xdst, bf16_t* xb, float* rstd_out,
                                             const bf16_t* yb, const int* tokp, const float* tokg, const int* toke, const LAS int* pst,
                                             const bf16_t* whi, const bf16_t* wlo, int tok0, f32x4 (&acc)[NT > 0 ? NT : 1], float& rstd_lane) {
    const int lane = F.lane, t = lane & 15, fq = lane >> 4, tok = tok0 + t;
    const float* xr = xsrc + (size_t)tok * DM + 8 * fq;
    bf16_t* xbr = xb + (size_t)tok * DM + 8 * fq;
    const bf16_t *y0 = nullptr, *y1 = nullptr; float g0 = 0.f, g1 = 0.f;
    if (MODE == 2) { const int p0 = pst[toke[2 * tok]] + tokp[2 * tok], p1 = pst[toke[2 * tok + 1]] + tokp[2 * tok + 1]; g0 = tokg[2 * tok]; g1 = tokg[2 * tok + 1];
        y0 = yb + (size_t)p0 * DM + 8 * fq; y1 = yb + (size_t)p1 * DM + 8 * fq; }
    float* xw = (MODE == 2) ? xdst + (size_t)tok * DM + 8 * fq : nullptr;
#pragma unroll
    for (int c = 0; c < (NT > 0 ? NT : 1); ++c) acc[c] = (f32x4){0.f, 0.f, 0.f, 0.f};
    float ss = 0.f;
#pragma unroll 4
    for (int s = 0; s < 32; ++s) {
        f32x4 a0 = __builtin_nontemporal_load((const GAS f32x4*)(xr + 32 * s)), a1 = __builtin_nontemporal_load((const GAS f32x4*)(xr + 32 * s + 4));
        if (MODE == 2) {
            const u32x4 w0 = *(const GAS u32x4*)(y0 + 32 * s), w1 = *(const GAS u32x4*)(y1 + 32 * s);
            a0[0] += g0 * bflo(w0.x) + g1 * bflo(w1.x); a0[1] += g0 * bfhi(w0.x) + g1 * bfhi(w1.x);
            a0[2] += g0 * bflo(w0.y) + g1 * bflo(w1.y); a0[3] += g0 * bfhi(w0.y) + g1 * bfhi(w1.y);
            a1[0] += g0 * bflo(w0.z) + g1 * bflo(w1.z); a1[1] += g0 * bfhi(w0.z) + g1 * bfhi(w1.z);
            a1[2] += g0 * bflo(w0.w) + g1 * bflo(w1.w); a1[3] += g0 * bfhi(w0.w) + g1 * bfhi(w1.w);
            *(GAS f32x4*)(xw + 32 * s) = a0; *(GAS f32x4*)(xw + 32 * s + 4) = a1;
        }
        ss += (a0[0] * a0[0] + a0[1] * a0[1]) + (a0[2] * a0[2] + a0[3] * a0[3]) + (a1[0] * a1[0] + a1[1] * a1[1]) + (a1[2] * a1[2] + a1[3] * a1[3]);
        u32x4 hi; hi.x = cvt_pk_bf16(a0[0], a0[1]); hi.y = cvt_pk_bf16(a0[2], a0[3]); hi.z = cvt_pk_bf16(a1[0], a1[1]); hi.w = cvt_pk_bf16(a1[2], a1[3]);
        *(GAS u32x4*)(xbr + 32 * s) = hi;
        if (NT > 0) {
            u32x4 lo;
            lo.x = cvt_pk_bf16(a0[0] - bflo(hi.x), a0[1] - bfhi(hi.x)); lo.y = cvt_pk_bf16(a0[2] - bflo(hi.y), a0[3] - bfhi(hi.y));
            lo.z = cvt_pk_bf16(a1[0] - bflo(hi.z), a1[1] - bfhi(hi.z)); lo.w = cvt_pk_bf16(a1[2] - bflo(hi.w), a1[3] - bfhi(hi.w));
            const bf16x8 Ah = __builtin_bit_cast(bf16x8, hi), Al = __builtin_bit_cast(bf16x8, lo);
#pragma unroll
            for (int c = 0; c < NT; ++c) {
                const bf16x8 Bh = *(const GAS bf16x8*)(whi + (size_t)(16 * c + t) * DM + 32 * s + 8 * fq);
                acc[c] = MFMA16(Ah, Bh, acc[c]); acc[c] = MFMA16(Al, Bh, acc[c]);
                if (WLO) { const bf16x8 Bl = *(const GAS bf16x8*)(wlo + (size_t)(16 * c + t) * DM + 32 * s + 8 * fq); acc[c] = MFMA16(Ah, Bl, acc[c]); }
            }
        }
    }
    ss += __shfl_xor(ss, 16); ss += __shfl_xor(ss, 32);
    rstd_lane = 1.0f / sqrtf(ss * (1.0f / DM) + EPS);
    if (fq == 0) rstd_out[tok] = rstd_lane;
}

__device__ __forceinline__ void phase_x0(const Frame& F, const Args& a) {
    f32x4 dummy[1]; float rs;
    for (int tb = F.vcu; tb < NTOK / 128; tb += F.G)
        rowpass_wave<0, 0>(F, a.in[0], nullptr, (bf16_t*)(a.ws + WS_XB), (float*)(a.ws + SM_RSTD), nullptr, nullptr, nullptr, nullptr, nullptr, nullptr, nullptr, tb * 128 + F.wave * 16, dummy, rs);
}


constexpr int RT_WB = 73728, RT_WBUF = 21760;
__device__ __forceinline__ void router_pass(const Frame& F, const bf16_t* xb, float* rstd_out, const bf16_t* whi, int tok0, f32x4 (&acc)[5], float& rstd_lane) {
    const int lane = F.lane, t = lane & 15, fq = lane >> 4, tok = tok0 + t;
    const bf16_t* xbr = xb + (size_t)tok * DM + 8 * fq;
    LAS unsigned char* WB = F.lds + RT_WB;
    u32x4 wr[3];
#define RT_LOAD(chunk) do { _Pragma("unroll") for (int i = 0; i < 3; ++i) { const int p = F.tid + 512 * i; if (p < 1280) wr[i] = *(const GAS u32x4*)(whi + (size_t)(p >> 4) * DM + (chunk) * 128 + (p & 15) * 8); } } while (0)
#define RT_STORE(buf) do { _Pragma("unroll") for (int i = 0; i < 3; ++i) { const int p = F.tid + 512 * i; if (p < 1280) *(LAS u32x4*)(WB + (buf) * RT_WBUF + (p >> 4) * 272 + (p & 15) * 16) = wr[i]; } } while (0)
    __syncthreads();
    RT_LOAD(0); RT_STORE(0);
    __syncthreads();
#pragma unroll
    for (int c = 0; c < 5; ++c) acc[c] = (f32x4){0.f, 0.f, 0.f, 0.f};
    float ss = 0.f;
    u32x4 xc[4], xn[4];
#pragma unroll
    for (int s4 = 0; s4 < 4; ++s4) xc[s4] = *(const GAS u32x4*)(xbr + 32 * s4);
    for (int chunk = 0; chunk < 8; ++chunk) {
        if (chunk + 1 < 8) { RT_LOAD(chunk + 1);
#pragma unroll
            for (int s4 = 0; s4 < 4; ++s4) xn[s4] = *(const GAS u32x4*)(xbr + 32 * ((chunk + 1) * 4 + s4)); }
        const LAS unsigned char* wb = WB + (chunk & 1) * RT_WBUF + t * 272 + fq * 16;
#pragma unroll
        for (int s4 = 0; s4 < 4; ++s4) {
            const u32x4 hi = xc[s4];
            { const float x0 = bflo(hi.x), x1 = bfhi(hi.x), x2 = bflo(hi.y), x3 = bfhi(hi.y), x4 = bflo(hi.z), x5 = bfhi(hi.z), x6 = bflo(hi.w), x7 = bfhi(hi.w);
              ss += (x0 * x0 + x1 * x1) + (x2 * x2 + x3 * x3) + (x4 * x4 + x5 * x5) + (x6 * x6 + x7 * x7); }
            const bf16x8 Ah = __builtin_bit_cast(bf16x8, hi);
#pragma unroll
            for (int c = 0; c < 5; ++c) { const bf16x8 Bh = *(const LAS bf16x8*)(wb + c * (16 * 272) + s4 * 64); acc[c] = MFMA16(Ah, Bh, acc[c]); } }
        if (chunk + 1 < 8) { RT_STORE((chunk + 1) & 1);
#pragma unroll
            for (int s4 = 0; s4 < 4; ++s4) xc[s4] = xn[s4]; }
        __syncthreads();
    }
#undef RT_LOAD
#undef RT_STORE
    ss += __shfl_xor(ss, 16); ss += __shfl_xor(ss, 32);
    rstd_lane = 1.0f / sqrtf(ss * (1.0f / DM) + EPS);
    if (fq == 0) rstd_out[tok] = rstd_lane;
}

__device__ __forceinline__ void phase_router(const Frame& F, const Args& a, int l, bool dry = false) {
    unsigned char* ws = a.ws;
    int* sparse = (int*)(ws + WS_QC);
    LAS float* lg = (LAS float*)(F.lds) + F.wave * (16 * 81);
    LAS float* rsl = (LAS float*)(F.lds + 65536) + F.wave * 16;
    LAS int* hist = (LAS int*)(F.lds + 70000);
    LAS int* bbase = (LAS int*)(F.lds + 70000 + 256);
    LAS int* a_e = (LAS int*)(F.lds + 71000);
    LAS int* a_r = (LAS int*)(F.lds + 72100);
    const bf16_t* whi = (const bf16_t*)(ws + WS_WR) + (size_t)l * 2 * 80 * 1024; const bf16_t* wlo = whi + 80 * 1024;
    unsigned* counts = (unsigned*)(ws + WS_CTL) + CW_CNT + l * 64 + (dry ? 4096 : 0);
    int* toke = (int*)(ws + SM_TOKE); float* tokg = (float*)(ws + SM_TOKG); int* tokp = (int*)(ws + SM_TOKP);
    const float* bg = a.in[14] + l * 8; const float* be = a.in[16] + l * 64;
    for (int tb = F.vcu; tb < NTOK / 128; tb += F.G) {
        __syncthreads();
        if (F.tid < 64) hist[F.tid] = 0;
        __syncthreads();
        f32x4 acc[5]; float rs;
        const int tok0 = tb * 128 + F.wave * 16;
        router_pass(F, (const bf16_t*)(ws + WS_XB), (float*)(ws + SM_RSTD), whi, tok0, acc, rs);
        const int t = F.lane & 15, fq = F.lane >> 4;
        if (fq == 0) rsl[t] = rs;
        LDS_WAIT();
#pragma unroll
        for (int c = 0; c < 5; ++c)
#pragma unroll
            for (int i = 0; i < 4; ++i) { const int tt = 4 * fq + i, col = 16 * c + t; const float bias = col < 8 ? bg[col] : (col < 72 ? be[col - 8] : 0.f);
                lg[tt * 81 + col] = acc[c][i] * rsl[tt] + bias; }
        LDS_WAIT();
        if (F.lane < 16) {
            const LAS float* L = lg + F.lane * 81;
            int grp = 0; float gm = L[0];
#pragma unroll
            for (int j = 1; j < 8; ++j) { const float v = L[j]; if (v > gm) { gm = v; grp = j; } }
            float den = 0.f;
#pragma unroll
            for (int j = 0; j < 8; ++j) den += __expf(L[j] - gm);
            const float pg = 1.0f / den;
            const LAS float* E = L + 8 + grp * 8;
            int i1 = 0; float v1 = E[0];
#pragma unroll
            for (int j = 1; j < 8; ++j) { const float v = E[j]; if (v > v1) { v1 = v; i1 = j; } }
            int i2 = (i1 == 0) ? 1 : 0; float v2 = -3.0e38f;
#pragma unroll
            for (int j = 0; j < 8; ++j) { const float v = E[j]; if (j != i1 && v > v2) { v2 = v; i2 = j; } }
            const float e2 = __expf(v2 - v1), s1 = 1.0f / (1.0f + e2);
            const int tok = tok0 + F.lane, e_a = grp * 8 + i1, e_b = grp * 8 + i2;
            toke[2 * tok] = e_a; toke[2 * tok + 1] = e_b; tokg[2 * tok] = pg * s1; tokg[2 * tok + 1] = pg * e2 * s1;
            const int la = (F.wave * 16 + F.lane) * 2;
            a_e[la] = e_a; a_e[la + 1] = e_b;
            a_r[la] = atomicAdd((int*)(hist + e_a), 1); a_r[la + 1] = atomicAdd((int*)(hist + e_b), 1);
        }
        __syncthreads();
        if (F.tid < 64) bbase[F.tid] = (int)atomicAdd(counts + F.tid, (unsigned)hist[F.tid]);
        __syncthreads();
        if (F.tid < 256) { const int tok = tb * 128 + (F.tid >> 1); const int e = a_e[F.tid], idx = bbase[e] + a_r[F.tid]; tokp[2 * tok + (F.tid & 1)] = idx; if (!dry) sparse[e * 32768 + idx] = tok; }
    }
}

__device__ __forceinline__ int moe_tables(const Frame& F, const unsigned* counts, LAS int* pst, LAS int* cnt) {
    __syncthreads();
    if (F.tid < 64) {
        const int c = (int)counts[F.tid]; const int pc = (c + 255) & ~255;
        int incl = pc;
#pragma unroll
        for (int o = 1; o < 64; o <<= 1) { const int t = __shfl_up(incl, o); if (F.lane >= o) incl += t; }
        const int start = incl - pc;
        cnt[F.tid] = c; pst[F.tid] = start; if (F.tid == 63) pst[64] = incl;
        for (int t = start >> 8; t < (incl >> 8); ++t) pst[256 + t] = F.tid;
    }
    __syncthreads();
    return pst[64] >> 8;
}
constexpr int MOE_TAB_OFF = 131072;
struct TokRec { int e0, e1, q0, q1; float g0, g1; };
__device__ __forceinline__ TokRec tok_rec(const int* toke, const int* tokp, const float* tokg, int tok) { TokRec r; r.e0 = toke[2 * tok]; r.e1 = toke[2 * tok + 1]; r.q0 = tokp[2 * tok]; r.q1 = tokp[2 * tok + 1]; r.g0 = tokg[2 * tok]; r.g1 = tokg[2 * tok + 1]; return r; }
template <bool GATES, bool FINAL>
__device__ __forceinline__ void combine_wave(const Frame& F, bf16_t* xb, float* rstd_out, float* fout, const bf16_t* yb, const TokRec tr, const LAS int* pst,
                                             const bf16_t* whi, const bf16_t* wlo, int tok0, f32x4& acc, float& rstd_lane) {
    const int lane = F.lane, t = lane & 15, fq = lane >> 4, tok = tok0 + t;
    bf16_t* xr = xb + (size_t)tok * DM + 8 * fq;
    const int p0 = pst[tr.e0] + tr.q0, p1 = pst[tr.e1] + tr.q1; const float g0 = tr.g0, g1 = tr.g1;
    const bf16_t* y0 = yb + (size_t)p0 * DM + 8 * fq; const bf16_t* y1 = yb + (size_t)p1 * DM + 8 * fq;
    float* fo = FINAL ? fout + (size_t)tok * DM + 8 * fq : nullptr;
    acc = (f32x4){0.f, 0.f, 0.f, 0.f};
    float ss = 0.f;
#pragma unroll 4
    for (int s = 0; s < 32; ++s) {
        const u32x4 x = *(const GAS u32x4*)(xr + 32 * s), w0 = *(const GAS u32x4*)(y0 + 32 * s), w1 = *(const GAS u32x4*)(y1 + 32 * s);
        float v[8];
        v[0] = bflo(x.x) + g0 * bflo(w0.x) + g1 * bflo(w1.x); v[1] = bfhi(x.x) + g0 * bfhi(w0.x) + g1 * bfhi(w1.x);
        v[2] = bflo(x.y) + g0 * bflo(w0.y) + g1 * bflo(w1.y); v[3] = bfhi(x.y) + g0 * bfhi(w0.y) + g1 * bfhi(w1.y);
        v[4] = bflo(x.z) + g0 * bflo(w0.z) + g1 * bflo(w1.z); v[5] = bfhi(x.z) + g0 * bfhi(w0.z) + g1 * bfhi(w1.z);
        v[6] = bflo(x.w) + g0 * bflo(w0.w) + g1 * bflo(w1.w); v[7] = bfhi(x.w) + g0 * bfhi(w0.w) + g1 * bfhi(w1.w);
        if (FINAL) { __builtin_nontemporal_store((f32x4){v[0], v[1], v[2], v[3]}, (GAS f32x4*)(fo + 32 * s)); __builtin_nontemporal_store((f32x4){v[4], v[5], v[6], v[7]}, (GAS f32x4*)(fo + 32 * s + 4)); }
        u32x4 hi; hi.x = cvt_pk_bf16(v[0], v[1]); hi.y = cvt_pk_bf16(v[2], v[3]); hi.z = cvt_pk_bf16(v[4], v[5]); hi.w = cvt_pk_bf16(v[6], v[7]);
        if (!FINAL) *(GAS u32x4*)(xr + 32 * s) = hi;
        { const float r0 = bflo(hi.x), r1 = bfhi(hi.x), r2 = bflo(hi.y), r3 = bfhi(hi.y), r4 = bflo(hi.z), r5 = bfhi(hi.z), r6 = bflo(hi.w), r7 = bfhi(hi.w);
          ss += (r0 * r0 + r1 * r1) + (r2 * r2 + r3 * r3) + (r4 * r4 + r5 * r5) + (r6 * r6 + r7 * r7); }
        if (GATES) { const bf16x8 Ah = __builtin_bit_cast(bf16x8, hi);
            const bf16x8 Bh = *(const GAS bf16x8*)(whi + (size_t)t * DM + 32 * s + 8 * fq), Bl = *(const GAS bf16x8*)(wlo + (size_t)t * DM + 32 * s + 8 * fq);
            acc = MFMA16(Ah, Bh, acc); acc = MFMA16(Ah, Bl, acc); }
    }
    ss += __shfl_xor(ss, 16); ss += __shfl_xor(ss, 32);
    rstd_lane = 1.0f / sqrtf(ss * (1.0f / DM) + EPS);
    if (!FINAL && fq == 0) rstd_out[tok] = rstd_lane;
}
template <bool FINAL>
__device__ __forceinline__ void combine_rows(const Frame& F, bf16_t* xb, float* rstd_out, float* fout, const bf16_t* yb, const int* toke, const int* tokp, const float* tokg, const LAS int* pst, int tok0) {
    const int lane = F.lane;
#pragma unroll 1
    for (int bt = 0; bt < 4; ++bt) {
        u32x4 xv[4][2], y0v[4][2], y1v[4][2]; float g0[4], g1[4];
#pragma unroll
        for (int t4 = 0; t4 < 4; ++t4) { const int tok = __builtin_amdgcn_readfirstlane(tok0 + 4 * bt + t4);
            const int p0 = __builtin_amdgcn_readfirstlane(pst[toke[2 * tok]] + tokp[2 * tok]), p1 = __builtin_amdgcn_readfirstlane(pst[toke[2 * tok + 1]] + tokp[2 * tok + 1]);
            g0[t4] = tokg[2 * tok]; g1[t4] = tokg[2 * tok + 1];
            const bf16_t* xr = xb + (size_t)tok * DM + 8 * lane; const bf16_t* r0 = yb + (size_t)p0 * DM + 8 * lane; const bf16_t* r1 = yb + (size_t)p1 * DM + 8 * lane;
#pragma unroll
            for (int j = 0; j < 2; ++j) { xv[t4][j] = *(const GAS u32x4*)(xr + 512 * j); y0v[t4][j] = *(const GAS u32x4*)(r0 + 512 * j); y1v[t4][j] = *(const GAS u32x4*)(r1 + 512 * j); } }
#pragma unroll
        for (int t4 = 0; t4 < 4; ++t4) { const int tok = tok0 + 4 * bt + t4; float ss = 0.f;
#pragma unroll
            for (int j = 0; j < 2; ++j) { const u32x4 x = xv[t4][j], w0 = y0v[t4][j], w1 = y1v[t4][j]; const float a0 = g0[t4], a1 = g1[t4];
                float v[8];
                v[0] = bflo(x.x) + a0 * bflo(w0.x) + a1 * bflo(w1.x); v[1] = bfhi(x.x) + a0 * bfhi(w0.x) + a1 * bfhi(w1.x);
                v[2] = bflo(x.y) + a0 * bflo(w0.y) + a1 * bflo(w1.y); v[3] = bfhi(x.y) + a0 * bfhi(w0.y) + a1 * bfhi(w1.y);
                v[4] = bflo(x.z) + a0 * bflo(w0.z) + a1 * bflo(w1.z); v[5] = bfhi(x.z) + a0 * bfhi(w0.z) + a1 * bfhi(w1.z);
                v[6] = bflo(x.w) + a0 * bflo(w0.w) + a1 * bflo(w1.w); v[7] = bfhi(x.w) + a0 * bfhi(w0.w) + a1 * bfhi(w1.w);
                if (FINAL) { float* fo = fout + (size_t)tok * DM + 512 * j + 8 * lane;
                    __builtin_nontemporal_store((f32x4){v[0], v[1], v[2], v[3]}, (GAS f32x4*)fo); __builtin_nontemporal_store((f32x4){v[4], v[5], v[6], v[7]}, (GAS f32x4*)(fo + 4)); }
                else { u32x4 hi; hi.x = cvt_pk_bf16(v[0], v[1]); hi.y = cvt_pk_bf16(v[2], v[3]); hi.z = cvt_pk_bf16(v[4], v[5]); hi.w = cvt_pk_bf16(v[6], v[7]);
                    *(GAS u32x4*)(xb + (size_t)tok * DM + 512 * j + 8 * lane) = hi;
                    const float r0 = bflo(hi.x), r1 = bfhi(hi.x), r2 = bflo(hi.y), r3 = bfhi(hi.y), r4 = bflo(hi.z), r5 = bfhi(hi.z), r6 = bflo(hi.w), r7 = bfhi(hi.w);
                    ss += (r0 * r0 + r1 * r1) + (r2 * r2 + r3 * r3) + (r4 * r4 + r5 * r5) + (r6 * r6 + r7 * r7); } }
            if (!FINAL) {
#pragma unroll
                for (int o = 1; o < 64; o <<= 1) ss += __shfl_xor(ss, o);
                if (lane == 0) rstd_out[tok] = 1.0f / sqrtf(ss * (1.0f / DM) + EPS); } }
    }
}
__device__ __forceinline__ void combine_rows_gates(const Frame& F, bf16_t* xb, float* rstd_out, float* gout, const bf16_t* yb, const int* toke, const int* tokp, const float* tokg, const LAS int* pst, int tok0,
                                                   const float* win  , const float* gain  ) {
    const int lane = F.lane;
    float wg[2][8][8];
#pragma unroll
    for (int j = 0; j < 2; ++j)
#pragma unroll
        for (int i = 0; i < 8; ++i) { const int k = 512 * j + 8 * lane + i; const float gk = gain[k]; const f32x4 a = *(const GAS f32x4*)(win + (size_t)k * 3080 + 3072), b = *(const GAS f32x4*)(win + (size_t)k * 3080 + 3076);
            wg[j][i][0] = a[0] * gk; wg[j][i][1] = a[1] * gk; wg[j][i][2] = a[2] * gk; wg[j][i][3] = a[3] * gk; wg[j][i][4] = b[0] * gk; wg[j][i][5] = b[1] * gk; wg[j][i][6] = b[2] * gk; wg[j][i][7] = b[3] * gk; }
#pragma unroll 1
    for (int bt = 0; bt < 8; ++bt) {
        u32x4 xv[2][2], y0v[2][2], y1v[2][2]; float g0[2], g1[2];
#pragma unroll
        for (int t2 = 0; t2 < 2; ++t2) { const int tok = __builtin_amdgcn_readfirstlane(tok0 + 2 * bt + t2);
            const int p0 = __builtin_amdgcn_readfirstlane(pst[toke[2 * tok]] + tokp[2 * tok]), p1 = __builtin_amdgcn_readfirstlane(pst[toke[2 * tok + 1]] + tokp[2 * tok + 1]);
            g0[t2] = tokg[2 * tok]; g1[t2] = tokg[2 * tok + 1];
            const bf16_t* xr = xb + (size_t)tok * DM + 8 * lane; const bf16_t* r0 = yb + (size_t)p0 * DM + 8 * lane; const bf16_t* r1 = yb + (size_t)p1 * DM + 8 * lane;
#pragma unroll
            for (int j = 0; j < 2; ++j) { xv[t2][j] = *(const GAS u32x4*)(xr + 512 * j); y0v[t2][j] = *(const GAS u32x4*)(r0 + 512 * j); y1v[t2][j] = *(const GAS u32x4*)(r1 + 512 * j); } }
#pragma unroll
        for (int t2 = 0; t2 < 2; ++t2) { const int tok = tok0 + 2 * bt + t2; float ss = 0.f, gs[8];
#pragma unroll
            for (int c = 0; c < 8; ++c) gs[c] = 0.f;
#pragma unroll
            for (int j = 0; j < 2; ++j) { const u32x4 x = xv[t2][j], w0 = y0v[t2][j], w1 = y1v[t2][j]; const float a0 = g0[t2], a1 = g1[t2];
                float v[8];
                v[0] = bflo(x.x) + a0 * bflo(w0.x) + a1 * bflo(w1.x); v[1] = bfhi(x.x) + a0 * bfhi(w0.x) + a1 * bfhi(w1.x);
                v[2] = bflo(x.y) + a0 * bflo(w0.y) + a1 * bflo(w1.y); v[3] = bfhi(x.y) + a0 * bfhi(w0.y) + a1 * bfhi(w1.y);
                v[4] = bflo(x.z) + a0 * bflo(w0.z) + a1 * bflo(w1.z); v[5] = bfhi(x.z) + a0 * bfhi(w0.z) + a1 * bfhi(w1.z);
                v[6] = bflo(x.w) + a0 * bflo(w0.w) + a1 * bflo(w1.w); v[7] = bfhi(x.w) + a0 * bfhi(w0.w) + a1 * bfhi(w1.w);
                u32x4 hi; hi.x = cvt_pk_bf16(v[0], v[1]); hi.y = cvt_pk_bf16(v[2], v[3]); hi.z = cvt_pk_bf16(v[4], v[5]); hi.w = cvt_pk_bf16(v[6], v[7]);
                *(GAS u32x4*)(xb + (size_t)tok * DM + 512 * j + 8 * lane) = hi;
                const float r[8] = {bflo(hi.x), bfhi(hi.x), bflo(hi.y), bfhi(hi.y), bflo(hi.z), bfhi(hi.z), bflo(hi.w), bfhi(hi.w)};
#pragma unroll
                for (int i = 0; i < 8; ++i) { ss += r[i] * r[i];
#pragma unroll
                    for (int c = 0; c < 8; ++c) gs[c] += r[i] * wg[j][i][c]; } }
#pragma unroll
            for (int o = 1; o < 64; o <<= 1) { ss += __shfl_xor(ss, o);
#pragma unroll
                for (int c = 0; c < 8; ++c) gs[c] += __shfl_xor(gs[c], o); }
            const float rs = 1.0f / sqrtf(ss * (1.0f / DM) + EPS);
            if (lane == 0) rstd_out[tok] = rs;
            if (lane < 8) { float gv = gs[0];
#pragma unroll
                for (int c = 1; c < 8; ++c) gv = (lane == c) ? gs[c] : gv;
                gout[(size_t)tok * 8 + lane] = gv * rs; } }
    }
}
__device__ __forceinline__ void phase_combine(const Frame& F, const Args& a, int l) {
    unsigned char* ws = a.ws;
    const bool gates = (l + 1 < NLAYER) && ((l + 1) & 1);
    const int j = (l + 1) >> 1;
    const bf16_t* whi = (const bf16_t*)(ws + WS_WG) + (size_t)j * 2 * 16 * 1024; const bf16_t* wlo = whi + 16 * 1024;
    float* gout = (float*)(ws + SM_GATES);
    LAS float* rsl = (LAS float*)(F.lds) + F.wave * 16;
    LAS int* pst = (LAS int*)(F.lds + MOE_TAB_OFF); LAS int* cnt = (LAS int*)(F.lds + MOE_TAB_OFF + 512);
    const int* tokp = (const int*)(ws + SM_TOKP); const float* tokg = (const float*)(ws + SM_TOKG); const int* toke = (const int*)(ws + SM_TOKE);
    TokRec tr = tok_rec(toke, tokp, tokg, F.vcu * 128 + F.wave * 16 + (F.lane & 15));
    (void)moe_tables(F, (const unsigned*)(ws + WS_CTL) + CW_CNT + l * 64, pst, cnt);
    bf16_t* xb = (bf16_t*)(ws + WS_XB); float* rstd = (float*)(ws + SM_RSTD); const bf16_t* yb = (const bf16_t*)(ws + WS_YB);
    for (int tb = F.vcu; tb < NTOK / 128; tb += F.G) {
        f32x4 acc; float rs; const int tok0 = tb * 128 + F.wave * 16;
        if (tb != F.vcu) tr = tok_rec(toke, tokp, tokg, tok0 + (F.lane & 15));
        if (l + 1 == NLAYER) combine_rows<true>(F, xb, rstd, a.out, yb, toke, tokp, tokg, pst, tok0);
        else if (gates) { combine_rows_gates(F, xb, rstd, gout, yb, toke, tokp, tokg, pst, tok0, a.in[7] + (size_t)j * DM * 3080, a.in[1] + (size_t)(2 * j + 1) * DM);
        } else combine_rows<false>(F, xb, rstd, nullptr, yb, toke, tokp, tokg, pst, tok0);
    }
}

constexpr int ATT_KB = 0, ATT_VT = 36864;
struct AttnRegs { u32x4 k[2]; u32x4 v0, v1; bf16x8 q0, q1; };
struct AttnStep { int d, b, h, r, blk; bool prime; };
__device__ __forceinline__ void attn_fetch(const Frame& F, const bf16_t* QKV, const AttnStep& u, AttnRegs& R) {
    const int tid = F.tid, fr = F.lane & 15, fq = F.lane >> 4; const bool valid = u.blk >= 0; const int s0 = u.blk * 128;
#pragma unroll
    for (int i = 0; i < 2; ++i) { const int id = tid + 512 * i, row = id >> 3, ch = id & 7;
        R.k[i] = (u32x4){0u, 0u, 0u, 0u};
        if (valid) R.k[i] = *(const GAS u32x4*)(QKV + ((size_t)(32 + u.b * 16 + u.h) * SEQ + (s0 + row) * u.d + u.r) * 64 + 8 * ch); }
    { const int pair = tid >> 3, ch = tid & 7;
        R.v0 = (u32x4){0u, 0u, 0u, 0u}; R.v1 = (u32x4){0u, 0u, 0u, 0u};
        if (valid) { const bf16_t* p = QKV + ((size_t)(64 + u.b * 16 + u.h) * SEQ + (s0 + 2 * pair) * u.d + u.r) * 64 + 8 * ch; R.v0 = *(const GAS u32x4*)p; R.v1 = *(const GAS u32x4*)(p + (size_t)u.d * 64); } }
    if (!u.prime) { const size_t qrow = (size_t)(u.b * 16 + u.h) * SEQ + (s0 + 16 * F.wave + fr) * u.d + u.r;
        R.q0 = *(const GAS bf16x8*)(QKV + qrow * 64 + 8 * fq); R.q1 = *(const GAS bf16x8*)(QKV + qrow * 64 + 32 + 8 * fq); }
}
__device__ __forceinline__ void attn_stage(const Frame& F, const AttnRegs& R, int slot) {
    LAS unsigned char* Kb = F.lds + ATT_KB; LAS unsigned* VT = (LAS unsigned*)(F.lds + ATT_VT);
#pragma unroll
    for (int i = 0; i < 2; ++i) { const int id = F.tid + 512 * i, row = id >> 3, ch = id & 7; *(LAS u32x4*)(Kb + (slot * 128 + row) * 144 + ch * 16) = R.k[i]; }
    { const int pair = F.tid >> 3, ch = F.tid & 7; const u32x4 v0 = R.v0, v1 = R.v1;
        LAS unsigned* o = VT + (8 * ch) * 129 + slot * 64 + pair;
        o[0 * 129] = (v0.x & 0xffffu) | (v1.x << 16); o[1 * 129] = (v0.x >> 16) | (v1.x & 0xffff0000u);
        o[2 * 129] = (v0.y & 0xffffu) | (v1.y << 16); o[3 * 129] = (v0.y >> 16) | (v1.y & 0xffff0000u);
        o[4 * 129] = (v0.z & 0xffffu) | (v1.z << 16); o[5 * 129] = (v0.z >> 16) | (v1.z & 0xffff0000u);
        o[6 * 129] = (v0.w & 0xffffu) | (v1.w << 16); o[7 * 129] = (v0.w >> 16) | (v1.w & 0xffff0000u); }
}
template <int MODE, bool FIRST>
__device__ __forceinline__ void attn_compute(const Frame& F, const AttnStep& u, const int par, const bf16x8 Q0, const bf16x8 Q1, float off2, bf16_t* part_out, float* l_out, bf16_t* OB, const bf16_t* PP1, const bf16_t* PP2, const float* PL1, const float* PL2) {
    const int lane = F.lane, w = F.wave, fr = lane & 15, fq = lane >> 4;
    const int si0 = u.blk * 128;
    const LAS unsigned char* Kb = F.lds + ATT_KB; const LAS unsigned* VT = (const LAS unsigned*)(F.lds + ATT_VT);
    const int iq = 16 * w + fr; const size_t qrow = (size_t)(u.b * SEQ + (si0 + iq) * u.d + u.r), hrow = (size_t)(u.b * 16 + u.h) * SEQ + (si0 + iq) * u.d + u.r;
    f32x4 O[4];
#pragma unroll
    for (int dt = 0; dt < 4; ++dt) O[dt] = (f32x4){0.f, 0.f, 0.f, 0.f};
    float lsum = 0.f;
#pragma unroll
    for (int up = 0; up < 5; ++up) {
        unsigned pk[4];
#pragma unroll
        for (int hh = 0; hh < 2; ++hh) {
            const int tt = 2 * up + hh;
            if (tt < 9) {
                const int kt = w + tt;
                const int prow = ((kt < 8) ? (par ^ 1) : par) * 128 + 16 * (kt & 7);
                const LAS unsigned char* kp = Kb + (prow + fr) * 144 + fq * 16;
                f32x4 s = (f32x4){0.f, 0.f, 0.f, 0.f};
                s = MFMA16(ld_frag_lds(kp), Q0, s); s = MFMA16(ld_frag_lds(kp + 64), Q1, s);
                float p[4];
                if (FIRST || tt == 0 || tt == 8) {
#pragma unroll
                    for (int i = 0; i < 4; ++i) { const int jk = 16 * kt + 4 * fq + i; const bool ok = (jk >= iq) && (jk <= iq + 128) && (!FIRST || jk >= 128);
                        p[i] = ok ? fast_exp2(s[i] - off2) : 0.f; }
                } else {
#pragma unroll
                    for (int i = 0; i < 4; ++i) p[i] = fast_exp2(s[i] - off2);
                }
                lsum += (p[0] + p[1]) + (p[2] + p[3]);
                pk[2 * hh] = cvt_pk_bf16(p[0], p[1]); pk[2 * hh + 1] = cvt_pk_bf16(p[2], p[3]);
            } else { pk[2 * hh] = 0u; pk[2 * hh + 1] = 0u; }
        }
        const bf16x8 Pf = mk_frag(pk[0], pk[1], pk[2], pk[3]);
        const int kt0 = w + 2 * up, kt1 = (2 * up + 1 < 9) ? kt0 + 1 : kt0;
        const int pb0 = ((kt0 < 8) ? (par ^ 1) : par) * 64 + 8 * (kt0 & 7), pb1 = ((kt1 < 8) ? (par ^ 1) : par) * 64 + 8 * (kt1 & 7);
#pragma unroll
        for (int dt = 0; dt < 4; ++dt) { const LAS unsigned* vp = VT + (16 * dt + fr) * 129 + 2 * fq;
            const bf16x8 V = mk_frag(vp[pb0], vp[pb0 + 1], vp[pb1], vp[pb1 + 1]);
            O[dt] = MFMA16(V, Pf, O[dt]); }
    }
    lsum += __shfl_xor(lsum, 16); lsum += __shfl_xor(lsum, 32);
    if (MODE == 0) {
        bf16_t* o = part_out + hrow * 64 + 4 * fq;
#pragma unroll
        for (int dt = 0; dt < 4; ++dt) { u32x2 wv; wv.x = cvt_pk_bf16(O[dt][0], O[dt][1]); wv.y = cvt_pk_bf16(O[dt][2], O[dt][3]); *(GAS u32x2*)(o + 16 * dt) = wv; }
        if (fq == 0) l_out[hrow] = lsum;
    } else {
        const float inv = 1.0f / (lsum + PL1[hrow] + PL2[hrow]);
        bf16_t* o = OB + hrow * 64 + 4 * fq;
#pragma unroll
        for (int dt = 0; dt < 4; ++dt) { const u32x2 x1 = *(const GAS u32x2*)(PP1 + hrow * 64 + 4 * fq + 16 * dt), x2 = *(const GAS u32x2*)(PP2 + hrow * 64 + 4 * fq + 16 * dt);
            const float o0 = (O[dt][0] + bflo(x1.x) + bflo(x2.x)) * inv, o1 = (O[dt][1] + bfhi(x1.x) + bfhi(x2.x)) * inv;
            const float o2 = (O[dt][2] + bflo(x1.y) + bflo(x2.y)) * inv, o3 = (O[dt][3] + bfhi(x1.y) + bfhi(x2.y)) * inv;
            u32x2 wv; wv.x = cvt_pk_bf16(o0, o1); wv.y = cvt_pk_bf16(o2, o3); *(GAS u32x2*)(o + 16 * dt) = wv; }
    }
}
__device__ __forceinline__ float attn_off2(const float* qg, const float* kg) {
    const int i = threadIdx.x & 63; float mx = fabsf(qg[i] * kg[i]);
#pragma unroll
    for (int o = 1; o < 64; o <<= 1) mx = fmaxf(mx, __shfl_xor(mx, o));
    return 8.0f * mx * LOG2E * 1.02f;
}
template <int MODE>
__device__ __forceinline__ AttnStep attn_step(int s, int vcu, int& br) {
    const int xcd = vcu >> 5, jb = vcu & 31; AttnStep u; int bhl, nblk0, o;
    if (MODE == 0) {
        if (s < 18) { const int ci = 2 * jb + (s >= 9 ? 1 : 0); o = s >= 9 ? s - 9 : s; u.d = 16; bhl = ci >> 4; u.r = ci & 15; nblk0 = 0; br = 0; }
        else { o = s - 18; u.d = 4; bhl = jb >> 3; u.r = (jb & 7) >> 1; nblk0 = 16 * (jb & 1); br = 1; }
    } else { o = s; u.d = 1; bhl = jb >> 3; u.r = 0; nblk0 = 16 * (jb & 7); br = 0; }
    const int bh = xcd + 8 * bhl; u.b = bh >> 4; u.h = bh & 15; u.blk = nblk0 + o - 1; u.prime = (o == 0);
    return u;
}
template <int MODE>
__device__ __forceinline__ void phase_attn(const Frame& F, const Args& a, int j) {
    unsigned char* ws = a.ws; const bf16_t* QKV = (const bf16_t*)(ws + WS_QKV);
    const float off2 = attn_off2(a.in[4] + j * 64, a.in[5] + j * 64);
    constexpr int NSTEP = (MODE == 0) ? 35 : 17;
    if (F.G != 256) return;
    AttnRegs R; R.q0 = (bf16x8){0, 0, 0, 0, 0, 0, 0, 0}; R.q1 = R.q0; int br = 0, ucount = 0;
    AttnStep st = attn_step<MODE>(0, F.vcu, br);
    attn_fetch(F, QKV, st, R);
    const bf16_t* P1 = (const bf16_t*)(ws + WS_P1); const bf16_t* P2 = (const bf16_t*)(ws + WS_P2); const float* L1 = (const float*)(ws + SM_L1); const float* L2 = (const float*)(ws + SM_L2);
    for (int s = 0; s < NSTEP; ++s) {
        __syncthreads();
        attn_stage(F, R, s & 1);
        const bf16x8 Q0 = R.q0, Q1 = R.q1;
        const AttnStep cur = st; const int cbr = br;
        if (s + 1 < NSTEP) { st = attn_step<MODE>(s + 1, F.vcu, br); attn_fetch(F, QKV, st, R); }
        __syncthreads();
        if (cur.prime) continue;
        const int slot = (MODE == 0 ? 0 : 32) + ucount; ++ucount; const int cl = 2 * j + (slot >= 24 ? 1 : 0); const int cit = (F.vcu * 8 + F.wave) + 2048 * (slot % 24);
        const bool do_cvt = (slot < 48) && (cit < MOE_ITEMS);
        CvtDesc cd = cvt_moe_desc(a, cl, do_cvt ? cit : 0); f32x4 cv[8];
        if (do_cvt) cvt_load(cd, F.lane, cv);
        if (cur.blk == 0) attn_compute<MODE, true>(F, cur, s & 1, Q0, Q1, off2, (bf16_t*)(ws + (cbr == 0 ? WS_P1 : WS_P2)), (float*)(ws + (cbr == 0 ? SM_L1 : SM_L2)), (bf16_t*)(ws + WS_OB), P1, P2, L1, L2);
        else attn_compute<MODE, false>(F, cur, s & 1, Q0, Q1, off2, (bf16_t*)(ws + (cbr == 0 ? WS_P1 : WS_P2)), (float*)(ws + (cbr == 0 ? SM_L1 : SM_L2)), (bf16_t*)(ws + WS_OB), P1, P2, L1, L2);
        if (do_cvt) cvt_finish(cd, F.lane, cv, (LAS float*)(F.lds + 71680 + F.wave * 8448));
    }
}
__device__ __forceinline__ void phase_attn_a(const Frame& F, const Args& a, int j) { phase_attn<0>(F, a, j); }
__device__ __forceinline__ void phase_attn_b(const Frame& F, const Args& a, int j) { phase_attn<1>(F, a, j); }

__device__ __forceinline__ float log_sigmoid(float x) { return fminf(x, 0.f) - __logf(1.0f + __expf(-fabsf(x))); }
__device__ __forceinline__ float wave_incl_scan_add(float v, int lane) {
#pragma unroll
    for (int o = 1; o < 64; o <<= 1) { const float t = __shfl_up(v, o); if (lane >= o) v += t; }
    return v;
}
__device__ __forceinline__ float wave_incl_scan_max(float v, int lane) {
#pragma unroll
    for (int o = 1; o < 64; o <<= 1) { const float t = __shfl_up(v, o); if (lane >= o) v = fmaxf(v, t); }
    return v;
}
__device__ __forceinline__ float wave_max(float v) {
#pragma unroll
    for (int o = 1; o < 64; o <<= 1) v = fmaxf(v, __shfl_xor(v, o));
    return v;
}
constexpr int B2_KWT = 0, B2_VT = 18432, B2_WS = 52224, B2_RAW = 56320, B2_OUT = 91904;
__device__ __forceinline__ int vt_col(int dv, int pair) { return (pair + (dv >> 5)) & 31; }
__device__ __forceinline__ void mlstm_fetch_v(const Frame& F, const bf16_t* QKV, int n0, int h, u32x4 (&v0)[2], u32x4 (&v1)[2]) {
#pragma unroll
    for (int i = 0; i < 2; ++i) { const int id = F.tid + 512 * i, ch = id & 31, pair = id >> 5;
        const bf16_t* p = QKV + (size_t)(n0 + 2 * pair) * 3072 + 1024 + h * 256 + 8 * ch;
        v0[i] = *(const GAS u32x4*)p; v1[i] = *(const GAS u32x4*)(p + 3072); }
}
__device__ __forceinline__ void mlstm_write_vT(const Frame& F, const u32x4 (&v0a)[2], const u32x4 (&v1a)[2], LAS unsigned* VT) {
#pragma unroll
    for (int i = 0; i < 2; ++i) { const int id = F.tid + 512 * i, ch = id & 31, pair = id >> 5; const u32x4 v0 = v0a[i], v1 = v1a[i];
        LAS unsigned* o = VT + (8 * ch) * 33 + ((pair + (ch >> 2)) & 31);
        o[0 * 33] = (v0.x & 0xffffu) | (v1.x << 16); o[1 * 33] = (v0.x >> 16) | (v1.x & 0xffff0000u);
        o[2 * 33] = (v0.y & 0xffffu) | (v1.y << 16); o[3 * 33] = (v0.y >> 16) | (v1.y & 0xffff0000u);
        o[4 * 33] = (v0.z & 0xffffu) | (v1.z << 16); o[5 * 33] = (v0.z >> 16) | (v1.z & 0xffff0000u);
        o[6 * 33] = (v0.w & 0xffffu) | (v1.w << 16); o[7 * 33] = (v0.w >> 16) | (v1.w & 0xffff0000u); }
}
__device__ __forceinline__ void mlstm_stage_vT(const Frame& F, const bf16_t* QKV, int n0, int h, LAS unsigned* VT) {
    u32x4 v0[2], v1[2]; mlstm_fetch_v(F, QKV, n0, h, v0, v1); mlstm_write_vT(F, v0, v1, VT);
}
__device__ __forceinline__ void phase_mlstm_local(const Frame& F, const Args& a, int j) {
    unsigned char* ws = a.ws; const bf16_t* QKV = (const bf16_t*)(ws + WS_QKV);
    const float* gates = (const float*)(ws + SM_GATES); const float* gb = a.in[10] + j * 8;
    const float* cw = a.in[8] + (size_t)j * 4 * 1024; const float* cb = a.in[9] + j * 1024;
    bf16_t* QC = (bf16_t*)(ws + WS_QC); bf16_t* KC = (bf16_t*)(ws + WS_KC);
    bf16_t* DC = (bf16_t*)(ws + WS_DC); float* DN = (float*)(ws + SM_DN); float* MLOC = (float*)(ws + SM_MLOC); float* BL = (float*)(ws + SM_BL);
    LAS unsigned char* KwT = F.lds + B2_KWT; LAS unsigned* VT = (LAS unsigned*)(F.lds + B2_VT); LAS float* wsm = (LAS float*)(F.lds + B2_WS);
    if (F.vcu >= 256) return;
    const int bh = F.vcu >> 5, sc = F.vcu & 31, b = bh >> 2, h = bh & 3, us = bh * 32 + sc;
    f32x4 Dacc[2][8], an = (f32x4){0.f, 0.f, 0.f, 0.f};
#pragma unroll
    for (int bt = 0; bt < 2; ++bt)
#pragma unroll
        for (int at = 0; at < 8; ++at) Dacc[bt][at] = (f32x4){0.f, 0.f, 0.f, 0.f};
    float mq = -__builtin_inff(), blsum = 0.f;
    LAS float* G2 = (LAS float*)(F.lds + B2_WS + 512);
    { const int w_ = F.wave, lane_ = F.lane; const int n0w = b * SEQ + (sc * 8 + w_) * 64;
        const float ipre = DBGG(gates[(size_t)(n0w + lane_) * 8 + h]) + gb[h]; const float fpre = DBGG(gates[(size_t)(n0w + lane_) * 8 + 4 + h]) + gb[4 + h];
        const float bs = wave_incl_scan_add(log_sigmoid(fpre), lane_); const float bL = __shfl(bs, 63);
        const float gs = bL - bs + ipre; const float ml = wave_max(gs);
        G2[w_ * 64 + lane_] = __expf(gs - ml);
        if (lane_ == 0) { G2[512 + 2 * w_] = bL; G2[512 + 2 * w_ + 1] = ml; } }
    u32x4 Rv0[2], Rv1[2], Rr[5];
    LAS unsigned char* raw = F.lds + B2_RAW;
#define B2_FETCH(FR, c_) do { _Pragma("unroll") for (int i = 0; i < 5; ++i) { const int p = FR.tid + 512 * i, r = p >> 5, hf = (p >> 4) & 1, c16 = p & 15; const int pos = (c_) * 64 - 3 + r; \
            Rr[i] = (u32x4){0u, 0u, 0u, 0u}; if (p < 67 * 32 && pos >= 0) Rr[i] = *(const GAS u32x4*)(QKV + (size_t)(b * SEQ + pos) * 3072 + hf * 512 + h * 128 + 8 * c16); } } while (0)
    B2_FETCH(F, sc * 8); mlstm_fetch_v(F, QKV, b * SEQ + sc * 8 * 64, h, Rv0, Rv1);
    for (int jc = 0; jc < 8; ++jc) {
        const Frame Fi = make_frame(F.lds);
        const int lane = Fi.lane, fr = lane & 15, fq = lane >> 4, w = Fi.wave;
        const int c = sc * 8 + jc, n0 = b * SEQ + c * 64;
        __syncthreads();
        if (Fi.tid < 64) { const int s = Fi.tid; const float bL = G2[512 + 2 * jc], ml = G2[512 + 2 * jc + 1];
            const float mn = fmaxf(bL + mq, ml); const float aa = __expf(bL + mq - mn), bb = __expf(ml - mn);
            wsm[s] = G2[jc * 64 + s] * bb;
            if (s == 0) wsm[64] = aa;
            mq = mn; blsum += bL; }
        mlstm_write_vT(Fi, Rv0, Rv1, VT);
#pragma unroll
        for (int i = 0; i < 5; ++i) { const int p = Fi.tid + 512 * i, r = p >> 5, hf = (p >> 4) & 1, c16 = p & 15; if (p < 67 * 32) *(LAS u32x4*)(raw + r * 528 + hf * 256 + c16 * 16) = Rr[i]; }
        if (jc + 1 < 8) { mlstm_fetch_v(Fi, QKV, b * SEQ + (c + 1) * 64, h, Rv0, Rv1); B2_FETCH(Fi, c + 1); }
        __syncthreads();
#pragma unroll
        for (int i = 0; i < 4; ++i) { const int id = Fi.tid + 512 * i, s = id & 63, ch = (id >> 6) & 15, isk = id >> 10;
            const int col = (isk ? 512 : 0) + h * 128 + 8 * ch;
            float accv[8];
#pragma unroll
            for (int e = 0; e < 8; ++e) accv[e] = cb[col + e];
#pragma unroll
            for (int jj = 0; jj < 4; ++jj) { const u32x4 x = *(const LAS u32x4*)(raw + (s + jj) * 528 + isk * 256 + ch * 16); const float* wj = cw + jj * 1024 + col;
                accv[0] += wj[0] * bflo(x.x); accv[1] += wj[1] * bfhi(x.x); accv[2] += wj[2] * bflo(x.y); accv[3] += wj[3] * bfhi(x.y);
                accv[4] += wj[4] * bflo(x.z); accv[5] += wj[5] * bfhi(x.z); accv[6] += wj[6] * bflo(x.w); accv[7] += wj[7] * bfhi(x.w); }
            const float scq = isk ? 0.08838834764831845f : 1.0f;
#pragma unroll
            for (int e = 0; e < 8; ++e) { const float v = accv[e]; accv[e] = v * fast_rcp(1.0f + __expf(-v)) * scq; }
            u32x4 o; o.x = cvt_pk_bf16(accv[0], accv[1]); o.y = cvt_pk_bf16(accv[2], accv[3]); o.z = cvt_pk_bf16(accv[4], accv[5]); o.w = cvt_pk_bf16(accv[6], accv[7]);
            *(LAS u32x4*)(F.lds + B2_OUT + isk * 17408 + s * 272 + ch * 16) = o;
            if (isk) { const float wv = wsm[s];
#pragma unroll
                for (int e = 0; e < 8; ++e) *(LAS bf16_t*)(KwT + (8 * ch + e) * 144 + 2 * s) = (bf16_t)f2bf(accv[e] * wv); } }
        __syncthreads();
#pragma unroll
        for (int i = 0; i < 4; ++i) { const int id = Fi.tid + 512 * i, c16 = id & 15, s = (id >> 4) & 63, isk = id >> 10;
            *(GAS u32x4*)((isk ? KC : QC) + ((size_t)(b * 4 + h) * SEQ + c * 64 + s) * 128 + 8 * c16) = *(const LAS u32x4*)(F.lds + B2_OUT + isk * 17408 + s * 272 + c16 * 16); }
        const float aa = wsm[64];
        bf16x8 Bv[2][2];
#pragma unroll
        for (int bt = 0; bt < 2; ++bt)
#pragma unroll
            for (int kk = 0; kk < 2; ++kk) { const int dvr = 16 * (2 * w + bt) + fr; const LAS unsigned* vp = VT + dvr * 33; const int p0 = 4 * fq + 16 * kk; Bv[bt][kk] = mk_frag(vp[vt_col(dvr, p0)], vp[vt_col(dvr, p0 + 1)], vp[vt_col(dvr, p0 + 2)], vp[vt_col(dvr, p0 + 3)]); }
        an *= aa;
#pragma unroll
        for (int at = 0; at < 8; ++at) {
            const LAS unsigned char* kp = KwT + (16 * at + fr) * 144 + 16 * fq;
            const bf16x8 A0 = ld_frag_lds(kp), A1 = ld_frag_lds(kp + 64);
#pragma unroll
            for (int bt = 0; bt < 2; ++bt) { f32x4 d = Dacc[bt][at] * aa; d = MFMA16(A0, Bv[bt][0], d); d = MFMA16(A1, Bv[bt][1], d); Dacc[bt][at] = d; }
            if (at == w) {
                const bf16x8 ones = mk_frag(0x3f803f80u, 0x3f803f80u, 0x3f803f80u, 0x3f803f80u);
                an = MFMA16(A0, ones, an); an = MFMA16(A1, ones, an); }
        }
    }
    { const int lane = F.lane, fr = lane & 15, fq = lane >> 4, w = F.wave;
        bf16_t* dcu = DC + (size_t)us * 32768;
#pragma unroll
        for (int bt = 0; bt < 2; ++bt)
#pragma unroll
            for (int at = 0; at < 8; ++at) { const f32x4 d = Dacc[bt][at]; u32x2 wv; wv.x = cvt_pk_bf16(d[0], d[1]); wv.y = cvt_pk_bf16(d[2], d[3]);
                *(GAS u32x2*)(dcu + (size_t)(16 * (2 * w + bt) + fr) * 128 + 16 * at + 4 * fq) = wv; }
        if (fr == 0) *(GAS f32x4*)(DN + (size_t)us * 128 + 16 * w + 4 * fq) = an;
        if (F.tid == 0) { MLOC[us] = mq; BL[us] = blsum; } }
#undef B2_FETCH
}
__device__ __forceinline__ void phase_mlstm_scan(const Frame& F, const Args& a) {
    unsigned char* ws = a.ws;
    if (F.vcu >= 256 || F.tid >= 256) return;
    const int bh = F.vcu >> 5, part = F.vcu & 31; const size_t eoff = (size_t)part * 1024 + F.tid * 4;
    const bf16_t* DC = (const bf16_t*)(ws + WS_DC); bf16_t* CS = (bf16_t*)(ws + WS_CS);
    const float* DN = (const float*)(ws + SM_DN); float* NS = (float*)(ws + SM_NS);
    const float* MLOC = (const float*)(ws + SM_MLOC); const float* BL = (const float*)(ws + SM_BL); float* MPREV = (float*)(ws + SM_MPREV);
    const bool doN = (part == 0) && (F.tid < 128);
    float st[4] = {0.f, 0.f, 0.f, 0.f}, nst = 0.f, m = 0.f;
    u32x2 dcA[8], dcB[8]; float blA[8], mlA[8], dnA[8], blB[8], mlB[8], dnB[8];
#define B3_LOAD(dc, bl, ml, dn, c0) do { _Pragma("unroll") for (int i = 0; i < 8; ++i) { const int u = bh * 32 + (c0) + i; dc[i] = *(const GAS u32x2*)(DC + (size_t)u * 32768 + eoff); bl[i] = BL[u]; ml[i] = MLOC[u]; dn[i] = doN ? DN[(size_t)u * 128 + F.tid] : 0.f; } } while (0)
#define B3_STEP(dc, bl, ml, dn, c0) do { _Pragma("unroll") for (int i = 0; i < 8; ++i) { const int u = bh * 32 + (c0) + i; \
            u32x2 o; o.x = cvt_pk_bf16(st[0], st[1]); o.y = cvt_pk_bf16(st[2], st[3]); \
            *(GAS u32x2*)(CS + (size_t)u * 32768 + eoff) = o; \
            if (doN) NS[(size_t)u * 128 + F.tid] = nst; \
            if (part == 0 && F.tid == 0) MPREV[u] = m; \
            const float mn = fmaxf(bl[i] + m, ml[i]); const float aa = __expf(bl[i] + m - mn), bb = __expf(ml[i] - mn); \
            st[0] = aa * st[0] + bb * bflo(dc[i].x); st[1] = aa * st[1] + bb * bfhi(dc[i].x); st[2] = aa * st[2] + bb * bflo(dc[i].y); st[3] = aa * st[3] + bb * bfhi(dc[i].y); \
            nst = aa * nst + bb * dn[i]; m = mn; } } while (0)
    B3_LOAD(dcA, blA, mlA, dnA, 0);
    for (int c0 = 0; c0 < 32; c0 += 16) {
        B3_LOAD(dcB, blB, mlB, dnB, c0 + 8);
        B3_STEP(dcA, blA, mlA, dnA, c0);
        if (c0 + 16 < 32) B3_LOAD(dcA, blA, mlA, dnA, c0 + 16);
        B3_STEP(dcB, blB, mlB, dnB, c0 + 8);
    }
#undef B3_LOAD
#undef B3_STEP
}
constexpr int B4_QS = 0, B4_KS = 17408, B4_VT = 34816, B4_SS = 68608, B4_SC = 77824, B4_KWT = 86016, B4_G = 104448;
__device__ __forceinline__ void phase_mlstm_out(const Frame& F, const Args& a, int j) {
    unsigned char* ws = a.ws; const bf16_t* QKV = (const bf16_t*)(ws + WS_QKV);
    const float* gates = (const float*)(ws + SM_GATES); const float* gb = a.in[10] + j * 8; const float* hg = a.in[11] + (size_t)j * 1024;
    const bf16_t* QC = (const bf16_t*)(ws + WS_QC); const bf16_t* KC = (const bf16_t*)(ws + WS_KC);
    const bf16_t* CS = (const bf16_t*)(ws + WS_CS); const float* NS = (const float*)(ws + SM_NS); const float* MPREV = (const float*)(ws + SM_MPREV);
    bf16_t* OB = (bf16_t*)(ws + WS_OB);
    LAS unsigned char* Qs = F.lds + B4_QS; LAS unsigned char* Ks = F.lds + B4_KS; LAS unsigned* VT = (LAS unsigned*)(F.lds + B4_VT); LAS unsigned char* Ss = F.lds + B4_SS; LAS unsigned char* KwT = F.lds + B4_KWT;
    LAS float* us = (LAS float*)(F.lds + B4_SC); LAS float* Ms = us + 64; LAS float* wint = us + 128; LAS float* eneg = us + 192; LAS float* npv = us + 256; LAS float* den = us + 384  ; LAS float* qn = us + 640  ; LAS float* hss = us + 1152  ;
    LAS float* wk = us + 1664  ; LAS float* scal = us + 1728;
    const int lane = F.lane, fr = lane & 15, fq = lane >> 4, w = F.wave;
    if (F.vcu >= 256) return;
    const int bh = F.vcu >> 5, sc = F.vcu & 31, b = bh >> 2, h = bh & 3;
    const int us0 = bh * 32 + sc;
    f32x4 Cst[2][8];
#pragma unroll
    for (int bt = 0; bt < 2; ++bt)
#pragma unroll
        for (int at = 0; at < 8; ++at) { const u32x2 x = *(const GAS u32x2*)(CS + (size_t)us0 * 32768 + (size_t)(16 * (2 * w + bt) + fr) * 128 + 16 * at + 4 * fq);
            Cst[bt][at] = (f32x4){bflo(x.x), bfhi(x.x), bflo(x.y), bfhi(x.y)}; }
    float mcur = MPREV[us0];
    LAS float* G4 = (LAS float*)(F.lds + B4_G);
    { const int n0w = b * SEQ + (sc * 8 + w) * 64;
        const float ipre = DBGG(gates[(size_t)(n0w + lane) * 8 + h]) + gb[h]; const float fpre = DBGG(gates[(size_t)(n0w + lane) * 8 + 4 + h]) + gb[4 + h];
        const float bs = wave_incl_scan_add(log_sigmoid(fpre), lane); const float uu = ipre - bs; const float pm = wave_incl_scan_max(uu, lane);
        const float bL = __shfl(bs, 63); const float gs = bL - bs + ipre; const float ml = wave_max(gs);
        G4[(w * 4 + 0) * 64 + lane] = bs; G4[(w * 4 + 1) * 64 + lane] = uu; G4[(w * 4 + 2) * 64 + lane] = pm; G4[(w * 4 + 3) * 64 + lane] = __expf(gs - ml);
        if (lane == 0) { G4[2048 + 2 * w] = bL; G4[2048 + 2 * w + 1] = ml; } }
    if (F.tid >= 64 && F.tid < 192) npv[F.tid - 64] = NS[(size_t)us0 * 128 + F.tid - 64];
    u32x4 Rqk[4], Rv0[2], Rv1[2];
#define B4_FETCH(FR, c_) do { const int n0_ = b * SEQ + (c_) * 64; \
        _Pragma("unroll") for (int i = 0; i < 4; ++i) { const int id = FR.tid + 512 * i, ch = id & 15, s = (id >> 4) & 63, isk = id >> 10; \
            Rqk[i] = *(const GAS u32x4*)((isk ? KC : QC) + ((size_t)(b * 4 + h) * SEQ + (c_) * 64 + s) * 128 + 8 * ch); } \
        mlstm_fetch_v(FR, QKV, n0_, h, Rv0, Rv1); } while (0)
    B4_FETCH(F, sc * 8);
    for (int jc = 0; jc < 8; ++jc) {
        const Frame Fi = make_frame(F.lds);
        const int lane = Fi.lane, fr = lane & 15, fq = lane >> 4, w = Fi.wave;
        const int c = sc * 8 + jc, n0 = b * SEQ + c * 64;
        __syncthreads();
        if (Fi.tid < 64) { const int s = Fi.tid; const float bs = G4[(jc * 4 + 0) * 64 + s], uu = G4[(jc * 4 + 1) * 64 + s], pm = G4[(jc * 4 + 2) * 64 + s];
            const float mp = mcur; const float M = fmaxf(mp, pm);
            us[s] = uu; Ms[s] = M; wint[s] = __expf(mp - M); eneg[s] = __expf(-(bs + M));
            const float bL = G4[2048 + 2 * jc], ml = G4[2048 + 2 * jc + 1];
            const float mn = fmaxf(bL + mp, ml); const float aa = __expf(bL + mp - mn), bb = __expf(ml - mn);
            wk[s] = G4[(jc * 4 + 3) * 64 + s] * bb;
            if (s == 0) scal[0] = aa;
            mcur = mn; }
#pragma unroll
        for (int i = 0; i < 4; ++i) { const int id = Fi.tid + 512 * i, ch = id & 15, s = (id >> 4) & 63, isk = id >> 10;
            *(LAS u32x4*)((isk ? Ks : Qs) + s * 272 + ch * 16) = Rqk[i]; }
        mlstm_write_vT(Fi, Rv0, Rv1, VT);
        if (jc + 1 < 8) B4_FETCH(Fi, c + 1);
        __syncthreads();
        u32x2 ogv[4][2]; f32x4 hgv[2];
#pragma unroll
        for (int dv = 0; dv < 2; ++dv) { const int col = h * 256 + 16 * (2 * w + dv) + 4 * fq; hgv[dv] = *(const GAS f32x4*)(hg + col);
#pragma unroll
            for (int tt = 0; tt < 4; ++tt) ogv[tt][dv] = *(const GAS u32x2*)(QKV + (size_t)(n0 + 16 * tt + fr) * 3072 + 2048 + col); }
#pragma unroll
        for (int i = 0; i < 2; ++i) { const int id = Fi.tid + 512 * i, s = id & 63, ch = id >> 6; const u32x4 kx = *(const LAS u32x4*)(Ks + s * 272 + ch * 16); const float wv = wk[s];
            LAS unsigned char* o = KwT + (8 * ch) * 144 + 2 * s;
            *(LAS bf16_t*)(o + 0 * 144) = (bf16_t)f2bf(bflo(kx.x) * wv); *(LAS bf16_t*)(o + 1 * 144) = (bf16_t)f2bf(bfhi(kx.x) * wv);
            *(LAS bf16_t*)(o + 2 * 144) = (bf16_t)f2bf(bflo(kx.y) * wv); *(LAS bf16_t*)(o + 3 * 144) = (bf16_t)f2bf(bfhi(kx.y) * wv);
            *(LAS bf16_t*)(o + 4 * 144) = (bf16_t)f2bf(bflo(kx.z) * wv); *(LAS bf16_t*)(o + 5 * 144) = (bf16_t)f2bf(bfhi(kx.z) * wv);
            *(LAS bf16_t*)(o + 6 * 144) = (bf16_t)f2bf(bflo(kx.w) * wv); *(LAS bf16_t*)(o + 7 * 144) = (bf16_t)f2bf(bfhi(kx.w) * wv); }
#pragma unroll
        for (int q2 = 0; q2 < 2; ++q2) { const int idx = 2 * w + q2, st = idx >> 2, tt = idx & 3;
            f32x4 sacc = (f32x4){0.f, 0.f, 0.f, 0.f};
            if (st <= tt) {
#pragma unroll
                for (int kk = 0; kk < 4; ++kk) sacc = MFMA16(ld_frag_lds(Ks + (16 * st + fr) * 272 + 16 * fq + 64 * kk), ld_frag_lds(Qs + (16 * tt + fr) * 272 + 16 * fq + 64 * kk), sacc);
            }
            const int t = 16 * tt + fr; const float Mt = Ms[t]; float p[4], rsum = 0.f;
#pragma unroll
            for (int i = 0; i < 4; ++i) { const int s = 16 * st + 4 * fq + i; p[i] = (s <= t) ? sacc[i] * __expf(us[s] - Mt) : 0.f; rsum += p[i]; }
            u32x2 wv; wv.x = cvt_pk_bf16(p[0], p[1]); wv.y = cvt_pk_bf16(p[2], p[3]);
            *(LAS u32x2*)(Ss + t * 144 + (16 * st + 4 * fq) * 2) = wv;
            rsum += __shfl_xor(rsum, 16); rsum += __shfl_xor(rsum, 32);
            if (fq == 0) den[st * 64 + t] = rsum; }
        { const int t = Fi.tid & 63, pp = Fi.tid >> 6; const LAS bf16_t* qr = (const LAS bf16_t*)(Qs + t * 272) + 16 * pp; float sacc = 0.f;
#pragma unroll
            for (int e = 0; e < 16; ++e) sacc += bf2f(qr[e]) * npv[16 * pp + e];
            qn[pp * 64 + t] = sacc; }
        __syncthreads();
        f32x4 acc[2][4];
#pragma unroll
        for (int dv = 0; dv < 2; ++dv)
#pragma unroll
            for (int tt = 0; tt < 4; ++tt) acc[dv][tt] = (f32x4){0.f, 0.f, 0.f, 0.f};
#pragma unroll
        for (int kk = 0; kk < 4; ++kk) {
            bf16x8 Bq[4];
#pragma unroll
            for (int tt = 0; tt < 4; ++tt) { const LAS unsigned char* qp = Qs + (16 * tt + fr) * 272 + 64 * kk + 8 * fq; const u32x2 lo = *(const LAS u32x2*)qp, hi = *(const LAS u32x2*)(qp + 32); Bq[tt] = mk_frag(lo.x, lo.y, hi.x, hi.y); }
#pragma unroll
            for (int dv = 0; dv < 2; ++dv) { const f32x4 c0 = Cst[dv][2 * kk], c1 = Cst[dv][2 * kk + 1];
                const bf16x8 Ac = mk_frag(cvt_pk_bf16(c0[0], c0[1]), cvt_pk_bf16(c0[2], c0[3]), cvt_pk_bf16(c1[0], c1[1]), cvt_pk_bf16(c1[2], c1[3]));
#pragma unroll
                for (int tt = 0; tt < 4; ++tt) acc[dv][tt] = MFMA16(Ac, Bq[tt], acc[dv][tt]); }
            __builtin_amdgcn_sched_barrier(0);
        }
#pragma unroll
        for (int tt = 0; tt < 4; ++tt) { const float wi = wint[16 * tt + fr];
#pragma unroll
            for (int dv = 0; dv < 2; ++dv) acc[dv][tt] *= wi; }
#pragma unroll
        for (int kk = 0; kk < 2; ++kk) {
            bf16x8 Bs[4], Avk[2];
#pragma unroll
            for (int dv = 0; dv < 2; ++dv) { const int dvr = 16 * (2 * w + dv) + fr; const LAS unsigned* vp = VT + dvr * 33; const int p0 = 4 * fq + 16 * kk; Avk[dv] = mk_frag(vp[vt_col(dvr, p0)], vp[vt_col(dvr, p0 + 1)], vp[vt_col(dvr, p0 + 2)], vp[vt_col(dvr, p0 + 3)]); }
#pragma unroll
            for (int tt = 0; tt < 4; ++tt) Bs[tt] = ld_frag_lds(Ss + (16 * tt + fr) * 144 + 16 * fq + 64 * kk);
#pragma unroll
            for (int dv = 0; dv < 2; ++dv)
#pragma unroll
                for (int tt = 0; tt < 4; ++tt) acc[dv][tt] = MFMA16(Avk[dv], Bs[tt], acc[dv][tt]);
            __builtin_amdgcn_sched_barrier(0);
        }
#pragma unroll
        for (int tt = 0; tt < 4; ++tt) { const int t = 16 * tt + fr; const float qnt = ((qn[t] + qn[64 + t]) + (qn[128 + t] + qn[192 + t])) + ((qn[256 + t] + qn[320 + t]) + (qn[384 + t] + qn[448 + t]));
            const float dn = ((den[t] + den[64 + t]) + (den[128 + t] + den[192 + t])) + wint[t] * qnt; const float inv = 1.0f / fmaxf(fabsf(dn), eneg[t]);
            float q = 0.f;
#pragma unroll
            for (int dv = 0; dv < 2; ++dv) { acc[dv][tt] *= inv; const f32x4 v = acc[dv][tt] * acc[dv][tt]; q += (v[0] + v[1]) + (v[2] + v[3]); }
            q += __shfl_xor(q, 16); q += __shfl_xor(q, 32);
            if (fq == 0) hss[w * 64 + t] = q; }
        __syncthreads();
#pragma unroll
        for (int tt = 0; tt < 4; ++tt) { const int t = 16 * tt + fr; const float hs = ((hss[t] + hss[64 + t]) + (hss[128 + t] + hss[192 + t])) + ((hss[256 + t] + hss[320 + t]) + (hss[384 + t] + hss[448 + t]));
            const float rst = 1.0f / sqrtf(hs * (1.0f / 256.0f) + EPS);
#pragma unroll
            for (int dv = 0; dv < 2; ++dv) { const int col = h * 256 + 16 * (2 * w + dv) + 4 * fq;
                const u32x2 og = ogv[tt][dv]; const f32x4 g4 = hgv[dv];
                const float o0 = acc[dv][tt][0] * rst * g4[0] * fast_rcp(1.0f + __expf(-bflo(og.x))), o1 = acc[dv][tt][1] * rst * g4[1] * fast_rcp(1.0f + __expf(-bfhi(og.x)));
                const float o2 = acc[dv][tt][2] * rst * g4[2] * fast_rcp(1.0f + __expf(-bflo(og.y))), o3 = acc[dv][tt][3] * rst * g4[3] * fast_rcp(1.0f + __expf(-bfhi(og.y)));
                u32x2 wv; wv.x = cvt_pk_bf16(o0, o1); wv.y = cvt_pk_bf16(o2, o3);
                *(GAS u32x2*)(OB + (size_t)(n0 + t) * DM + col) = wv; } }
        { const float aa = scal[0];
            bf16x8 Avk[2][2];
#pragma unroll
            for (int kk = 0; kk < 2; ++kk)
#pragma unroll
                for (int dv = 0; dv < 2; ++dv) { const int dvr = 16 * (2 * w + dv) + fr; const LAS unsigned* vp = VT + dvr * 33; const int p0 = 4 * fq + 16 * kk; Avk[kk][dv] = mk_frag(vp[vt_col(dvr, p0)], vp[vt_col(dvr, p0 + 1)], vp[vt_col(dvr, p0 + 2)], vp[vt_col(dvr, p0 + 3)]); }
#pragma unroll
            for (int bt = 0; bt < 2; ++bt)
#pragma unroll
                for (int at = 0; at < 8; ++at) Cst[bt][at] *= aa;
#pragma unroll
            for (int at = 0; at < 8; ++at) { const LAS unsigned char* kp = KwT + (16 * at + fr) * 144 + 16 * fq; const bf16x8 A0 = ld_frag_lds(kp), A1 = ld_frag_lds(kp + 64);
#pragma unroll
                for (int bt = 0; bt < 2; ++bt) { Cst[bt][at] = MFMA16(A0, Avk[0][bt], Cst[bt][at]); Cst[bt][at] = MFMA16(A1, Avk[1][bt], Cst[bt][at]); } }
            if (Fi.tid >= 64 && Fi.tid < 192) { const int dk = Fi.tid - 64; const LAS unsigned char* kr = KwT + dk * 144; float sum = 0.f;
#pragma unroll
                for (int q8 = 0; q8 < 8; ++q8) { const u32x4 x = *(const LAS u32x4*)(kr + 16 * q8); sum += ((bflo(x.x) + bfhi(x.x)) + (bflo(x.y) + bfhi(x.y))) + ((bflo(x.z) + bfhi(x.z)) + (bflo(x.w) + bfhi(x.w))); }
                npv[dk] = aa * npv[dk] + sum; } }
    }
#undef B4_FETCH
}


#ifdef PROBE_BUF
__device__ __forceinline__ void probe_scan(const Frame& F, const Args& a) {
    unsigned* ctl = (unsigned*)(a.ws + WS_CTL);
    unsigned bad = 0; float ms = 0.f;
    for (size_t i = (size_t)F.vcu * 512 + F.tid; i < (size_t)(PROBE_N); i += (size_t)F.G * 512) {
        float v;
        if (PROBE_KIND == 0) v = bf2f(((const bf16_t*)(a.ws + PROBE_BUF))[i]); else v = ((const float*)(a.ws + PROBE_BUF))[i];
        if (fabsf(v) < 1e30f) ms += v * v; else ++bad;
    }
    if (PROBE_STAT == 2) { bad = 0; ms = 0.f;
        for (int u = F.vcu * 8 + F.wave; u < (int)((PROBE_N) / 32768); u += F.G * 8) { unsigned b2 = 0;
            for (int i = F.lane; i < 32768; i += 64) { const float v = bf2f(((const bf16_t*)(a.ws + PROBE_BUF))[(size_t)u * 32768 + i]); if (!(fabsf(v) < 1e30f)) b2 = 1; }
            b2 = __any(b2) ? 1u : 0u; if (F.lane == 0) bad += b2 * 32768u; } }
    atomicAdd(ctl + 20000, bad); atomicAdd((float*)(ctl + 20064), ms);
}
__device__ __forceinline__ void probe_fill(const Frame& F, const Args& a) {
    const unsigned* ctl = (const unsigned*)(a.ws + WS_CTL);
    const float f = (float)ctl[20000] / (float)(PROBE_N), msq = ((const float*)ctl)[20064] / (float)(PROBE_N);
    const float c = sqrtf(PROBE_STAT != 1 ? 10.0f * f : msq);
    for (size_t i = (size_t)F.vcu * 512 + F.tid; i < (size_t)NTOK * DM; i += (size_t)F.G * 512) a.out[i] = c;
}
#endif
constexpr int NPHASE = 1 + NLAYER * 10;

typedef const __attribute__((address_space(4))) Args* KArgsPtr;
__device__ __forceinline__ Args opaque_args() {
#if defined(__HIP_DEVICE_COMPILE__)
    KArgsPtr p = (KArgsPtr)__builtin_amdgcn_kernarg_segment_ptr(); asm volatile("" : "+s"(p)); return *p;
#else
    return Args{};
#endif
}
#define SITE() const Frame FP = make_frame(lds); const Args A = opaque_args(); unsigned char* const ws = A.ws; (void)ws
__global__ void __launch_bounds__(512, 2) mk_fwd(Args args) {
    extern __shared__ __attribute__((aligned(16))) unsigned char lds_raw[];
    LAS unsigned char* const lds = (LAS unsigned char*)lds_raw;
    volatile LAS unsigned* MISC = (volatile LAS unsigned*)(lds + MISC_OFF);
    if (threadIdx.x < 32) MISC[threadIdx.x] = 0u;
    __syncthreads();
    const int lo = args.ph_lo, hi = args.ph_hi;
    XcdBarrier bar; bar.bar = (unsigned*)(args.ws + WS_CTL) + CW_BAR; bar.x = 0; bar.st = nullptr;
    if (hi - lo > 1) bar = xcd_barrier_post((unsigned*)(args.ws + WS_CTL) + CW_BAR, MISC + 8);
#define IN(k) (lo <= (k) && (k) < hi)
#ifdef XBAR_EXTRA
#define SEAM(k) do { if (IN(k) && IN((k) + 1)) { xcd_barrier(bar); xcd_barrier(bar); } } while (0)
#else
#define SEAM(k) do { if (IN(k) && IN((k) + 1)) xcd_barrier(bar); } while (0)
#endif
    if (PHON(0) && IN(0)) for (int rep_ = 0; rep_ < NREP(0); ++rep_) { SITE(); p0_weights(FP, A); phase_x0(FP, A); }
    SEAM(0);
    for (int l = 0; l < NLAYER; ++l) {
        const int pb = 1 + l * 10, j = l >> 1;
        if ((l & 1) == 0) {
            if (PHON(1) && IN(pb)) for (int rep_ = 0; rep_ < NREP(1); ++rep_) { SITE(); pg8::Gemm g{(const bf16_t*)(ws + WS_XB), (const bf16_t*)(ws + WS_WQKV) + (size_t)j * 3072 * DM, DM, 0, nullptr, nullptr, nullptr};
                pg8::StaticOrder S; S.init(NTOK / 256, 12, FP.G, (int)blockIdx.x, nullptr);
                pg8::EpiQKV E{(bf16_t*)(ws + WS_QKV), (const float*)(ws + SM_RSTD), A.in[4] + j * 64, A.in[5] + j * 64, 0.125f * LOG2E};
                pg8::gemm_phase<pg8::EpiQKV, true, false>(lds, FP.tid, g, S, E); }
            SEAM(pb);
            if (PHON(2) && IN(pb + 1)) for (int rep_ = 0; rep_ < NREP(2); ++rep_) { SITE(); phase_attn_a(FP, A, j); }
            SEAM(pb + 1);
            if (PHON(3) && IN(pb + 2)) for (int rep_ = 0; rep_ < NREP(3); ++rep_) { SITE(); phase_attn_b(FP, A, j); }
            if (IN(pb + 2) && IN(pb + 4)) xcd_barrier(bar);
            if (PHON(4) && IN(pb + 4)) { SITE(); pg8::Gemm g{(const bf16_t*)(ws + WS_OB), (const bf16_t*)(ws + WS_WO) + (size_t)j * DM * DM, DM, 0, nullptr, nullptr, nullptr};
                pg8::StaticOrder S; S.init(NTOK / 256, 4, FP.G, (int)blockIdx.x, nullptr);
                pg8::EpiResidB E{(bf16_t*)(ws + WS_XB)};
                pg8::gemm_phase<pg8::EpiResidB, true, false, true>(lds, FP.tid, g, S, E); }
            SEAM(pb + 4);
        } else {
            if (PHON(5) && IN(pb)) for (int rep_ = 0; rep_ < NREP(5); ++rep_) { SITE(); pg8::Gemm g{(const bf16_t*)(ws + WS_XB), (const bf16_t*)(ws + WS_WIN) + (size_t)j * 3072 * DM, DM, 0, nullptr, nullptr, nullptr};
                pg8::StaticOrder S; S.init(NTOK / 256, 12, FP.G, (int)blockIdx.x, nullptr);
                pg8::EpiBf16 E{(bf16_t*)(ws + WS_QKV), 3072, (const float*)(ws + SM_RSTD)};
                pg8::gemm_phase<pg8::EpiBf16, true, false>(lds, FP.tid, g, S, E); }
            SEAM(pb);
            if (PHON(6) && IN(pb + 1)) for (int rep_ = 0; rep_ < NREP(6); ++rep_) { SITE(); phase_mlstm_local(FP, A, j); }
            SEAM(pb + 1);
            if (PHON(7) && IN(pb + 2)) for (int rep_ = 0; rep_ < NREP(7); ++rep_) { SITE(); phase_mlstm_scan(FP, A); }
            SEAM(pb + 2);
            if (PHON(8) && IN(pb + 3)) for (int rep_ = 0; rep_ < NREP(8); ++rep_) { SITE(); phase_mlstm_out(FP, A, j); }
            SEAM(pb + 3);
            if (PHON(9) && IN(pb + 4)) { SITE(); pg8::Gemm g{(const bf16_t*)(ws + WS_OB), (const bf16_t*)(ws + WS_WMO) + (size_t)j * DM * DM, DM, 0, nullptr, nullptr, nullptr};
                pg8::StaticOrder S; S.init(NTOK / 256, 4, FP.G, (int)blockIdx.x, nullptr);
                pg8::EpiResidB E{(bf16_t*)(ws + WS_XB)};
                pg8::gemm_phase<pg8::EpiResidB, true, false>(lds, FP.tid, g, S, E); }
            SEAM(pb + 4);
        }
        if (PHON(10) && IN(pb + 5)) for (int rep_ = 0; rep_ < NREP(10); ++rep_) { SITE(); phase_router(FP, A, l, rep_ + 1 < NREP(10)); }
        if (IN(pb + 5) && IN(pb + 7)) xcd_barrier(bar);
        if (PHON(12) && IN(pb + 7)) for (int rep_ = 0; rep_ < NREP(12); ++rep_) { SITE();
            LAS int* pst = (LAS int*)(lds + MOE_TAB_OFF); LAS int* cnt = (LAS int*)(lds + MOE_TAB_OFF + 512);
            const int ntiles = __builtin_amdgcn_readfirstlane(moe_tables(FP, (const unsigned*)(ws + WS_CTL) + CW_CNT + l * 64, pst, cnt));
            pg8::Gemm g{(const bf16_t*)(ws + WS_XB), (const bf16_t*)(ws + WS_WGU) + (size_t)l * 64 * DM * DM, DM, (size_t)DM * DM * 2, (const int*)(ws + WS_QC), pst, cnt};
            pg8::StaticOrder S; S.init(ntiles, 4, FP.G, (int)blockIdx.x, pst);
            pg8::EpiGU E{(bf16_t*)(ws + WS_ACT), (const float*)(ws + SM_RSTD), (const int*)(ws + WS_QC), pst, cnt};
            pg8::gemm_phase<pg8::EpiGU, true, true>(lds, FP.tid, g, S, E); }
        SEAM(pb + 7);
        if (PHON(13) && IN(pb + 8)) for (int rep_ = 0; rep_ < NREP(13); ++rep_) { SITE();
            LAS int* pst = (LAS int*)(lds + MOE_TAB_OFF); LAS int* cnt = (LAS int*)(lds + MOE_TAB_OFF + 512);
            const int ntiles = __builtin_amdgcn_readfirstlane(moe_tables(FP, (const unsigned*)(ws + WS_CTL) + CW_CNT + l * 64, pst, cnt));
            pg8::Gemm g{(const bf16_t*)(ws + WS_ACT), (const bf16_t*)(ws + WS_WD) + (size_t)l * 64 * DM * FFE, FFE, (size_t)DM * FFE * 2, nullptr, pst, cnt};
            pg8::StaticOrder S; S.init(ntiles, 4, FP.G, (int)blockIdx.x, pst);
            pg8::EpiBf16 E{(bf16_t*)(ws + WS_YB), DM, nullptr};
            pg8::gemm_phase<pg8::EpiBf16, true, false>(lds, FP.tid, g, S, E); }
        SEAM(pb + 8);
        if (PHON(14) && IN(pb + 9)) { SITE(); phase_combine(FP, A, l); }
        SEAM(pb + 9);
    }
#ifdef PROBE_BUF
    if (IN(NPHASE)) { SITE(); probe_scan(FP, A); }
    if (IN(NPHASE + 1)) { SITE(); probe_fill(FP, A); }
#endif
#undef IN
#undef SEAM
}

extern "C" void kernel_launch(void* const* d_in, const int* in_sizes, int n_in, void* d_out, int out_size, void* d_ws, size_t ws_size, hipStream_t stream) {
    static int grid = 0;
    if (grid == 0) {
        if (n_in != 20 || out_size != NTOK * DM || ws_size < WS_END) { fprintf(stderr, "kernel_launch: unexpected shapes (n_in %d, out %d, ws %zu < %zu); nothing launched\n", n_in, out_size, ws_size, (size_t)WS_END); grid = -1; return; }
        int dev = 0, cus = 0, per_cu = 0;
        if (hipGetDevice(&dev) != hipSuccess || hipDeviceGetAttribute(&cus, hipDeviceAttributeMultiprocessorCount, dev) != hipSuccess) { grid = -1; return; }
        if (hipFuncSetAttribute((const void*)mk_fwd, hipFuncAttributeMaxDynamicSharedMemorySize, LDS_BYTES) != hipSuccess) { fprintf(stderr, "kernel_launch: hipFuncSetAttribute failed\n"); grid = -1; return; }
        if (hipOccupancyMaxActiveBlocksPerMultiprocessor(&per_cu, (const void*)mk_fwd, 512, LDS_BYTES) != hipSuccess || per_cu < 1) { fprintf(stderr, "kernel_launch: occupancy query says %d\n", per_cu); }
        (void)hipGetLastError();
        grid = cus;
        if (grid != 256) { fprintf(stderr, "kernel_launch: built for a 256-CU device, found %d CUs; nothing launched\n", cus); grid = -1; return; }
    }
    if (grid < 0) return;
    if (hipMemsetAsync((char*)d_ws + WS_CTL, 0, CTL_ZERO_BYTES, stream) != hipSuccess) return;
    Args a{};
    for (int i = 0; i < 20; ++i) a.in[i] = (const float*)d_in[i];
    a.out = (float*)d_out; a.ws = (unsigned char*)d_ws;
#if MK_ONE_LAUNCH
    a.ph_lo = 0; a.ph_hi = NPHASE;
    hipLaunchKernelGGL(mk_fwd, dim3(grid), dim3(512), LDS_BYTES, stream, a);
#else
    int np = NPHASE;
#ifdef PROBE_BUF
    np += 2;
#endif
    for (int p = 0; p < np; ++p) { a.ph_lo = p; a.ph_hi = p + 1; hipLaunchKernelGGL(mk_fwd, dim3(grid), dim3(512), LDS_BYTES, stream, a); }
#endif
}
```

```cpp
#include <hip/hip_runtime.h>
#include <cstdio>
#include <cstdint>

#ifndef MK_ONE_LAUNCH
#define MK_ONE_LAUNCH 1
#endif

#ifndef PHMASK
#define PHMASK 0xFFFFFFFFu
#endif
#define PHON(n) ((PHMASK >> (n)) & 1u)
#ifndef REPMASK
#define REPMASK 0u
#endif
#define NREP(n) (1 + (int)((REPMASK >> (n)) & 1u))
#ifdef DBG_NOGATES
#define DBGG(x) 0.0f
#else
#define DBGG(x) (x)
#endif

#define LAS __attribute__((address_space(3)))
#define GAS __attribute__((address_space(1)))
typedef unsigned short bf16_t;
typedef short bf16x8 __attribute__((ext_vector_type(8)));
typedef float f32x4 __attribute__((ext_vector_type(4)));
typedef float f32x2 __attribute__((ext_vector_type(2)));
typedef unsigned u32x4 __attribute__((ext_vector_type(4)));
typedef unsigned u32x2 __attribute__((ext_vector_type(2)));

constexpr int NTOK = 32768, SEQ = 16384, DM = 1024, NLAYER = 4;
constexpr int NEXP = 64, FFE = 512;
constexpr int PMAX = 81920;
constexpr float EPS = 1e-6f;
constexpr float LOG2E = 1.4426950408889634f;

constexpr size_t MiB = 1u << 20;
constexpr size_t WS_CTL = 0, CTL_ZERO_BYTES = 1 * MiB;
constexpr size_t WS_WQKV = 2 * MiB, WS_WO = 14 * MiB, WS_WIN = 18 * MiB, WS_WMO = 30 * MiB, WS_WR = 34 * MiB, WS_WG = 36 * MiB;
constexpr size_t WS_SMALL = 37 * MiB;
constexpr size_t SM_RSTD = WS_SMALL, SM_GATES = WS_SMALL + 256 * 1024, SM_TOKE = WS_SMALL + 1280 * 1024, SM_TOKG = WS_SMALL + 1536 * 1024,
                 SM_TOKP = WS_SMALL + 1792 * 1024, SM_ROWTOK = WS_SMALL + 2 * MiB, SM_TILEEXP = WS_SMALL + 2 * MiB + 512 * 1024,
                 SM_MLOC = WS_SMALL + 2 * MiB + 768 * 1024, SM_BL = SM_MLOC + 8192, SM_MPREV = SM_MLOC + 16384,
                 SM_DN = WS_SMALL + 3 * MiB, SM_NS = WS_SMALL + 4 * MiB, SM_L1 = WS_SMALL + 5 * MiB, SM_L2 = WS_SMALL + 7 * MiB;
constexpr size_t WS_WGU = 64 * MiB, WS_WD = 576 * MiB, WS_XB = 832 * MiB, WS_QKV = 898 * MiB, WS_OB = 1090 * MiB,
                 WS_P1 = 1170 * MiB, WS_P2 = 1234 * MiB, WS_CS = 1298 * MiB, WS_QC = 1426 * MiB, WS_KC = 1458 * MiB, WS_END = 1490 * MiB;
constexpr size_t WS_YB = WS_QKV, WS_ACT = WS_OB, WS_DC = WS_P1;
constexpr int CW_BAR = 4096, CW_CNT = 16384;

constexpr int LDS_BYTES = 147456;
constexpr int MISC_OFF = 147456 - 512;

__device__ __forceinline__ unsigned f2bf(float f) { unsigned u = __builtin_bit_cast(unsigned, f); return (u + 0x7fffu + ((u >> 16) & 1u)) >> 16; }
__device__ __forceinline__ float bf2f(unsigned h) { return __builtin_bit_cast(float, h << 16); }
typedef __bf16 bf16x2_t __attribute__((ext_vector_type(2)));
__device__ __forceinline__ unsigned cvt_pk_bf16(float lo, float hi) { f32x2 v = {lo, hi}; bf16x2_t r = __builtin_convertvector(v, bf16x2_t); return __builtin_bit_cast(unsigned, r); }
__device__ __forceinline__ float bflo(unsigned w) { return __builtin_bit_cast(float, w << 16); }
__device__ __forceinline__ float bfhi(unsigned w) { return __builtin_bit_cast(float, w & 0xffff0000u); }
__device__ __forceinline__ float fast_exp2(float x) { return __builtin_amdgcn_exp2f(x); }
__device__ __forceinline__ float fast_rcp(float x) { return __builtin_amdgcn_rcpf(x); }
#define LDS_WAIT() asm volatile("s_waitcnt lgkmcnt(0)" ::: "memory")
#define VM_WAIT() asm volatile("s_waitcnt vmcnt(0)" ::: "memory")

#define XB_TMO      128
#define XB_XCNT(j)  (256  + 64 * (j))
#define XB_XSUB(j)  (1280 + 64 * (j))
#define XB_XGEN(j)  (2304 + 64 * (j))
#define XB_TOP      3328
#define XB_TOPGEN   3392
#define XCD_BAR_WORDS 3456
#define XB_SPIN_CAP (1u << 18)
__device__ __forceinline__ unsigned xb_ld(unsigned* p)              { return __hip_atomic_load(p, __ATOMIC_RELAXED, __HIP_MEMORY_SCOPE_AGENT); }
__device__ __forceinline__ unsigned xb_add(unsigned* p, unsigned v) { return __hip_atomic_fetch_add(p, v, __ATOMIC_RELAXED, __HIP_MEMORY_SCOPE_AGENT); }
__device__ __forceinline__ unsigned xb_xcc_id() { return (unsigned)__builtin_amdgcn_s_getreg((3 << 11) | 20) & 0xFu; }
#define XB_SPIN(cond, bar) do { unsigned _sp = 0; while (cond) { __builtin_amdgcn_s_sleep(1); \
    if ((++_sp & 255u) == 0u) { if (xb_ld(&(bar)[XB_TMO])) break; if (_sp > XB_SPIN_CAP) { atomicAdd(&(bar)[XB_TMO], 1u); break; } } } } while (0)
struct XcdBarrier { unsigned* bar; unsigned x; volatile LAS unsigned* st; };
__device__ __forceinline__ XcdBarrier xcd_barrier_post(unsigned* bar, volatile LAS unsigned* st) {
    XcdBarrier b; b.bar = bar; b.x = xb_xcc_id(); b.st = st;
    if (threadIdx.x == 0) (void)xb_add(&bar[XB_XCNT(b.x)], 1u);
    return b;
}
__device__ __forceinline__ void xcd_barrier_complete(unsigned* bar, unsigned x, unsigned& nloc, unsigned& nx) {
    const unsigned G = gridDim.x * gridDim.y * gridDim.z;
    unsigned sum, cnt, mine, sp = 0u;
    for (;;) {
        sum = 0u; cnt = 0u; mine = 0u;
#pragma unroll
        for (unsigned j = 0; j < 16; ++j) { const unsigned c = xb_ld(&bar[XB_XCNT(j)]); sum += c; cnt += (c > 0u) ? 1u : 0u; mine = (j == x) ? c : mine; }
        if (sum == G) break;
        __builtin_amdgcn_s_sleep(1);
        if ((++sp & 255u) == 0u) { if (xb_ld(&bar[XB_TMO])) break; if (sp > XB_SPIN_CAP) { atomicAdd(&bar[XB_TMO], 1u); break; } }
    }
    nloc = mine > 0u ? mine : 1u; nx = cnt > 0u ? cnt : 1u;
}
__device__ __forceinline__ void xcd_barrier(const XcdBarrier& b) {
    asm volatile("s_waitcnt vmcnt(0)" ::: "memory");
    __syncthreads();
    if (threadIdx.x == 0) {
        unsigned* bar = b.bar;
        __builtin_amdgcn_s_waitcnt(0);
        unsigned nloc = b.st[0], nx = b.st[1];
        if (nloc == 0u) { xcd_barrier_complete(bar, b.x, nloc, nx); b.st[0] = nloc; b.st[1] = nx; }
        const unsigned old = xb_add(&bar[XB_XSUB(b.x)], 1u);
        const unsigned gen = old / nloc;
        if (old + 1u == (gen + 1u) * nloc) {
            __builtin_amdgcn_fence(__ATOMIC_RELEASE, "agent");
            asm volatile("s_waitcnt vmcnt(0)" ::: "memory");
            const unsigned og = xb_add(&bar[XB_TOP], 1u);
            const unsigned tg = og / nx;
            if (og + 1u == (tg + 1u) * nx) xb_add(&bar[XB_TOPGEN], 1u);
            else XB_SPIN(xb_ld(&bar[XB_TOPGEN]) == tg, bar);
            __builtin_amdgcn_fence(__ATOMIC_ACQUIRE, "agent");
            xb_add(&bar[XB_XGEN(b.x)], 1u);
            asm volatile("s_waitcnt vmcnt(0)" ::: "memory");
        } else {
            XB_SPIN(xb_ld(&bar[XB_XGEN(b.x)]) == gen, bar);
            __builtin_amdgcn_fence(__ATOMIC_ACQUIRE, "agent");
            asm volatile("s_waitcnt vmcnt(0)" ::: "memory");
        }
    }
    __syncthreads();
}

namespace pg8 {
constexpr int BM = 256, BK = 64, HALF = 128, HTB = HALF * BK * 2, STAGE_BYTES = 8 * HTB, NXCD = 8, WGM = 8;
__host__ __device__ __forceinline__ int lds_byte(int r, int c) { const int st = (r >> 4) * 2 + (c >> 5), rr = r & 15, cc = c & 31, ob = rr * 64 + cc * 2; return st * 1024 + (ob ^ (((ob >> 9) & 1) << 5)); }
__host__ __device__ __forceinline__ void stage_rc(int b, int& R, int& C) { const int st = b / 1024, sb = b % 1024, swz = sb ^ (((sb >> 9) & 1) << 5); R = (st >> 1) * 16 + swz / 64; C = (st & 1) * 32 + (swz % 64) / 2; }
__host__ __device__ __forceinline__ int perm32(int rho) { const int n = rho >> 4, i = rho & 15; return 8 * (i >> 2) + 4 * n + (i & 3); }

struct Unit { int pm, pn, e; };
struct Gemm { const bf16_t* A; const bf16_t* Bt; int K; size_t b_estride; const int* sparse; const LAS int* pst; const LAS int* cnt; };

struct StaticOrder {
    int nM, nN, nwg, G, c; const LAS int* pst;
    __device__ void init(int nM_, int nN_, int G_, int c_, const LAS int* pst_) { nM = nM_; nN = nN_; nwg = nM * nN; G = G_; c = c_; pst = pst_; }
    __device__ bool next(int i, Unit& u) const {
        const long L = (long)i * G + c; if (L >= nwg) return false;
        int wgid = (int)L; { const int q = nwg / NXCD, r = nwg % NXCD, xcd = wgid % NXCD, off = wgid / NXCD; wgid = (xcd < r ? xcd * (q + 1) : r * (q + 1) + (xcd - r) * q) + off; }
        const int nig = WGM * nN, gid = wgid / nig, fm = gid * WGM, gsz = (nM - fm) < WGM ? (nM - fm) : WGM;
        u.pm = fm + ((wgid % nig) % gsz); u.pn = (wgid % nig) / gsz;
        u.e = pst ? __builtin_amdgcn_readfirstlane(pst[256 + u.pm]) : 0;
        return true;
    }
};

template <class Epi, bool ALIGN_EPI, bool GATHER, bool A_HM = false>
__device__ __forceinline__ void gemm_phase(LAS unsigned char* lds, const int tid, const Gemm g, const StaticOrder& S, const Epi& E) {
    const int wid = __builtin_amdgcn_readfirstlane(tid >> 6), lane = tid & 63, wr = wid >> 2, wc = wid & 3, fr = lane & 15, fq = lane >> 4;
    const int K = g.K, nt = K / BK;
    int RA[2], CA[2]; unsigned voffB[2];
#pragma unroll
    for (int i = 0; i < 2; ++i) { int R, C; stage_rc(tid * 16 + i * 8192, R, C); const int Rb = Epi::PERM ? ((R & ~31) + perm32(R & 31)) : R;
        RA[i] = R; CA[i] = C; voffB[i] = (unsigned)(Rb * K + C) * 2u; }
    const size_t kstep = (size_t)(BK * 2);
    const size_t hstep = (size_t)HALF * K * 2;
    const size_t tstep = 2 * hstep;
    const size_t akstep = A_HM ? (size_t)16384 * 128 : kstep, ahstep = A_HM ? (size_t)HALF * 128 : hstep;
#define PG8_ABASE(pm_) (A_HM ? ((size_t)((pm_) >> 6) * 16 * 16384 + (size_t)((pm_) & 63) * 256) * 128 : (size_t)(pm_) * tstep)
    const unsigned ldsw = (unsigned)wid * 1024u;
    const int aoff = lds_byte(wr * 64 + fr, fq * 8), boff = lds_byte(wc * 32 + fr, fq * 8);
#define PG8_SA(b, h) (((b) * 2 + (h)) * HTB)
#define PG8_SB(b, h) ((4 + (b) * 2 + (h)) * HTB)
#define PG8_STAGE(bufoff, gbase, voff) do { _Pragma("unroll") for (int _i = 0; _i < 2; ++_i) \
        __builtin_amdgcn_global_load_lds((const unsigned*)((const char*)(gbase) + (voff)[_i]), (LAS unsigned*)(lds + (bufoff) + ldsw + _i * 8192), 16, 0, 0); } while (0)
#define PG8_LDA(dst, b, h) do { _Pragma("unroll") for (int m = 0; m < 4; ++m) _Pragma("unroll") for (int k = 0; k < 2; ++k) dst[m][k] = *(const LAS bf16x8*)(lds + PG8_SA(b, h) + aoff + m * 2048 + k * 1024); } while (0)
#define PG8_LDB(dst, b, h) do { _Pragma("unroll") for (int n = 0; n < 2; ++n) _Pragma("unroll") for (int k = 0; k < 2; ++k) dst[n][k] = *(const LAS bf16x8*)(lds + PG8_SB(b, h) + boff + n * 2048 + k * 1024); } while (0)
#define PG8_MMA(ai, bj, At, Bt) do { __builtin_amdgcn_s_setprio(1); _Pragma("unroll") for (int m = 0; m < 4; ++m) _Pragma("unroll") for (int n = 0; n < 2; ++n) _Pragma("unroll") for (int k = 0; k < 2; ++k) \
        acc[ai][bj][m][n] = __builtin_amdgcn_mfma_f32_16x16x32_bf16(Bt[n][k], At[m][k], acc[ai][bj][m][n], 0, 0, 0); __builtin_amdgcn_s_setprio(0); } while (0)
#define PG8_WAIT_V(n) asm volatile("s_waitcnt vmcnt(" #n ")" ::: "memory")
#define PG8_WAIT_L(n) asm volatile("s_waitcnt lgkmcnt(" #n ")" ::: "memory")
#define PG8_BAR __builtin_amdgcn_s_barrier()
#define PG8_SCHED __builtin_amdgcn_sched_barrier(0)
#define PG8_AOFFS(dst, unit) do { _Pragma("unroll") for (int _h = 0; _h < 2; ++_h) _Pragma("unroll") for (int _i = 0; _i < 2; ++_i) { \
        const int _j = (unit).pm * BM + _h * HALF + RA[_i] - g.pst[(unit).e]; const int _src = (_j < g.cnt[(unit).e]) ? g.sparse[(unit).e * 32768 + _j] : NTOK; dst[_h][_i] = (unsigned)(_src * K + CA[_i]) * 2u; } } while (0)
    Unit cur, nxt; int ui = 0;
    if (!S.next(0, cur)) return;
    f32x4 acc[2][2][4][2];
#pragma unroll
    for (int a = 0; a < 2; ++a)
#pragma unroll
        for (int b = 0; b < 2; ++b)
#pragma unroll
            for (int m = 0; m < 4; ++m)
#pragma unroll
                for (int n = 0; n < 2; ++n) acc[a][b][m][n] = (f32x4){0.f, 0.f, 0.f, 0.f};
    bf16x8 At[4][2], B0[2][2], B1[2][2];
    unsigned voffA[2]; unsigned cAo[2][2], nAo[2][2];
#pragma unroll
    for (int i = 0; i < 2; ++i) voffA[i] = (unsigned)(RA[i] * (A_HM ? 64 : K) + CA[i]) * 2u;
    const char* cA = (const char*)g.A;
    if constexpr (GATHER) { PG8_AOFFS(cAo, cur); } else { cA += PG8_ABASE(cur.pm); }
    const char* cB = (const char*)g.Bt + (size_t)cur.e * g.b_estride + (size_t)cur.pn * tstep;
#define PG8_STAGE_A(bufoff, base, h, nx) do { if constexpr (GATHER) { _Pragma("unroll") for (int _i = 0; _i < 2; ++_i) { const unsigned _o = (nx) ? nAo[h][_i] : cAo[h][_i]; \
            __builtin_amdgcn_global_load_lds((const unsigned*)((const char*)(base) + _o), (LAS unsigned*)(lds + (bufoff) + ldsw + _i * 8192), 16, 0, 0); } } \
        else { PG8_STAGE(bufoff, (base) + (h) * ahstep, voffA); } } while (0)
    PG8_STAGE(PG8_SB(0, 0), cB, voffB); PG8_STAGE(PG8_SB(0, 1), cB + hstep, voffB); PG8_STAGE_A(PG8_SA(0, 0), cA, 0, false); PG8_STAGE_A(PG8_SA(0, 1), cA, 1, false);
    if (wr == 1) PG8_BAR;
    PG8_WAIT_V(2); PG8_BAR;
    PG8_STAGE(PG8_SB(1, 0), cB + kstep, voffB); PG8_STAGE_A(PG8_SA(1, 0), cA + akstep, 0, false); PG8_STAGE(PG8_SB(1, 1), cB + hstep + kstep, voffB);
    PG8_WAIT_V(6); PG8_BAR;
    for (;;) {
        const bool has_next = S.next(ui + 1, nxt);
        const char* nA = cA;
        if constexpr (GATHER) { if (has_next) { PG8_AOFFS(nAo, nxt); } else {
#pragma unroll
            for (int h = 0; h < 2; ++h)
#pragma unroll
                for (int i = 0; i < 2; ++i) nAo[h][i] = cAo[h][i]; } }
        else { if (has_next) nA = (const char*)g.A + PG8_ABASE(nxt.pm); }
        const char* nB = has_next ? (const char*)g.Bt + (size_t)nxt.e * g.b_estride + (size_t)nxt.pn * tstep : cB;
        for (int t = 0; t < nt; t += 2) {
            const bool last = (t == nt - 2);
            const char* a1 = cA + (size_t)(t + 1) * akstep;
            const char* a2 = last ? nA : cA + (size_t)(t + 2) * akstep; const char* b2 = last ? nB : cB + (size_t)(t + 2) * kstep;
            const char* a3 = a2 + akstep; const char* b3 = b2 + kstep;
            PG8_LDB(B0, 0, 0); PG8_LDB(B1, 0, 1); PG8_SCHED; PG8_LDA(At, 0, 0); PG8_STAGE_A(PG8_SA(1, 1), a1, 1, false);
            PG8_WAIT_V(8); PG8_WAIT_L(0); PG8_BAR; PG8_MMA(0, 0, At, B0); PG8_MMA(0, 1, At, B1); PG8_BAR; PG8_SCHED;
            PG8_LDA(At, 0, 1); PG8_STAGE(PG8_SB(0, 0), b2, voffB); PG8_STAGE(PG8_SB(0, 1), b2 + hstep, voffB); PG8_STAGE_A(PG8_SA(0, 0), a2, 0, last);
            PG8_WAIT_V(8); PG8_WAIT_L(0); PG8_BAR; PG8_MMA(1, 0, At, B0); PG8_MMA(1, 1, At, B1); PG8_BAR; PG8_SCHED;
            PG8_LDB(B0, 1, 0); PG8_LDB(B1, 1, 1); PG8_SCHED; PG8_LDA(At, 1, 0); PG8_STAGE_A(PG8_SA(0, 1), a2, 1, last);
            PG8_WAIT_V(8); PG8_WAIT_L(0); PG8_BAR; PG8_MMA(0, 0, At, B0); PG8_MMA(0, 1, At, B1); PG8_BAR; PG8_SCHED;
            PG8_LDA(At, 1, 1); PG8_STAGE(PG8_SB(1, 0), b3, voffB); PG8_STAGE(PG8_SB(1, 1), b3 + hstep, voffB); PG8_STAGE_A(PG8_SA(1, 0), a3, 0, last);
            PG8_WAIT_V(8); PG8_WAIT_L(0); PG8_BAR; PG8_MMA(1, 0, At, B0); PG8_MMA(1, 1, At, B1); PG8_BAR; PG8_SCHED;
        }
        if constexpr (ALIGN_EPI) { if (wr == 0) PG8_BAR; }
        E(acc, cur, wr, wc, fr, fq);
        if (!has_next) break;
#pragma unroll
        for (int a = 0; a < 2; ++a)
#pragma unroll
            for (int b = 0; b < 2; ++b)
#pragma unroll
                for (int m = 0; m < 4; ++m)
#pragma unroll
                    for (int n = 0; n < 2; ++n) acc[a][b][m][n] = (f32x4){0.f, 0.f, 0.f, 0.f};
        cur = nxt; cB = nB; cA = nA; ++ui;
        if constexpr (GATHER) {
#pragma unroll
        for (int h = 0; h < 2; ++h)
#pragma unroll
            for (int i = 0; i < 2; ++i) cAo[h][i] = nAo[h][i]; }
        if constexpr (ALIGN_EPI) { if (wr == 1) PG8_BAR; }
    }
    PG8_WAIT_V(0);
    if constexpr (!ALIGN_EPI) { if (wr == 0) PG8_BAR; }
    PG8_BAR;
#undef PG8_SA
#undef PG8_SB
#undef PG8_STAGE
#undef PG8_LDA
#undef PG8_LDB
#undef PG8_MMA
#undef PG8_WAIT_V
#undef PG8_WAIT_L
#undef PG8_BAR
#undef PG8_SCHED
#undef PG8_AOFFS
#undef PG8_STAGE_A
#undef PG8_ABASE
}


struct EpiQKV {
    static constexpr bool PERM = true;
    bf16_t* O; const float* rstd; const float* qg; const float* kg; float qscale;
    __device__ __forceinline__ void operator()(const f32x4 (&acc)[2][2][4][2], const Unit& u, int wr, int wc, int fr, int fq) const {
        const int part = u.pn >> 2, head = 4 * (u.pn & 3) + wc;
        f32x4 gv[2][2];
#pragma unroll
        for (int bj = 0; bj < 2; ++bj)
#pragma unroll
            for (int n = 0; n < 2; ++n) { const int dim = 32 * bj + 8 * fq + 4 * n;
                if (part == 0) gv[bj][n] = *(const f32x4*)(qg + dim) * qscale; else if (part == 1) gv[bj][n] = *(const f32x4*)(kg + dim); else gv[bj][n] = (f32x4){1.f, 1.f, 1.f, 1.f}; }
#pragma unroll
        for (int ai = 0; ai < 2; ++ai)
#pragma unroll
            for (int m = 0; m < 4; ++m) {
                const int row = u.pm * BM + ai * HALF + wr * 64 + m * 16 + fr; const float rs = rstd[row];
                f32x4 v[2][2]; float ss = 0.f;
#pragma unroll
                for (int bj = 0; bj < 2; ++bj)
#pragma unroll
                    for (int n = 0; n < 2; ++n) { v[bj][n] = acc[ai][bj][m][n] * rs; const f32x4 q = v[bj][n] * v[bj][n]; ss += (q[0] + q[1]) + (q[2] + q[3]); }
                float sc = 1.f;
                if (part < 2) { ss += __shfl_xor(ss, 16); ss += __shfl_xor(ss, 32); sc = 1.0f / sqrtf(ss * (1.0f / 64.0f) + EPS); }
                bf16_t* rowp = O + ((size_t)(part * 32 + (row / SEQ) * 16 + head) * SEQ + (row % SEQ)) * 64 + 8 * fq;
#pragma unroll
                for (int bj = 0; bj < 2; ++bj) { const f32x4 v0 = v[bj][0] * gv[bj][0] * sc, v1 = v[bj][1] * gv[bj][1] * sc;
                    u32x4 w; w.x = cvt_pk_bf16(v0[0], v0[1]); w.y = cvt_pk_bf16(v0[2], v0[3]); w.z = cvt_pk_bf16(v1[0], v1[1]); w.w = cvt_pk_bf16(v1[2], v1[3]);
                    *(u32x4*)(rowp + 32 * bj) = w; }
            }
    }
};
struct EpiBf16 {
    static constexpr bool PERM = true;
    bf16_t* O; int ldc; const float* rscale;
    __device__ __forceinline__ void operator()(const f32x4 (&acc)[2][2][4][2], const Unit& u, int wr, int wc, int fr, int fq) const {
        const int col0 = u.pn * BM + wc * 32 + 8 * fq;
#pragma unroll
        for (int ai = 0; ai < 2; ++ai)
#pragma unroll
            for (int m = 0; m < 4; ++m) { const int row = u.pm * BM + ai * HALF + wr * 64 + m * 16 + fr; const float rs = rscale ? rscale[row] : 1.f;
                bf16_t* rowp = O + (size_t)row * ldc + col0;
#pragma unroll
                for (int bj = 0; bj < 2; ++bj) { const f32x4 v0 = acc[ai][bj][m][0] * rs, v1 = acc[ai][bj][m][1] * rs;
                    u32x4 w; w.x = cvt_pk_bf16(v0[0], v0[1]); w.y = cvt_pk_bf16(v0[2], v0[3]); w.z = cvt_pk_bf16(v1[0], v1[1]); w.w = cvt_pk_bf16(v1[2], v1[3]);
                    *(u32x4*)(rowp + bj * HALF) = w; } }
    }
};
struct EpiResid {
    static constexpr bool PERM = false;
    const float* xin; float* out;
    __device__ __forceinline__ void operator()(const f32x4 (&acc)[2][2][4][2], const Unit& u, int wr, int wc, int fr, int fq) const {
        const int col0 = u.pn * BM + wc * 32 + 4 * fq;
#pragma unroll
        for (int ai = 0; ai < 2; ++ai)
#pragma unroll
            for (int m = 0; m < 4; ++m) { const size_t off = (size_t)(u.pm * BM + ai * HALF + wr * 64 + m * 16 + fr) * DM + col0;
#pragma unroll
                for (int bj = 0; bj < 2; ++bj)
#pragma unroll
                    for (int n = 0; n < 2; ++n) { const f32x4 b = *(const f32x4*)(xin + off + bj * HALF + n * 16); *(f32x4*)(out + off + bj * HALF + n * 16) = b + acc[ai][bj][m][n]; } }
    }
};
struct EpiResidB {
    static constexpr bool PERM = true;
    bf16_t* X;
    __device__ __forceinline__ void operator()(const f32x4 (&acc)[2][2][4][2], const Unit& u, int wr, int wc, int fr, int fq) const {
        const int col0 = u.pn * BM + wc * 32 + 8 * fq;
#pragma unroll
        for (int ai = 0; ai < 2; ++ai)
#pragma unroll
            for (int m = 0; m < 4; ++m) { bf16_t* rowp = X + (size_t)(u.pm * BM + ai * HALF + wr * 64 + m * 16 + fr) * DM + col0;
#pragma unroll
                for (int bj = 0; bj < 2; ++bj) { const u32x4 x = *(const u32x4*)(rowp + bj * HALF); const f32x4 a0 = acc[ai][bj][m][0], a1 = acc[ai][bj][m][1];
                    u32x4 w; w.x = cvt_pk_bf16(bflo(x.x) + a0[0], bfhi(x.x) + a0[1]); w.y = cvt_pk_bf16(bflo(x.y) + a0[2], bfhi(x.y) + a0[3]);
                    w.z = cvt_pk_bf16(bflo(x.z) + a1[0], bfhi(x.z) + a1[1]); w.w = cvt_pk_bf16(bflo(x.w) + a1[2], bfhi(x.w) + a1[3]);
                    *(u32x4*)(rowp + bj * HALF) = w; } }
    }
};
struct EpiGU {
    static constexpr bool PERM = true;
    bf16_t* O; const float* rstd; const int* sparse; const LAS int* pst; const LAS int* cnt;
    __device__ __forceinline__ void operator()(const f32x4 (&acc)[2][2][4][2], const Unit& u, int wr, int wc, int fr, int fq) const {
        const int col0 = u.pn * HALF + wc * 32 + 8 * fq;
#pragma unroll
        for (int ai = 0; ai < 2; ++ai)
#pragma unroll
            for (int m = 0; m < 4; ++m) { const int row = u.pm * BM + ai * HALF + wr * 64 + m * 16 + fr; const int jj = row - pst[u.e]; const float rs = (jj < cnt[u.e]) ? rstd[sparse[u.e * 32768 + jj]] : 0.f;
                float o[8];
#pragma unroll
                for (int n = 0; n < 2; ++n)
#pragma unroll
                    for (int i = 0; i < 4; ++i) { const float gg = acc[ai][0][m][n][i] * rs, uu = acc[ai][1][m][n][i] * rs;
                        o[n * 4 + i] = gg * fast_rcp(1.0f + fast_exp2(-gg * LOG2E)) * uu; }
                u32x4 w; w.x = cvt_pk_bf16(o[0], o[1]); w.y = cvt_pk_bf16(o[2], o[3]); w.z = cvt_pk_bf16(o[4], o[5]); w.w = cvt_pk_bf16(o[6], o[7]);
                *(u32x4*)(O + (size_t)row * FFE + col0) = w; }
    }
};
}

struct Frame {
    LAS unsigned char* lds;
    int tid, lane, wave, vcu, G;
};
struct Args { const float* in[20]; float* out; unsigned char* ws; int ph_lo, ph_hi; };
__device__ __forceinline__ Frame make_frame(LAS unsigned char* lds) {
    Frame F; int t = threadIdx.x; asm volatile("" : "+v"(t));
    F.lds = lds; F.tid = t; F.lane = t & 63; F.wave = __builtin_amdgcn_readfirstlane(t >> 6);
    F.G = gridDim.x; { const int bx = blockIdx.x; F.vcu = (F.G % 8 == 0) ? (bx % 8) * (F.G / 8) + bx / 8 : bx; }
    return F;
}

__device__ __forceinline__ bf16x8 ld_frag_lds(const LAS unsigned char* p) { return *(const LAS bf16x8*)p; }
__device__ __forceinline__ bf16x8 mk_frag(unsigned a, unsigned b, unsigned c, unsigned d) { u32x4 w = {a, b, c, d}; return __builtin_bit_cast(bf16x8, w); }
#define MFMA16(a, b, c) __builtin_amdgcn_mfma_f32_16x16x32_bf16(a, b, c, 0, 0, 0)

struct CvtDesc { const float* src; int ldsrc, k0, scol; const float* kscale; bf16_t* dst; int K, drow; };
__device__ __forceinline__ void cvt_load(const CvtDesc& d, int lane, f32x4 (&v)[8]) {
#pragma unroll
    for (int i = 0; i < 8; ++i) v[i] = __builtin_nontemporal_load((const GAS f32x4*)(d.src + (size_t)(d.k0 + 8 * i + (lane >> 3)) * d.ldsrc + d.scol + 4 * (lane & 7)));
}
__device__ __forceinline__ void cvt_finish(const CvtDesc& d, int lane, const f32x4 (&v)[8], LAS float* scr) {
#pragma unroll
    for (int i = 0; i < 8; ++i) { const int kk = 8 * i + (lane >> 3); const float s = d.kscale ? d.kscale[d.k0 + kk] : 1.f; LAS float* p = scr + kk * 33 + 4 * (lane & 7);
        p[0] = v[i][0] * s; p[1] = v[i][1] * s; p[2] = v[i][2] * s; p[3] = v[i][3] * s; }
    LDS_WAIT(); asm volatile("" ::: "memory");
    const int c = lane & 7;
#pragma unroll
    for (int j = 0; j < 4; ++j) { const int n = (lane >> 3) + 8 * j; const LAS float* s = scr + (8 * c) * 33 + n;
        u32x4 o; o.x = cvt_pk_bf16(s[0 * 33], s[1 * 33]); o.y = cvt_pk_bf16(s[2 * 33], s[3 * 33]); o.z = cvt_pk_bf16(s[4 * 33], s[5 * 33]); o.w = cvt_pk_bf16(s[6 * 33], s[7 * 33]);
        __builtin_nontemporal_store(o, (GAS u32x4*)(d.dst + (size_t)(d.drow + n) * d.K + d.k0 + 8 * c)); }
    LDS_WAIT(); asm volatile("" ::: "memory");
}
__device__ __forceinline__ void cvt_item(const float* src, int ldsrc, int k0, int scol, const float* kscale, bf16_t* dst, int K, int drow, LAS float* scr, int lane) {
    const CvtDesc d{src, ldsrc, k0, scol, kscale, dst, K, drow}; f32x4 v[8]; cvt_load(d, lane, v); cvt_finish(d, lane, v, scr);
}
constexpr int MOE_ITEMS = 64 * 16 * 32 + 64 * 8 * 32;
__device__ __forceinline__ CvtDesc cvt_moe_desc(const Args& a, int l, int it) {
    constexpr int I_GU = 64 * 16 * 32;
    unsigned char* ws = a.ws; CvtDesc d;
    if (it < I_GU) { const int e = it / (16 * 32), q = it % (16 * 32), kb = q / 32, nb = q % 32;
        const int pn = nb >> 3, bj = (nb >> 2) & 1, c32 = nb & 3; const int le = l * 64 + e;
        d.src = (bj ? a.in[18] : a.in[17]) + (size_t)le * DM * FFE; d.ldsrc = FFE; d.k0 = kb * 64; d.scol = 128 * pn + 32 * c32; d.kscale = a.in[2] + (size_t)l * DM;
        d.dst = (bf16_t*)(ws + WS_WGU) + (size_t)le * DM * DM; d.K = DM; d.drow = nb * 32; }
    else { const int r = it - I_GU; const int e = r / (8 * 32), q = r % (8 * 32), kb = q / 32, nb = q % 32; const int le = l * 64 + e;
        d.src = a.in[19] + (size_t)le * FFE * DM; d.ldsrc = DM; d.k0 = kb * 64; d.scol = nb * 32; d.kscale = nullptr;
        d.dst = (bf16_t*)(ws + WS_WD) + (size_t)le * DM * FFE; d.K = FFE; d.drow = nb * 32; }
    return d;
}

__device__ __forceinline__ void p0_weights(const Frame& F, const Args& a) {
    LAS float* scr = (LAS float*)(F.lds + F.wave * 16384);
    const int gw = F.vcu * 8 + F.wave, NGW = F.G * 8;
    unsigned char* ws = a.ws;
    constexpr int I_QKV = 2 * 16 * 96, I_O = 2 * 16 * 32, I_IN = 2 * 16 * 96, I_MO = 2 * 16 * 32;
    constexpr int NITEMS = I_QKV + I_O + I_IN + I_MO;
    for (int it = gw; it < NITEMS; it += NGW) {
        int r = it;
        if (r < I_QKV) { const int j = r / (16 * 96), q = r % (16 * 96), kb = q / 96, nb = q % 96;
            const int pn = nb >> 3, bj = (nb >> 2) & 1, wc = nb & 3, part = pn >> 2, head = 4 * (pn & 3) + wc;
            cvt_item(a.in[3] + (size_t)j * DM * 3072, 3072, kb * 64, part * 1024 + head * 64 + 32 * bj, a.in[1] + (size_t)(2 * j) * DM, (bf16_t*)(ws + WS_WQKV) + (size_t)j * 3072 * DM, DM, nb * 32, scr, F.lane); continue; }
        r -= I_QKV;
        if (r < I_O) { const int j = r / (16 * 32), q = r % (16 * 32), kb = q / 32, nb = q % 32;
            cvt_item(a.in[6] + (size_t)j * DM * DM, DM, kb * 64, nb * 32, nullptr, (bf16_t*)(ws + WS_WO) + (size_t)j * DM * DM, DM, nb * 32, scr, F.lane); continue; }
        r -= I_O;
        if (r < I_IN) { const int j = r / (16 * 96), q = r % (16 * 96), kb = q / 96, nb = q % 96;
            cvt_item(a.in[7] + (size_t)j * DM * 3080, 3080, kb * 64, nb * 32, a.in[1] + (size_t)(2 * j + 1) * DM, (bf16_t*)(ws + WS_WIN) + (size_t)j * 3072 * DM, DM, nb * 32, scr, F.lane); continue; }
        r -= I_IN;
        { const int j = r / (16 * 32), q = r % (16 * 32), kb = q / 32, nb = q % 32;
            cvt_item(a.in[12] + (size_t)j * DM * DM, DM, kb * 64, nb * 32, nullptr, (bf16_t*)(ws + WS_WMO) + (size_t)j * DM * DM, DM, nb * 32, scr, F.lane); }
    }
    {
        const int gt = F.vcu * 512 + F.tid, NT = F.G * 512;
        for (int i = gt; i < 4 * 80 * 1024; i += NT) { const int l = i / (80 * 1024), c = (i / 1024) % 80, k = i % 1024;
            float w = 0.f;
            if (c < 8) w = a.in[13][((size_t)l * DM + k) * 8 + c]; else if (c < 72) w = a.in[15][((size_t)l * DM + k) * 64 + (c - 8)];
            w *= a.in[2][l * DM + k];
            const unsigned hi = f2bf(w); const unsigned lo = f2bf(w - bf2f(hi));
            bf16_t* base = (bf16_t*)(ws + WS_WR) + (size_t)l * 2 * 80 * 1024;
            base[c * 1024 + k] = (bf16_t)hi; base[80 * 1024 + c * 1024 + k] = (bf16_t)lo; }
        for (int i = gt; i < 2 * 16 * 1024; i += NT) { const int j = i / (16 * 1024), c = (i / 1024) % 16, k = i % 1024;
            float w = 0.f; if (c < 8) w = a.in[7][((size_t)j * DM + k) * 3080 + 3072 + c] * a.in[1][(2 * j + 1) * DM + k];
            const unsigned hi = f2bf(w); const unsigned lo = f2bf(w - bf2f(hi));
            bf16_t* base = (bf16_t*)(ws + WS_WG) + (size_t)j * 2 * 16 * 1024;
            base[c * 1024 + k] = (bf16_t)hi; base[16 * 1024 + c * 1024 + k] = (bf16_t)lo; }
        if (F.vcu == 0) { for (int i = F.tid; i < DM / 2; i += 512) ((unsigned*)((bf16_t*)(ws + WS_XB) + (size_t)NTOK * DM))[i] = 0u;
            if (F.tid == 0) ((float*)(ws + SM_RSTD))[NTOK] = 0.f; }
    }
}

template <int MODE, int NT, bool WLO = false>
__device__ __forceinline__ void rowpass_wave(const Frame& F, const float* xsrc, float* xdst, bf16_t* xb, float* rstd_out,
                                             const bf16_t* yb, const int* tokp, const float* tokg, const int* toke, const LAS int* pst,
                                             const bf16_t* whi, const bf16_t* wlo, int tok0, f32x4 (&acc)[NT > 0 ? NT : 1], float& rstd_lane) {
    const int lane = F.lane, t = lane & 15, fq = lane >> 4, tok = tok0 + t;
    const float* xr = xsrc + (size_t)tok * DM + 8 * fq;
    bf16_t* xbr = xb + (size_t)tok * DM + 8 * fq;
    const bf16_t *y0 = nullptr, *y1 = nullptr; float g0 = 0.f, g1 = 0.f;
    if (MODE == 2) { const int p0 = pst[toke[2 * tok]] + tokp[2 * tok], p1 = pst[toke[2 * tok + 1]] + tokp[2 * tok + 1]; g0 = tokg[2 * tok]; g1 = tokg[2 * tok + 1];
        y0 = yb + (size_t)p0 * DM + 8 * fq; y1 = yb + (size_t)p1 * DM + 8 * fq; }
    float* xw = (MODE == 2) ? xdst + (size_t)tok * DM + 8 * fq : nullptr;
#pragma unroll
    for (int c = 0; c < (NT > 0 ? NT : 1); ++c) acc[c] = (f32x4){0.f, 0.f, 0.f, 0.f};
    float ss = 0.f;
#pragma unroll 4
    for (int s = 0; s < 32; ++s) {
        f32x4 a0 = __builtin_nontemporal_load((const GAS f32x4*)(xr + 32 * s)), a1 = __builtin_nontemporal_load((const GAS f32x4*)(xr + 32 * s + 4));
        if (MODE == 2) {
            const u32x4 w0 = *(const GAS u32x4*)(y0 + 32 * s), w1 = *(const GAS u32x4*)(y1 + 32 * s);
            a0[0] += g0 * bflo(w0.x) + g1 * bflo(w1.x); a0[1] += g0 * bfhi(w0.x) + g1 * bfhi(w1.x);
            a0[2] += g0 * bflo(w0.y) + g1 * bflo(w1.y); a0[3] += g0 * bfhi(w0.y) + g1 * bfhi(w1.y);
            a1[0] += g0 * bflo(w0.z) + g1 * bflo(w1.z); a1[1] += g0 * bfhi(w0.z) + g1 * bfhi(w1.z);
            a1[2] += g0 * bflo(w0.w) + g1 * bflo(w1.w); a1[3] += g0 * bfhi(w0.w) + g1 * bfhi(w1.w);
            *(GAS f32x4*)(xw + 32 * s) = a0; *(GAS f32x4*)(xw + 32 * s + 4) = a1;
        }
        ss += (a0[0] * a0[0] + a0[1] * a0[1]) + (a0[2] * a0[2] + a0[3] * a0[3]) + (a1[0] * a1[0] + a1[1] * a1[1]) + (a1[2] * a1[2] + a1[3] * a1[3]);
        u32x4 hi; hi.x = cvt_pk_bf16(a0[0], a0[1]); hi.y = cvt_pk_bf16(a0[2], a0[3]); hi.z = cvt_pk_bf16(a1[0], a1[1]); hi.w = cvt_pk_bf16(a1[2], a1[3]);
        *(GAS u32x4*)(xbr + 32 * s) = hi;
        if (NT > 0) {
            u32x4 lo;
            lo.x = cvt_pk_bf16(a0[0] - bflo(hi.x), a0[1] - bfhi(hi.x)); lo.y = cvt_pk_bf16(a0[2] - bflo(hi.y), a0[3] - bfhi(hi.y));
            lo.z = cvt_pk_bf16(a1[0] - bflo(hi.z), a1[1] - bfhi(hi.z)); lo.w = cvt_pk_bf16(a1[2] - bflo(hi.w), a1[3] - bfhi(hi.w));
            const bf16x8 Ah = __builtin_bit_cast(bf16x8, hi), Al = __builtin_bit_cast(bf16x8, lo);
#pragma unroll
            for (int c = 0; c < NT; ++c) {
                const bf16x8 Bh = *(const GAS bf16x8*)(whi + (size_t)(16 * c + t) * DM + 32 * s + 8 * fq);
                acc[c] = MFMA16(Ah, Bh, acc[c]); acc[c] = MFMA16(Al, Bh, acc[c]);
                if (WLO) { const bf16x8 Bl = *(const GAS bf16x8*)(wlo + (size_t)(16 * c + t) * DM + 32 * s + 8 * fq); acc[c] = MFMA16(Ah, Bl, acc[c]); }
            }
        }
    }
    ss += __shfl_xor(ss, 16); ss += __shfl_xor(ss, 32);
    rstd_lane = 1.0f / sqrtf(ss * (1.0f / DM) + EPS);
    if (fq == 0) rstd_out[tok] = rstd_lane;
}

__device__ __forceinline__ void phase_x0(const Frame& F, const Args& a) {
    f32x4 dummy[1]; float rs;
    for (int tb = F.vcu; tb < NTOK / 128; tb += F.G)
        rowpass_wave<0, 0>(F, a.in[0], nullptr, (bf16_t*)(a.ws + WS_XB), (float*)(a.ws + SM_RSTD), nullptr, nullptr, nullptr, nullptr, nullptr, nullptr, nullptr, tb * 128 + F.wave * 16, dummy, rs);
}


constexpr int RT_WB = 73728, RT_WBUF = 21760;
__device__ __forceinline__ void router_pass(const Frame& F, const bf16_t* xb, float* rstd_out, const bf16_t* whi, int tok0, f32x4 (&acc)[5], float& rstd_lane) {
    const int lane = F.lane, t = lane & 15, fq = lane >> 4, tok = tok0 + t;
    const bf16_t* xbr = xb + (size_t)tok * DM + 8 * fq;
    LAS unsigned char* WB = F.lds + RT_WB;
    u32x4 wr[3];
#define RT_LOAD(chunk) do { _Pragma("unroll") for (int i = 0; i < 3; ++i) { const int p = F.tid + 512 * i; if (p < 1280) wr[i] = *(const GAS u32x4*)(whi + (size_t)(p >> 4) * DM + (chunk) * 128 + (p & 15) * 8); } } while (0)
#define RT_STORE(buf) do { _Pragma("unroll") for (int i = 0; i < 3; ++i) { const int p = F.tid + 512 * i; if (p < 1280) *(LAS u32x4*)(WB + (buf) * RT_WBUF + (p >> 4) * 272 + (p & 15) * 16) = wr[i]; } } while (0)
    __syncthreads();
    RT_LOAD(0); RT_STORE(0);
    __syncthreads();
#pragma unroll
    for (int c = 0; c < 5; ++c) acc[c] = (f32x4){0.f, 0.f, 0.f, 0.f};
    float ss = 0.f;
    u32x4 xc[4], xn[4];
#pragma unroll
    for (int s4 = 0; s4 < 4; ++s4) xc[s4] = *(const GAS u32x4*)(xbr + 32 * s4);
    for (int chunk = 0; chunk < 8; ++chunk) {
        if (chunk + 1 < 8) { RT_LOAD(chunk + 1);
#pragma unroll
            for (int s4 = 0; s4 < 4; ++s4) xn[s4] = *(const GAS u32x4*)(xbr + 32 * ((chunk + 1) * 4 + s4)); }
        const LAS unsigned char* wb = WB + (chunk & 1) * RT_WBUF + t * 272 + fq * 16;
#pragma unroll
        for (int s4 = 0; s4 < 4; ++s4) {
            const u32x4 hi = xc[s4];
            { const float x0 = bflo(hi.x), x1 = bfhi(hi.x), x2 = bflo(hi.y), x3 = bfhi(hi.y), x4 = bflo(hi.z), x5 = bfhi(hi.z), x6 = bflo(hi.w), x7 = bfhi(hi.w);
              ss += (x0 * x0 + x1 * x1) + (x2 * x2 + x3 * x3) + (x4 * x4 + x5 * x5) + (x6 * x6 + x7 * x7); }
            const bf16x8 Ah = __builtin_bit_cast(bf16x8, hi);
#pragma unroll
            for (int c = 0; c < 5; ++c) { const bf16x8 Bh = *(const LAS bf16x8*)(wb + c * (16 * 272) + s4 * 64); acc[c] = MFMA16(Ah, Bh, acc[c]); } }
        if (chunk + 1 < 8) { RT_STORE((chunk + 1) & 1);
#pragma unroll
            for (int s4 = 0; s4 < 4; ++s4) xc[s4] = xn[s4]; }
        __syncthreads();
    }
#undef RT_LOAD
#undef RT_STORE
    ss += __shfl_xor(ss, 16); ss += __shfl_xor(ss, 32);
    rstd_lane = 1.0f / sqrtf(ss * (1.0f / DM) + EPS);
    if (fq == 0) rstd_out[tok] = rstd_lane;
}

__device__ __forceinline__ void phase_router(const Frame& F, const Args& a, int l, bool dry = false) {
    unsigned char* ws = a.ws;
    int* sparse = (int*)(ws + WS_QC);
    LAS float* lg = (LAS float*)(F.lds) + F.wave * (16 * 81);
    LAS float* rsl = (LAS float*)(F.lds + 65536) + F.wave * 16;
    LAS int* hist = (LAS int*)(F.lds + 70000);
    LAS int* bbase = (LAS int*)(F.lds + 70000 + 256);
    LAS int* a_e = (LAS int*)(F.lds + 71000);
    LAS int* a_r = (LAS int*)(F.lds + 72100);
    const bf16_t* whi = (const bf16_t*)(ws + WS_WR) + (size_t)l * 2 * 80 * 1024; const bf16_t* wlo = whi + 80 * 1024;
    unsigned* counts = (unsigned*)(ws + WS_CTL) + CW_CNT + l * 64 + (dry ? 4096 : 0);
    int* toke = (int*)(ws + SM_TOKE); float* tokg = (float*)(ws + SM_TOKG); int* tokp = (int*)(ws + SM_TOKP);
    const float* bg = a.in[14] + l * 8; const float* be = a.in[16] + l * 64;
    for (int tb = F.vcu; tb < NTOK / 128; tb += F.G) {
        __syncthreads();
        if (F.tid < 64) hist[F.tid] = 0;
        __syncthreads();
        f32x4 acc[5]; float rs;
        const int tok0 = tb * 128 + F.wave * 16;
        router_pass(F, (const bf16_t*)(ws + WS_XB), (float*)(ws + SM_RSTD), whi, tok0, acc, rs);
        const int t = F.lane & 15, fq = F.lane >> 4;
        if (fq == 0) rsl[t] = rs;
        LDS_WAIT();
#pragma unroll
        for (int c = 0; c < 5; ++c)
#pragma unroll
            for (int i = 0; i < 4; ++i) { const int tt = 4 * fq + i, col = 16 * c + t; const float bias = col < 8 ? bg[col] : (col < 72 ? be[col - 8] : 0.f);
                lg[tt * 81 + col] = acc[c][i] * rsl[tt] + bias; }
        LDS_WAIT();
        if (F.lane < 16) {
            const LAS float* L = lg + F.lane * 81;
            int grp = 0; float gm = L[0];
#pragma unroll
            for (int j = 1; j < 8; ++j) { const float v = L[j]; if (v > gm) { gm = v; grp = j; } }
            float den = 0.f;
#pragma unroll
            for (int j = 0; j < 8; ++j) den += __expf(L[j] - gm);
            const float pg = 1.0f / den;
            const LAS float* E = L + 8 + grp * 8;
            int i1 = 0; float v1 = E[0];
#pragma unroll
            for (int j = 1; j < 8; ++j) { const float v = E[j]; if (v > v1) { v1 = v; i1 = j; } }
            int i2 = (i1 == 0) ? 1 : 0; float v2 = -3.0e38f;
#pragma unroll
            for (int j = 0; j < 8; ++j) { const float v = E[j]; if (j != i1 && v > v2) { v2 = v; i2 = j; } }
            const float e2 = __expf(v2 - v1), s1 = 1.0f / (1.0f + e2);
            const int tok = tok0 + F.lane, e_a = grp * 8 + i1, e_b = grp * 8 + i2;
            toke[2 * tok] = e_a; toke[2 * tok + 1] = e_b; tokg[2 * tok] = pg * s1; tokg[2 * tok + 1] = pg * e2 * s1;
            const int la = (F.wave * 16 + F.lane) * 2;
            a_e[la] = e_a; a_e[la + 1] = e_b;
            a_r[la] = atomicAdd((int*)(hist + e_a), 1); a_r[la + 1] = atomicAdd((int*)(hist + e_b), 1);
        }
        __syncthreads();
        if (F.tid < 64) bbase[F.tid] = (int)atomicAdd(counts + F.tid, (unsigned)hist[F.tid]);
        __syncthreads();
        if (F.tid < 256) { const int tok = tb * 128 + (F.tid >> 1); const int e = a_e[F.tid], idx = bbase[e] + a_r[F.tid]; tokp[2 * tok + (F.tid & 1)] = idx; if (!dry) sparse[e * 32768 + idx] = tok; }
    }
}

__device__ __forceinline__ int moe_tables(const Frame& F, const unsigned* counts, LAS int* pst, LAS int* cnt) {
    __syncthreads();
    if (F.tid < 64) {
        const int c = (int)counts[F.tid]; const int pc = (c + 255) & ~255;
        int incl = pc;
#pragma unroll
        for (int o = 1; o < 64; o <<= 1) { const int t = __shfl_up(incl, o); if (F.lane >= o) incl += t; }
        const int start = incl - pc;
        cnt[F.tid] = c; pst[F.tid] = start; if (F.tid == 63) pst[64] = incl;
        for (int t = start >> 8; t < (incl >> 8); ++t) pst[256 + t] = F.tid;
    }
    __syncthreads();
    return pst[64] >> 8;
}
constexpr int MOE_TAB_OFF = 131072;
struct TokRec { int e0, e1, q0, q1; float g0, g1; };
__device__ __forceinline__ TokRec tok_rec(const int* toke, const int* tokp, const float* tokg, int tok) { TokRec r; r.e0 = toke[2 * tok]; r.e1 = toke[2 * tok + 1]; r.q0 = tokp[2 * tok]; r.q1 = tokp[2 * tok + 1]; r.g0 = tokg[2 * tok]; r.g1 = tokg[2 * tok + 1]; return r; }
template <bool GATES, bool FINAL>
__device__ __forceinline__ void combine_wave(const Frame& F, bf16_t* xb, float* rstd_out, float* fout, const bf16_t* yb, const TokRec tr, const LAS int* pst,
                                             const bf16_t* whi, const bf16_t* wlo, int tok0, f32x4& acc, float& rstd_lane) {
    const int lane = F.lane, t = lane & 15, fq = lane >> 4, tok = tok0 + t;
    bf16_t* xr = xb + (size_t)tok * DM + 8 * fq;
    const int p0 = pst[tr.e0] + tr.q0, p1 = pst[tr.e1] + tr.q1; const float g0 = tr.g0, g1 = tr.g1;
    const bf16_t* y0 = yb + (size_t)p0 * DM + 8 * fq; const bf16_t* y1 = yb + (size_t)p1 * DM + 8 * fq;
    float* fo = FINAL ? fout + (size_t)tok * DM + 8 * fq : nullptr;
    acc = (f32x4){0.f, 0.f, 0.f, 0.f};
    float ss = 0.f;
#pragma unroll 4
    for (int s = 0; s < 32; ++s) {
        const u32x4 x = *(const GAS u32x4*)(xr + 32 * s), w0 = *(const GAS u32x4*)(y0 + 32 * s), w1 = *(const GAS u32x4*)(y1 + 32 * s);
        float v[8];
        v[0] = bflo(x.x) + g0 * bflo(w0.x) + g1 * bflo(w1.x); v[1] = bfhi(x.x) + g0 * bfhi(w0.x) + g1 * bfhi(w1.x);
        v[2] = bflo(x.y) + g0 * bflo(w0.y) + g1 * bflo(w1.y); v[3] = bfhi(x.y) + g0 * bfhi(w0.y) + g1 * bfhi(w1.y);
        v[4] = bflo(x.z) + g0 * bflo(w0.z) + g1 * bflo(w1.z); v[5] = bfhi(x.z) + g0 * bfhi(w0.z) + g1 * bfhi(w1.z);
        v[6] = bflo(x.w) + g0 * bflo(w0.w) + g1 * bflo(w1.w); v[7] = bfhi(x.w) + g0 * bfhi(w0.w) + g1 * bfhi(w1.w);
        if (FINAL) { __builtin_nontemporal_store((f32x4){v[0], v[1], v[2], v[3]}, (GAS f32x4*)(fo + 32 * s)); __builtin_nontemporal_store((f32x4){v[4], v[5], v[6], v[7]}, (GAS f32x4*)(fo + 32 * s + 4)); }
        u32x4 hi; hi.x = cvt_pk_bf16(v[0], v[1]); hi.y = cvt_pk_bf16(v[2], v[3]); hi.z = cvt_pk_bf16(v[4], v[5]); hi.w = cvt_pk_bf16(v[6], v[7]);
        if (!FINAL) *(GAS u32x4*)(xr + 32 * s) = hi;
        { const float r0 = bflo(hi.x), r1 = bfhi(hi.x), r2 = bflo(hi.y), r3 = bfhi(hi.y), r4 = bflo(hi.z), r5 = bfhi(hi.z), r6 = bflo(hi.w), r7 = bfhi(hi.w);
          ss += (r0 * r0 + r1 * r1) + (r2 * r2 + r3 * r3) + (r4 * r4 + r5 * r5) + (r6 * r6 + r7 * r7); }
        if (GATES) { const bf16x8 Ah = __builtin_bit_cast(bf16x8, hi);
            const bf16x8 Bh = *(const GAS bf16x8*)(whi + (size_t)t * DM + 32 * s + 8 * fq), Bl = *(const GAS bf16x8*)(wlo + (size_t)t * DM + 32 * s + 8 * fq);
            acc = MFMA16(Ah, Bh, acc); acc = MFMA16(Ah, Bl, acc); }
    }
    ss += __shfl_xor(ss, 16); ss += __shfl_xor(ss, 32);
    rstd_lane = 1.0f / sqrtf(ss * (1.0f / DM) + EPS);
    if (!FINAL && fq == 0) rstd_out[tok] = rstd_lane;
}
template <bool FINAL>
__device__ __forceinline__ void combine_rows(const Frame& F, bf16_t* xb, float* rstd_out, float* fout, const bf16_t* yb, const int* toke, const int* tokp, const float* tokg, const LAS int* pst, int tok0) {
    const int lane = F.lane;
#pragma unroll 1
    for (int bt = 0; bt < 4; ++bt) {
        u32x4 xv[4][2], y0v[4][2], y1v[4][2]; float g0[4], g1[4];
#pragma unroll
        for (int t4 = 0; t4 < 4; ++t4) { const int tok = __builtin_amdgcn_readfirstlane(tok0 + 4 * bt + t4);
            const int p0 = __builtin_amdgcn_readfirstlane(pst[toke[2 * tok]] + tokp[2 * tok]), p1 = __builtin_amdgcn_readfirstlane(pst[toke[2 * tok + 1]] + tokp[2 * tok + 1]);
            g0[t4] = tokg[2 * tok]; g1[t4] = tokg[2 * tok + 1];
            const bf16_t* xr = xb + (size_t)tok * DM + 8 * lane; const bf16_t* r0 = yb + (size_t)p0 * DM + 8 * lane; const bf16_t* r1 = yb + (size_t)p1 * DM + 8 * lane;
#pragma unroll
            for (int j = 0; j < 2; ++j) { xv[t4][j] = *(const GAS u32x4*)(xr + 512 * j); y0v[t4][j] = *(const GAS u32x4*)(r0 + 512 * j); y1v[t4][j] = *(const GAS u32x4*)(r1 + 512 * j); } }
#pragma unroll
        for (int t4 = 0; t4 < 4; ++t4) { const int tok = tok0 + 4 * bt + t4; float ss = 0.f;
#pragma unroll
            for (int j = 0; j < 2; ++j) { const u32x4 x = xv[t4][j], w0 = y0v[t4][j], w1 = y1v[t4][j]; const float a0 = g0[t4], a1 = g1[t4];
                float v[8];
                v[0] = bflo(x.x) + a0 * bflo(w0.x) + a1 * bflo(w1.x); v[1] = bfhi(x.x) + a0 * bfhi(w0.x) + a1 * bfhi(w1.x);
                v[2] = bflo(x.y) + a0 * bflo(w0.y) + a1 * bflo(w1.y); v[3] = bfhi(x.y) + a0 * bfhi(w0.y) + a1 * bfhi(w1.y);
                v[4] = bflo(x.z) + a0 * bflo(w0.z) + a1 * bflo(w1.z); v[5] = bfhi(x.z) + a0 * bfhi(w0.z) + a1 * bfhi(w1.z);
                v[6] = bflo(x.w) + a0 * bflo(w0.w) + a1 * bflo(w1.w); v[7] = bfhi(x.w) + a0 * bfhi(w0.w) + a1 * bfhi(w1.w);
                if (FINAL) { float* fo = fout + (size_t)tok * DM + 512 * j + 8 * lane;
                    __builtin_nontemporal_store((f32x4){v[0], v[1], v[2], v[3]}, (GAS f32x4*)fo); __builtin_nontemporal_store((f32x4){v[4], v[5], v[6], v[7]}, (GAS f32x4*)(fo + 4)); }
                else { u32x4 hi; hi.x = cvt_pk_bf16(v[0], v[1]); hi.y = cvt_pk_bf16(v[2], v[3]); hi.z = cvt_pk_bf16(v[4], v[5]); hi.w = cvt_pk_bf16(v[6], v[7]);
                    *(GAS u32x4*)(xb + (size_t)tok * DM + 512 * j + 8 * lane) = hi;
                    const float r0 = bflo(hi.x), r1 = bfhi(hi.x), r2 = bflo(hi.y), r3 = bfhi(hi.y), r4 = bflo(hi.z), r5 = bfhi(hi.z), r6 = bflo(hi.w), r7 = bfhi(hi.w);
                    ss += (r0 * r0 + r1 * r1) + (r2 * r2 + r3 * r3) + (r4 * r4 + r5 * r5) + (r6 * r6 + r7 * r7); } }
            if (!FINAL) {
#pragma unroll
                for (int o = 1; o < 64; o <<= 1) ss += __shfl_xor(ss, o);
                if (lane == 0) rstd_out[tok] = 1.0f / sqrtf(ss * (1.0f / DM) + EPS); } }
    }
}
__device__ __forceinline__ void combine_rows_gates(const Frame& F, bf16_t* xb, float* rstd_out, float* gout, const bf16_t* yb, const int* toke, const int* tokp, const float* tokg, const LAS int* pst, int tok0,
                                                   const float* win  , const float* gain  ) {
    const int lane = F.lane;
    float wg[2][8][8];
#pragma unroll
    for (int j = 0; j < 2; ++j)
#pragma unroll
        for (int i = 0; i < 8; ++i) { const int k = 512 * j + 8 * lane + i; const float gk = gain[k]; const f32x4 a = *(const GAS f32x4*)(win + (size_t)k * 3080 + 3072), b = *(const GAS f32x4*)(win + (size_t)k * 3080 + 3076);
            wg[j][i][0] = a[0] * gk; wg[j][i][1] = a[1] * gk; wg[j][i][2] = a[2] * gk; wg[j][i][3] = a[3] * gk; wg[j][i][4] = b[0] * gk; wg[j][i][5] = b[1] * gk; wg[j][i][6] = b[2] * gk; wg[j][i][7] = b[3] * gk; }
#pragma unroll 1
    for (int bt = 0; bt < 8; ++bt) {
        u32x4 xv[2][2], y0v[2][2], y1v[2][2]; float g0[2], g1[2];
#pragma unroll
        for (int t2 = 0; t2 < 2; ++t2) { const int tok = __builtin_amdgcn_readfirstlane(tok0 + 2 * bt + t2);
            const int p0 = __builtin_amdgcn_readfirstlane(pst[toke[2 * tok]] + tokp[2 * tok]), p1 = __builtin_amdgcn_readfirstlane(pst[toke[2 * tok + 1]] + tokp[2 * tok + 1]);
            g0[t2] = tokg[2 * tok]; g1[t2] = tokg[2 * tok + 1];
            const bf16_t* xr = xb + (size_t)tok * DM + 8 * lane; const bf16_t* r0 = yb + (size_t)p0 * DM + 8 * lane; const bf16_t* r1 = yb + (size_t)p1 * DM + 8 * lane;
#pragma unroll
            for (int j = 0; j < 2; ++j) { xv[t2][j] = *(const GAS u32x4*)(xr + 512 * j); y0v[t2][j] = *(const GAS u32x4*)(r0 + 512 * j); y1v[t2][j] = *(const GAS u32x4*)(r1 + 512 * j); } }
#pragma unroll
        for (int t2 = 0; t2 < 2; ++t2) { const int tok = tok0 + 2 * bt + t2; float ss = 0.f, gs[8];
#pragma unroll
            for (int c = 0; c < 8; ++c) gs[c] = 0.f;
#pragma unroll
            for (int j = 0; j < 2; ++j) { const u32x4 x = xv[t2][j], w0 = y0v[t2][j], w1 = y1v[t2][j]; const float a0 = g0[t2], a1 = g1[t2];
                float v[8];
                v[0] = bflo(x.x) + a0 * bflo(w0.x) + a1 * bflo(w1.x); v[1] = bfhi(x.x) + a0 * bfhi(w0.x) + a1 * bfhi(w1.x);
                v[2] = bflo(x.y) + a0 * bflo(w0.y) + a1 * bflo(w1.y); v[3] = bfhi(x.y) + a0 * bfhi(w0.y) + a1 * bfhi(w1.y);
                v[4] = bflo(x.z) + a0 * bflo(w0.z) + a1 * bflo(w1.z); v[5] = bfhi(x.z) + a0 * bfhi(w0.z) + a1 * bfhi(w1.z);
                v[6] = bflo(x.w) + a0 * bflo(w0.w) + a1 * bflo(w1.w); v[7] = bfhi(x.w) + a0 * bfhi(w0.w) + a1 * bfhi(w1.w);
                u32x4 hi; hi.x = cvt_pk_bf16(v[0], v[1]); hi.y = cvt_pk_bf16(v[2], v[3]); hi.z = cvt_pk_bf16(v[4], v[5]); hi.w = cvt_pk_bf16(v[6], v[7]);
                *(GAS u32x4*)(xb + (size_t)tok * DM + 512 * j + 8 * lane) = hi;
                const float r[8] = {bflo(hi.x), bfhi(hi.x), bflo(hi.y), bfhi(hi.y), bflo(hi.z), bfhi(hi.z), bflo(hi.w), bfhi(hi.w)};
#pragma unroll
                for (int i = 0; i < 8; ++i) { ss += r[i] * r[i];
#pragma unroll
                    for (int c = 0; c < 8; ++c) gs[c] += r[i] * wg[j][i][c]; } }
#pragma unroll
            for (int o = 1; o < 64; o <<= 1) { ss += __shfl_xor(ss, o);
#pragma unroll
                for (int c = 0; c < 8; ++c) gs[c] += __shfl_xor(gs[c], o); }
            const float rs = 1.0f / sqrtf(ss * (1.0f / DM) + EPS);
            if (lane == 0) rstd_out[tok] = rs;
            if (lane < 8) { float gv = gs[0];
#pragma unroll
                for (int c = 1; c < 8; ++c) gv = (lane == c) ? gs[c] : gv;
                gout[(size_t)tok * 8 + lane] = gv * rs; } }
    }
}
__device__ __forceinline__ void phase_combine(const Frame& F, const Args& a, int l) {
    unsigned char* ws = a.ws;
    const bool gates = (l + 1 < NLAYER) && ((l + 1) & 1);
    const int j = (l + 1) >> 1;
    const bf16_t* whi = (const bf16_t*)(ws + WS_WG) + (size_t)j * 2 * 16 * 1024; const bf16_t* wlo = whi + 16 * 1024;
    float* gout = (float*)(ws + SM_GATES);
    LAS float* rsl = (LAS float*)(F.lds) + F.wave * 16;
    LAS int* pst = (LAS int*)(F.lds + MOE_TAB_OFF); LAS int* cnt = (LAS int*)(F.lds + MOE_TAB_OFF + 512);
    const int* tokp = (const int*)(ws + SM_TOKP); const float* tokg = (const float*)(ws + SM_TOKG); const int* toke = (const int*)(ws + SM_TOKE);
    TokRec tr = tok_rec(toke, tokp, tokg, F.vcu * 128 + F.wave * 16 + (F.lane & 15));
    (void)moe_tables(F, (const unsigned*)(ws + WS_CTL) + CW_CNT + l * 64, pst, cnt);
    bf16_t* xb = (bf16_t*)(ws + WS_XB); float* rstd = (float*)(ws + SM_RSTD); const bf16_t* yb = (const bf16_t*)(ws + WS_YB);
    for (int tb = F.vcu; tb < NTOK / 128; tb += F.G) {
        f32x4 acc; float rs; const int tok0 = tb * 128 + F.wave * 16;
        if (tb != F.vcu) tr = tok_rec(toke, tokp, tokg, tok0 + (F.lane & 15));
        if (l + 1 == NLAYER) combine_rows<true>(F, xb, rstd, a.out, yb, toke, tokp, tokg, pst, tok0);
        else if (gates) { combine_rows_gates(F, xb, rstd, gout, yb, toke, tokp, tokg, pst, tok0, a.in[7] + (size_t)j * DM * 3080, a.in[1] + (size_t)(2 * j + 1) * DM);
        } else combine_rows<false>(F, xb, rstd, nullptr, yb, toke, tokp, tokg, pst, tok0);
    }
}

constexpr int ATT_KB = 0, ATT_VT = 36864;
struct AttnRegs { u32x4 k[2]; u32x4 v0, v1; bf16x8 q0, q1; };
struct AttnStep { int d, b, h, r, blk; bool prime; };
__device__ __forceinline__ void attn_fetch(const Frame& F, const bf16_t* QKV, const AttnStep& u, AttnRegs& R) {
    const int tid = F.tid, fr = F.lane & 15, fq = F.lane >> 4; const bool valid = u.blk >= 0; const int s0 = u.blk * 128;
#pragma unroll
    for (int i = 0; i < 2; ++i) { const int id = tid + 512 * i, row = id >> 3, ch = id & 7;
        R.k[i] = (u32x4){0u, 0u, 0u, 0u};
        if (valid) R.k[i] = *(const GAS u32x4*)(QKV + ((size_t)(32 + u.b * 16 + u.h) * SEQ + (s0 + row) * u.d + u.r) * 64 + 8 * ch); }
    { const int pair = tid >> 3, ch = tid & 7;
        R.v0 = (u32x4){0u, 0u, 0u, 0u}; R.v1 = (u32x4){0u, 0u, 0u, 0u};
        if (valid) { const bf16_t* p = QKV + ((size_t)(64 + u.b * 16 + u.h) * SEQ + (s0 + 2 * pair) * u.d + u.r) * 64 + 8 * ch; R.v0 = *(const GAS u32x4*)p; R.v1 = *(const GAS u32x4*)(p + (size_t)u.d * 64); } }
    if (!u.prime) { const size_t qrow = (size_t)(u.b * 16 + u.h) * SEQ + (s0 + 16 * F.wave + fr) * u.d + u.r;
        R.q0 = *(const GAS bf16x8*)(QKV + qrow * 64 + 8 * fq); R.q1 = *(const GAS bf16x8*)(QKV + qrow * 64 + 32 + 8 * fq); }
}
__device__ __forceinline__ void attn_stage(const Frame& F, const AttnRegs& R, int slot) {
    LAS unsigned char* Kb = F.lds + ATT_KB; LAS unsigned* VT = (LAS unsigned*)(F.lds + ATT_VT);
#pragma unroll
    for (int i = 0; i < 2; ++i) { const int id = F.tid + 512 * i, row = id >> 3, ch = id & 7; *(LAS u32x4*)(Kb + (slot * 128 + row) * 144 + ch * 16) = R.k[i]; }
    { const int pair = F.tid >> 3, ch = F.tid & 7; const u32x4 v0 = R.v0, v1 = R.v1;
        LAS unsigned* o = VT + (8 * ch) * 129 + slot * 64 + pair;
        o[0 * 129] = (v0.x & 0xffffu) | (v1.x << 16); o[1 * 129] = (v0.x >> 16) | (v1.x & 0xffff0000u);
        o[2 * 129] = (v0.y & 0xffffu) | (v1.y << 16); o[3 * 129] = (v0.y >> 16) | (v1.y & 0xffff0000u);
        o[4 * 129] = (v0.z & 0xffffu) | (v1.z << 16); o[5 * 129] = (v0.z >> 16) | (v1.z & 0xffff0000u);
        o[6 * 129] = (v0.w & 0xffffu) | (v1.w << 16); o[7 * 129] = (v0.w >> 16) | (v1.w & 0xffff0000u); }
}
template <int MODE, bool FIRST>
__device__ __forceinline__ void attn_compute(const Frame& F, const AttnStep& u, const int par, const bf16x8 Q0, const bf16x8 Q1, float off2, bf16_t* part_out, float* l_out, bf16_t* OB, const bf16_t* PP1, const bf16_t* PP2, const float* PL1, const float* PL2) {
    const int lane = F.lane, w = F.wave, fr = lane & 15, fq = lane >> 4;
    const int si0 = u.blk * 128;
    const LAS unsigned char* Kb = F.lds + ATT_KB; const LAS unsigned* VT = (const LAS unsigned*)(F.lds + ATT_VT);
    const int iq = 16 * w + fr; const size_t qrow = (size_t)(u.b * SEQ + (si0 + iq) * u.d + u.r), hrow = (size_t)(u.b * 16 + u.h) * SEQ + (si0 + iq) * u.d + u.r;
    f32x4 O[4];
#pragma unroll
    for (int dt = 0; dt < 4; ++dt) O[dt] = (f32x4){0.f, 0.f, 0.f, 0.f};
    float lsum = 0.f;
#pragma unroll
    for (int up = 0; up < 5; ++up) {
        unsigned pk[4];
#pragma unroll
        for (int hh = 0; hh < 2; ++hh) {
            const int tt = 2 * up + hh;
            if (tt < 9) {
                const int kt = w + tt;
                const int prow = ((kt < 8) ? (par ^ 1) : par) * 128 + 16 * (kt & 7);
                const LAS unsigned char* kp = Kb + (prow + fr) * 144 + fq * 16;
                f32x4 s = (f32x4){0.f, 0.f, 0.f, 0.f};
                s = MFMA16(ld_frag_lds(kp), Q0, s); s = MFMA16(ld_frag_lds(kp + 64), Q1, s);
                float p[4];
                if (FIRST || tt == 0 || tt == 8) {
#pragma unroll
                    for (int i = 0; i < 4; ++i) { const int jk = 16 * kt + 4 * fq + i; const bool ok = (jk >= iq) && (jk <= iq + 128) && (!FIRST || jk >= 128);
                        p[i] = ok ? fast_exp2(s[i] - off2) : 0.f; }
                } else {
#pragma unroll
                    for (int i = 0; i < 4; ++i) p[i] = fast_exp2(s[i] - off2);
                }
                lsum += (p[0] + p[1]) + (p[2] + p[3]);
                pk[2 * hh] = cvt_pk_bf16(p[0], p[1]); pk[2 * hh + 1] = cvt_pk_bf16(p[2], p[3]);
            } else { pk[2 * hh] = 0u; pk[2 * hh + 1] = 0u; }
        }
        const bf16x8 Pf = mk_frag(pk[0], pk[1], pk[2], pk[3]);
        const int kt0 = w + 2 * up, kt1 = (2 * up + 1 < 9) ? kt0 + 1 : kt0;
        const int pb0 = ((kt0 < 8) ? (par ^ 1) : par) * 64 + 8 * (kt0 & 7), pb1 = ((kt1 < 8) ? (par ^ 1) : par) * 64 + 8 * (kt1 & 7);
#pragma unroll
        for (int dt = 0; dt < 4; ++dt) { const LAS unsigned* vp = VT + (16 * dt + fr) * 129 + 2 * fq;
            const bf16x8 V = mk_frag(vp[pb0], vp[pb0 + 1], vp[pb1], vp[pb1 + 1]);
            O[dt] = MFMA16(V, Pf, O[dt]); }
    }
    lsum += __shfl_xor(lsum, 16); lsum += __shfl_xor(lsum, 32);
    if (MODE == 0) {
        bf16_t* o = part_out + hrow * 64 + 4 * fq;
#pragma unroll
        for (int dt = 0; dt < 4; ++dt) { u32x2 wv; wv.x = cvt_pk_bf16(O[dt][0], O[dt][1]); wv.y = cvt_pk_bf16(O[dt][2], O[dt][3]); *(GAS u32x2*)(o + 16 * dt) = wv; }
        if (fq == 0) l_out[hrow] = lsum;
    } else {
        const float inv = 1.0f / (lsum + PL1[hrow] + PL2[hrow]);
        bf16_t* o = OB + hrow * 64 + 4 * fq;
#pragma unroll
        for (int dt = 0; dt < 4; ++dt) { const u32x2 x1 = *(const GAS u32x2*)(PP1 + hrow * 64 + 4 * fq + 16 * dt), x2 = *(const GAS u32x2*)(PP2 + hrow * 64 + 4 * fq + 16 * dt);
            const float o0 = (O[dt][0] + bflo(x1.x) + bflo(x2.x)) * inv, o1 = (O[dt][1] + bfhi(x1.x) + bfhi(x2.x)) * inv;
            const float o2 = (O[dt][2] + bflo(x1.y) + bflo(x2.y)) * inv, o3 = (O[dt][3] + bfhi(x1.y) + bfhi(x2.y)) * inv;
            u32x2 wv; wv.x = cvt_pk_bf16(o0, o1); wv.y = cvt_pk_bf16(o2, o3); *(GAS u32x2*)(o + 16 * dt) = wv; }
    }
}
__device__ __forceinline__ float attn_off2(const float* qg, const float* kg) {
    const int i = threadIdx.x & 63; float mx = fabsf(qg[i] * kg[i]);
#pragma unroll
    for (int o = 1; o < 64; o <<= 1) mx = fmaxf(mx, __shfl_xor(mx, o));
    return 8.0f * mx * LOG2E * 1.02f;
}
template <int MODE>
__device__ __forceinline__ AttnStep attn_step(int s, int vcu, int& br) {
    const int xcd = vcu >> 5, jb = vcu & 31; AttnStep u; int bhl, nblk0, o;
    if (MODE == 0) {
        if (s < 18) { const int ci = 2 * jb + (s >= 9 ? 1 : 0); o = s >= 9 ? s - 9 : s; u.d = 16; bhl = ci >> 4; u.r = ci & 15; nblk0 = 0; br = 0; }
        else { o = s - 18; u.d = 4; bhl = jb >> 3; u.r = (jb & 7) >> 1; nblk0 = 16 * (jb & 1); br = 1; }
    } else { o = s; u.d = 1; bhl = jb >> 3; u.r = 0; nblk0 = 16 * (jb & 7); br = 0; }
    const int bh = xcd + 8 * bhl; u.b = bh >> 4; u.h = bh & 15; u.blk = nblk0 + o - 1; u.prime = (o == 0);
    return u;
}
template <int MODE>
__device__ __forceinline__ void phase_attn(const Frame& F, const Args& a, int j) {
    unsigned char* ws = a.ws; const bf16_t* QKV = (const bf16_t*)(ws + WS_QKV);
    const float off2 = attn_off2(a.in[4] + j * 64, a.in[5] + j * 64);
    constexpr int NSTEP = (MODE == 0) ? 35 : 17;
    if (F.G != 256) return;
    AttnRegs R; R.q0 = (bf16x8){0, 0, 0, 0, 0, 0, 0, 0}; R.q1 = R.q0; int br = 0, ucount = 0;
    AttnStep st = attn_step<MODE>(0, F.vcu, br);
    attn_fetch(F, QKV, st, R);
    const bf16_t* P1 = (const bf16_t*)(ws + WS_P1); const bf16_t* P2 = (const bf16_t*)(ws + WS_P2); const float* L1 = (const float*)(ws + SM_L1); const float* L2 = (const float*)(ws + SM_L2);
    for (int s = 0; s < NSTEP; ++s) {
        __syncthreads();
        attn_stage(F, R, s & 1);
        const bf16x8 Q0 = R.q0, Q1 = R.q1;
        const AttnStep cur = st; const int cbr = br;
        if (s + 1 < NSTEP) { st = attn_step<MODE>(s + 1, F.vcu, br); attn_fetch(F, QKV, st, R); }
        __syncthreads();
        if (cur.prime) continue;
        const int slot = (MODE == 0 ? 0 : 32) + ucount; ++ucount; const int cl = 2 * j + (slot >= 24 ? 1 : 0); const int cit = (F.vcu * 8 + F.wave) + 2048 * (slot % 24);
        const bool do_cvt = (slot < 48) && (cit < MOE_ITEMS);
        CvtDesc cd = cvt_moe_desc(a, cl, do_cvt ? cit : 0); f32x4 cv[8];
        if (do_cvt) cvt_load(cd, F.lane, cv);
        if (cur.blk == 0) attn_compute<MODE, true>(F, cur, s & 1, Q0, Q1, off2, (bf16_t*)(ws + (cbr == 0 ? WS_P1 : WS_P2)), (float*)(ws + (cbr == 0 ? SM_L1 : SM_L2)), (bf16_t*)(ws + WS_OB), P1, P2, L1, L2);
        else attn_compute<MODE, false>(F, cur, s & 1, Q0, Q1, off2, (bf16_t*)(ws + (cbr == 0 ? WS_P1 : WS_P2)), (float*)(ws + (cbr == 0 ? SM_L1 : SM_L2)), (bf16_t*)(ws + WS_OB), P1, P2, L1, L2);
        if (do_cvt) cvt_finish(cd, F.lane, cv, (LAS float*)(F.lds + 71680 + F.wave * 8448));
    }
}
__device__ __forceinline__ void phase_attn_a(const Frame& F, const Args& a, int j) { phase_attn<0>(F, a, j); }
__device__ __forceinline__ void phase_attn_b(const Frame& F, const Args& a, int j) { phase_attn<1>(F, a, j); }

__device__ __forceinline__ float log_sigmoid(float x) { return fminf(x, 0.f) - __logf(1.0f + __expf(-fabsf(x))); }
__device__ __forceinline__ float wave_incl_scan_add(float v, int lane) {
#pragma unroll
    for (int o = 1; o < 64; o <<= 1) { const float t = __shfl_up(v, o); if (lane >= o) v += t; }
    return v;
}
__device__ __forceinline__ float wave_incl_scan_max(float v, int lane) {
#pragma unroll
    for (int o = 1; o < 64; o <<= 1) { const float t = __shfl_up(v, o); if (lane >= o) v = fmaxf(v, t); }
    return v;
}
__device__ __forceinline__ float wave_max(float v) {
#pragma unroll
    for (int o = 1; o < 64; o <<= 1) v = fmaxf(v, __shfl_xor(v, o));
    return v;
}
constexpr int B2_KWT = 0, B2_VT = 18432, B2_WS = 52224, B2_RAW = 56320, B2_OUT = 91904;
__device__ __forceinline__ int vt_col(int dv, int pair) { return (pair + (dv >> 5)) & 31; }
__device__ __forceinline__ void mlstm_fetch_v(const Frame& F, const bf16_t* QKV, int n0, int h, u32x4 (&v0)[2], u32x4 (&v1)[2]) {
#pragma unroll
    for (int i = 0; i < 2; ++i) { const int id = F.tid + 512 * i, ch = id & 31, pair = id >> 5;
        const bf16_t* p = QKV + (size_t)(n0 + 2 * pair) * 3072 + 1024 + h * 256 + 8 * ch;
        v0[i] = *(const GAS u32x4*)p; v1[i] = *(const GAS u32x4*)(p + 3072); }
}
__device__ __forceinline__ void mlstm_write_vT(const Frame& F, const u32x4 (&v0a)[2], const u32x4 (&v1a)[2], LAS unsigned* VT) {
#pragma unroll
    for (int i = 0; i < 2; ++i) { const int id = F.tid + 512 * i, ch = id & 31, pair = id >> 5; const u32x4 v0 = v0a[i], v1 = v1a[i];
        LAS unsigned* o = VT + (8 * ch) * 33 + ((pair + (ch >> 2)) & 31);
        o[0 * 33] = (v0.x & 0xffffu) | (v1.x << 16); o[1 * 33] = (v0.x >> 16) | (v1.x & 0xffff0000u);
        o[2 * 33] = (v0.y & 0xffffu) | (v1.y << 16); o[3 * 33] = (v0.y >> 16) | (v1.y & 0xffff0000u);
        o[4 * 33] = (v0.z & 0xffffu) | (v1.z << 16); o[5 * 33] = (v0.z >> 16) | (v1.z & 0xffff0000u);
        o[6 * 33] = (v0.w & 0xffffu) | (v1.w << 16); o[7 * 33] = (v0.w >> 16) | (v1.w & 0xffff0000u); }
}
__device__ __forceinline__ void mlstm_stage_vT(const Frame& F, const bf16_t* QKV, int n0, int h, LAS unsigned* VT) {
    u32x4 v0[2], v1[2]; mlstm_fetch_v(F, QKV, n0, h, v0, v1); mlstm_write_vT(F, v0, v1, VT);
}
__device__ __forceinline__ void phase_mlstm_local(const Frame& F, const Args& a, int j) {
    unsigned char* ws = a.ws; const bf16_t* QKV = (const bf16_t*)(ws + WS_QKV);
    const float* gates = (const float*)(ws + SM_GATES); const float* gb = a.in[10] + j * 8;
    const float* cw = a.in[8] + (size_t)j * 4 * 1024; const float* cb = a.in[9] + j * 1024;
    bf16_t* QC = (bf16_t*)(ws + WS_QC); bf16_t* KC = (bf16_t*)(ws + WS_KC);
    bf16_t* DC = (bf16_t*)(ws + WS_DC); float* DN = (float*)(ws + SM_DN); float* MLOC = (float*)(ws + SM_MLOC); float* BL = (float*)(ws + SM_BL);
    LAS unsigned char* KwT = F.lds + B2_KWT; LAS unsigned* VT = (LAS unsigned*)(F.lds + B2_VT); LAS float* wsm = (LAS float*)(F.lds + B2_WS);
    if (F.vcu >= 256) return;
    const int bh = F.vcu >> 5, sc = F.vcu & 31, b = bh >> 2, h = bh & 3, us = bh * 32 + sc;
    f32x4 Dacc[2][8], an = (f32x4){0.f, 0.f, 0.f, 0.f};
#pragma unroll
    for (int bt = 0; bt < 2; ++bt)
#pragma unroll
        for (int at = 0; at < 8; ++at) Dacc[bt][at] = (f32x4){0.f, 0.f, 0.f, 0.f};
    float mq = -__builtin_inff(), blsum = 0.f;
    LAS float* G2 = (LAS float*)(F.lds + B2_WS + 512);
    { const int w_ = F.wave, lane_ = F.lane; const int n0w = b * SEQ + (sc * 8 + w_) * 64;
        const float ipre = DBGG(gates[(size_t)(n0w + lane_) * 8 + h]) + gb[h]; const float fpre = DBGG(gates[(size_t)(n0w + lane_) * 8 + 4 + h]) + gb[4 + h];
        const float bs = wave_incl_scan_add(log_sigmoid(fpre), lane_); const float bL = __shfl(bs, 63);
        const float gs = bL - bs + ipre; const float ml = wave_max(gs);
        G2[w_ * 64 + lane_] = __expf(gs - ml);
        if (lane_ == 0) { G2[512 + 2 * w_] = bL; G2[512 + 2 * w_ + 1] = ml; } }
    u32x4 Rv0[2], Rv1[2], Rr[5];
    LAS unsigned char* raw = F.lds + B2_RAW;
#define B2_FETCH(FR, c_) do { _Pragma("unroll") for (int i = 0; i < 5; ++i) { const int p = FR.tid + 512 * i, r = p >> 5, hf = (p >> 4) & 1, c16 = p & 15; const int pos = (c_) * 64 - 3 + r; \
            Rr[i] = (u32x4){0u, 0u, 0u, 0u}; if (p < 67 * 32 && pos >= 0) Rr[i] = *(const GAS u32x4*)(QKV + (size_t)(b * SEQ + pos) * 3072 + hf * 512 + h * 128 + 8 * c16); } } while (0)
    B2_FETCH(F, sc * 8); mlstm_fetch_v(F, QKV, b * SEQ + sc * 8 * 64, h, Rv0, Rv1);
    for (int jc = 0; jc < 8; ++jc) {
        const Frame Fi = make_frame(F.lds);
        const int lane = Fi.lane, fr = lane & 15, fq = lane >> 4, w = Fi.wave;
        const int c = sc * 8 + jc, n0 = b * SEQ + c * 64;
        __syncthreads();
        if (Fi.tid < 64) { const int s = Fi.tid; const float bL = G2[512 + 2 * jc], ml = G2[512 + 2 * jc + 1];
            const float mn = fmaxf(bL + mq, ml); const float aa = __expf(bL + mq - mn), bb = __expf(ml - mn);
            wsm[s] = G2[jc * 64 + s] * bb;
            if (s == 0) wsm[64] = aa;
            mq = mn; blsum += bL; }
        mlstm_write_vT(Fi, Rv0, Rv1, VT);
#pragma unroll
        for (int i = 0; i < 5; ++i) { const int p = Fi.tid + 512 * i, r = p >> 5, hf = (p >> 4) & 1, c16 = p & 15; if (p < 67 * 32) *(LAS u32x4*)(raw + r * 528 + hf * 256 + c16 * 16) = Rr[i]; }
        if (jc + 1 < 8) { mlstm_fetch_v(Fi, QKV, b * SEQ + (c + 1) * 64, h, Rv0, Rv1); B2_FETCH(Fi, c + 1); }
        __syncthreads();
#pragma unroll
        for (int i = 0; i < 4; ++i) { const int id = Fi.tid + 512 * i, s = id & 63, ch = (id >> 6) & 15, isk = id >> 10;
            const int col = (isk ? 512 : 0) + h * 128 + 8 * ch;
            float accv[8];
#pragma unroll
            for (int e = 0; e < 8; ++e) accv[e] = cb[col + e];
#pragma unroll
            for (int jj = 0; jj < 4; ++jj) { const u32x4 x = *(const LAS u32x4*)(raw + (s + jj) * 528 + isk * 256 + ch * 16); const float* wj = cw + jj * 1024 + col;
                accv[0] += wj[0] * bflo(x.x); accv[1] += wj[1] * bfhi(x.x); accv[2] += wj[2] * bflo(x.y); accv[3] += wj[3] * bfhi(x.y);
                accv[4] += wj[4] * bflo(x.z); accv[5] += wj[5] * bfhi(x.z); accv[6] += wj[6] * bflo(x.w); accv[7] += wj[7] * bfhi(x.w); }
            const float scq = isk ? 0.08838834764831845f : 1.0f;
#pragma unroll
            for (int e = 0; e < 8; ++e) { const float v = accv[e]; accv[e] = v * fast_rcp(1.0f + __expf(-v)) * scq; }
            u32x4 o; o.x = cvt_pk_bf16(accv[0], accv[1]); o.y = cvt_pk_bf16(accv[2], accv[3]); o.z = cvt_pk_bf16(accv[4], accv[5]); o.w = cvt_pk_bf16(accv[6], accv[7]);
            *(LAS u32x4*)(F.lds + B2_OUT + isk * 17408 + s * 272 + ch * 16) = o;
            if (isk) { const float wv = wsm[s];
#pragma unroll
                for (int e = 0; e < 8; ++e) *(LAS bf16_t*)(KwT + (8 * ch + e) * 144 + 2 * s) = (bf16_t)f2bf(accv[e] * wv); } }
        __syncthreads();
#pragma unroll
        for (int i = 0; i < 4; ++i) { const int id = Fi.tid + 512 * i, c16 = id & 15, s = (id >> 4) & 63, isk = id >> 10;
            *(GAS u32x4*)((isk ? KC : QC) + ((size_t)(b * 4 + h) * SEQ + c * 64 + s) * 128 + 8 * c16) = *(const LAS u32x4*)(F.lds + B2_OUT + isk * 17408 + s * 272 + c16 * 16); }
        const float aa = wsm[64];
        bf16x8 Bv[2][2];
#pragma unroll
        for (int bt = 0; bt < 2; ++bt)
#pragma unroll
            for (int kk = 0; kk < 2; ++kk) { const int dvr = 16 * (2 * w + bt) + fr; const LAS unsigned* vp = VT + dvr * 33; const int p0 = 4 * fq + 16 * kk; Bv[bt][kk] = mk_frag(vp[vt_col(dvr, p0)], vp[vt_col(dvr, p0 + 1)], vp[vt_col(dvr, p0 + 2)], vp[vt_col(dvr, p0 + 3)]); }
        an *= aa;
#pragma unroll
        for (int at = 0; at < 8; ++at) {
            const LAS unsigned char* kp = KwT + (16 * at + fr) * 144 + 16 * fq;
            const bf16x8 A0 = ld_frag_lds(kp), A1 = ld_frag_lds(kp + 64);
#pragma unroll
            for (int bt = 0; bt < 2; ++bt) { f32x4 d = Dacc[bt][at] * aa; d = MFMA16(A0, Bv[bt][0], d); d = MFMA16(A1, Bv[bt][1], d); Dacc[bt][at] = d; }
            if (at == w) {
                const bf16x8 ones = mk_frag(0x3f803f80u, 0x3f803f80u, 0x3f803f80u, 0x3f803f80u);
                an = MFMA16(A0, ones, an); an = MFMA16(A1, ones, an); }
        }
    }
    { const int lane = F.lane, fr = lane & 15, fq = lane >> 4, w = F.wave;
        bf16_t* dcu = DC + (size_t)us * 32768;
#pragma unroll
        for (int bt = 0; bt < 2; ++bt)
#pragma unroll
            for (int at = 0; at < 8; ++at) { const f32x4 d = Dacc[bt][at]; u32x2 wv; wv.x = cvt_pk_bf16(d[0], d[1]); wv.y = cvt_pk_bf16(d[2], d[3]);
                *(GAS u32x2*)(dcu + (size_t)(16 * (2 * w + bt) + fr) * 128 + 16 * at + 4 * fq) = wv; }
        if (fr == 0) *(GAS f32x4*)(DN + (size_t)us * 128 + 16 * w + 4 * fq) = an;
        if (F.tid == 0) { MLOC[us] = mq; BL[us] = blsum; } }
#undef B2_FETCH
}
__device__ __forceinline__ void phase_mlstm_scan(const Frame& F, const Args& a) {
    unsigned char* ws = a.ws;
    if (F.vcu >= 256 || F.tid >= 256) return;
    const int bh = F.vcu >> 5, part = F.vcu & 31; const size_t eoff = (size_t)part * 1024 + F.tid * 4;
    const bf16_t* DC = (const bf16_t*)(ws + WS_DC); bf16_t* CS = (bf16_t*)(ws + WS_CS);
    const float* DN = (const float*)(ws + SM_DN); float* NS = (float*)(ws + SM_NS);
    const float* MLOC = (const float*)(ws + SM_MLOC); const float* BL = (const float*)(ws + SM_BL); float* MPREV = (float*)(ws + SM_MPREV);
    const bool doN = (part == 0) && (F.tid < 128);
    float st[4] = {0.f, 0.f, 0.f, 0.f}, nst = 0.f, m = 0.f;
    u32x2 dcA[8], dcB[8]; float blA[8], mlA[8], dnA[8], blB[8], mlB[8], dnB[8];
#define B3_LOAD(dc, bl, ml, dn, c0) do { _Pragma("unroll") for (int i = 0; i < 8; ++i) { const int u = bh * 32 + (c0) + i; dc[i] = *(const GAS u32x2*)(DC + (size_t)u * 32768 + eoff); bl[i] = BL[u]; ml[i] = MLOC[u]; dn[i] = doN ? DN[(size_t)u * 128 + F.tid] : 0.f; } } while (0)
#define B3_STEP(dc, bl, ml, dn, c0) do { _Pragma("unroll") for (int i = 0; i < 8; ++i) { const int u = bh * 32 + (c0) + i; \
            u32x2 o; o.x = cvt_pk_bf16(st[0], st[1]); o.y = cvt_pk_bf16(st[2], st[3]); \
            *(GAS u32x2*)(CS + (size_t)u * 32768 + eoff) = o; \
            if (doN) NS[(size_t)u * 128 + F.tid] = nst; \
            if (part == 0 && F.tid == 0) MPREV[u] = m; \
            const float mn = fmaxf(bl[i] + m, ml[i]); const float aa = __expf(bl[i] + m - mn), bb = __expf(ml[i] - mn); \
            st[0] = aa * st[0] + bb * bflo(dc[i].x); st[1] = aa * st[1] + bb * bfhi(dc[i].x); st[2] = aa * st[2] + bb * bflo(dc[i].y); st[3] = aa * st[3] + bb * bfhi(dc[i].y); \
            nst = aa * nst + bb * dn[i]; m = mn; } } while (0)
    B3_LOAD(dcA, blA, mlA, dnA, 0);
    for (int c0 = 0; c0 < 32; c0 += 16) {
        B3_LOAD(dcB, blB, mlB, dnB, c0 + 8);
        B3_STEP(dcA, blA, mlA, dnA, c0);
        if (c0 + 16 < 32) B3_LOAD(dcA, blA, mlA, dnA, c0 + 16);
        B3_STEP(dcB, blB, mlB, dnB, c0 + 8);
    }
#undef B3_LOAD
#undef B3_STEP
}
constexpr int B4_QS = 0, B4_KS = 17408, B4_VT = 34816, B4_SS = 68608, B4_SC = 77824, B4_KWT = 86016, B4_G = 104448, B4_RED = 112768;
__device__ __forceinline__ void phase_mlstm_out(const Frame& F, const Args& a, int j) {
    unsigned char* ws = a.ws; const bf16_t* QKV = (const bf16_t*)(ws + WS_QKV);
    const float* gates = (const float*)(ws + SM_GATES); const float* gb = a.in[10] + j * 8; const float* hg = a.in[11] + (size_t)j * 1024;
    const bf16_t* QC = (const bf16_t*)(ws + WS_QC); const bf16_t* KC = (const bf16_t*)(ws + WS_KC);
    const bf16_t* CS = (const bf16_t*)(ws + WS_CS); const float* NS = (const float*)(ws + SM_NS); const float* MPREV = (const float*)(ws + SM_MPREV);
    bf16_t* OB = (bf16_t*)(ws + WS_OB);
    LAS unsigned char* Qs = F.lds + B4_QS; LAS unsigned char* Ks = F.lds + B4_KS; LAS unsigned* VT = (LAS unsigned*)(F.lds + B4_VT); LAS unsigned char* Ss = F.lds + B4_SS; LAS unsigned char* KwT = F.lds + B4_KWT;
    LAS float* us = (LAS float*)(F.lds + B4_SC); LAS float* Ms = us + 64; LAS float* wint = us + 128; LAS float* eneg = us + 192; LAS float* npv = us + 256; LAS float* den = us + 384  ; LAS float* qn = us + 640  ; LAS float* hss = us + 1152  ;
    LAS float* wk = us + 1664  ; LAS float* scal = us + 1728;
    const int lane = F.lane, fr = lane & 15, fq = lane >> 4, w = F.wave;
    if (F.vcu >= 256) return;
    const int bh = F.vcu >> 5, sc = F.vcu & 31, b = bh >> 2, h = bh & 3;
    const int us0 = bh * 32 + sc;
    f32x4 Cst[2][8];
#pragma unroll
    for (int bt = 0; bt < 2; ++bt)
#pragma unroll
        for (int at = 0; at < 8; ++at) { const u32x2 x = *(const GAS u32x2*)(CS + (size_t)us0 * 32768 + (size_t)(16 * (2 * w + bt) + fr) * 128 + 16 * at + 4 * fq);
            Cst[bt][at] = (f32x4){bflo(x.x), bfhi(x.x), bflo(x.y), bfhi(x.y)}; }
    float mcur = MPREV[us0];
    LAS float* G4 = (LAS float*)(F.lds + B4_G);
    { const int n0w = b * SEQ + (sc * 8 + w) * 64;
        const float ipre = DBGG(gates[(size_t)(n0w + lane) * 8 + h]) + gb[h]; const float fpre = DBGG(gates[(size_t)(n0w + lane) * 8 + 4 + h]) + gb[4 + h];
        const float bs = wave_incl_scan_add(log_sigmoid(fpre), lane); const float uu = ipre - bs; const float pm = wave_incl_scan_max(uu, lane);
        const float bL = __shfl(bs, 63); const float gs = bL - bs + ipre; const float ml = wave_max(gs);
        G4[(w * 4 + 0) * 64 + lane] = bs; G4[(w * 4 + 1) * 64 + lane] = uu; G4[(w * 4 + 2) * 64 + lane] = pm; G4[(w * 4 + 3) * 64 + lane] = __expf(gs - ml);
        if (lane == 0) { G4[2048 + 2 * w] = bL; G4[2048 + 2 * w + 1] = ml; } }
    if (F.tid >= 64 && F.tid < 192) npv[F.tid - 64] = NS[(size_t)us0 * 128 + F.tid - 64];
    u32x4 Rqk[4], Rv0[2], Rv1[2];
#define B4_FETCH(FR, c_) do { const int n0_ = b * SEQ + (c_) * 64; \
        _Pragma("unroll") for (int i = 0; i < 4; ++i) { const int id = FR.tid + 512 * i, ch = id & 15, s = (id >> 4) & 63, isk = id >> 10; \
            Rqk[i] = *(const GAS u32x4*)((isk ? KC : QC) + ((size_t)(b * 4 + h) * SEQ + (c_) * 64 + s) * 128 + 8 * ch); } \
        mlstm_fetch_v(FR, QKV, n0_, h, Rv0, Rv1); } while (0)
    B4_FETCH(F, sc * 8);
    for (int jc = 0; jc < 8; ++jc) {
        const Frame Fi = make_frame(F.lds);
        const int lane = Fi.lane, fr = lane & 15, fq = lane >> 4, w = Fi.wave;
        const int c = sc * 8 + jc, n0 = b * SEQ + c * 64;
        __syncthreads();
        if (Fi.tid < 64) { const int s = Fi.tid; const float bs = G4[(jc * 4 + 0) * 64 + s], uu = G4[(jc * 4 + 1) * 64 + s], pm = G4[(jc * 4 + 2) * 64 + s];
            const float mp = mcur; const float M = fmaxf(mp, pm);
            us[s] = uu; Ms[s] = M; wint[s] = __expf(mp - M); eneg[s] = __expf(-(bs + M));
            const float bL = G4[2048 + 2 * jc], ml = G4[2048 + 2 * jc + 1];
            const float mn = fmaxf(bL + mp, ml); const float aa = __expf(bL + mp - mn), bb = __expf(ml - mn);
            wk[s] = G4[(jc * 4 + 3) * 64 + s] * bb;
            if (s == 0) scal[0] = aa;
            mcur = mn; }
#pragma unroll
        for (int i = 0; i < 4; ++i) { const int id = Fi.tid + 512 * i, ch = id & 15, s = (id >> 4) & 63, isk = id >> 10;
            *(LAS u32x4*)((isk ? Ks : Qs) + s * 272 + ch * 16) = Rqk[i]; }
        mlstm_write_vT(Fi, Rv0, Rv1, VT);
        if (jc + 1 < 8) B4_FETCH(Fi, c + 1);
        __syncthreads();
        u32x2 ogv[4][2]; f32x4 hgv[2];
#pragma unroll
        for (int dv = 0; dv < 2; ++dv) { const int col = h * 256 + 16 * (2 * w + dv) + 4 * fq; hgv[dv] = *(const GAS f32x4*)(hg + col);
#pragma unroll
            for (int tt = 0; tt < 4; ++tt) ogv[tt][dv] = *(const GAS u32x2*)(QKV + (size_t)(n0 + 16 * tt + fr) * 3072 + 2048 + col); }
#pragma unroll
        for (int i = 0; i < 2; ++i) { const int id = Fi.tid + 512 * i, s = id & 63, ch = id >> 6; const u32x4 kx = *(const LAS u32x4*)(Ks + s * 272 + ch * 16); const float wv = wk[s];
            LAS unsigned char* o = KwT + (8 * ch) * 144 + 2 * s;
            *(LAS bf16_t*)(o + 0 * 144) = (bf16_t)f2bf(bflo(kx.x) * wv); *(LAS bf16_t*)(o + 1 * 144) = (bf16_t)f2bf(bfhi(kx.x) * wv);
            *(LAS bf16_t*)(o + 2 * 144) = (bf16_t)f2bf(bflo(kx.y) * wv); *(LAS bf16_t*)(o + 3 * 144) = (bf16_t)f2bf(bfhi(kx.y) * wv);
            *(LAS bf16_t*)(o + 4 * 144) = (bf16_t)f2bf(bflo(kx.z) * wv); *(LAS bf16_t*)(o + 5 * 144) = (bf16_t)f2bf(bfhi(kx.z) * wv);
            *(LAS bf16_t*)(o + 6 * 144) = (bf16_t)f2bf(bflo(kx.w) * wv); *(LAS bf16_t*)(o + 7 * 144) = (bf16_t)f2bf(bfhi(kx.w) * wv); }
#pragma unroll
        for (int q2 = 0; q2 < 2; ++q2) { const int idx = 2 * w + q2, st = idx >> 2, tt = idx & 3;
            f32x4 sacc = (f32x4){0.f, 0.f, 0.f, 0.f};
            if (st <= tt) {
#pragma unroll
                for (int kk = 0; kk < 4; ++kk) sacc = MFMA16(ld_frag_lds(Ks + (16 * st + fr) * 272 + 16 * fq + 64 * kk), ld_frag_lds(Qs + (16 * tt + fr) * 272 + 16 * fq + 64 * kk), sacc);
            }
            const int t = 16 * tt + fr; const float Mt = Ms[t]; float p[4], rsum = 0.f;
#pragma unroll
            for (int i = 0; i < 4; ++i) { const int s = 16 * st + 4 * fq + i; p[i] = (s <= t) ? sacc[i] * __expf(us[s] - Mt) : 0.f; rsum += p[i]; }
            u32x2 wv; wv.x = cvt_pk_bf16(p[0], p[1]); wv.y = cvt_pk_bf16(p[2], p[3]);
            *(LAS u32x2*)(Ss + t * 144 + (16 * st + 4 * fq) * 2) = wv;
            rsum += __shfl_xor(rsum, 16); rsum += __shfl_xor(rsum, 32);
            if (fq == 0) den[st * 64 + t] = rsum; }
        { const int t = Fi.tid & 63, pp = Fi.tid >> 6; const LAS bf16_t* qr = (const LAS bf16_t*)(Qs + t * 272) + 16 * pp; float sacc = 0.f;
#pragma unroll
            for (int e = 0; e < 16; ++e) sacc += bf2f(qr[e]) * npv[16 * pp + e];
            qn[pp * 64 + t] = sacc; }
        __syncthreads();
        f32x4 acc[2][4];
#pragma unroll
        for (int dv = 0; dv < 2; ++dv)
#pragma unroll
            for (int tt = 0; tt < 4; ++tt) acc[dv][tt] = (f32x4){0.f, 0.f, 0.f, 0.f};
#pragma unroll
        for (int kk = 0; kk < 4; ++kk) {
            bf16x8 Bq[4];
#pragma unroll
            for (int tt = 0; tt < 4; ++tt) { const LAS unsigned char* qp = Qs + (16 * tt + fr) * 272 + 64 * kk + 8 * fq; const u32x2 lo = *(const LAS u32x2*)qp, hi = *(const LAS u32x2*)(qp + 32); Bq[tt] = mk_frag(lo.x, lo.y, hi.x, hi.y); }
#pragma unroll
            for (int dv = 0; dv < 2; ++dv) { const f32x4 c0 = Cst[dv][2 * kk], c1 = Cst[dv][2 * kk + 1];
                const bf16x8 Ac = mk_frag(cvt_pk_bf16(c0[0], c0[1]), cvt_pk_bf16(c0[2], c0[3]), cvt_pk_bf16(c1[0], c1[1]), cvt_pk_bf16(c1[2], c1[3]));
#pragma unroll
                for (int tt = 0; tt < 4; ++tt) acc[dv][tt] = MFMA16(Ac, Bq[tt], acc[dv][tt]); }
            __builtin_amdgcn_sched_barrier(0);
        }
#pragma unroll
        for (int tt = 0; tt < 4; ++tt) { const float wi = wint[16 * tt + fr];
#pragma unroll
            for (int dv = 0; dv < 2; ++dv) acc[dv][tt] *= wi; }
#pragma unroll
        for (int kk = 0; kk < 2; ++kk) {
            bf16x8 Bs[4], Avk[2];
#pragma unroll
            for (int dv = 0; dv < 2; ++dv) { const int dvr = 16 * (2 * w + dv) + fr; const LAS unsigned* vp = VT + dvr * 33; const int p0 = 4 * fq + 16 * kk; Avk[dv] = mk_frag(vp[vt_col(dvr, p0)], vp[vt_col(dvr, p0 + 1)], vp[vt_col(dvr, p0 + 2)], vp[vt_col(dvr, p0 + 3)]); }
#pragma unroll
            for (int tt = 0; tt < 4; ++tt) Bs[tt] = ld_frag_lds(Ss + (16 * tt + fr) * 144 + 16 * fq + 64 * kk);
#pragma unroll
            for (int dv = 0; dv < 2; ++dv)
#pragma unroll
                for (int tt = 0; tt < 4; ++tt) acc[dv][tt] = MFMA16(Avk[dv], Bs[tt], acc[dv][tt]);
            __builtin_amdgcn_sched_barrier(0);
        }
        LAS float* redw = (LAS float*)(F.lds + B4_RED) + w * 64;
        { const int t = lane; const float qnt = ((qn[t] + qn[64 + t]) + (qn[128 + t] + qn[192 + t])) + ((qn[256 + t] + qn[320 + t]) + (qn[384 + t] + qn[448 + t]));
            const float dn = ((den[t] + den[64 + t]) + (den[128 + t] + den[192 + t])) + wint[t] * qnt; redw[t] = 1.0f / fmaxf(fabsf(dn), eneg[t]); }
        LDS_WAIT(); asm volatile("" ::: "memory");
#pragma unroll
        for (int tt = 0; tt < 4; ++tt) { const int t = 16 * tt + fr; const float inv = redw[t];
            float q = 0.f;
#pragma unroll
            for (int dv = 0; dv < 2; ++dv) { acc[dv][tt] *= inv; const f32x4 v = acc[dv][tt] * acc[dv][tt]; q += (v[0] + v[1]) + (v[2] + v[3]); }
            q += __shfl_xor(q, 16); q += __shfl_xor(q, 32);
            if (fq == 0) hss[w * 64 + t] = q; }
        __syncthreads();
        { const int t = lane; const float hs = ((hss[t] + hss[64 + t]) + (hss[128 + t] + hss[192 + t])) + ((hss[256 + t] + hss[320 + t]) + (hss[384 + t] + hss[448 + t]));
            redw[t] = 1.0f / sqrtf(hs * (1.0f / 256.0f) + EPS); }
        LDS_WAIT(); asm volatile("" ::: "memory");
#pragma unroll
        for (int tt = 0; tt < 4; ++tt) { const int t = 16 * tt + fr; const float rst = redw[t];
#pragma unroll
            for (int dv = 0; dv < 2; ++dv) { const int col = h * 256 + 16 * (2 * w + dv) + 4 * fq;
                const u32x2 og = ogv[tt][dv]; const f32x4 g4 = hgv[dv];
                const float o0 = acc[dv][tt][0] * rst * g4[0] * fast_rcp(1.0f + __expf(-bflo(og.x))), o1 = acc[dv][tt][1] * rst * g4[1] * fast_rcp(1.0f + __expf(-bfhi(og.x)));
                const float o2 = acc[dv][tt][2] * rst * g4[2] * fast_rcp(1.0f + __expf(-bflo(og.y))), o3 = acc[dv][tt][3] * rst * g4[3] * fast_rcp(1.0f + __expf(-bfhi(og.y)));
                u32x2 wv; wv.x = cvt_pk_bf16(o0, o1); wv.y = cvt_pk_bf16(o2, o3);
                *(GAS u32x2*)(OB + (size_t)(n0 + t) * DM + col) = wv; } }
        { const float aa = scal[0];
            bf16x8 Avk[2][2];
#pragma unroll
            for (int kk = 0; kk < 2; ++kk)
#pragma unroll
                for (int dv = 0; dv < 2; ++dv) { const int dvr = 16 * (2 * w + dv) + fr; const LAS unsigned* vp = VT + dvr * 33; const int p0 = 4 * fq + 16 * kk; Avk[kk][dv] = mk_frag(vp[vt_col(dvr, p0)], vp[vt_col(dvr, p0 + 1)], vp[vt_col(dvr, p0 + 2)], vp[vt_col(dvr, p0 + 3)]); }
#pragma unroll
            for (int bt = 0; bt < 2; ++bt)
#pragma unroll
                for (int at = 0; at < 8; ++at) Cst[bt][at] *= aa;
#pragma unroll
            for (int at = 0; at < 8; ++at) { const LAS unsigned char* kp = KwT + (16 * at + fr) * 144 + 16 * fq; const bf16x8 A0 = ld_frag_lds(kp), A1 = ld_frag_lds(kp + 64);
#pragma unroll
                for (int bt = 0; bt < 2; ++bt) { Cst[bt][at] = MFMA16(A0, Avk[0][bt], Cst[bt][at]); Cst[bt][at] = MFMA16(A1, Avk[1][bt], Cst[bt][at]); } }
            if (Fi.tid >= 64 && Fi.tid < 192) { const int dk = Fi.tid - 64; const LAS unsigned char* kr = KwT + dk * 144; float sum = 0.f;
#pragma unroll
                for (int q8 = 0; q8 < 8; ++q8) { const u32x4 x = *(const LAS u32x4*)(kr + 16 * q8); sum += ((bflo(x.x) + bfhi(x.x)) + (bflo(x.y) + bfhi(x.y))) + ((bflo(x.z) + bfhi(x.z)) + (bflo(x.w) + bfhi(x.w))); }
                npv[dk] = aa * npv[dk] + sum; } }
    }
#undef B4_FETCH
}


#ifdef PROBE_BUF
__device__ __forceinline__ void probe_scan(const Frame& F, const Args& a) {
    unsigned* ctl = (unsigned*)(a.ws + WS_CTL);
    unsigned bad = 0; float ms = 0.f;
    for (size_t i = (size_t)F.vcu * 512 + F.tid; i < (size_t)(PROBE_N); i += (size_t)F.G * 512) {
        float v;
        if (PROBE_KIND == 0) v = bf2f(((const bf16_t*)(a.ws + PROBE_BUF))[i]); else v = ((const float*)(a.ws + PROBE_BUF))[i];
        if (fabsf(v) < 1e30f) ms += v * v; else ++bad;
    }
    if (PROBE_STAT == 2) { bad = 0; ms = 0.f;
        for (int u = F.vcu * 8 + F.wave; u < (int)((PROBE_N) / 32768); u += F.G * 8) { unsigned b2 = 0;
            for (int i = F.lane; i < 32768; i += 64) { const float v = bf2f(((const bf16_t*)(a.ws + PROBE_BUF))[(size_t)u * 32768 + i]); if (!(fabsf(v) < 1e30f)) b2 = 1; }
            b2 = __any(b2) ? 1u : 0u; if (F.lane == 0) bad += b2 * 32768u; } }
    atomicAdd(ctl + 20000, bad); atomicAdd((float*)(ctl + 20064), ms);
}
__device__ __forceinline__ void probe_fill(const Frame& F, const Args& a) {
    const unsigned* ctl = (const unsigned*)(a.ws + WS_CTL);
    const float f = (float)ctl[20000] / (float)(PROBE_N), msq = ((const float*)ctl)[20064] / (float)(PROBE_N);
    const float c = sqrtf(PROBE_STAT != 1 ? 10.0f * f : msq);
    for (size_t i = (size_t)F.vcu * 512 + F.tid; i < (size_t)NTOK * DM; i += (size_t)F.G * 512) a.out[i] = c;
}
#endif
constexpr int NPHASE = 1 + NLAYER * 10;

typedef const __attribute__((address_space(4))) Args* KArgsPtr;
__device__ __forceinline__ Args opaque_args() {
#if defined(__HIP_DEVICE_COMPILE__)
    KArgsPtr p = (KArgsPtr)__builtin_amdgcn_kernarg_segment_ptr(); asm volatile("" : "+s"(p)); return *p;
#else
    return Args{};
#endif
}
#define SITE() const Frame FP = make_frame(lds); const Args A = opaque_args(); unsigned char* const ws = A.ws; (void)ws
__global__ void __launch_bounds__(512, 2) mk_fwd(Args args) {
    extern __shared__ __attribute__((aligned(16))) unsigned char lds_raw[];
    LAS unsigned char* const lds = (LAS unsigned char*)lds_raw;
    volatile LAS unsigned* MISC = (volatile LAS unsigned*)(lds + MISC_OFF);
    if (threadIdx.x < 32) MISC[threadIdx.x] = 0u;
    __syncthreads();
    const int lo = args.ph_lo, hi = args.ph_hi;
    XcdBarrier bar; bar.bar = (unsigned*)(args.ws + WS_CTL) + CW_BAR; bar.x = 0; bar.st = nullptr;
    if (hi - lo > 1) bar = xcd_barrier_post((unsigned*)(args.ws + WS_CTL) + CW_BAR, MISC + 8);
#define IN(k) (lo <= (k) && (k) < hi)
#ifdef XBAR_EXTRA
#define SEAM(k) do { if (IN(k) && IN((k) + 1)) { xcd_barrier(bar); xcd_barrier(bar); } } while (0)
#else
#define SEAM(k) do { if (IN(k) && IN((k) + 1)) xcd_barrier(bar); } while (0)
#endif
    if (PHON(0) && IN(0)) for (int rep_ = 0; rep_ < NREP(0); ++rep_) { SITE(); p0_weights(FP, A); phase_x0(FP, A); }
    SEAM(0);
    for (int l = 0; l < NLAYER; ++l) {
        const int pb = 1 + l * 10, j = l >> 1;
        if ((l & 1) == 0) {
            if (PHON(1) && IN(pb)) for (int rep_ = 0; rep_ < NREP(1); ++rep_) { SITE(); pg8::Gemm g{(const bf16_t*)(ws + WS_XB), (const bf16_t*)(ws + WS_WQKV) + (size_t)j * 3072 * DM, DM, 0, nullptr, nullptr, nullptr};
                pg8::StaticOrder S; S.init(NTOK / 256, 12, FP.G, (int)blockIdx.x, nullptr);
                pg8::EpiQKV E{(bf16_t*)(ws + WS_QKV), (const float*)(ws + SM_RSTD), A.in[4] + j * 64, A.in[5] + j * 64, 0.125f * LOG2E};
                pg8::gemm_phase<pg8::EpiQKV, true, false>(lds, FP.tid, g, S, E); }
            SEAM(pb);
            if (PHON(2) && IN(pb + 1)) for (int rep_ = 0; rep_ < NREP(2); ++rep_) { SITE(); phase_attn_a(FP, A, j); }
            SEAM(pb + 1);
            if (PHON(3) && IN(pb + 2)) for (int rep_ = 0; rep_ < NREP(3); ++rep_) { SITE(); phase_attn_b(FP, A, j); }
            if (IN(pb + 2) && IN(pb + 4)) xcd_barrier(bar);
            if (PHON(4) && IN(pb + 4)) { SITE(); pg8::Gemm g{(const bf16_t*)(ws + WS_OB), (const bf16_t*)(ws + WS_WO) + (size_t)j * DM * DM, DM, 0, nullptr, nullptr, nullptr};
                pg8::StaticOrder S; S.init(NTOK / 256, 4, FP.G, (int)blockIdx.x, nullptr);
                pg8::EpiResidB E{(bf16_t*)(ws + WS_XB)};
                pg8::gemm_phase<pg8::EpiResidB, true, false, true>(lds, FP.tid, g, S, E); }
            SEAM(pb + 4);
        } else {
            if (PHON(5) && IN(pb)) for (int rep_ = 0; rep_ < NREP(5); ++rep_) { SITE(); pg8::Gemm g{(const bf16_t*)(ws + WS_XB), (const bf16_t*)(ws + WS_WIN) + (size_t)j * 3072 * DM, DM, 0, nullptr, nullptr, nullptr};
                pg8::StaticOrder S; S.init(NTOK / 256, 12, FP.G, (int)blockIdx.x, nullptr);
                pg8::EpiBf16 E{(bf16_t*)(ws + WS_QKV), 3072, (const float*)(ws + SM_RSTD)};
                pg8::gemm_phase<pg8::EpiBf16, true, false>(lds, FP.tid, g, S, E); }
            SEAM(pb);
            if (PHON(6) && IN(pb + 1)) for (int rep_ = 0; rep_ < NREP(6); ++rep_) { SITE(); phase_mlstm_local(FP, A, j); }
            SEAM(pb + 1);
            if (PHON(7) && IN(pb + 2)) for (int rep_ = 0; rep_ < NREP(7); ++rep_) { SITE(); phase_mlstm_scan(FP, A); }
            SEAM(pb + 2);
            if (PHON(8) && IN(pb + 3)) for (int rep_ = 0; rep_ < NREP(8); ++rep_) { SITE(); phase_mlstm_out(FP, A, j); }
            SEAM(pb + 3);
            if (PHON(9) && IN(pb + 4)) { SITE(); pg8::Gemm g{(const bf16_t*)(ws + WS_OB), (const bf16_t*)(ws + WS_WMO) + (size_t)j * DM * DM, DM, 0, nullptr, nullptr, nullptr};
                pg8::StaticOrder S; S.init(NTOK / 256, 4, FP.G, (int)blockIdx.x, nullptr);
                pg8::EpiResidB E{(bf16_t*)(ws + WS_XB)};
                pg8::gemm_phase<pg8::EpiResidB, true, false>(lds, FP.tid, g, S, E); }
            SEAM(pb + 4);
        }
        if (PHON(10) && IN(pb + 5)) for (int rep_ = 0; rep_ < NREP(10); ++rep_) { SITE(); phase_router(FP, A, l, rep_ + 1 < NREP(10)); }
        if (IN(pb + 5) && IN(pb + 7)) xcd_barrier(bar);
        if (PHON(12) && IN(pb + 7)) for (int rep_ = 0; rep_ < NREP(12); ++rep_) { SITE();
            LAS int* pst = (LAS int*)(lds + MOE_TAB_OFF); LAS int* cnt = (LAS int*)(lds + MOE_TAB_OFF + 512);
            const int ntiles = __builtin_amdgcn_readfirstlane(moe_tables(FP, (const unsigned*)(ws + WS_CTL) + CW_CNT + l * 64, pst, cnt));
            pg8::Gemm g{(const bf16_t*)(ws + WS_XB), (const bf16_t*)(ws + WS_WGU) + (size_t)l * 64 * DM * DM, DM, (size_t)DM * DM * 2, (const int*)(ws + WS_QC), pst, cnt};
            pg8::StaticOrder S; S.init(ntiles, 4, FP.G, (int)blockIdx.x, pst);
            pg8::EpiGU E{(bf16_t*)(ws + WS_ACT), (const float*)(ws + SM_RSTD), (const int*)(ws + WS_QC), pst, cnt};
            pg8::gemm_phase<pg8::EpiGU, true, true>(lds, FP.tid, g, S, E); }
        SEAM(pb + 7);
        if (PHON(13) && IN(pb + 8)) for (int rep_ = 0; rep_ < NREP(13); ++rep_) { SITE();
            LAS int* pst = (LAS int*)(lds + MOE_TAB_OFF); LAS int* cnt = (LAS int*)(lds + MOE_TAB_OFF + 512);
            const int ntiles = __builtin_amdgcn_readfirstlane(moe_tables(FP, (const unsigned*)(ws + WS_CTL) + CW_CNT + l * 64, pst, cnt));
            pg8::Gemm g{(const bf16_t*)(ws + WS_ACT), (const bf16_t*)(ws + WS_WD) + (size_t)l * 64 * DM * FFE, FFE, (size_t)DM * FFE * 2, nullptr, pst, cnt};
            pg8::StaticOrder S; S.init(ntiles, 4, FP.G, (int)blockIdx.x, pst);
            pg8::EpiBf16 E{(bf16_t*)(ws + WS_YB), DM, nullptr};
            pg8::gemm_phase<pg8::EpiBf16, true, false>(lds, FP.tid, g, S, E); }
        SEAM(pb + 8);
        if (PHON(14) && IN(pb + 9)) { SITE(); phase_combine(FP, A, l); }
        SEAM(pb + 9);
    }
#ifdef PROBE_BUF
    if (IN(NPHASE)) { SITE(); probe_scan(FP, A); }
    if (IN(NPHASE + 1)) { SITE(); probe_fill(FP, A); }
#endif
#undef IN
#undef SEAM
}

extern "C" void kernel_launch(void* const* d_in, const int* in_sizes, int n_in, void* d_out, int out_size, void* d_ws, size_t ws_size, hipStream_t stream) {
    static int grid = 0;
    if (grid == 0) {
        if (n_in != 20 || out_size != NTOK * DM || ws_size < WS_END) { fprintf(stderr, "kernel_launch: unexpected shapes (n_in %d, out %d, ws %zu < %zu); nothing launched\n", n_in, out_size, ws_size, (size_t)WS_END); grid = -1; return; }
        int dev = 0, cus = 0, per_cu = 0;
        if (hipGetDevice(&dev) != hipSuccess || hipDeviceGetAttribute(&cus, hipDeviceAttributeMultiprocessorCount, dev) != hipSuccess) { grid = -1; return; }
        if (hipFuncSetAttribute((const void*)mk_fwd, hipFuncAttributeMaxDynamicSharedMemorySize, LDS_BYTES) != hipSuccess) { fprintf(stderr, "kernel_launch: hipFuncSetAttribute failed\n"); grid = -1; return; }
        if (hipOccupancyMaxActiveBlocksPerMultiprocessor(&per_cu, (const void*)mk_fwd, 512, LDS_BYTES) != hipSuccess || per_cu < 1) { fprintf(stderr, "kernel_launch: occupancy query says %d\n", per_cu); }
        (void)hipGetLastError();
        grid = cus;
        if (grid != 256) { fprintf(stderr, "kernel_launch: built for a 256-CU device, found %d CUs; nothing launched\n", cus); grid = -1; return; }
    }
    if (grid < 0) return;
    if (hipMemsetAsync((char*)d_ws + WS_CTL, 0, CTL_ZERO_BYTES, stream) != hipSuccess) return;
    Args a{};
    for (int i = 0; i < 20; ++i) a.in[i] = (const float*)d_in[i];
    a.out = (float*)d_out; a.ws = (unsigned char*)d_ws;
#if MK_ONE_LAUNCH
    a.ph_lo = 0; a.ph_hi = NPHASE;
    hipLaunchKernelGGL(mk_fwd, dim3(grid), dim3(512), LDS_BYTES, stream, a);
#else
    int np = NPHASE;
#ifdef PROBE_BUF
    np += 2;
#endif
    for (int p = 0; p < np; ++p) { a.ph_lo = p; a.ph_hi = p + 1; hipLaunchKernelGGL(mk_fwd, dim3(grid), dim3(512), LDS_BYTES, stream, a); }
#endif
}
```

```cpp
#include <hip/hip_runtime.h>
#include <cstdio>
#include <cstdint>

#ifndef MK_ONE_LAUNCH
#define MK_ONE_LAUNCH 1
#endif

#ifndef PHMASK
#define PHMASK 0xFFFFFFFFu
#endif
#define PHON(n) ((PHMASK >> (n)) & 1u)
#ifndef REPMASK
#define REPMASK 0u
#endif
#define NREP(n) (1 + (int)((REPMASK >> (n)) & 1u))
#ifdef DBG_NOGATES
#define DBGG(x) 0.0f
#else
#define DBGG(x) (x)
#endif

#define LAS __attribute__((address_space(3)))
#define GAS __attribute__((address_space(1)))
typedef unsigned short bf16_t;
typedef short bf16x8 __attribute__((ext_vector_type(8)));
typedef float f32x4 __attribute__((ext_vector_type(4)));
typedef float f32x2 __attribute__((ext_vector_type(2)));
typedef unsigned u32x4 __attribute__((ext_vector_type(4)));
typedef unsigned u32x2 __attribute__((ext_vector_type(2)));

constexpr int NTOK = 32768, SEQ = 16384, DM = 1024, NLAYER = 4;
constexpr int NEXP = 64, FFE = 512;
constexpr int PMAX = 81920;
constexpr float EPS = 1e-6f;
constexpr float LOG2E = 1.4426950408889634f;

constexpr size_t MiB = 1u << 20;
constexpr size_t WS_CTL = 0, CTL_ZERO_BYTES = 1 * MiB;
constexpr size_t WS_WQKV = 2 * MiB, WS_WO = 14 * MiB, WS_WIN = 18 * MiB, WS_WMO = 30 * MiB, WS_WR = 34 * MiB, WS_WG = 36 * MiB;
constexpr size_t WS_SMALL = 37 * MiB;
constexpr size_t SM_RSTD = WS_SMALL, SM_GATES = WS_SMALL + 256 * 1024, SM_TOKE = WS_SMALL + 1280 * 1024, SM_TOKG = WS_SMALL + 1536 * 1024,
                 SM_TOKP = WS_SMALL + 1792 * 1024, SM_ROWTOK = WS_SMALL + 2 * MiB, SM_TILEEXP = WS_SMALL + 2 * MiB + 512 * 1024,
                 SM_MLOC = WS_SMALL + 2 * MiB + 768 * 1024, SM_BL = SM_MLOC + 8192, SM_MPREV = SM_MLOC + 16384,
                 SM_DN = WS_SMALL + 3 * MiB, SM_NS = WS_SMALL + 4 * MiB, SM_L1 = WS_SMALL + 5 * MiB, SM_L2 = WS_SMALL + 7 * MiB;
constexpr size_t WS_WGU = 64 * MiB, WS_WD = 576 * MiB, WS_XB = 832 * MiB, WS_QKV = 898 * MiB, WS_OB = 1090 * MiB,
                 WS_P1 = 1170 * MiB, WS_P2 = 1234 * MiB, WS_CS = 1298 * MiB, WS_QC = 1426 * MiB, WS_KC = 1458 * MiB, WS_END = 1490 * MiB;
constexpr size_t WS_YB = WS_QKV, WS_ACT = WS_OB, WS_DC = WS_P1;
constexpr int CW_BAR = 4096, CW_CNT = 16384;

constexpr int LDS_BYTES = 147456;
constexpr int MISC_OFF = 147456 - 512;

__device__ __forceinline__ unsigned f2bf(float f) { unsigned u = __builtin_bit_cast(unsigned, f); return (u + 0x7fffu + ((u >> 16) & 1u)) >> 16; }
__device__ __forceinline__ float bf2f(unsigned h) { return __builtin_bit_cast(float, h << 16); }
typedef __bf16 bf16x2_t __attribute__((ext_vector_type(2)));
__device__ __forceinline__ unsigned cvt_pk_bf16(float lo, float hi) { f32x2 v = {lo, hi}; bf16x2_t r = __builtin_convertvector(v, bf16x2_t); return __builtin_bit_cast(unsigned, r); }
__device__ __forceinline__ float bflo(unsigned w) { return __builtin_bit_cast(float, w << 16); }
__device__ __forceinline__ float bfhi(unsigned w) { return __builtin_bit_cast(float, w & 0xffff0000u); }
__device__ __forceinline__ float fast_exp2(float x) { return __builtin_amdgcn_exp2f(x); }
__device__ __forceinline__ float fast_rcp(float x) { return __builtin_amdgcn_rcpf(x); }
#define LDS_WAIT() asm volatile("s_waitcnt lgkmcnt(0)" ::: "memory")
#define VM_WAIT() asm volatile("s_waitcnt vmcnt(0)" ::: "memory")

#define XB_TMO      128
#define XB_XCNT(j)  (256  + 64 * (j))
#define XB_XSUB(j)  (1280 + 64 * (j))
#define XB_XGEN(j)  (2304 + 64 * (j))
#define XB_TOP      3328
#define XB_TOPGEN   3392
#define XCD_BAR_WORDS 3456
#define XB_SPIN_CAP (1u << 18)
__device__ __forceinline__ unsigned xb_ld(unsigned* p)              { return __hip_atomic_load(p, __ATOMIC_RELAXED, __HIP_MEMORY_SCOPE_AGENT); }
__device__ __forceinline__ unsigned xb_add(unsigned* p, unsigned v) { return __hip_atomic_fetch_add(p, v, __ATOMIC_RELAXED, __HIP_MEMORY_SCOPE_AGENT); }
__device__ __forceinline__ unsigned xb_xcc_id() { return (unsigned)__builtin_amdgcn_s_getreg((3 << 11) | 20) & 0xFu; }
#define XB_SPIN(cond, bar) do { unsigned _sp = 0; while (cond) { __builtin_amdgcn_s_sleep(1); \
    if ((++_sp & 255u) == 0u) { if (xb_ld(&(bar)[XB_TMO])) break; if (_sp > XB_SPIN_CAP) { atomicAdd(&(bar)[XB_TMO], 1u); break; } } } } while (0)
struct XcdBarrier { unsigned* bar; unsigned x; volatile LAS unsigned* st; };
__device__ __forceinline__ XcdBarrier xcd_barrier_post(unsigned* bar, volatile LAS unsigned* st) {
    XcdBarrier b; b.bar = bar; b.x = xb_xcc_id(); b.st = st;
    if (threadIdx.x == 0) (void)xb_add(&bar[XB_XCNT(b.x)], 1u);
    return b;
}
__device__ __forceinline__ void xcd_barrier_complete(unsigned* bar, unsigned x, unsigned& nloc, unsigned& nx) {
    const unsigned G = gridDim.x * gridDim.y * gridDim.z;
    unsigned sum, cnt, mine, sp = 0u;
    for (;;) {
        sum = 0u; cnt = 0u; mine = 0u;
#pragma unroll
        for (unsigned j = 0; j < 16; ++j) { const unsigned c = xb_ld(&bar[XB_XCNT(j)]); sum += c; cnt += (c > 0u) ? 1u : 0u; mine = (j == x) ? c : mine; }
        if (sum == G) break;
        __builtin_amdgcn_s_sleep(1);
        if ((++sp & 255u) == 0u) { if (xb_ld(&bar[XB_TMO])) break; if (sp > XB_SPIN_CAP) { atomicAdd(&bar[XB_TMO], 1u); break; } }
    }
    nloc = mine > 0u ? mine : 1u; nx = cnt > 0u ? cnt : 1u;
}
__device__ __forceinline__ void xcd_barrier(const XcdBarrier& b) {
    asm volatile("s_waitcnt vmcnt(0)" ::: "memory");
    __syncthreads();
    if (threadIdx.x == 0) {
        unsigned* bar = b.bar;
        __builtin_amdgcn_s_waitcnt(0);
        unsigned nloc = b.st[0], nx = b.st[1];
        if (nloc == 0u) { xcd_barrier_complete(bar, b.x, nloc, nx); b.st[0] = nloc; b.st[1] = nx; }
        const unsigned old = xb_add(&bar[XB_XSUB(b.x)], 1u);
        const unsigned gen = old / nloc;
        if (old + 1u == (gen + 1u) * nloc) {
            __builtin_amdgcn_fence(__ATOMIC_RELEASE, "agent");
            asm volatile("s_waitcnt vmcnt(0)" ::: "memory");
            const unsigned og = xb_add(&bar[XB_TOP], 1u);
            const unsigned tg = og / nx;
            if (og + 1u == (tg + 1u) * nx) xb_add(&bar[XB_TOPGEN], 1u);
            else XB_SPIN(xb_ld(&bar[XB_TOPGEN]) == tg, bar);
            __builtin_amdgcn_fence(__ATOMIC_ACQUIRE, "agent");
            xb_add(&bar[XB_XGEN(b.x)], 1u);
            asm volatile("s_waitcnt vmcnt(0)" ::: "memory");
        } else {
            XB_SPIN(xb_ld(&bar[XB_XGEN(b.x)]) == gen, bar);
            __builtin_amdgcn_fence(__ATOMIC_ACQUIRE, "agent");
            asm volatile("s_waitcnt vmcnt(0)" ::: "memory");
        }
    }
    __syncthreads();
}

namespace pg8 {
constexpr int BM = 256, BK = 64, HALF = 128, HTB = HALF * BK * 2, STAGE_BYTES = 8 * HTB, NXCD = 8, WGM = 8;
__host__ __device__ __forceinline__ int lds_byte(int r, int c) { const int st = (r >> 4) * 2 + (c >> 5), rr = r & 15, cc = c & 31, ob = rr * 64 + cc * 2; return st * 1024 + (ob ^ (((ob >> 9) & 1) << 5)); }
__host__ __device__ __forceinline__ void stage_rc(int b, int& R, int& C) { const int st = b / 1024, sb = b % 1024, swz = sb ^ (((sb >> 9) & 1) << 5); R = (st >> 1) * 16 + swz / 64; C = (st & 1) * 32 + (swz % 64) / 2; }
__host__ __device__ __forceinline__ int perm32(int rho) { const int n = rho >> 4, i = rho & 15; return 8 * (i >> 2) + 4 * n + (i & 3); }

struct Unit { int pm, pn, e; };
struct Gemm { const bf16_t* A; const bf16_t* Bt; int K; size_t b_estride; const int* sparse; const LAS int* pst; const LAS int* cnt; };

struct StaticOrder {
    int nM, nN, nwg, G, c; const LAS int* pst;
    __device__ void init(int nM_, int nN_, int G_, int c_, const LAS int* pst_) { nM = nM_; nN = nN_; nwg = nM * nN; G = G_; c = c_; pst = pst_; }
    __device__ bool next(int i, Unit& u) const {
        const long L = (long)i * G + c; if (L >= nwg) return false;
        int wgid = (int)L; { const int q = nwg / NXCD, r = nwg % NXCD, xcd = wgid % NXCD, off = wgid / NXCD; wgid = (xcd < r ? xcd * (q + 1) : r * (q + 1) + (xcd - r) * q) + off; }
        const int nig = WGM * nN, gid = wgid / nig, fm = gid * WGM, gsz = (nM - fm) < WGM ? (nM - fm) : WGM;
        u.pm = fm + ((wgid % nig) % gsz); u.pn = (wgid % nig) / gsz;
        u.e = pst ? __builtin_amdgcn_readfirstlane(pst[256 + u.pm]) : 0;
        return true;
    }
};

template <class Epi, bool ALIGN_EPI, bool GATHER, bool A_HM = false>
__device__ __forceinline__ void gemm_phase(LAS unsigned char* lds, const int tid, const Gemm g, const StaticOrder& S, const Epi& E) {
    const int wid = __builtin_amdgcn_readfirstlane(tid >> 6), lane = tid & 63, wr = wid >> 2, wc = wid & 3, fr = lane & 15, fq = lane >> 4;
    const int K = g.K, nt = K / BK;
    int RA[2], CA[2]; unsigned voffB[2];
#pragma unroll
    for (int i = 0; i < 2; ++i) { int R, C; stage_rc(tid * 16 + i * 8192, R, C); const int Rb = Epi::PERM ? ((R & ~31) + perm32(R & 31)) : R;
        RA[i] = R; CA[i] = C; voffB[i] = (unsigned)(Rb * K + C) * 2u; }
    const size_t kstep = (size_t)(BK * 2);
    const size_t hstep = (size_t)HALF * K * 2;
    const size_t tstep = 2 * hstep;
    const size_t akstep = A_HM ? (size_t)16384 * 128 : kstep, ahstep = A_HM ? (size_t)HALF * 128 : hstep;
#define PG8_ABASE(pm_) (A_HM ? ((size_t)((pm_) >> 6) * 16 * 16384 + (size_t)((pm_) & 63) * 256) * 128 : (size_t)(pm_) * tstep)
    const unsigned ldsw = (unsigned)wid * 1024u;
    const int aoff = lds_byte(wr * 64 + fr, fq * 8), boff = lds_byte(wc * 32 + fr, fq * 8);
#define PG8_SA(b, h) (((b) * 2 + (h)) * HTB)
#define PG8_SB(b, h) ((4 + (b) * 2 + (h)) * HTB)
#define PG8_STAGE(bufoff, gbase, voff) do { _Pragma("unroll") for (int _i = 0; _i < 2; ++_i) \
        __builtin_amdgcn_global_load_lds((const unsigned*)((const char*)(gbase) + (voff)[_i]), (LAS unsigned*)(lds + (bufoff) + ldsw + _i * 8192), 16, 0, 0); } while (0)
#define PG8_LDA(dst, b, h) do { _Pragma("unroll") for (int m = 0; m < 4; ++m) _Pragma("unroll") for (int k = 0; k < 2; ++k) dst[m][k] = *(const LAS bf16x8*)(lds + PG8_SA(b, h) + aoff + m * 2048 + k * 1024); } while (0)
#define PG8_LDB(dst, b, h) do { _Pragma("unroll") for (int n = 0; n < 2; ++n) _Pragma("unroll") for (int k = 0; k < 2; ++k) dst[n][k] = *(const LAS bf16x8*)(lds + PG8_SB(b, h) + boff + n * 2048 + k * 1024); } while (0)
#define PG8_MMA(ai, bj, At, Bt) do { __builtin_amdgcn_s_setprio(1); _Pragma("unroll") for (int m = 0; m < 4; ++m) _Pragma("unroll") for (int n = 0; n < 2; ++n) _Pragma("unroll") for (int k = 0; k < 2; ++k) \
        acc[ai][bj][m][n] = __builtin_amdgcn_mfma_f32_16x16x32_bf16(Bt[n][k], At[m][k], acc[ai][bj][m][n], 0, 0, 0); __builtin_amdgcn_s_setprio(0); } while (0)
#define PG8_WAIT_V(n) asm volatile("s_waitcnt vmcnt(" #n ")" ::: "memory")
#define PG8_WAIT_L(n) asm volatile("s_waitcnt lgkmcnt(" #n ")" ::: "memory")
#define PG8_BAR __builtin_amdgcn_s_barrier()
#define PG8_SCHED __builtin_amdgcn_sched_barrier(0)
#define PG8_AOFFS(dst, unit) do { _Pragma("unroll") for (int _h = 0; _h < 2; ++_h) _Pragma("unroll") for (int _i = 0; _i < 2; ++_i) { \
        const int _j = (unit).pm * BM + _h * HALF + RA[_i] - g.pst[(unit).e]; const int _src = (_j < g.cnt[(unit).e]) ? g.sparse[(unit).e * 32768 + _j] : NTOK; dst[_h][_i] = (unsigned)(_src * K + CA[_i]) * 2u; } } while (0)
    Unit cur, nxt; int ui = 0;
    if (!S.next(0, cur)) return;
    f32x4 acc[2][2][4][2];
#pragma unroll
    for (int a = 0; a < 2; ++a)
#pragma unroll
        for (int b = 0; b < 2; ++b)
#pragma unroll
            for (int m = 0; m < 4; ++m)
#pragma unroll
                for (int n = 0; n < 2; ++n) acc[a][b][m][n] = (f32x4){0.f, 0.f, 0.f, 0.f};
    bf16x8 At[4][2], B0[2][2], B1[2][2];
    unsigned voffA[2]; unsigned cAo[2][2], nAo[2][2];
#pragma unroll
    for (int i = 0; i < 2; ++i) voffA[i] = (unsigned)(RA[i] * (A_HM ? 64 : K) + CA[i]) * 2u;
    const char* cA = (const char*)g.A;
    if constexpr (GATHER) { PG8_AOFFS(cAo, cur); } else { cA += PG8_ABASE(cur.pm); }
    const char* cB = (const char*)g.Bt + (size_t)cur.e * g.b_estride + (size_t)cur.pn * tstep;
#define PG8_STAGE_A(bufoff, base, h, nx) do { if constexpr (GATHER) { _Pragma("unroll") for (int _i = 0; _i < 2; ++_i) { const unsigned _o = (nx) ? nAo[h][_i] : cAo[h][_i]; \
            __builtin_amdgcn_global_load_lds((const unsigned*)((const char*)(base) + _o), (LAS unsigned*)(lds + (bufoff) + ldsw + _i * 8192), 16, 0, 0); } } \
        else { PG8_STAGE(bufoff, (base) + (h) * ahstep, voffA); } } while (0)
    PG8_STAGE(PG8_SB(0, 0), cB, voffB); PG8_STAGE(PG8_SB(0, 1), cB + hstep, voffB); PG8_STAGE_A(PG8_SA(0, 0), cA, 0, false); PG8_STAGE_A(PG8_SA(0, 1), cA, 1, false);
    if (wr == 1) PG8_BAR;
    PG8_WAIT_V(2); PG8_BAR;
    PG8_STAGE(PG8_SB(1, 0), cB + kstep, voffB); PG8_STAGE_A(PG8_SA(1, 0), cA + akstep, 0, false); PG8_STAGE(PG8_SB(1, 1), cB + hstep + kstep, voffB);
    PG8_WAIT_V(6); PG8_BAR;
    for (;;) {
        const bool has_next = S.next(ui + 1, nxt);
        const char* nA = cA;
        if constexpr (GATHER) { if (has_next) { PG8_AOFFS(nAo, nxt); } else {
#pragma unroll
            for (int h = 0; h < 2; ++h)
#pragma unroll
                for (int i = 0; i < 2; ++i) nAo[h][i] = cAo[h][i]; } }
        else { if (has_next) nA = (const char*)g.A + PG8_ABASE(nxt.pm); }
        const char* nB = has_next ? (const char*)g.Bt + (size_t)nxt.e * g.b_estride + (size_t)nxt.pn * tstep : cB;
        for (int t = 0; t < nt; t += 2) {
            const bool last = (t == nt - 2);
            const char* a1 = cA + (size_t)(t + 1) * akstep;
            const char* a2 = last ? nA : cA + (size_t)(t + 2) * akstep; const char* b2 = last ? nB : cB + (size_t)(t + 2) * kstep;
            const char* a3 = a2 + akstep; const char* b3 = b2 + kstep;
            PG8_LDB(B0, 0, 0); PG8_LDB(B1, 0, 1); PG8_SCHED; PG8_LDA(At, 0, 0); PG8_STAGE_A(PG8_SA(1, 1), a1, 1, false);
            PG8_WAIT_V(8); PG8_WAIT_L(0); PG8_BAR; PG8_MMA(0, 0, At, B0); PG8_MMA(0, 1, At, B1); PG8_BAR; PG8_SCHED;
            PG8_LDA(At, 0, 1); PG8_STAGE(PG8_SB(0, 0), b2, voffB); PG8_STAGE(PG8_SB(0, 1), b2 + hstep, voffB); PG8_STAGE_A(PG8_SA(0, 0), a2, 0, last);
            PG8_WAIT_V(8); PG8_WAIT_L(0); PG8_BAR; PG8_MMA(1, 0, At, B0); PG8_MMA(1, 1, At, B1); PG8_BAR; PG8_SCHED;
            PG8_LDB(B0, 1, 0); PG8_LDB(B1, 1, 1); PG8_SCHED; PG8_LDA(At, 1, 0); PG8_STAGE_A(PG8_SA(0, 1), a2, 1, last);
            PG8_WAIT_V(8); PG8_WAIT_L(0); PG8_BAR; PG8_MMA(0, 0, At, B0); PG8_MMA(0, 1, At, B1); PG8_BAR; PG8_SCHED;
            PG8_LDA(At, 1, 1); PG8_STAGE(PG8_SB(1, 0), b3, voffB); PG8_STAGE(PG8_SB(1, 1), b3 + hstep, voffB); PG8_STAGE_A(PG8_SA(1, 0), a3, 0, last);
            PG8_WAIT_V(8); PG8_WAIT_L(0); PG8_BAR; PG8_MMA(1, 0, At, B0); PG8_MMA(1, 1, At, B1); PG8_BAR; PG8_SCHED;
        }
        if constexpr (ALIGN_EPI) { if (wr == 0) PG8_BAR; }
        E(acc, cur, wr, wc, fr, fq);
        if (!has_next) break;
#pragma unroll
        for (int a = 0; a < 2; ++a)
#pragma unroll
            for (int b = 0; b < 2; ++b)
#pragma unroll
                for (int m = 0; m < 4; ++m)
#pragma unroll
                    for (int n = 0; n < 2; ++n) acc[a][b][m][n] = (f32x4){0.f, 0.f, 0.f, 0.f};
        cur = nxt; cB = nB; cA = nA; ++ui;
        if constexpr (GATHER) {
#pragma unroll
        for (int h = 0; h < 2; ++h)
#pragma unroll
            for (int i = 0; i < 2; ++i) cAo[h][i] = nAo[h][i]; }
        if constexpr (ALIGN_EPI) { if (wr == 1) PG8_BAR; }
    }
    PG8_WAIT_V(0);
    if constexpr (!ALIGN_EPI) { if (wr == 0) PG8_BAR; }
    PG8_BAR;
#undef PG8_SA
#undef PG8_SB
#undef PG8_STAGE
#undef PG8_LDA
#undef PG8_LDB
#undef PG8_MMA
#undef PG8_WAIT_V
#undef PG8_WAIT_L
#undef PG8_BAR
#undef PG8_SCHED
#undef PG8_AOFFS
#undef PG8_STAGE_A
#undef PG8_ABASE
}


struct EpiQKV {
    static constexpr bool PERM = true;
    bf16_t* O; const float* rstd; const float* qg; const float* kg; float qscale;
    __device__ __forceinline__ void operator()(const f32x4 (&acc)[2][2][4][2], const Unit& u, int wr, int wc, int fr, int fq) const {
        const int part = u.pn >> 2, head = 4 * (u.pn & 3) + wc;
        f32x4 gv[2][2];
#pragma unroll
        for (int bj = 0; bj < 2; ++bj)
#pragma unroll
            for (int n = 0; n < 2; ++n) { const int dim = 32 * bj + 8 * fq + 4 * n;
                if (part == 0) gv[bj][n] = *(const f32x4*)(qg + dim) * qscale; else if (part == 1) gv[bj][n] = *(const f32x4*)(kg + dim); else gv[bj][n] = (f32x4){1.f, 1.f, 1.f, 1.f}; }
#pragma unroll
        for (int ai = 0; ai < 2; ++ai)
#pragma unroll
            for (int m = 0; m < 4; ++m) {
                const int row = u.pm * BM + ai * HALF + wr * 64 + m * 16 + fr; const float rs = rstd[row];
                f32x4 v[2][2]; float ss = 0.f;
#pragma unroll
                for (int bj = 0; bj < 2; ++bj)
#pragma unroll
                    for (int n = 0; n < 2; ++n) { v[bj][n] = acc[ai][bj][m][n] * rs; const f32x4 q = v[bj][n] * v[bj][n]; ss += (q[0] + q[1]) + (q[2] + q[3]); }
                float sc = 1.f;
                if (part < 2) { ss += __shfl_xor(ss, 16); ss += __shfl_xor(ss, 32); sc = 1.0f / sqrtf(ss * (1.0f / 64.0f) + EPS); }
                bf16_t* rowp = O + ((size_t)(part * 32 + (row / SEQ) * 16 + head) * SEQ + (row % SEQ)) * 64 + 8 * fq;
#pragma unroll
                for (int bj = 0; bj < 2; ++bj) { const f32x4 v0 = v[bj][0] * gv[bj][0] * sc, v1 = v[bj][1] * gv[bj][1] * sc;
                    u32x4 w; w.x = cvt_pk_bf16(v0[0], v0[1]); w.y = cvt_pk_bf16(v0[2], v0[3]); w.z = cvt_pk_bf16(v1[0], v1[1]); w.w = cvt_pk_bf16(v1[2], v1[3]);
                    *(u32x4*)(rowp + 32 * bj) = w; }
            }
    }
};
struct EpiBf16 {
    static constexpr bool PERM = true;
    bf16_t* O; int ldc; const float* rscale;
    __device__ __forceinline__ void operator()(const f32x4 (&acc)[2][2][4][2], const Unit& u, int wr, int wc, int fr, int fq) const {
        const int col0 = u.pn * BM + wc * 32 + 8 * fq;
#pragma unroll
        for (int ai = 0; ai < 2; ++ai)
#pragma unroll
            for (int m = 0; m < 4; ++m) { const int row = u.pm * BM + ai * HALF + wr * 64 + m * 16 + fr; const float rs = rscale ? rscale[row] : 1.f;
                bf16_t* rowp = O + (size_t)row * ldc + col0;
#pragma unroll
                for (int bj = 0; bj < 2; ++bj) { const f32x4 v0 = acc[ai][bj][m][0] * rs, v1 = acc[ai][bj][m][1] * rs;
                    u32x4 w; w.x = cvt_pk_bf16(v0[0], v0[1]); w.y = cvt_pk_bf16(v0[2], v0[3]); w.z = cvt_pk_bf16(v1[0], v1[1]); w.w = cvt_pk_bf16(v1[2], v1[3]);
                    *(u32x4*)(rowp + bj * HALF) = w; } }
    }
};
struct EpiResid {
    static constexpr bool PERM = false;
    const float* xin; float* out;
    __device__ __forceinline__ void operator()(const f32x4 (&acc)[2][2][4][2], const Unit& u, int wr, int wc, int fr, int fq) const {
        const int col0 = u.pn * BM + wc * 32 + 4 * fq;
#pragma unroll
        for (int ai = 0; ai < 2; ++ai)
#pragma unroll
            for (int m = 0; m < 4; ++m) { const size_t off = (size_t)(u.pm * BM + ai * HALF + wr * 64 + m * 16 + fr) * DM + col0;
#pragma unroll
                for (int bj = 0; bj < 2; ++bj)
#pragma unroll
                    for (int n = 0; n < 2; ++n) { const f32x4 b = *(const f32x4*)(xin + off + bj * HALF + n * 16); *(f32x4*)(out + off + bj * HALF + n * 16) = b + acc[ai][bj][m][n]; } }
    }
};
struct EpiResidB {
    static constexpr bool PERM = true;
    bf16_t* X;
    __device__ __forceinline__ void operator()(const f32x4 (&acc)[2][2][4][2], const Unit& u, int wr, int wc, int fr, int fq) const {
        const int col0 = u.pn * BM + wc * 32 + 8 * fq;
#pragma unroll
        for (int ai = 0; ai < 2; ++ai)
#pragma unroll
            for (int m = 0; m < 4; ++m) { bf16_t* rowp = X + (size_t)(u.pm * BM + ai * HALF + wr * 64 + m * 16 + fr) * DM + col0;
#pragma unroll
                for (int bj = 0; bj < 2; ++bj) { const u32x4 x = *(const u32x4*)(rowp + bj * HALF); const f32x4 a0 = acc[ai][bj][m][0], a1 = acc[ai][bj][m][1];
                    u32x4 w; w.x = cvt_pk_bf16(bflo(x.x) + a0[0], bfhi(x.x) + a0[1]); w.y = cvt_pk_bf16(bflo(x.y) + a0[2], bfhi(x.y) + a0[3]);
                    w.z = cvt_pk_bf16(bflo(x.z) + a1[0], bfhi(x.z) + a1[1]); w.w = cvt_pk_bf16(bflo(x.w) + a1[2], bfhi(x.w) + a1[3]);
                    *(u32x4*)(rowp + bj * HALF) = w; } }
    }
};
struct EpiGU {
    static constexpr bool PERM = true;
    bf16_t* O; const float* rstd; const int* sparse; const LAS int* pst; const LAS int* cnt;
    __device__ __forceinline__ void operator()(const f32x4 (&acc)[2][2][4][2], const Unit& u, int wr, int wc, int fr, int fq) const {
        const int col0 = u.pn * HALF + wc * 32 + 8 * fq;
#pragma unroll
        for (int ai = 0; ai < 2; ++ai)
#pragma unroll
            for (int m = 0; m < 4; ++m) { const int row = u.pm * BM + ai * HALF + wr * 64 + m * 16 + fr; const int jj = row - pst[u.e]; const float rs = (jj < cnt[u.e]) ? rstd[sparse[u.e * 32768 + jj]] : 0.f;
                float o[8];
#pragma unroll
                for (int n = 0; n < 2; ++n)
#pragma unroll
                    for (int i = 0; i < 4; ++i) { const float gg = acc[ai][0][m][n][i] * rs, uu = acc[ai][1][m][n][i] * rs;
                        o[n * 4 + i] = gg * fast_rcp(1.0f + fast_exp2(-gg * LOG2E)) * uu; }
                u32x4 w; w.x = cvt_pk_bf16(o[0], o[1]); w.y = cvt_pk_bf16(o[2], o[3]); w.z = cvt_pk_bf16(o[4], o[5]); w.w = cvt_pk_bf16(o[6], o[7]);
                *(u32x4*)(O + (size_t)row * FFE + col0) = w; }
    }
};
}

struct Frame {
    LAS unsigned char* lds;
    int tid, lane, wave, vcu, G;
};
struct Args { const float* in[20]; float* out; unsigned char* ws; int ph_lo, ph_hi; };
__device__ __forceinline__ Frame make_frame(LAS unsigned char* lds) {
    Frame F; int t = threadIdx.x; asm volatile("" : "+v"(t));
    F.lds = lds; F.tid = t; F.lane = t & 63; F.wave = __builtin_amdgcn_readfirstlane(t >> 6);
    F.G = gridDim.x; { const int bx = blockIdx.x; F.vcu = (F.G % 8 == 0) ? (bx % 8) * (F.G / 8) + bx / 8 : bx; }
    return F;
}

__device__ __forceinline__ bf16x8 ld_frag_lds(const LAS unsigned char* p) { return *(const LAS bf16x8*)p; }
__device__ __forceinline__ bf16x8 mk_frag(unsigned a, unsigned b, unsigned c, unsigned d) { u32x4 w = {a, b, c, d}; return __builtin_bit_cast(bf16x8, w); }
#define MFMA16(a, b, c) __builtin_amdgcn_mfma_f32_16x16x32_bf16(a, b, c, 0, 0, 0)

struct CvtDesc { const float* src; int ldsrc, k0, scol; const float* kscale; bf16_t* dst; int K, drow; };
__device__ __forceinline__ void cvt_load(const CvtDesc& d, int lane, f32x4 (&v)[8]) {
#pragma unroll
    for (int i = 0; i < 8; ++i) v[i] = __builtin_nontemporal_load((const GAS f32x4*)(d.src + (size_t)(d.k0 + 8 * i + (lane >> 3)) * d.ldsrc + d.scol + 4 * (lane & 7)));
}
__device__ __forceinline__ void cvt_finish(const CvtDesc& d, int lane, const f32x4 (&v)[8], LAS float* scr) {
#pragma unroll
    for (int i = 0; i < 8; ++i) { const int kk = 8 * i + (lane >> 3); const float s = d.kscale ? d.kscale[d.k0 + kk] : 1.f; LAS float* p = scr + kk * 33 + 4 * (lane & 7);
        p[0] = v[i][0] * s; p[1] = v[i][1] * s; p[2] = v[i][2] * s; p[3] = v[i][3] * s; }
    LDS_WAIT(); asm volatile("" ::: "memory");
    const int c = lane & 7;
#pragma unroll
    for (int j = 0; j < 4; ++j) { const int n = (lane >> 3) + 8 * j; const LAS float* s = scr + (8 * c) * 33 + n;
        u32x4 o; o.x = cvt_pk_bf16(s[0 * 33], s[1 * 33]); o.y = cvt_pk_bf16(s[2 * 33], s[3 * 33]); o.z = cvt_pk_bf16(s[4 * 33], s[5 * 33]); o.w = cvt_pk_bf16(s[6 * 33], s[7 * 33]);
        __builtin_nontemporal_store(o, (GAS u32x4*)(d.dst + (size_t)(d.drow + n) * d.K + d.k0 + 8 * c)); }
    LDS_WAIT(); asm volatile("" ::: "memory");
}
__device__ __forceinline__ void cvt_item(const float* src, int ldsrc, int k0, int scol, const float* kscale, bf16_t* dst, int K, int drow, LAS float* scr, int lane) {
    const CvtDesc d{src, ldsrc, k0, scol, kscale, dst, K, drow}; f32x4 v[8]; cvt_load(d, lane, v); cvt_finish(d, lane, v, scr);
}
constexpr int MOE_ITEMS = 64 * 16 * 32 + 64 * 8 * 32;
__device__ __forceinline__ CvtDesc cvt_moe_desc(const Args& a, int l, int it) {
    constexpr int I_GU = 64 * 16 * 32;
    unsigned char* ws = a.ws; CvtDesc d;
    if (it < I_GU) { const int e = it / (16 * 32), q = it % (16 * 32), kb = q / 32, nb = q % 32;
        const int pn = nb >> 3, bj = (nb >> 2) & 1, c32 = nb & 3; const int le = l * 64 + e;
        d.src = (bj ? a.in[18] : a.in[17]) + (size_t)le * DM * FFE; d.ldsrc = FFE; d.k0 = kb * 64; d.scol = 128 * pn + 32 * c32; d.kscale = a.in[2] + (size_t)l * DM;
        d.dst = (bf16_t*)(ws + WS_WGU) + (size_t)le * DM * DM; d.K = DM; d.drow = nb * 32; }
    else { const int r = it - I_GU; const int e = r / (8 * 32), q = r % (8 * 32), kb = q / 32, nb = q % 32; const int le = l * 64 + e;
        d.src = a.in[19] + (size_t)le * FFE * DM; d.ldsrc = DM; d.k0 = kb * 64; d.scol = nb * 32; d.kscale = nullptr;
        d.dst = (bf16_t*)(ws + WS_WD) + (size_t)le * DM * FFE; d.K = FFE; d.drow = nb * 32; }
    return d;
}

__device__ __forceinline__ void p0_weights(const Frame& F, const Args& a) {
    LAS float* scr = (LAS float*)(F.lds + F.wave * 16384);
    const int gw = F.vcu * 8 + F.wave, NGW = F.G * 8;
    unsigned char* ws = a.ws;
    constexpr int I_QKV = 2 * 16 * 96, I_O = 2 * 16 * 32, I_IN = 2 * 16 * 96, I_MO = 2 * 16 * 32;
    constexpr int NITEMS = I_QKV + I_O + I_IN + I_MO;
    for (int it = gw; it < NITEMS; it += NGW) {
        int r = it;
        if (r < I_QKV) { const int j = r / (16 * 96), q = r % (16 * 96), kb = q / 96, nb = q % 96;
            const int pn = nb >> 3, bj = (nb >> 2) & 1, wc = nb & 3, part = pn >> 2, head = 4 * (pn & 3) + wc;
            cvt_item(a.in[3] + (size_t)j * DM * 3072, 3072, kb * 64, part * 1024 + head * 64 + 32 * bj, a.in[1] + (size_t)(2 * j) * DM, (bf16_t*)(ws + WS_WQKV) + (size_t)j * 3072 * DM, DM, nb * 32, scr, F.lane); continue; }
        r -= I_QKV;
        if (r < I_O) { const int j = r / (16 * 32), q = r % (16 * 32), kb = q / 32, nb = q % 32;
            cvt_item(a.in[6] + (size_t)j * DM * DM, DM, kb * 64, nb * 32, nullptr, (bf16_t*)(ws + WS_WO) + (size_t)j * DM * DM, DM, nb * 32, scr, F.lane); continue; }
        r -= I_O;
        if (r < I_IN) { const int j = r / (16 * 96), q = r % (16 * 96), kb = q / 96, nb = q % 96;
            cvt_item(a.in[7] + (size_t)j * DM * 3080, 3080, kb * 64, nb * 32, a.in[1] + (size_t)(2 * j + 1) * DM, (bf16_t*)(ws + WS_WIN) + (size_t)j * 3072 * DM, DM, nb * 32, scr, F.lane); continue; }
        r -= I_IN;
        { const int j = r / (16 * 32), q = r % (16 * 32), kb = q / 32, nb = q % 32;
            cvt_item(a.in[12] + (size_t)j * DM * DM, DM, kb * 64, nb * 32, nullptr, (bf16_t*)(ws + WS_WMO) + (size_t)j * DM * DM, DM, nb * 32, scr, F.lane); }
    }
    {
        const int gt = F.vcu * 512 + F.tid, NT = F.G * 512;
        for (int i = gt; i < 4 * 80 * 1024; i += NT) { const int l = i / (80 * 1024), c = (i / 1024) % 80, k = i % 1024;
            float w = 0.f;
            if (c < 8) w = a.in[13][((size_t)l * DM + k) * 8 + c]; else if (c < 72) w = a.in[15][((size_t)l * DM + k) * 64 + (c - 8)];
            w *= a.in[2][l * DM + k];
            const unsigned hi = f2bf(w); const unsigned lo = f2bf(w - bf2f(hi));
            bf16_t* base = (bf16_t*)(ws + WS_WR) + (size_t)l * 2 * 80 * 1024;
            base[c * 1024 + k] = (bf16_t)hi; base[80 * 1024 + c * 1024 + k] = (bf16_t)lo; }
        for (int i = gt; i < 2 * 16 * 1024; i += NT) { const int j = i / (16 * 1024), c = (i / 1024) % 16, k = i % 1024;
            float w = 0.f; if (c < 8) w = a.in[7][((size_t)j * DM + k) * 3080 + 3072 + c] * a.in[1][(2 * j + 1) * DM + k];
            const unsigned hi = f2bf(w); const unsigned lo = f2bf(w - bf2f(hi));
            bf16_t* base = (bf16_t*)(ws + WS_WG) + (size_t)j * 2 * 16 * 1024;
            base[c * 1024 + k] = (bf16_t)hi; base[16 * 1024 + c * 1024 + k] = (bf16_t)lo; }
        if (F.vcu == 0) { for (int i = F.tid; i < DM / 2; i += 512) ((unsigned*)((bf16_t*)(ws + WS_XB) + (size_t)NTOK * DM))[i] = 0u;
            if (F.tid == 0) ((float*)(ws + SM_RSTD))[NTOK] = 0.f; }
    }
}

template <int MODE, int NT, bool WLO = false>
__device__ __forceinline__ void rowpass_wave(const Frame& F, const float* xsrc, float* xdst, bf16_t* xb, float* rstd_out,
                                             const bf16_t* yb, const int* tokp, const float* tokg, const int* toke, const LAS int* pst,
                                             const bf16_t* whi, const bf16_t* wlo, int tok0, f32x4 (&acc)[NT > 0 ? NT : 1], float& rstd_lane) {
    const int lane = F.lane, t = lane & 15, fq = lane >> 4, tok = tok0 + t;
    const float* xr = xsrc + (size_t)tok * DM + 8 * fq;
    bf16_t* xbr = xb + (size_t)tok * DM + 8 * fq;
    const bf16_t *y0 = nullptr, *y1 = nullptr; float g0 = 0.f, g1 = 0.f;
    if (MODE == 2) { const int p0 = pst[toke[2 * tok]] + tokp[2 * tok], p1 = pst[toke[2 * tok + 1]] + tokp[2 * tok + 1]; g0 = tokg[2 * tok]; g1 = tokg[2 * tok + 1];
        y0 = yb + (size_t)p0 * DM + 8 * fq; y1 = yb + (size_t)p1 * DM + 8 * fq; }
    float* xw = (MODE == 2) ? xdst + (size_t)tok * DM + 8 * fq : nullptr;
#pragma unroll
    for (int c = 0; c < (NT > 0 ? NT : 1); ++c) acc[c] = (f32x4){0.f, 0.f, 0.f, 0.f};
    float ss = 0.f;
#pragma unroll 4
    for (int s = 0; s < 32; ++s) {
        f32x4 a0 = __builtin_nontemporal_load((const GAS f32x4*)(xr + 32 * s)), a1 = __builtin_nontemporal_load((const GAS f32x4*)(xr + 32 * s + 4));
        if (MODE == 2) {
            const u32x4 w0 = *(const GAS u32x4*)(y0 + 32 * s), w1 = *(const GAS u32x4*)(y1 + 32 * s);
            a0[0] += g0 * bflo(w0.x) + g1 * bflo(w1.x); a0[1] += g0 * bfhi(w0.x) + g1 * bfhi(w1.x);
            a0[2] += g0 * bflo(w0.y) + g1 * bflo(w1.y); a0[3] += g0 * bfhi(w0.y) + g1 * bfhi(w1.y);
            a1[0] += g0 * bflo(w0.z) + g1 * bflo(w1.z); a1[1] += g0 * bfhi(w0.z) + g1 * bfhi(w1.z);
            a1[2] += g0 * bflo(w0.w) + g1 * bflo(w1.w); a1[3] += g0 * bfhi(w0.w) + g1 * bfhi(w1.w);
            *(GAS f32x4*)(xw + 32 * s) = a0; *(GAS f32x4*)(xw + 32 * s + 4) = a1;
        }
        ss += (a0[0] * a0[0] + a0[1] * a0[1]) + (a0[2] * a0[2] + a0[3] * a0[3]) + (a1[0] * a1[0] + a1[1] * a1[1]) + (a1[2] * a1[2] + a1[3] * a1[3]);
        u32x4 hi; hi.x = cvt_pk_bf16(a0[0], a0[1]); hi.y = cvt_pk_bf16(a0[2], a0[3]); hi.z = cvt_pk_bf16(a1[0], a1[1]); hi.w = cvt_pk_bf16(a1[2], a1[3]);
        *(GAS u32x4*)(xbr + 32 * s) = hi;
        if (NT > 0) {
            u32x4 lo;
            lo.x = cvt_pk_bf16(a0[0] - bflo(hi.x), a0[1] - bfhi(hi.x)); lo.y = cvt_pk_bf16(a0[2] - bflo(hi.y), a0[3] - bfhi(hi.y));
            lo.z = cvt_pk_bf16(a1[0] - bflo(hi.z), a1[1] - bfhi(hi.z)); lo.w = cvt_pk_bf16(a1[2] - bflo(hi.w), a1[3] - bfhi(hi.w));
            const bf16x8 Ah = __builtin_bit_cast(bf16x8, hi), Al = __builtin_bit_cast(bf16x8, lo);
#pragma unroll
            for (int c = 0; c < NT; ++c) {
                const bf16x8 Bh = *(const GAS bf16x8*)(whi + (size_t)(16 * c + t) * DM + 32 * s + 8 * fq);
                acc[c] = MFMA16(Ah, Bh, acc[c]); acc[c] = MFMA16(Al, Bh, acc[c]);
                if (WLO) { const bf16x8 Bl = *(const GAS bf16x8*)(wlo + (size_t)(16 * c + t) * DM + 32 * s + 8 * fq); acc[c] = MFMA16(Ah, Bl, acc[c]); }
            }
        }
    }
    ss += __shfl_xor(ss, 16); ss += __shfl_xor(ss, 32);
    rstd_lane = 1.0f / sqrtf(ss * (1.0f / DM) + EPS);
    if (fq == 0) rstd_out[tok] = rstd_lane;
}

__device__ __forceinline__ void phase_x0(const Frame& F, const Args& a) {
    f32x4 dummy[1]; float rs;
    for (int tb = F.vcu; tb < NTOK / 128; tb += F.G)
        rowpass_wave<0, 0>(F, a.in[0], nullptr, (bf16_t*)(a.ws + WS_XB), (float*)(a.ws + SM_RSTD), nullptr, nullptr, nullptr, nullptr, nullptr, nullptr, nullptr, tb * 128 + F.wave * 16, dummy, rs);
}


constexpr int RT_WB = 73728, RT_WBUF = 21760;
__device__ __forceinline__ void router_pass(const Frame& F, const bf16_t* xb, float* rstd_out, const bf16_t* whi, int tok0, f32x4 (&acc)[5], float& rstd_lane) {
    const int lane = F.lane, t = lane & 15, fq = lane >> 4, tok = tok0 + t;
    const bf16_t* xbr = xb + (size_t)tok * DM + 8 * fq;
    LAS unsigned char* WB = F.lds + RT_WB;
    u32x4 wr[3];
#define RT_LOAD(chunk) do { _Pragma("unroll") for (int i = 0; i < 3; ++i) { const int p = F.tid + 512 * i; if (p < 1280) wr[i] = *(const GAS u32x4*)(whi + (size_t)(p >> 4) * DM + (chunk) * 128 + (p & 15) * 8); } } while (0)
#define RT_STORE(buf) do { _Pragma("unroll") for (int i = 0; i < 3; ++i) { const int p = F.tid + 512 * i; if (p < 1280) *(LAS u32x4*)(WB + (buf) * RT_WBUF + (p >> 4) * 272 + (p & 15) * 16) = wr[i]; } } while (0)
    __syncthreads();
    RT_LOAD(0); RT_STORE(0);
    __syncthreads();
#pragma unroll
    for (int c = 0; c < 5; ++c) acc[c] = (f32x4){0.f, 0.f, 0.f, 0.f};
    float ss = 0.f;
    u32x4 xc[4], xn[4];
#pragma unroll
    for (int s4 = 0; s4 < 4; ++s4) xc[s4] = *(const GAS u32x4*)(xbr + 32 * s4);
    for (int chunk = 0; chunk < 8; ++chunk) {
        if (chunk + 1 < 8) { RT_LOAD(chunk + 1);
#pragma unroll
            for (int s4 = 0; s4 < 4; ++s4) xn[s4] = *(const GAS u32x4*)(xbr + 32 * ((chunk + 1) * 4 + s4)); }
        const LAS unsigned char* wb = WB + (chunk & 1) * RT_WBUF + t * 272 + fq * 16;
#pragma unroll
        for (int s4 = 0; s4 < 4; ++s4) {
            const u32x4 hi = xc[s4];
            { const float x0 = bflo(hi.x), x1 = bfhi(hi.x), x2 = bflo(hi.y), x3 = bfhi(hi.y), x4 = bflo(hi.z), x5 = bfhi(hi.z), x6 = bflo(hi.w), x7 = bfhi(hi.w);
              ss += (x0 * x0 + x1 * x1) + (x2 * x2 + x3 * x3) + (x4 * x4 + x5 * x5) + (x6 * x6 + x7 * x7); }
            const bf16x8 Ah = __builtin_bit_cast(bf16x8, hi);
#pragma unroll
            for (int c = 0; c < 5; ++c) { const bf16x8 Bh = *(const LAS bf16x8*)(wb + c * (16 * 272) + s4 * 64); acc[c] = MFMA16(Ah, Bh, acc[c]); } }
        if (chunk + 1 < 8) { RT_STORE((chunk + 1) & 1);
#pragma unroll
            for (int s4 = 0; s4 < 4; ++s4) xc[s4] = xn[s4]; }
        __syncthreads();
    }
#undef RT_LOAD
#undef RT_STORE
    ss += __shfl_xor(ss, 16); ss += __shfl_xor(ss, 32);
    rstd_lane = 1.0f / sqrtf(ss * (1.0f / DM) + EPS);
    if (fq == 0) rstd_out[tok] = rstd_lane;
}

__device__ __forceinline__ void phase_router(const Frame& F, const Args& a, int l, bool dry = false) {
    unsigned char* ws = a.ws;
    int* sparse = (int*)(ws + WS_QC);
    LAS float* lg = (LAS float*)(F.lds) + F.wave * (16 * 81);
    LAS float* rsl = (LAS float*)(F.lds + 65536) + F.wave * 16;
    LAS int* hist = (LAS int*)(F.lds + 70000);
    LAS int* bbase = (LAS int*)(F.lds + 70000 + 256);
    LAS int* a_e = (LAS int*)(F.lds + 71000);
    LAS int* a_r = (LAS int*)(F.lds + 72100);
    const bf16_t* whi = (const bf16_t*)(ws + WS_WR) + (size_t)l * 2 * 80 * 1024; const bf16_t* wlo = whi + 80 * 1024;
    unsigned* counts = (unsigned*)(ws + WS_CTL) + CW_CNT + l * 64 + (dry ? 4096 : 0);
    int* toke = (int*)(ws + SM_TOKE); float* tokg = (float*)(ws + SM_TOKG); int* tokp = (int*)(ws + SM_TOKP);
    const float* bg = a.in[14] + l * 8; const float* be = a.in[16] + l * 64;
    for (int tb = F.vcu; tb < NTOK / 128; tb += F.G) {
        __syncthreads();
        if (F.tid < 64) hist[F.tid] = 0;
        __syncthreads();
        f32x4 acc[5]; float rs;
        const int tok0 = tb * 128 + F.wave * 16;
        router_pass(F, (const bf16_t*)(ws + WS_XB), (float*)(ws + SM_RSTD), whi, tok0, acc, rs);
        const int t = F.lane & 15, fq = F.lane >> 4;
        if (fq == 0) rsl[t] = rs;
        LDS_WAIT();
#pragma unroll
        for (int c = 0; c < 5; ++c)
#pragma unroll
            for (int i = 0; i < 4; ++i) { const int tt = 4 * fq + i, col = 16 * c + t; const float bias = col < 8 ? bg[col] : (col < 72 ? be[col - 8] : 0.f);
                lg[tt * 81 + col] = acc[c][i] * rsl[tt] + bias; }
        LDS_WAIT();
        if (F.lane < 16) {
            const LAS float* L = lg + F.lane * 81;
            int grp = 0; float gm = L[0];
#pragma unroll
            for (int j = 1; j < 8; ++j) { const float v = L[j]; if (v > gm) { gm = v; grp = j; } }
            float den = 0.f;
#pragma unroll
            for (int j = 0; j < 8; ++j) den += __expf(L[j] - gm);
            const float pg = 1.0f / den;
            const LAS float* E = L + 8 + grp * 8;
            int i1 = 0; float v1 = E[0];
#pragma unroll
            for (int j = 1; j < 8; ++j) { const float v = E[j]; if (v > v1) { v1 = v; i1 = j; } }
            int i2 = (i1 == 0) ? 1 : 0; float v2 = -3.0e38f;
#pragma unroll
            for (int j = 0; j < 8; ++j) { const float v = E[j]; if (j != i1 && v > v2) { v2 = v; i2 = j; } }
            const float e2 = __expf(v2 - v1), s1 = 1.0f / (1.0f + e2);
            const int tok = tok0 + F.lane, e_a = grp * 8 + i1, e_b = grp * 8 + i2;
            toke[2 * tok] = e_a; toke[2 * tok + 1] = e_b; tokg[2 * tok] = pg * s1; tokg[2 * tok + 1] = pg * e2 * s1;
            const int la = (F.wave * 16 + F.lane) * 2;
            a_e[la] = e_a; a_e[la + 1] = e_b;
            a_r[la] = atomicAdd((int*)(hist + e_a), 1); a_r[la + 1] = atomicAdd((int*)(hist + e_b), 1);
        }
        __syncthreads();
        if (F.tid < 64) bbase[F.tid] = (int)atomicAdd(counts + F.tid, (unsigned)hist[F.tid]);
        __syncthreads();
        if (F.tid < 256) { const int tok = tb * 128 + (F.tid >> 1); const int e = a_e[F.tid], idx = bbase[e] + a_r[F.tid]; tokp[2 * tok + (F.tid & 1)] = idx; if (!dry) sparse[e * 32768 + idx] = tok; }
    }
}

__device__ __forceinline__ int moe_tables(const Frame& F, const unsigned* counts, LAS int* pst, LAS int* cnt) {
    __syncthreads();
    if (F.tid < 64) {
        const int c = (int)counts[F.tid]; const int pc = (c + 255) & ~255;
        int incl = pc;
#pragma unroll
        for (int o = 1; o < 64; o <<= 1) { const int t = __shfl_up(incl, o); if (F.lane >= o) incl += t; }
        const int start = incl - pc;
        cnt[F.tid] = c; pst[F.tid] = start; if (F.tid == 63) pst[64] = incl;
        for (int t = start >> 8; t < (incl >> 8); ++t) pst[256 + t] = F.tid;
    }
    __syncthreads();
    return pst[64] >> 8;
}
constexpr int MOE_TAB_OFF = 131072;
struct TokRec { int e0, e1, q0, q1; float g0, g1; };
__device__ __forceinline__ TokRec tok_rec(const int* toke, const int* tokp, const float* tokg, int tok) { TokRec r; r.e0 = toke[2 * tok]; r.e1 = toke[2 * tok + 1]; r.q0 = tokp[2 * tok]; r.q1 = tokp[2 * tok + 1]; r.g0 = tokg[2 * tok]; r.g1 = tokg[2 * tok + 1]; return r; }
template <bool GATES, bool FINAL>
__device__ __forceinline__ void combine_wave(const Frame& F, bf16_t* xb, float* rstd_out, float* fout, const bf16_t* yb, const TokRec tr, const LAS int* pst,
                                             const bf16_t* whi, const bf16_t* wlo, int tok0, f32x4& acc, float& rstd_lane) {
    const int lane = F.lane, t = lane & 15, fq = lane >> 4, tok = tok0 + t;
    bf16_t* xr = xb + (size_t)tok * DM + 8 * fq;
    const int p0 = pst[tr.e0] + tr.q0, p1 = pst[tr.e1] + tr.q1; const float g0 = tr.g0, g1 = tr.g1;
    const bf16_t* y0 = yb + (size_t)p0 * DM + 8 * fq; const bf16_t* y1 = yb + (size_t)p1 * DM + 8 * fq;
    float* fo = FINAL ? fout + (size_t)tok * DM + 8 * fq : nullptr;
    acc = (f32x4){0.f, 0.f, 0.f, 0.f};
    float ss = 0.f;
#pragma unroll 4
    for (int s = 0; s < 32; ++s) {
        const u32x4 x = *(const GAS u32x4*)(xr + 32 * s), w0 = *(const GAS u32x4*)(y0 + 32 * s), w1 = *(const GAS u32x4*)(y1 + 32 * s);
        float v[8];
        v[0] = bflo(x.x) + g0 * bflo(w0.x) + g1 * bflo(w1.x); v[1] = bfhi(x.x) + g0 * bfhi(w0.x) + g1 * bfhi(w1.x);
        v[2] = bflo(x.y) + g0 * bflo(w0.y) + g1 * bflo(w1.y); v[3] = bfhi(x.y) + g0 * bfhi(w0.y) + g1 * bfhi(w1.y);
        v[4] = bflo(x.z) + g0 * bflo(w0.z) + g1 * bflo(w1.z); v[5] = bfhi(x.z) + g0 * bfhi(w0.z) + g1 * bfhi(w1.z);
        v[6] = bflo(x.w) + g0 * bflo(w0.w) + g1 * bflo(w1.w); v[7] = bfhi(x.w) + g0 * bfhi(w0.w) + g1 * bfhi(w1.w);
        if (FINAL) { __builtin_nontemporal_store((f32x4){v[0], v[1], v[2], v[3]}, (GAS f32x4*)(fo + 32 * s)); __builtin_nontemporal_store((f32x4){v[4], v[5], v[6], v[7]}, (GAS f32x4*)(fo + 32 * s + 4)); }
        u32x4 hi; hi.x = cvt_pk_bf16(v[0], v[1]); hi.y = cvt_pk_bf16(v[2], v[3]); hi.z = cvt_pk_bf16(v[4], v[5]); hi.w = cvt_pk_bf16(v[6], v[7]);
        if (!FINAL) *(GAS u32x4*)(xr + 32 * s) = hi;
        { const float r0 = bflo(hi.x), r1 = bfhi(hi.x), r2 = bflo(hi.y), r3 = bfhi(hi.y), r4 = bflo(hi.z), r5 = bfhi(hi.z), r6 = bflo(hi.w), r7 = bfhi(hi.w);
          ss += (r0 * r0 + r1 * r1) + (r2 * r2 + r3 * r3) + (r4 * r4 + r5 * r5) + (r6 * r6 + r7 * r7); }
        if (GATES) { const bf16x8 Ah = __builtin_bit_cast(bf16x8, hi);
            const bf16x8 Bh = *(const GAS bf16x8*)(whi + (size_t)t * DM + 32 * s + 8 * fq), Bl = *(const GAS bf16x8*)(wlo + (size_t)t * DM + 32 * s + 8 * fq);
            acc = MFMA16(Ah, Bh, acc); acc = MFMA16(Ah, Bl, acc); }
    }
    ss += __shfl_xor(ss, 16); ss += __shfl_xor(ss, 32);
    rstd_lane = 1.0f / sqrtf(ss * (1.0f / DM) + EPS);
    if (!FINAL && fq == 0) rstd_out[tok] = rstd_lane;
}
template <bool FINAL>
__device__ __forceinline__ void combine_rows(const Frame& F, bf16_t* xb, float* rstd_out, float* fout, const bf16_t* yb, const int* toke, const int* tokp, const float* tokg, const LAS int* pst, int tok0) {
    const int lane = F.lane;
#pragma unroll 1
    for (int bt = 0; bt < 4; ++bt) {
        u32x4 xv[4][2], y0v[4][2], y1v[4][2]; float g0[4], g1[4];
#pragma unroll
        for (int t4 = 0; t4 < 4; ++t4) { const int tok = __builtin_amdgcn_readfirstlane(tok0 + 4 * bt + t4);
            const int p0 = __builtin_amdgcn_readfirstlane(pst[toke[2 * tok]] + tokp[2 * tok]), p1 = __builtin_amdgcn_readfirstlane(pst[toke[2 * tok + 1]] + tokp[2 * tok + 1]);
            g0[t4] = tokg[2 * tok]; g1[t4] = tokg[2 * tok + 1];
            const bf16_t* xr = xb + (size_t)tok * DM + 8 * lane; const bf16_t* r0 = yb + (size_t)p0 * DM + 8 * lane; const bf16_t* r1 = yb + (size_t)p1 * DM + 8 * lane;
#pragma unroll
            for (int j = 0; j < 2; ++j) { xv[t4][j] = *(const GAS u32x4*)(xr + 512 * j); y0v[t4][j] = *(const GAS u32x4*)(r0 + 512 * j); y1v[t4][j] = *(const GAS u32x4*)(r1 + 512 * j); } }
#pragma unroll
        for (int t4 = 0; t4 < 4; ++t4) { const int tok = tok0 + 4 * bt + t4; float ss = 0.f;
#pragma unroll
            for (int j = 0; j < 2; ++j) { const u32x4 x = xv[t4][j], w0 = y0v[t4][j], w1 = y1v[t4][j]; const float a0 = g0[t4], a1 = g1[t4];
                float v[8];
                v[0] = bflo(x.x) + a0 * bflo(w0.x) + a1 * bflo(w1.x); v[1] = bfhi(x.x) + a0 * bfhi(w0.x) + a1 * bfhi(w1.x);
                v[2] = bflo(x.y) + a0 * bflo(w0.y) + a1 * bflo(w1.y); v[3] = bfhi(x.y) + a0 * bfhi(w0.y) + a1 * bfhi(w1.y);
                v[4] = bflo(x.z) + a0 * bflo(w0.z) + a1 * bflo(w1.z); v[5] = bfhi(x.z) + a0 * bfhi(w0.z) + a1 * bfhi(w1.z);
                v[6] = bflo(x.w) + a0 * bflo(w0.w) + a1 * bflo(w1.w); v[7] = bfhi(x.w) + a0 * bfhi(w0.w) + a1 * bfhi(w1.w);
                if (FINAL) { float* fo = fout + (size_t)tok * DM + 512 * j + 8 * lane;
                    __builtin_nontemporal_store((f32x4){v[0], v[1], v[2], v[3]}, (GAS f32x4*)fo); __builtin_nontemporal_store((f32x4){v[4], v[5], v[6], v[7]}, (GAS f32x4*)(fo + 4)); }
                else { u32x4 hi; hi.x = cvt_pk_bf16(v[0], v[1]); hi.y = cvt_pk_bf16(v[2], v[3]); hi.z = cvt_pk_bf16(v[4], v[5]); hi.w = cvt_pk_bf16(v[6], v[7]);
                    *(GAS u32x4*)(xb + (size_t)tok * DM + 512 * j + 8 * lane) = hi;
                    const float r0 = bflo(hi.x), r1 = bfhi(hi.x), r2 = bflo(hi.y), r3 = bfhi(hi.y), r4 = bflo(hi.z), r5 = bfhi(hi.z), r6 = bflo(hi.w), r7 = bfhi(hi.w);
                    ss += (r0 * r0 + r1 * r1) + (r2 * r2 + r3 * r3) + (r4 * r4 + r5 * r5) + (r6 * r6 + r7 * r7); } }
            if (!FINAL) {
#pragma unroll
                for (int o = 1; o < 64; o <<= 1) ss += __shfl_xor(ss, o);
                if (lane == 0) rstd_out[tok] = 1.0f / sqrtf(ss * (1.0f / DM) + EPS); } }
    }
}
__device__ __forceinline__ void combine_rows_gates(const Frame& F, bf16_t* xb, float* rstd_out, float* gout, const bf16_t* yb, const int* toke, const int* tokp, const float* tokg, const LAS int* pst, int tok0,
                                                   const float* win  , const float* gain  ) {
    const int lane = F.lane;
    float wg[2][8][8];
#pragma unroll
    for (int j = 0; j < 2; ++j)
#pragma unroll
        for (int i = 0; i < 8; ++i) { const int k = 512 * j + 8 * lane + i; const float gk = gain[k]; const f32x4 a = *(const GAS f32x4*)(win + (size_t)k * 3080 + 3072), b = *(const GAS f32x4*)(win + (size_t)k * 3080 + 3076);
            wg[j][i][0] = a[0] * gk; wg[j][i][1] = a[1] * gk; wg[j][i][2] = a[2] * gk; wg[j][i][3] = a[3] * gk; wg[j][i][4] = b[0] * gk; wg[j][i][5] = b[1] * gk; wg[j][i][6] = b[2] * gk; wg[j][i][7] = b[3] * gk; }
#pragma unroll 1
    for (int bt = 0; bt < 8; ++bt) {
        u32x4 xv[2][2], y0v[2][2], y1v[2][2]; float g0[2], g1[2];
#pragma unroll
        for (int t2 = 0; t2 < 2; ++t2) { const int tok = __builtin_amdgcn_readfirstlane(tok0 + 2 * bt + t2);
            const int p0 = __builtin_amdgcn_readfirstlane(pst[toke[2 * tok]] + tokp[2 * tok]), p1 = __builtin_amdgcn_readfirstlane(pst[toke[2 * tok + 1]] + tokp[2 * tok + 1]);
            g0[t2] = tokg[2 * tok]; g1[t2] = tokg[2 * tok + 1];
            const bf16_t* xr = xb + (size_t)tok * DM + 8 * lane; const bf16_t* r0 = yb + (size_t)p0 * DM + 8 * lane; const bf16_t* r1 = yb + (size_t)p1 * DM + 8 * lane;
#pragma unroll
            for (int j = 0; j < 2; ++j) { xv[t2][j] = *(const GAS u32x4*)(xr + 512 * j); y0v[t2][j] = *(const GAS u32x4*)(r0 + 512 * j); y1v[t2][j] = *(const GAS u32x4*)(r1 + 512 * j); } }
#pragma unroll
        for (int t2 = 0; t2 < 2; ++t2) { const int tok = tok0 + 2 * bt + t2; float ss = 0.f, gs[8];
#pragma unroll
            for (int c = 0; c < 8; ++c) gs[c] = 0.f;
#pragma unroll
            for (int j = 0; j < 2; ++j) { const u32x4 x = xv[t2][j], w0 = y0v[t2][j], w1 = y1v[t2][j]; const float a0 = g0[t2], a1 = g1[t2];
                float v[8];
                v[0] = bflo(x.x) + a0 * bflo(w0.x) + a1 * bflo(w1.x); v[1] = bfhi(x.x) + a0 * bfhi(w0.x) + a1 * bfhi(w1.x);
                v[2] = bflo(x.y) + a0 * bflo(w0.y) + a1 * bflo(w1.y); v[3] = bfhi(x.y) + a0 * bfhi(w0.y) + a1 * bfhi(w1.y);
                v[4] = bflo(x.z) + a0 * bflo(w0.z) + a1 * bflo(w1.z); v[5] = bfhi(x.z) + a0 * bfhi(w0.z) + a1 * bfhi(w1.z);
                v[6] = bflo(x.w) + a0 * bflo(w0.w) + a1 * bflo(w1.w); v[7] = bfhi(x.w) + a0 * bfhi(w0.w) + a1 * bfhi(w1.w);
                u32x4 hi; hi.x = cvt_pk_bf16(v[0], v[1]); hi.y = cvt_pk_bf16(v[2], v[3]); hi.z = cvt_pk_bf16(v[4], v[5]); hi.w = cvt_pk_bf16(v[6], v[7]);
                *(GAS u32x4*)(xb + (size_t)tok * DM + 512 * j + 8 * lane) = hi;
                const float r[8] = {bflo(hi.x), bfhi(hi.x), bflo(hi.y), bfhi(hi.y), bflo(hi.z), bfhi(hi.z), bflo(hi.w), bfhi(hi.w)};
#pragma unroll
                for (int i = 0; i < 8; ++i) { ss += r[i] * r[i];
#pragma unroll
                    for (int c = 0; c < 8; ++c) gs[c] += r[i] * wg[j][i][c]; } }
#pragma unroll
            for (int o = 1; o < 64; o <<= 1) { ss += __shfl_xor(ss, o);
#pragma unroll
                for (int c = 0; c < 8; ++c) gs[c] += __shfl_xor(gs[c], o); }
            const float rs = 1.0f / sqrtf(ss * (1.0f / DM) + EPS);
            if (lane == 0) rstd_out[tok] = rs;
            if (lane < 8) { float gv = gs[0];
#pragma unroll
                for (int c = 1; c < 8; ++c) gv = (lane == c) ? gs[c] : gv;
                gout[(size_t)tok * 8 + lane] = gv * rs; } }
    }
}
__device__ __forceinline__ void phase_combine(const Frame& F, const Args& a, int l) {
    unsigned char* ws = a.ws;
    const bool gates = (l + 1 < NLAYER) && ((l + 1) & 1);
    const int j = (l + 1) >> 1;
    const bf16_t* whi = (const bf16_t*)(ws + WS_WG) + (size_t)j * 2 * 16 * 1024; const bf16_t* wlo = whi + 16 * 1024;
    float* gout = (float*)(ws + SM_GATES);
    LAS float* rsl = (LAS float*)(F.lds) + F.wave * 16;
    LAS int* pst = (LAS int*)(F.lds + MOE_TAB_OFF); LAS int* cnt = (LAS int*)(F.lds + MOE_TAB_OFF + 512);
    const int* tokp = (const int*)(ws + SM_TOKP); const float* tokg = (const float*)(ws + SM_TOKG); const int* toke = (const int*)(ws + SM_TOKE);
    TokRec tr = tok_rec(toke, tokp, tokg, F.vcu * 128 + F.wave * 16 + (F.lane & 15));
    (void)moe_tables(F, (const unsigned*)(ws + WS_CTL) + CW_CNT + l * 64, pst, cnt);
    bf16_t* xb = (bf16_t*)(ws + WS_XB); float* rstd = (float*)(ws + SM_RSTD); const bf16_t* yb = (const bf16_t*)(ws + WS_YB);
    for (int tb = F.vcu; tb < NTOK / 128; tb += F.G) {
        f32x4 acc; float rs; const int tok0 = tb * 128 + F.wave * 16;
        if (tb != F.vcu) tr = tok_rec(toke, tokp, tokg, tok0 + (F.lane & 15));
        if (l + 1 == NLAYER) combine_rows<true>(F, xb, rstd, a.out, yb, toke, tokp, tokg, pst, tok0);
        else if (gates) { combine_rows_gates(F, xb, rstd, gout, yb, toke, tokp, tokg, pst, tok0, a.in[7] + (size_t)j * DM * 3080, a.in[1] + (size_t)(2 * j + 1) * DM);
        } else combine_rows<false>(F, xb, rstd, nullptr, yb, toke, tokp, tokg, pst, tok0);
    }
}

constexpr int ATT_KB = 0, ATT_VT = 36864;
struct AttnRegs { u32x4 k[2]; u32x4 v0, v1; bf16x8 q0, q1; };
struct AttnStep { int d, b, h, r, blk; bool prime; };
__device__ __forceinline__ void attn_fetch(const Frame& F, const bf16_t* QKV, const AttnStep& u, AttnRegs& R) {
    const int tid = F.tid, fr = F.lane & 15, fq = F.lane >> 4; const bool valid = u.blk >= 0; const int s0 = u.blk * 128;
#pragma unroll
    for (int i = 0; i < 2; ++i) { const int id = tid + 512 * i, row = id >> 3, ch = id & 7;
        R.k[i] = (u32x4){0u, 0u, 0u, 0u};
        if (valid) R.k[i] = *(const GAS u32x4*)(QKV + ((size_t)(32 + u.b * 16 + u.h) * SEQ + (s0 + row) * u.d + u.r) * 64 + 8 * ch); }
    { const int pair = tid >> 3, ch = tid & 7;
        R.v0 = (u32x4){0u, 0u, 0u, 0u}; R.v1 = (u32x4){0u, 0u, 0u, 0u};
        if (valid) { const bf16_t* p = QKV + ((size_t)(64 + u.b * 16 + u.h) * SEQ + (s0 + 2 * pair) * u.d + u.r) * 64 + 8 * ch; R.v0 = *(const GAS u32x4*)p; R.v1 = *(const GAS u32x4*)(p + (size_t)u.d * 64); } }
    if (!u.prime) { const size_t qrow = (size_t)(u.b * 16 + u.h) * SEQ + (s0 + 16 * F.wave + fr) * u.d + u.r;
        R.q0 = *(const GAS bf16x8*)(QKV + qrow * 64 + 8 * fq); R.q1 = *(const GAS bf16x8*)(QKV + qrow * 64 + 32 + 8 * fq); }
}
__device__ __forceinline__ void attn_stage(const Frame& F, const AttnRegs& R, int slot) {
    LAS unsigned char* Kb = F.lds + ATT_KB; LAS unsigned* VT = (LAS unsigned*)(F.lds + ATT_VT);
#pragma unroll
    for (int i = 0; i < 2; ++i) { const int id = F.tid + 512 * i, row = id >> 3, ch = id & 7; *(LAS u32x4*)(Kb + (slot * 128 + row) * 144 + ch * 16) = R.k[i]; }
    { const int pair = F.tid >> 3, ch = F.tid & 7; const u32x4 v0 = R.v0, v1 = R.v1;
        LAS unsigned* o = VT + (8 * ch) * 129 + slot * 64 + pair;
        o[0 * 129] = (v0.x & 0xffffu) | (v1.x << 16); o[1 * 129] = (v0.x >> 16) | (v1.x & 0xffff0000u);
        o[2 * 129] = (v0.y & 0xffffu) | (v1.y << 16); o[3 * 129] = (v0.y >> 16) | (v1.y & 0xffff0000u);
        o[4 * 129] = (v0.z & 0xffffu) | (v1.z << 16); o[5 * 129] = (v0.z >> 16) | (v1.z & 0xffff0000u);
        o[6 * 129] = (v0.w & 0xffffu) | (v1.w << 16); o[7 * 129] = (v0.w >> 16) | (v1.w & 0xffff0000u); }
}
template <int MODE, bool FIRST>
__device__ __forceinline__ void attn_compute(const Frame& F, const AttnStep& u, const int par, const bf16x8 Q0, const bf16x8 Q1, float off2, bf16_t* part_out, float* l_out, bf16_t* OB, const bf16_t* PP1, const bf16_t* PP2, const float* PL1, const float* PL2) {
    const int lane = F.lane, w = F.wave, fr = lane & 15, fq = lane >> 4;
    const int si0 = u.blk * 128;
    const LAS unsigned char* Kb = F.lds + ATT_KB; const LAS unsigned* VT = (const LAS unsigned*)(F.lds + ATT_VT);
    const int iq = 16 * w + fr; const size_t qrow = (size_t)(u.b * SEQ + (si0 + iq) * u.d + u.r), hrow = (size_t)(u.b * 16 + u.h) * SEQ + (si0 + iq) * u.d + u.r;
    f32x4 O[4];
#pragma unroll
    for (int dt = 0; dt < 4; ++dt) O[dt] = (f32x4){0.f, 0.f, 0.f, 0.f};
    float lsum = 0.f;
#pragma unroll
    for (int up = 0; up < 5; ++up) {
        unsigned pk[4];
#pragma unroll
        for (int hh = 0; hh < 2; ++hh) {
            const int tt = 2 * up + hh;
            if (tt < 9) {
                const int kt = w + tt;
                const int prow = ((kt < 8) ? (par ^ 1) : par) * 128 + 16 * (kt & 7);
                const LAS unsigned char* kp = Kb + (prow + fr) * 144 + fq * 16;
                f32x4 s = (f32x4){0.f, 0.f, 0.f, 0.f};
                s = MFMA16(ld_frag_lds(kp), Q0, s); s = MFMA16(ld_frag_lds(kp + 64), Q1, s);
                float p[4];
                if (FIRST || tt == 0 || tt == 8) {
#pragma unroll
                    for (int i = 0; i < 4; ++i) { const int jk = 16 * kt + 4 * fq + i; const bool ok = (jk >= iq) && (jk <= iq + 128) && (!FIRST || jk >= 128);
                        p[i] = ok ? fast_exp2(s[i] - off2) : 0.f; }
                } else {
#pragma unroll
                    for (int i = 0; i < 4; ++i) p[i] = fast_exp2(s[i] - off2);
                }
                lsum += (p[0] + p[1]) + (p[2] + p[3]);
                pk[2 * hh] = cvt_pk_bf16(p[0], p[1]); pk[2 * hh + 1] = cvt_pk_bf16(p[2], p[3]);
            } else { pk[2 * hh] = 0u; pk[2 * hh + 1] = 0u; }
        }
        const bf16x8 Pf = mk_frag(pk[0], pk[1], pk[2], pk[3]);
        const int kt0 = w + 2 * up, kt1 = (2 * up + 1 < 9) ? kt0 + 1 : kt0;
        const int pb0 = ((kt0 < 8) ? (par ^ 1) : par) * 64 + 8 * (kt0 & 7), pb1 = ((kt1 < 8) ? (par ^ 1) : par) * 64 + 8 * (kt1 & 7);
#pragma unroll
        for (int dt = 0; dt < 4; ++dt) { const LAS unsigned* vp = VT + (16 * dt + fr) * 129 + 2 * fq;
            const bf16x8 V = mk_frag(vp[pb0], vp[pb0 + 1], vp[pb1], vp[pb1 + 1]);
            O[dt] = MFMA16(V, Pf, O[dt]); }
    }
    lsum += __shfl_xor(lsum, 16); lsum += __shfl_xor(lsum, 32);
    if (MODE == 0) {
        bf16_t* o = part_out + hrow * 64 + 4 * fq;
#pragma unroll
        for (int dt = 0; dt < 4; ++dt) { u32x2 wv; wv.x = cvt_pk_bf16(O[dt][0], O[dt][1]); wv.y = cvt_pk_bf16(O[dt][2], O[dt][3]); *(GAS u32x2*)(o + 16 * dt) = wv; }
        if (fq == 0) l_out[hrow] = lsum;
    } else {
        const float inv = 1.0f / (lsum + PL1[hrow] + PL2[hrow]);
        bf16_t* o = OB + hrow * 64 + 4 * fq;
#pragma unroll
        for (int dt = 0; dt < 4; ++dt) { const u32x2 x1 = *(const GAS u32x2*)(PP1 + hrow * 64 + 4 * fq + 16 * dt), x2 = *(const GAS u32x2*)(PP2 + hrow * 64 + 4 * fq + 16 * dt);
            const float o0 = (O[dt][0] + bflo(x1.x) + bflo(x2.x)) * inv, o1 = (O[dt][1] + bfhi(x1.x) + bfhi(x2.x)) * inv;
            const float o2 = (O[dt][2] + bflo(x1.y) + bflo(x2.y)) * inv, o3 = (O[dt][3] + bfhi(x1.y) + bfhi(x2.y)) * inv;
            u32x2 wv; wv.x = cvt_pk_bf16(o0, o1); wv.y = cvt_pk_bf16(o2, o3); *(GAS u32x2*)(o + 16 * dt) = wv; }
    }
}
__device__ __forceinline__ float attn_off2(const float* qg, const float* kg) {
    const int i = threadIdx.x & 63; float mx = fabsf(qg[i] * kg[i]);
#pragma unroll
    for (int o = 1; o < 64; o <<= 1) mx = fmaxf(mx, __shfl_xor(mx, o));
    return 8.0f * mx * LOG2E * 1.02f;
}
template <int MODE>
__device__ __forceinline__ AttnStep attn_step(int s, int vcu, int& br) {
    const int xcd = vcu >> 5, jb = vcu & 31; AttnStep u; int bhl, nblk0, o;
    if (MODE == 0) {
        if (s < 18) { const int ci = 2 * jb + (s >= 9 ? 1 : 0); o = s >= 9 ? s - 9 : s; u.d = 16; bhl = ci >> 4; u.r = ci & 15; nblk0 = 0; br = 0; }
        else { o = s - 18; u.d = 4; bhl = jb >> 3; u.r = (jb & 7) >> 1; nblk0 = 16 * (jb & 1); br = 1; }
    } else { o = s; u.d = 1; bhl = jb >> 3; u.r = 0; nblk0 = 16 * (jb & 7); br = 0; }
    const int bh = xcd + 8 * bhl; u.b = bh >> 4; u.h = bh & 15; u.blk = nblk0 + o - 1; u.prime = (o == 0);
    return u;
}
template <int MODE>
__device__ __forceinline__ void phase_attn(const Frame& F, const Args& a, int j) {
    unsigned char* ws = a.ws; const bf16_t* QKV = (const bf16_t*)(ws + WS_QKV);
    const float off2 = attn_off2(a.in[4] + j * 64, a.in[5] + j * 64);
    constexpr int NSTEP = (MODE == 0) ? 35 : 17;
    if (F.G != 256) return;
    AttnRegs R; R.q0 = (bf16x8){0, 0, 0, 0, 0, 0, 0, 0}; R.q1 = R.q0; int br = 0, ucount = 0;
    AttnStep st = attn_step<MODE>(0, F.vcu, br);
    attn_fetch(F, QKV, st, R);
    const bf16_t* P1 = (const bf16_t*)(ws + WS_P1); const bf16_t* P2 = (const bf16_t*)(ws + WS_P2); const float* L1 = (const float*)(ws + SM_L1); const float* L2 = (const float*)(ws + SM_L2);
    for (int s = 0; s < NSTEP; ++s) {
        __syncthreads();
        attn_stage(F, R, s & 1);
        const bf16x8 Q0 = R.q0, Q1 = R.q1;
        const AttnStep cur = st; const int cbr = br;
        if (s + 1 < NSTEP) { st = attn_step<MODE>(s + 1, F.vcu, br); attn_fetch(F, QKV, st, R); }
        __syncthreads();
        if (cur.prime) continue;
        const int slot = (MODE == 0 ? 0 : 32) + ucount; ++ucount; const int cl = 2 * j + (slot >= 24 ? 1 : 0); const int cit = (F.vcu * 8 + F.wave) + 2048 * (slot % 24);
        const bool do_cvt = (slot < 48) && (cit < MOE_ITEMS);
        CvtDesc cd = cvt_moe_desc(a, cl, do_cvt ? cit : 0); f32x4 cv[8];
        if (do_cvt) cvt_load(cd, F.lane, cv);
        if (cur.blk == 0) attn_compute<MODE, true>(F, cur, s & 1, Q0, Q1, off2, (bf16_t*)(ws + (cbr == 0 ? WS_P1 : WS_P2)), (float*)(ws + (cbr == 0 ? SM_L1 : SM_L2)), (bf16_t*)(ws + WS_OB), P1, P2, L1, L2);
        else attn_compute<MODE, false>(F, cur, s & 1, Q0, Q1, off2, (bf16_t*)(ws + (cbr == 0 ? WS_P1 : WS_P2)), (float*)(ws + (cbr == 0 ? SM_L1 : SM_L2)), (bf16_t*)(ws + WS_OB), P1, P2, L1, L2);
        if (do_cvt) cvt_finish(cd, F.lane, cv, (LAS float*)(F.lds + 71680 + F.wave * 8448));
    }
}
__device__ __forceinline__ void phase_attn_a(const Frame& F, const Args& a, int j) { phase_attn<0>(F, a, j); }
__device__ __forceinline__ void phase_attn_b(const Frame& F, const Args& a, int j) { phase_attn<1>(F, a, j); }

__device__ __forceinline__ float log_sigmoid(float x) { return fminf(x, 0.f) - __logf(1.0f + __expf(-fabsf(x))); }
__device__ __forceinline__ float wave_incl_scan_add(float v, int lane) {
#pragma unroll
    for (int o = 1; o < 64; o <<= 1) { const float t = __shfl_up(v, o); if (lane >= o) v += t; }
    return v;
}
__device__ __forceinline__ float wave_incl_scan_max(float v, int lane) {
#pragma unroll
    for (int o = 1; o < 64; o <<= 1) { const float t = __shfl_up(v, o); if (lane >= o) v = fmaxf(v, t); }
    return v;
}
__device__ __forceinline__ float wave_max(float v) {
#pragma unroll
    for (int o = 1; o < 64; o <<= 1) v = fmaxf(v, __shfl_xor(v, o));
    return v;
}
constexpr int B2_KWT = 0, B2_VT = 18432, B2_WS = 52224, B2_RAW = 56320, B2_OUT = 91904;
__device__ __forceinline__ int vt_col(int dv, int pair) { return (pair + (dv >> 5)) & 31; }
__device__ __forceinline__ void mlstm_fetch_v(const Frame& F, const bf16_t* QKV, int n0, int h, u32x4 (&v0)[2], u32x4 (&v1)[2]) {
#pragma unroll
    for (int i = 0; i < 2; ++i) { const int id = F.tid + 512 * i, ch = id & 31, pair = id >> 5;
        const bf16_t* p = QKV + (size_t)(n0 + 2 * pair) * 3072 + 1024 + h * 256 + 8 * ch;
        v0[i] = *(const GAS u32x4*)p; v1[i] = *(const GAS u32x4*)(p + 3072); }
}
__device__ __forceinline__ void mlstm_write_vT(const Frame& F, const u32x4 (&v0a)[2], const u32x4 (&v1a)[2], LAS unsigned* VT) {
#pragma unroll
    for (int i = 0; i < 2; ++i) { const int id = F.tid + 512 * i, ch = id & 31, pair = id >> 5; const u32x4 v0 = v0a[i], v1 = v1a[i];
        LAS unsigned* o = VT + (8 * ch) * 33 + ((pair + (ch >> 2)) & 31);
        o[0 * 33] = (v0.x & 0xffffu) | (v1.x << 16); o[1 * 33] = (v0.x >> 16) | (v1.x & 0xffff0000u);
        o[2 * 33] = (v0.y & 0xffffu) | (v1.y << 16); o[3 * 33] = (v0.y >> 16) | (v1.y & 0xffff0000u);
        o[4 * 33] = (v0.z & 0xffffu) | (v1.z << 16); o[5 * 33] = (v0.z >> 16) | (v1.z & 0xffff0000u);
        o[6 * 33] = (v0.w & 0xffffu) | (v1.w << 16); o[7 * 33] = (v0.w >> 16) | (v1.w & 0xffff0000u); }
}
__device__ __forceinline__ void mlstm_stage_vT(const Frame& F, const bf16_t* QKV, int n0, int h, LAS unsigned* VT) {
    u32x4 v0[2], v1[2]; mlstm_fetch_v(F, QKV, n0, h, v0, v1); mlstm_write_vT(F, v0, v1, VT);
}
__device__ __forceinline__ void phase_mlstm_local(const Frame& F, const Args& a, int j) {
    unsigned char* ws = a.ws; const bf16_t* QKV = (const bf16_t*)(ws + WS_QKV);
    const float* gates = (const float*)(ws + SM_GATES); const float* gb = a.in[10] + j * 8;
    const float* cw = a.in[8] + (size_t)j * 4 * 1024; const float* cb = a.in[9] + j * 1024;
    bf16_t* QC = (bf16_t*)(ws + WS_QC); bf16_t* KC = (bf16_t*)(ws + WS_KC);
    bf16_t* DC = (bf16_t*)(ws + WS_DC); float* DN = (float*)(ws + SM_DN); float* MLOC = (float*)(ws + SM_MLOC); float* BL = (float*)(ws + SM_BL);
    LAS unsigned char* KwT = F.lds + B2_KWT; LAS unsigned* VT = (LAS unsigned*)(F.lds + B2_VT); LAS float* wsm = (LAS float*)(F.lds + B2_WS);
    if (F.vcu >= 256) return;
    const int bh = F.vcu >> 5, sc = F.vcu & 31, b = bh >> 2, h = bh & 3, us = bh * 32 + sc;
    f32x4 Dacc[2][8], an = (f32x4){0.f, 0.f, 0.f, 0.f};
#pragma unroll
    for (int bt = 0; bt < 2; ++bt)
#pragma unroll
        for (int at = 0; at < 8; ++at) Dacc[bt][at] = (f32x4){0.f, 0.f, 0.f, 0.f};
    float mq = -__builtin_inff(), blsum = 0.f;
    LAS float* G2 = (LAS float*)(F.lds + B2_WS + 512);
    { const int w_ = F.wave, lane_ = F.lane; const int n0w = b * SEQ + (sc * 8 + w_) * 64;
        const float ipre = DBGG(gates[(size_t)(n0w + lane_) * 8 + h]) + gb[h]; const float fpre = DBGG(gates[(size_t)(n0w + lane_) * 8 + 4 + h]) + gb[4 + h];
        const float bs = wave_incl_scan_add(log_sigmoid(fpre), lane_); const float bL = __shfl(bs, 63);
        const float gs = bL - bs + ipre; const float ml = wave_max(gs);
        G2[w_ * 64 + lane_] = __expf(gs - ml);
        if (lane_ == 0) { G2[512 + 2 * w_] = bL; G2[512 + 2 * w_ + 1] = ml; } }
    u32x4 Rv0[2], Rv1[2], Rr[5];
    LAS unsigned char* raw = F.lds + B2_RAW;
#define B2_FETCH(FR, c_) do { _Pragma("unroll") for (int i = 0; i < 5; ++i) { const int p = FR.tid + 512 * i, r = p >> 5, hf = (p >> 4) & 1, c16 = p & 15; const int pos = (c_) * 64 - 3 + r; \
            Rr[i] = (u32x4){0u, 0u, 0u, 0u}; if (p < 67 * 32 && pos >= 0) Rr[i] = *(const GAS u32x4*)(QKV + (size_t)(b * SEQ + pos) * 3072 + hf * 512 + h * 128 + 8 * c16); } } while (0)
    B2_FETCH(F, sc * 8); mlstm_fetch_v(F, QKV, b * SEQ + sc * 8 * 64, h, Rv0, Rv1);
    for (int jc = 0; jc < 8; ++jc) {
        const Frame Fi = make_frame(F.lds);
        const int lane = Fi.lane, fr = lane & 15, fq = lane >> 4, w = Fi.wave;
        const int c = sc * 8 + jc, n0 = b * SEQ + c * 64;
        __syncthreads();
        if (Fi.tid < 64) { const int s = Fi.tid; const float bL = G2[512 + 2 * jc], ml = G2[512 + 2 * jc + 1];
            const float mn = fmaxf(bL + mq, ml); const float aa = __expf(bL + mq - mn), bb = __expf(ml - mn);
            wsm[s] = G2[jc * 64 + s] * bb;
            if (s == 0) wsm[64] = aa;
            mq = mn; blsum += bL; }
        mlstm_write_vT(Fi, Rv0, Rv1, VT);
#pragma unroll
        for (int i = 0; i < 5; ++i) { const int p = Fi.tid + 512 * i, r = p >> 5, hf = (p >> 4) & 1, c16 = p & 15; if (p < 67 * 32) *(LAS u32x4*)(raw + r * 528 + hf * 256 + c16 * 16) = Rr[i]; }
        if (jc + 1 < 8) { mlstm_fetch_v(Fi, QKV, b * SEQ + (c + 1) * 64, h, Rv0, Rv1); B2_FETCH(Fi, c + 1); }
        __syncthreads();
#pragma unroll
        for (int i = 0; i < 4; ++i) { const int id = Fi.tid + 512 * i, s = id & 63, ch = (id >> 6) & 15, isk = id >> 10;
            const int col = (isk ? 512 : 0) + h * 128 + 8 * ch;
            float accv[8];
#pragma unroll
            for (int e = 0; e < 8; ++e) accv[e] = cb[col + e];
#pragma unroll
            for (int jj = 0; jj < 4; ++jj) { const u32x4 x = *(const LAS u32x4*)(raw + (s + jj) * 528 + isk * 256 + ch * 16); const float* wj = cw + jj * 1024 + col;
                accv[0] += wj[0] * bflo(x.x); accv[1] += wj[1] * bfhi(x.x); accv[2] += wj[2] * bflo(x.y); accv[3] += wj[3] * bfhi(x.y);
                accv[4] += wj[4] * bflo(x.z); accv[5] += wj[5] * bfhi(x.z); accv[6] += wj[6] * bflo(x.w); accv[7] += wj[7] * bfhi(x.w); }
            const float scq = isk ? 0.08838834764831845f : 1.0f;
#pragma unroll
            for (int e = 0; e < 8; ++e) { const float v = accv[e]; accv[e] = v * fast_rcp(1.0f + __expf(-v)) * scq; }
            u32x4 o; o.x = cvt_pk_bf16(accv[0], accv[1]); o.y = cvt_pk_bf16(accv[2], accv[3]); o.z = cvt_pk_bf16(accv[4], accv[5]); o.w = cvt_pk_bf16(accv[6], accv[7]);
            *(LAS u32x4*)(F.lds + B2_OUT + isk * 17408 + s * 272 + ch * 16) = o;
            if (isk) { const float wv = wsm[s];
#pragma unroll
                for (int e = 0; e < 8; ++e) *(LAS bf16_t*)(KwT + (8 * ch + e) * 144 + 2 * s) = (bf16_t)f2bf(accv[e] * wv); } }
        __syncthreads();
#pragma unroll
        for (int i = 0; i < 4; ++i) { const int id = Fi.tid + 512 * i, c16 = id & 15, s = (id >> 4) & 63, isk = id >> 10;
            *(GAS u32x4*)((isk ? KC : QC) + ((size_t)(b * 4 + h) * SEQ + c * 64 + s) * 128 + 8 * c16) = *(const LAS u32x4*)(F.lds + B2_OUT + isk * 17408 + s * 272 + c16 * 16); }
        const float aa = wsm[64];
        bf16x8 Bv[2][2];
#pragma unroll
        for (int bt = 0; bt < 2; ++bt)
#pragma unroll
            for (int kk = 0; kk < 2; ++kk) { const int dvr = 16 * (2 * w + bt) + fr; const LAS unsigned* vp = VT + dvr * 33; const int p0 = 4 * fq + 16 * kk; Bv[bt][kk] = mk_frag(vp[vt_col(dvr, p0)], vp[vt_col(dvr, p0 + 1)], vp[vt_col(dvr, p0 + 2)], vp[vt_col(dvr, p0 + 3)]); }
        an *= aa;
#pragma unroll
        for (int at = 0; at < 8; ++at) {
            const LAS unsigned char* kp = KwT + (16 * at + fr) * 144 + 16 * fq;
            const bf16x8 A0 = ld_frag_lds(kp), A1 = ld_frag_lds(kp + 64);
#pragma unroll
            for (int bt = 0; bt < 2; ++bt) { f32x4 d = Dacc[bt][at] * aa; d = MFMA16(A0, Bv[bt][0], d); d = MFMA16(A1, Bv[bt][1], d); Dacc[bt][at] = d; }
            if (at == w) {
                const bf16x8 ones = mk_frag(0x3f803f80u, 0x3f803f80u, 0x3f803f80u, 0x3f803f80u);
                an = MFMA16(A0, ones, an); an = MFMA16(A1, ones, an); }
        }
    }
    { const int lane = F.lane, fr = lane & 15, fq = lane >> 4, w = F.wave;
        bf16_t* dcu = DC + (size_t)us * 32768;
#pragma unroll
        for (int bt = 0; bt < 2; ++bt)
#pragma unroll
            for (int at = 0; at < 8; ++at) { const f32x4 d = Dacc[bt][at]; u32x2 wv; wv.x = cvt_pk_bf16(d[0], d[1]); wv.y = cvt_pk_bf16(d[2], d[3]);
                *(GAS u32x2*)(dcu + (size_t)(16 * (2 * w + bt) + fr) * 128 + 16 * at + 4 * fq) = wv; }
        if (fr == 0) *(GAS f32x4*)(DN + (size_t)us * 128 + 16 * w + 4 * fq) = an;
        if (F.tid == 0) { MLOC[us] = mq; BL[us] = blsum; } }
#undef B2_FETCH
}
__device__ __forceinline__ void phase_mlstm_scan(const Frame& F, const Args& a) {
    unsigned char* ws = a.ws;
    if (F.vcu >= 256 || F.tid >= 256) return;
    const int bh = F.vcu >> 5, part = F.vcu & 31; const size_t eoff = (size_t)part * 1024 + F.tid * 4;
    const bf16_t* DC = (const bf16_t*)(ws + WS_DC); bf16_t* CS = (bf16_t*)(ws + WS_CS);
    const float* DN = (const float*)(ws + SM_DN); float* NS = (float*)(ws + SM_NS);
    const float* MLOC = (const float*)(ws + SM_MLOC); const float* BL = (const float*)(ws + SM_BL); float* MPREV = (float*)(ws + SM_MPREV);
    const bool doN = (part == 0) && (F.tid < 128);
    float st[4] = {0.f, 0.f, 0.f, 0.f}, nst = 0.f, m = 0.f;
    u32x2 dcA[8], dcB[8]; float blA[8], mlA[8], dnA[8], blB[8], mlB[8], dnB[8];
#define B3_LOAD(dc, bl, ml, dn, c0) do { _Pragma("unroll") for (int i = 0; i < 8; ++i) { const int u = bh * 32 + (c0) + i; dc[i] = *(const GAS u32x2*)(DC + (size_t)u * 32768 + eoff); bl[i] = BL[u]; ml[i] = MLOC[u]; dn[i] = doN ? DN[(size_t)u * 128 + F.tid] : 0.f; } } while (0)
#define B3_STEP(dc, bl, ml, dn, c0) do { _Pragma("unroll") for (int i = 0; i < 8; ++i) { const int u = bh * 32 + (c0) + i; \
            u32x2 o; o.x = cvt_pk_bf16(st[0], st[1]); o.y = cvt_pk_bf16(st[2], st[3]); \
            *(GAS u32x2*)(CS + (size_t)u * 32768 + eoff) = o; \
            if (doN) NS[(size_t)u * 128 + F.tid] = nst; \
            if (part == 0 && F.tid == 0) MPREV[u] = m; \
            const float mn = fmaxf(bl[i] + m, ml[i]); const float aa = __expf(bl[i] + m - mn), bb = __expf(ml[i] - mn); \
            st[0] = aa * st[0] + bb * bflo(dc[i].x); st[1] = aa * st[1] + bb * bfhi(dc[i].x); st[2] = aa * st[2] + bb * bflo(dc[i].y); st[3] = aa * st[3] + bb * bfhi(dc[i].y); \
            nst = aa * nst + bb * dn[i]; m = mn; } } while (0)
    B3_LOAD(dcA, blA, mlA, dnA, 0);
    for (int c0 = 0; c0 < 32; c0 += 16) {
        B3_LOAD(dcB, blB, mlB, dnB, c0 + 8);
        B3_STEP(dcA, blA, mlA, dnA, c0);
        if (c0 + 16 < 32) B3_LOAD(dcA, blA, mlA, dnA, c0 + 16);
        B3_STEP(dcB, blB, mlB, dnB, c0 + 8);
    }
#undef B3_LOAD
#undef B3_STEP
}
constexpr int B4_QS = 0, B4_KS = 17408, B4_VT = 34816, B4_SS = 68608, B4_SC = 77824, B4_KWT = 86016, B4_G = 104448, B4_RED = 112768;
__device__ __forceinline__ void phase_mlstm_out(const Frame& F, const Args& a, int j) {
    unsigned char* ws = a.ws; const bf16_t* QKV = (const bf16_t*)(ws + WS_QKV);
    const float* gates = (const float*)(ws + SM_GATES); const float* gb = a.in[10] + j * 8; const float* hg = a.in[11] + (size_t)j * 1024;
    const bf16_t* QC = (const bf16_t*)(ws + WS_QC); const bf16_t* KC = (const bf16_t*)(ws + WS_KC);
    const bf16_t* CS = (const bf16_t*)(ws + WS_CS); const float* NS = (const float*)(ws + SM_NS); const float* MPREV = (const float*)(ws + SM_MPREV);
    bf16_t* OB = (bf16_t*)(ws + WS_OB);
    LAS unsigned char* Qs = F.lds + B4_QS; LAS unsigned char* Ks = F.lds + B4_KS; LAS unsigned* VT = (LAS unsigned*)(F.lds + B4_VT); LAS unsigned char* Ss = F.lds + B4_SS; LAS unsigned char* KwT = F.lds + B4_KWT;
    LAS float* us = (LAS float*)(F.lds + B4_SC); LAS float* Ms = us + 64; LAS float* wint = us + 128; LAS float* eneg = us + 192; LAS float* npv = us + 256; LAS float* den = us + 384  ; LAS float* qn = us + 640  ; LAS float* hss = us + 1152  ;
    LAS float* wk = us + 1664  ; LAS float* scal = us + 1728;
    const int lane = F.lane, fr = lane & 15, fq = lane >> 4, w = F.wave;
    if (F.vcu >= 256) return;
    const int bh = F.vcu >> 5, sc = F.vcu & 31, b = bh >> 2, h = bh & 3;
    const int us0 = bh * 32 + sc;
    f32x4 Cst[2][8];
#pragma unroll
    for (int bt = 0; bt < 2; ++bt)
#pragma unroll
        for (int at = 0; at < 8; ++at) { const u32x2 x = *(const GAS u32x2*)(CS + (size_t)us0 * 32768 + (size_t)(16 * (2 * w + bt) + fr) * 128 + 16 * at + 4 * fq);
            Cst[bt][at] = (f32x4){bflo(x.x), bfhi(x.x), bflo(x.y), bfhi(x.y)}; }
    float mcur = MPREV[us0];
    LAS float* G4 = (LAS float*)(F.lds + B4_G);
    { const int n0w = b * SEQ + (sc * 8 + w) * 64;
        const float ipre = DBGG(gates[(size_t)(n0w + lane) * 8 + h]) + gb[h]; const float fpre = DBGG(gates[(size_t)(n0w + lane) * 8 + 4 + h]) + gb[4 + h];
        const float bs = wave_incl_scan_add(log_sigmoid(fpre), lane); const float uu = ipre - bs; const float pm = wave_incl_scan_max(uu, lane);
        const float bL = __shfl(bs, 63); const float gs = bL - bs + ipre; const float ml = wave_max(gs);
        G4[(w * 4 + 0) * 64 + lane] = bs; G4[(w * 4 + 1) * 64 + lane] = uu; G4[(w * 4 + 2) * 64 + lane] = pm; G4[(w * 4 + 3) * 64 + lane] = __expf(gs - ml);
        if (lane == 0) { G4[2048 + 2 * w] = bL; G4[2048 + 2 * w + 1] = ml; } }
    if (F.tid >= 64 && F.tid < 192) npv[F.tid - 64] = NS[(size_t)us0 * 128 + F.tid - 64];
    u32x4 Rqk[4], Rv0[2], Rv1[2];
#define B4_FETCH(FR, c_) do { const int n0_ = b * SEQ + (c_) * 64; \
        _Pragma("unroll") for (int i = 0; i < 4; ++i) { const int id = FR.tid + 512 * i, ch = id & 15, s = (id >> 4) & 63, isk = id >> 10; \
            Rqk[i] = *(const GAS u32x4*)((isk ? KC : QC) + ((size_t)(b * 4 + h) * SEQ + (c_) * 64 + s) * 128 + 8 * ch); } \
        mlstm_fetch_v(FR, QKV, n0_, h, Rv0, Rv1); } while (0)
    B4_FETCH(F, sc * 8);
    for (int jc = 0; jc < 8; ++jc) {
        const Frame Fi = make_frame(F.lds);
        const int lane = Fi.lane, fr = lane & 15, fq = lane >> 4, w = Fi.wave;
        const int c = sc * 8 + jc, n0 = b * SEQ + c * 64;
        __syncthreads();
        if (Fi.tid < 64) { const int s = Fi.tid; const float bs = G4[(jc * 4 + 0) * 64 + s], uu = G4[(jc * 4 + 1) * 64 + s], pm = G4[(jc * 4 + 2) * 64 + s];
            const float mp = mcur; const float M = fmaxf(mp, pm);
            us[s] = uu; Ms[s] = M; wint[s] = __expf(mp - M); eneg[s] = __expf(-(bs + M));
            const float bL = G4[2048 + 2 * jc], ml = G4[2048 + 2 * jc + 1];
            const float mn = fmaxf(bL + mp, ml); const float aa = __expf(bL + mp - mn), bb = __expf(ml - mn);
            wk[s] = G4[(jc * 4 + 3) * 64 + s] * bb;
            if (s == 0) scal[0] = aa;
            mcur = mn; }
#pragma unroll
        for (int i = 0; i < 4; ++i) { const int id = Fi.tid + 512 * i, ch = id & 15, s = (id >> 4) & 63, isk = id >> 10;
            *(LAS u32x4*)((isk ? Ks : Qs) + s * 272 + ch * 16) = Rqk[i]; }
        mlstm_write_vT(Fi, Rv0, Rv1, VT);
        if (jc + 1 < 8) B4_FETCH(Fi, c + 1);
        __syncthreads();
        u32x2 ogv[4][2]; f32x4 hgv[2];
#pragma unroll
        for (int dv = 0; dv < 2; ++dv) { const int col = h * 256 + 16 * (2 * w + dv) + 4 * fq; hgv[dv] = *(const GAS f32x4*)(hg + col);
#pragma unroll
            for (int tt = 0; tt < 4; ++tt) ogv[tt][dv] = *(const GAS u32x2*)(QKV + (size_t)(n0 + 16 * tt + fr) * 3072 + 2048 + col); }
#pragma unroll
        for (int i = 0; i < 2; ++i) { const int id = Fi.tid + 512 * i, s = id & 63, ch = id >> 6; const u32x4 kx = *(const LAS u32x4*)(Ks + s * 272 + ch * 16); const float wv = wk[s];
            LAS unsigned char* o = KwT + (8 * ch) * 144 + 2 * s;
            *(LAS bf16_t*)(o + 0 * 144) = (bf16_t)f2bf(bflo(kx.x) * wv); *(LAS bf16_t*)(o + 1 * 144) = (bf16_t)f2bf(bfhi(kx.x) * wv);
            *(LAS bf16_t*)(o + 2 * 144) = (bf16_t)f2bf(bflo(kx.y) * wv); *(LAS bf16_t*)(o + 3 * 144) = (bf16_t)f2bf(bfhi(kx.y) * wv);
            *(LAS bf16_t*)(o + 4 * 144) = (bf16_t)f2bf(bflo(kx.z) * wv); *(LAS bf16_t*)(o + 5 * 144) = (bf16_t)f2bf(bfhi(kx.z) * wv);
            *(LAS bf16_t*)(o + 6 * 144) = (bf16_t)f2bf(bflo(kx.w) * wv); *(LAS bf16_t*)(o + 7 * 144) = (bf16_t)f2bf(bfhi(kx.w) * wv); }
#pragma unroll
        for (int q2 = 0; q2 < 2; ++q2) { const int idx = 2 * w + q2, st = idx >> 2, tt = idx & 3;
            f32x4 sacc = (f32x4){0.f, 0.f, 0.f, 0.f};
            if (st <= tt) {
#pragma unroll
                for (int kk = 0; kk < 4; ++kk) sacc = MFMA16(ld_frag_lds(Ks + (16 * st + fr) * 272 + 16 * fq + 64 * kk), ld_frag_lds(Qs + (16 * tt + fr) * 272 + 16 * fq + 64 * kk), sacc);
            }
            const int t = 16 * tt + fr; const float Mt = Ms[t]; float p[4], rsum = 0.f;
#pragma unroll
            for (int i = 0; i < 4; ++i) { const int s = 16 * st + 4 * fq + i; p[i] = (s <= t) ? sacc[i] * __expf(us[s] - Mt) : 0.f; rsum += p[i]; }
            u32x2 wv; wv.x = cvt_pk_bf16(p[0], p[1]); wv.y = cvt_pk_bf16(p[2], p[3]);
            *(LAS u32x2*)(Ss + t * 144 + (16 * st + 4 * fq) * 2) = wv;
            rsum += __shfl_xor(rsum, 16); rsum += __shfl_xor(rsum, 32);
            if (fq == 0) den[st * 64 + t] = rsum; }
        { const int t = Fi.tid & 63, pp = Fi.tid >> 6; const u32x4 qa = *(const LAS u32x4*)(Qs + t * 272 + 32 * pp), qb = *(const LAS u32x4*)(Qs + t * 272 + 32 * pp + 16);
            const f32x4 n0v = *(const LAS f32x4*)(npv + 16 * pp), n1v = *(const LAS f32x4*)(npv + 16 * pp + 4), n2v = *(const LAS f32x4*)(npv + 16 * pp + 8), n3v = *(const LAS f32x4*)(npv + 16 * pp + 12);
            float sacc = 0.f;
            sacc += bflo(qa.x) * n0v[0]; sacc += bfhi(qa.x) * n0v[1]; sacc += bflo(qa.y) * n0v[2]; sacc += bfhi(qa.y) * n0v[3];
            sacc += bflo(qa.z) * n1v[0]; sacc += bfhi(qa.z) * n1v[1]; sacc += bflo(qa.w) * n1v[2]; sacc += bfhi(qa.w) * n1v[3];
            sacc += bflo(qb.x) * n2v[0]; sacc += bfhi(qb.x) * n2v[1]; sacc += bflo(qb.y) * n2v[2]; sacc += bfhi(qb.y) * n2v[3];
            sacc += bflo(qb.z) * n3v[0]; sacc += bfhi(qb.z) * n3v[1]; sacc += bflo(qb.w) * n3v[2]; sacc += bfhi(qb.w) * n3v[3];
            qn[pp * 64 + t] = sacc; }
        __syncthreads();
        f32x4 acc[2][4];
#pragma unroll
        for (int dv = 0; dv < 2; ++dv)
#pragma unroll
            for (int tt = 0; tt < 4; ++tt) acc[dv][tt] = (f32x4){0.f, 0.f, 0.f, 0.f};
#pragma unroll
        for (int kk = 0; kk < 4; ++kk) {
            bf16x8 Bq[4];
#pragma unroll
            for (int tt = 0; tt < 4; ++tt) { const LAS unsigned char* qp = Qs + (16 * tt + fr) * 272 + 64 * kk + 8 * fq; const u32x2 lo = *(const LAS u32x2*)qp, hi = *(const LAS u32x2*)(qp + 32); Bq[tt] = mk_frag(lo.x, lo.y, hi.x, hi.y); }
#pragma unroll
            for (int dv = 0; dv < 2; ++dv) { const f32x4 c0 = Cst[dv][2 * kk], c1 = Cst[dv][2 * kk + 1];
                const bf16x8 Ac = mk_frag(cvt_pk_bf16(c0[0], c0[1]), cvt_pk_bf16(c0[2], c0[3]), cvt_pk_bf16(c1[0], c1[1]), cvt_pk_bf16(c1[2], c1[3]));
#pragma unroll
                for (int tt = 0; tt < 4; ++tt) acc[dv][tt] = MFMA16(Ac, Bq[tt], acc[dv][tt]); }
            __builtin_amdgcn_sched_barrier(0);
        }
#pragma unroll
        for (int tt = 0; tt < 4; ++tt) { const float wi = wint[16 * tt + fr];
#pragma unroll
            for (int dv = 0; dv < 2; ++dv) acc[dv][tt] *= wi; }
#pragma unroll
        for (int kk = 0; kk < 2; ++kk) {
            bf16x8 Bs[4], Avk[2];
#pragma unroll
            for (int dv = 0; dv < 2; ++dv) { const int dvr = 16 * (2 * w + dv) + fr; const LAS unsigned* vp = VT + dvr * 33; const int p0 = 4 * fq + 16 * kk; Avk[dv] = mk_frag(vp[vt_col(dvr, p0)], vp[vt_col(dvr, p0 + 1)], vp[vt_col(dvr, p0 + 2)], vp[vt_col(dvr, p0 + 3)]); }
#pragma unroll
            for (int tt = 0; tt < 4; ++tt) Bs[tt] = ld_frag_lds(Ss + (16 * tt + fr) * 144 + 16 * fq + 64 * kk);
#pragma unroll
            for (int dv = 0; dv < 2; ++dv)
#pragma unroll
                for (int tt = 0; tt < 4; ++tt) acc[dv][tt] = MFMA16(Avk[dv], Bs[tt], acc[dv][tt]);
            __builtin_amdgcn_sched_barrier(0);
        }
        LAS float* redw = (LAS float*)(F.lds + B4_RED) + w * 64;
        { const int t = lane; const float qnt = ((qn[t] + qn[64 + t]) + (qn[128 + t] + qn[192 + t])) + ((qn[256 + t] + qn[320 + t]) + (qn[384 + t] + qn[448 + t]));
            const float dn = ((den[t] + den[64 + t]) + (den[128 + t] + den[192 + t])) + wint[t] * qnt; redw[t] = 1.0f / fmaxf(fabsf(dn), eneg[t]); }
        LDS_WAIT(); asm volatile("" ::: "memory");
#pragma unroll
        for (int tt = 0; tt < 4; ++tt) { const int t = 16 * tt + fr; const float inv = redw[t];
            float q = 0.f;
#pragma unroll
            for (int dv = 0; dv < 2; ++dv) { acc[dv][tt] *= inv; const f32x4 v = acc[dv][tt] * acc[dv][tt]; q += (v[0] + v[1]) + (v[2] + v[3]); }
            q += __shfl_xor(q, 16); q += __shfl_xor(q, 32);
            if (fq == 0) hss[w * 64 + t] = q; }
        __syncthreads();
        { const int t = lane; const float hs = ((hss[t] + hss[64 + t]) + (hss[128 + t] + hss[192 + t])) + ((hss[256 + t] + hss[320 + t]) + (hss[384 + t] + hss[448 + t]));
            redw[t] = 1.0f / sqrtf(hs * (1.0f / 256.0f) + EPS); }
        LDS_WAIT(); asm volatile("" ::: "memory");
#pragma unroll
        for (int tt = 0; tt < 4; ++tt) { const int t = 16 * tt + fr; const float rst = redw[t];
#pragma unroll
            for (int dv = 0; dv < 2; ++dv) { const int col = h * 256 + 16 * (2 * w + dv) + 4 * fq;
                const u32x2 og = ogv[tt][dv]; const f32x4 g4 = hgv[dv];
                const float o0 = acc[dv][tt][0] * rst * g4[0] * fast_rcp(1.0f + __expf(-bflo(og.x))), o1 = acc[dv][tt][1] * rst * g4[1] * fast_rcp(1.0f + __expf(-bfhi(og.x)));
                const float o2 = acc[dv][tt][2] * rst * g4[2] * fast_rcp(1.0f + __expf(-bflo(og.y))), o3 = acc[dv][tt][3] * rst * g4[3] * fast_rcp(1.0f + __expf(-bfhi(og.y)));
                u32x2 wv; wv.x = cvt_pk_bf16(o0, o1); wv.y = cvt_pk_bf16(o2, o3);
                *(GAS u32x2*)(OB + (size_t)(n0 + t) * DM + col) = wv; } }
        { const float aa = scal[0];
            bf16x8 Avk[2][2];
#pragma unroll
            for (int kk = 0; kk < 2; ++kk)
#pragma unroll
                for (int dv = 0; dv < 2; ++dv) { const int dvr = 16 * (2 * w + dv) + fr; const LAS unsigned* vp = VT + dvr * 33; const int p0 = 4 * fq + 16 * kk; Avk[kk][dv] = mk_frag(vp[vt_col(dvr, p0)], vp[vt_col(dvr, p0 + 1)], vp[vt_col(dvr, p0 + 2)], vp[vt_col(dvr, p0 + 3)]); }
#pragma unroll
            for (int bt = 0; bt < 2; ++bt)
#pragma unroll
                for (int at = 0; at < 8; ++at) Cst[bt][at] *= aa;
#pragma unroll
            for (int at = 0; at < 8; ++at) { const LAS unsigned char* kp = KwT + (16 * at + fr) * 144 + 16 * fq; const bf16x8 A0 = ld_frag_lds(kp), A1 = ld_frag_lds(kp + 64);
#pragma unroll
                for (int bt = 0; bt < 2; ++bt) { Cst[bt][at] = MFMA16(A0, Avk[0][bt], Cst[bt][at]); Cst[bt][at] = MFMA16(A1, Avk[1][bt], Cst[bt][at]); } }
            if (Fi.tid >= 64 && Fi.tid < 192) { const int dk = Fi.tid - 64; const LAS unsigned char* kr = KwT + dk * 144; float sum = 0.f;
#pragma unroll
                for (int q8 = 0; q8 < 8; ++q8) { const u32x4 x = *(const LAS u32x4*)(kr + 16 * q8); sum += ((bflo(x.x) + bfhi(x.x)) + (bflo(x.y) + bfhi(x.y))) + ((bflo(x.z) + bfhi(x.z)) + (bflo(x.w) + bfhi(x.w))); }
                npv[dk] = aa * npv[dk] + sum; } }
    }
#undef B4_FETCH
}


#ifdef PROBE_BUF
__device__ __forceinline__ void probe_scan(const Frame& F, const Args& a) {
    unsigned* ctl = (unsigned*)(a.ws + WS_CTL);
    unsigned bad = 0; float ms = 0.f;
    for (size_t i = (size_t)F.vcu * 512 + F.tid; i < (size_t)(PROBE_N); i += (size_t)F.G * 512) {
        float v;
        if (PROBE_KIND == 0) v = bf2f(((const bf16_t*)(a.ws + PROBE_BUF))[i]); else v = ((const float*)(a.ws + PROBE_BUF))[i];
        if (fabsf(v) < 1e30f) ms += v * v; else ++bad;
    }
    if (PROBE_STAT == 2) { bad = 0; ms = 0.f;
        for (int u = F.vcu * 8 + F.wave; u < (int)((PROBE_N) / 32768); u += F.G * 8) { unsigned b2 = 0;
            for (int i = F.lane; i < 32768; i += 64) { const float v = bf2f(((const bf16_t*)(a.ws + PROBE_BUF))[(size_t)u * 32768 + i]); if (!(fabsf(v) < 1e30f)) b2 = 1; }
            b2 = __any(b2) ? 1u : 0u; if (F.lane == 0) bad += b2 * 32768u; } }
    atomicAdd(ctl + 20000, bad); atomicAdd((float*)(ctl + 20064), ms);
}
__device__ __forceinline__ void probe_fill(const Frame& F, const Args& a) {
    const unsigned* ctl = (const unsigned*)(a.ws + WS_CTL);
    const float f = (float)ctl[20000] / (float)(PROBE_N), msq = ((const float*)ctl)[20064] / (float)(PROBE_N);
    const float c = sqrtf(PROBE_STAT != 1 ? 10.0f * f : msq);
    for (size_t i = (size_t)F.vcu * 512 + F.tid; i < (size_t)NTOK * DM; i += (size_t)F.G * 512) a.out[i] = c;
}
#endif
constexpr int NPHASE = 1 + NLAYER * 10;

typedef const __attribute__((address_space(4))) Args* KArgsPtr;
__device__ __forceinline__ Args opaque_args() {
#if defined(__HIP_DEVICE_COMPILE__)
    KArgsPtr p = (KArgsPtr)__builtin_amdgcn_kernarg_segment_ptr(); asm volatile("" : "+s"(p)); return *p;
#else
    return Args{};
#endif
}
#define SITE() const Frame FP = make_frame(lds); const Args A = opaque_args(); unsigned char* const ws = A.ws; (void)ws
__global__ void __launch_bounds__(512, 2) mk_fwd(Args args) {
    extern __shared__ __attribute__((aligned(16))) unsigned char lds_raw[];
    LAS unsigned char* const lds = (LAS unsigned char*)lds_raw;
    volatile LAS unsigned* MISC = (volatile LAS unsigned*)(lds + MISC_OFF);
    if (threadIdx.x < 32) MISC[threadIdx.x] = 0u;
    __syncthreads();
    const int lo = args.ph_lo, hi = args.ph_hi;
    XcdBarrier bar; bar.bar = (unsigned*)(args.ws + WS_CTL) + CW_BAR; bar.x = 0; bar.st = nullptr;
    if (hi - lo > 1) bar = xcd_barrier_post((unsigned*)(args.ws + WS_CTL) + CW_BAR, MISC + 8);
#define IN(k) (lo <= (k) && (k) < hi)
#ifdef XBAR_EXTRA
#define SEAM(k) do { if (IN(k) && IN((k) + 1)) { xcd_barrier(bar); xcd_barrier(bar); } } while (0)
#else
#define SEAM(k) do { if (IN(k) && IN((k) + 1)) xcd_barrier(bar); } while (0)
#endif
    if (PHON(0) && IN(0)) for (int rep_ = 0; rep_ < NREP(0); ++rep_) { SITE(); p0_weights(FP, A); phase_x0(FP, A); }
    SEAM(0);
    for (int l = 0; l < NLAYER; ++l) {
        const int pb = 1 + l * 10, j = l >> 1;
        if ((l & 1) == 0) {
            if (PHON(1) && IN(pb)) for (int rep_ = 0; rep_ < NREP(1); ++rep_) { SITE(); pg8::Gemm g{(const bf16_t*)(ws + WS_XB), (const bf16_t*)(ws + WS_WQKV) + (size_t)j * 3072 * DM, DM, 0, nullptr, nullptr, nullptr};
                pg8::StaticOrder S; S.init(NTOK / 256, 12, FP.G, (int)blockIdx.x, nullptr);
                pg8::EpiQKV E{(bf16_t*)(ws + WS_QKV), (const float*)(ws + SM_RSTD), A.in[4] + j * 64, A.in[5] + j * 64, 0.125f * LOG2E};
                pg8::gemm_phase<pg8::EpiQKV, true, false>(lds, FP.tid, g, S, E); }
            SEAM(pb);
            if (PHON(2) && IN(pb + 1)) for (int rep_ = 0; rep_ < NREP(2); ++rep_) { SITE(); phase_attn_a(FP, A, j); }
            SEAM(pb + 1);
            if (PHON(3) && IN(pb + 2)) for (int rep_ = 0; rep_ < NREP(3); ++rep_) { SITE(); phase_attn_b(FP, A, j); }
            if (IN(pb + 2) && IN(pb + 4)) xcd_barrier(bar);
            if (PHON(4) && IN(pb + 4)) { SITE(); pg8::Gemm g{(const bf16_t*)(ws + WS_OB), (const bf16_t*)(ws + WS_WO) + (size_t)j * DM * DM, DM, 0, nullptr, nullptr, nullptr};
                pg8::StaticOrder S; S.init(NTOK / 256, 4, FP.G, (int)blockIdx.x, nullptr);
                pg8::EpiResidB E{(bf16_t*)(ws + WS_XB)};
                pg8::gemm_phase<pg8::EpiResidB, true, false, true>(lds, FP.tid, g, S, E); }
            SEAM(pb + 4);
        } else {
            if (PHON(5) && IN(pb)) for (int rep_ = 0; rep_ < NREP(5); ++rep_) { SITE(); pg8::Gemm g{(const bf16_t*)(ws + WS_XB), (const bf16_t*)(ws + WS_WIN) + (size_t)j * 3072 * DM, DM, 0, nullptr, nullptr, nullptr};
                pg8::StaticOrder S; S.init(NTOK / 256, 12, FP.G, (int)blockIdx.x, nullptr);
                pg8::EpiBf16 E{(bf16_t*)(ws + WS_QKV), 3072, (const float*)(ws + SM_RSTD)};
                pg8::gemm_phase<pg8::EpiBf16, true, false>(lds, FP.tid, g, S, E); }
            SEAM(pb);
            if (PHON(6) && IN(pb + 1)) for (int rep_ = 0; rep_ < NREP(6); ++rep_) { SITE(); phase_mlstm_local(FP, A, j); }
            SEAM(pb + 1);
            if (PHON(7) && IN(pb + 2)) for (int rep_ = 0; rep_ < NREP(7); ++rep_) { SITE(); phase_mlstm_scan(FP, A); }
            SEAM(pb + 2);
            if (PHON(8) && IN(pb + 3)) for (int rep_ = 0; rep_ < NREP(8); ++rep_) { SITE(); phase_mlstm_out(FP, A, j); }
            SEAM(pb + 3);
            if (PHON(9) && IN(pb + 4)) { SITE(); pg8::Gemm g{(const bf16_t*)(ws + WS_OB), (const bf16_t*)(ws + WS_WMO) + (size_t)j * DM * DM, DM, 0, nullptr, nullptr, nullptr};
                pg8::StaticOrder S; S.init(NTOK / 256, 4, FP.G, (int)blockIdx.x, nullptr);
                pg8::EpiResidB E{(bf16_t*)(ws + WS_XB)};
                pg8::gemm_phase<pg8::EpiResidB, true, false>(lds, FP.tid, g, S, E); }
            SEAM(pb + 4);
        }
        if (PHON(10) && IN(pb + 5)) for (int rep_ = 0; rep_ < NREP(10); ++rep_) { SITE(); phase_router(FP, A, l, rep_ + 1 < NREP(10)); }
        if (IN(pb + 5) && IN(pb + 7)) xcd_barrier(bar);
        if (PHON(12) && IN(pb + 7)) for (int rep_ = 0; rep_ < NREP(12); ++rep_) { SITE();
            LAS int* pst = (LAS int*)(lds + MOE_TAB_OFF); LAS int* cnt = (LAS int*)(lds + MOE_TAB_OFF + 512);
            const int ntiles = __builtin_amdgcn_readfirstlane(moe_tables(FP, (const unsigned*)(ws + WS_CTL) + CW_CNT + l * 64, pst, cnt));
            pg8::Gemm g{(const bf16_t*)(ws + WS_XB), (const bf16_t*)(ws + WS_WGU) + (size_t)l * 64 * DM * DM, DM, (size_t)DM * DM * 2, (const int*)(ws + WS_QC), pst, cnt};
            pg8::StaticOrder S; S.init(ntiles, 4, FP.G, (int)blockIdx.x, pst);
            pg8::EpiGU E{(bf16_t*)(ws + WS_ACT), (const float*)(ws + SM_RSTD), (const int*)(ws + WS_QC), pst, cnt};
            pg8::gemm_phase<pg8::EpiGU, true, true>(lds, FP.tid, g, S, E); }
        SEAM(pb + 7);
        if (PHON(13) && IN(pb + 8)) for (int rep_ = 0; rep_ < NREP(13); ++rep_) { SITE();
            LAS int* pst = (LAS int*)(lds + MOE_TAB_OFF); LAS int* cnt = (LAS int*)(lds + MOE_TAB_OFF + 512);
            const int ntiles = __builtin_amdgcn_readfirstlane(moe_tables(FP, (const unsigned*)(ws + WS_CTL) + CW_CNT + l * 64, pst, cnt));
            pg8::Gemm g{(const bf16_t*)(ws + WS_ACT), (const bf16_t*)(ws + WS_WD) + (size_t)l * 64 * DM * FFE, FFE, (size_t)DM * FFE * 2, nullptr, pst, cnt};
            pg8::StaticOrder S; S.init(ntiles, 4, FP.G, (int)blockIdx.x, pst);
            pg8::EpiBf16 E{(bf16_t*)(ws + WS_YB), DM, nullptr};
            pg8::gemm_phase<pg8::EpiBf16, true, false>(lds, FP.tid, g, S, E); }
        SEAM(pb + 8);
        if (PHON(14) && IN(pb + 9)) { SITE(); phase_combine(FP, A, l); }
        SEAM(pb + 9);
    }
#ifdef PROBE_BUF
    if (IN(NPHASE)) { SITE(); probe_scan(FP, A); }
    if (IN(NPHASE + 1)) { SITE(); probe_fill(FP, A); }
#endif
#undef IN
#undef SEAM
}

extern "C" void kernel_launch(void* const* d_in, const int* in_sizes, int n_in, void* d_out, int out_size, void* d_ws, size_t ws_size, hipStream_t stream) {
    static int grid = 0;
    if (grid == 0) {
        if (n_in != 20 || out_size != NTOK * DM || ws_size < WS_END) { fprintf(stderr, "kernel_launch: unexpected shapes (n_in %d, out %d, ws %zu < %zu); nothing launched\n", n_in, out_size, ws_size, (size_t)WS_END); grid = -1; return; }
        int dev = 0, cus = 0, per_cu = 0;
        if (hipGetDevice(&dev) != hipSuccess || hipDeviceGetAttribute(&cus, hipDeviceAttributeMultiprocessorCount, dev) != hipSuccess) { grid = -1; return; }
        if (hipFuncSetAttribute((const void*)mk_fwd, hipFuncAttributeMaxDynamicSharedMemorySize, LDS_BYTES) != hipSuccess) { fprintf(stderr, "kernel_launch: hipFuncSetAttribute failed\n"); grid = -1; return; }
        if (hipOccupancyMaxActiveBlocksPerMultiprocessor(&per_cu, (const void*)mk_fwd, 512, LDS_BYTES) != hipSuccess || per_cu < 1) { fprintf(stderr, "kernel_launch: occupancy query says %d\n", per_cu); }
        (void)hipGetLastError();
        grid = cus;
        if (grid != 256) { fprintf(stderr, "kernel_launch: built for a 256-CU device, found %d CUs; nothing launched\n", cus); grid = -1; return; }
    }
    if (grid < 0) return;
    if (hipMemsetAsync((char*)d_ws + WS_CTL, 0, CTL_ZERO_BYTES, stream) != hipSuccess) return;
    Args a{};
    for (int i = 0; i < 20; ++i) a.in[i] = (const float*)d_in[i];
    a.out = (float*)d_out; a.ws = (unsigned char*)d_ws;
#if MK_ONE_LAUNCH
    a.ph_lo = 0; a.ph_hi = NPHASE;
    hipLaunchKernelGGL(mk_fwd, dim3(grid), dim3(512), LDS_BYTES, stream, a);
#else
    int np = NPHASE;
#ifdef PROBE_BUF
    np += 2;
#endif
    for (int p = 0; p < np; ++p) { a.ph_lo = p; a.ph_hi = p + 1; hipLaunchKernelGGL(mk_fwd, dim3(grid), dim3(512), LDS_BYTES, stream, a); }
#endif
}
```

```cpp
#include <hip/hip_runtime.h>
#include <cstdio>
#include <cstdint>

#ifndef MK_ONE_LAUNCH
#define MK_ONE_LAUNCH 1
#endif

#ifndef PHMASK
#define PHMASK 0xFFFFFFFFu
#endif
#define PHON(n) ((PHMASK >> (n)) & 1u)
#ifndef REPMASK
#define REPMASK 0u
#endif
#define NREP(n) (1 + (int)((REPMASK >> (n)) & 1u))
#ifdef DBG_NOGATES
#define DBGG(x) 0.0f
#else
#define DBGG(x) (x)
#endif

#define LAS __attribute__((address_space(3)))
#define GAS __attribute__((address_space(1)))
typedef unsigned short bf16_t;
typedef short bf16x8 __attribute__((ext_vector_type(8)));
typedef float f32x4 __attribute__((ext_vector_type(4)));
typedef float f32x2 __attribute__((ext_vector_type(2)));
typedef unsigned u32x4 __attribute__((ext_vector_type(4)));
typedef unsigned u32x2 __attribute__((ext_vector_type(2)));

constexpr int NTOK = 32768, SEQ = 16384, DM = 1024, NLAYER = 4;
constexpr int NEXP = 64, FFE = 512;
constexpr int PMAX = 81920;
constexpr float EPS = 1e-6f;
constexpr float LOG2E = 1.4426950408889634f;

constexpr size_t MiB = 1u << 20;
constexpr size_t WS_CTL = 0, CTL_ZERO_BYTES = 1 * MiB;
constexpr size_t WS_WQKV = 2 * MiB, WS_WO = 14 * MiB, WS_WIN = 18 * MiB, WS_WMO = 30 * MiB, WS_WR = 34 * MiB, WS_WG = 36 * MiB;
constexpr size_t WS_SMALL = 37 * MiB;
constexpr size_t SM_RSTD = WS_SMALL, SM_GATES = WS_SMALL + 256 * 1024, SM_TOKE = WS_SMALL + 1280 * 1024, SM_TOKG = WS_SMALL + 1536 * 1024,
                 SM_TOKP = WS_SMALL + 1792 * 1024, SM_ROWTOK = WS_SMALL + 2 * MiB, SM_TILEEXP = WS_SMALL + 2 * MiB + 512 * 1024,
                 SM_MLOC = WS_SMALL + 2 * MiB + 768 * 1024, SM_BL = SM_MLOC + 8192, SM_MPREV = SM_MLOC + 16384,
                 SM_DN = WS_SMALL + 3 * MiB, SM_NS = WS_SMALL + 4 * MiB, SM_L1 = WS_SMALL + 5 * MiB, SM_L2 = WS_SMALL + 7 * MiB;
constexpr size_t WS_WGU = 64 * MiB, WS_WD = 576 * MiB, WS_XB = 832 * MiB, WS_QKV = 898 * MiB, WS_OB = 1090 * MiB,
                 WS_P1 = 1170 * MiB, WS_P2 = 1234 * MiB, WS_CS = 1298 * MiB, WS_QC = 1426 * MiB, WS_KC = 1458 * MiB, WS_END = 1490 * MiB;
constexpr size_t WS_YB = WS_QKV, WS_ACT = WS_OB, WS_DC = WS_P1;
constexpr int CW_BAR = 4096, CW_CNT = 16384;

constexpr int LDS_BYTES = 147456;
constexpr int MISC_OFF = 147456 - 512;

__device__ __forceinline__ unsigned f2bf(float f) { unsigned u = __builtin_bit_cast(unsigned, f); return (u + 0x7fffu + ((u >> 16) & 1u)) >> 16; }
__device__ __forceinline__ float bf2f(unsigned h) { return __builtin_bit_cast(float, h << 16); }
typedef __bf16 bf16x2_t __attribute__((ext_vector_type(2)));
__device__ __forceinline__ unsigned cvt_pk_bf16(float lo, float hi) { f32x2 v = {lo, hi}; bf16x2_t r = __builtin_convertvector(v, bf16x2_t); return __builtin_bit_cast(unsigned, r); }
__device__ __forceinline__ float bflo(unsigned w) { return __builtin_bit_cast(float, w << 16); }
__device__ __forceinline__ float bfhi(unsigned w) { return __builtin_bit_cast(float, w & 0xffff0000u); }
__device__ __forceinline__ float fast_exp2(float x) { return __builtin_amdgcn_exp2f(x); }
__device__ __forceinline__ float fast_rcp(float x) { return __builtin_amdgcn_rcpf(x); }
#define LDS_WAIT() asm volatile("s_waitcnt lgkmcnt(0)" ::: "memory")
#define VM_WAIT() asm volatile("s_waitcnt vmcnt(0)" ::: "memory")

#define XB_TMO      128
#define XB_XCNT(j)  (256  + 64 * (j))
#define XB_XSUB(j)  (1280 + 64 * (j))
#define XB_XGEN(j)  (2304 + 64 * (j))
#define XB_TOP      3328
#define XB_TOPGEN   3392
#define XCD_BAR_WORDS 3456
#define XB_SPIN_CAP (1u << 18)
__device__ __forceinline__ unsigned xb_ld(unsigned* p)              { return __hip_atomic_load(p, __ATOMIC_RELAXED, __HIP_MEMORY_SCOPE_AGENT); }
__device__ __forceinline__ unsigned xb_add(unsigned* p, unsigned v) { return __hip_atomic_fetch_add(p, v, __ATOMIC_RELAXED, __HIP_MEMORY_SCOPE_AGENT); }
__device__ __forceinline__ unsigned xb_xcc_id() { return (unsigned)__builtin_amdgcn_s_getreg((3 << 11) | 20) & 0xFu; }
#define XB_SPIN(cond, bar) do { unsigned _sp = 0; while (cond) { __builtin_amdgcn_s_sleep(1); \
    if ((++_sp & 255u) == 0u) { if (xb_ld(&(bar)[XB_TMO])) break; if (_sp > XB_SPIN_CAP) { atomicAdd(&(bar)[XB_TMO], 1u); break; } } } } while (0)
struct XcdBarrier { unsigned* bar; unsigned x; volatile LAS unsigned* st; };
__device__ __forceinline__ XcdBarrier xcd_barrier_post(unsigned* bar, volatile LAS unsigned* st) {
    XcdBarrier b; b.bar = bar; b.x = xb_xcc_id(); b.st = st;
    if (threadIdx.x == 0) (void)xb_add(&bar[XB_XCNT(b.x)], 1u);
    return b;
}
__device__ __forceinline__ void xcd_barrier_complete(unsigned* bar, unsigned x, unsigned& nloc, unsigned& nx) {
    const unsigned G = gridDim.x * gridDim.y * gridDim.z;
    unsigned sum, cnt, mine, sp = 0u;
    for (;;) {
        sum = 0u; cnt = 0u; mine = 0u;
#pragma unroll
        for (unsigned j = 0; j < 16; ++j) { const unsigned c = xb_ld(&bar[XB_XCNT(j)]); sum += c; cnt += (c > 0u) ? 1u : 0u; mine = (j == x) ? c : mine; }
        if (sum == G) break;
        __builtin_amdgcn_s_sleep(1);
        if ((++sp & 255u) == 0u) { if (xb_ld(&bar[XB_TMO])) break; if (sp > XB_SPIN_CAP) { atomicAdd(&bar[XB_TMO], 1u); break; } }
    }
    nloc = mine > 0u ? mine : 1u; nx = cnt > 0u ? cnt : 1u;
}
__device__ __forceinline__ void xcd_barrier(const XcdBarrier& b) {
    asm volatile("s_waitcnt vmcnt(0)" ::: "memory");
    __syncthreads();
    if (threadIdx.x == 0) {
        unsigned* bar = b.bar;
        __builtin_amdgcn_s_waitcnt(0);
        unsigned nloc = b.st[0], nx = b.st[1];
        if (nloc == 0u) { xcd_barrier_complete(bar, b.x, nloc, nx); b.st[0] = nloc; b.st[1] = nx; }
        const unsigned old = xb_add(&bar[XB_XSUB(b.x)], 1u);
        const unsigned gen = old / nloc;
        if (old + 1u == (gen + 1u) * nloc) {
            __builtin_amdgcn_fence(__ATOMIC_RELEASE, "agent");
            asm volatile("s_waitcnt vmcnt(0)" ::: "memory");
            const unsigned og = xb_add(&bar[XB_TOP], 1u);
            const unsigned tg = og / nx;
            if (og + 1u == (tg + 1u) * nx) xb_add(&bar[XB_TOPGEN], 1u);
            else XB_SPIN(xb_ld(&bar[XB_TOPGEN]) == tg, bar);
            __builtin_amdgcn_fence(__ATOMIC_ACQUIRE, "agent");
            xb_add(&bar[XB_XGEN(b.x)], 1u);
            asm volatile("s_waitcnt vmcnt(0)" ::: "memory");
        } else {
            XB_SPIN(xb_ld(&bar[XB_XGEN(b.x)]) == gen, bar);
            __builtin_amdgcn_fence(__ATOMIC_ACQUIRE, "agent");
            asm volatile("s_waitcnt vmcnt(0)" ::: "memory");
        }
    }
    __syncthreads();
}

namespace pg8 {
constexpr int BM = 256, BK = 64, HALF = 128, HTB = HALF * BK * 2, STAGE_BYTES = 8 * HTB, NXCD = 8, WGM = 8;
__host__ __device__ __forceinline__ int lds_byte(int r, int c) { const int st = (r >> 4) * 2 + (c >> 5), rr = r & 15, cc = c & 31, ob = rr * 64 + cc * 2; return st * 1024 + (ob ^ (((ob >> 9) & 1) << 5)); }
__host__ __device__ __forceinline__ void stage_rc(int b, int& R, int& C) { const int st = b / 1024, sb = b % 1024, swz = sb ^ (((sb >> 9) & 1) << 5); R = (st >> 1) * 16 + swz / 64; C = (st & 1) * 32 + (swz % 64) / 2; }
__host__ __device__ __forceinline__ int perm32(int rho) { const int n = rho >> 4, i = rho & 15; return 8 * (i >> 2) + 4 * n + (i & 3); }

struct Unit { int pm, pn, e; };
struct Gemm { const bf16_t* A; const bf16_t* Bt; int K; size_t b_estride; const int* sparse; const LAS int* pst; const LAS int* cnt; };

struct StaticOrder {
    int nM, nN, nwg, G, c; const LAS int* pst;
    __device__ void init(int nM_, int nN_, int G_, int c_, const LAS int* pst_) { nM = nM_; nN = nN_; nwg = nM * nN; G = G_; c = c_; pst = pst_; }
    __device__ bool next(int i, Unit& u) const {
        const long L = (long)i * G + c; if (L >= nwg) return false;
        int wgid = (int)L; { const int q = nwg / NXCD, r = nwg % NXCD, xcd = wgid % NXCD, off = wgid / NXCD; wgid = (xcd < r ? xcd * (q + 1) : r * (q + 1) + (xcd - r) * q) + off; }
        const int nig = WGM * nN, gid = wgid / nig, fm = gid * WGM, gsz = (nM - fm) < WGM ? (nM - fm) : WGM;
        u.pm = fm + ((wgid % nig) % gsz); u.pn = (wgid % nig) / gsz;
        u.e = pst ? __builtin_amdgcn_readfirstlane(pst[256 + u.pm]) : 0;
        return true;
    }
};

template <class Epi, bool ALIGN_EPI, bool GATHER, bool A_HM = false>
__device__ __forceinline__ void gemm_phase(LAS unsigned char* lds, const int tid, const Gemm g, const StaticOrder& S, const Epi& E) {
    const int wid = __builtin_amdgcn_readfirstlane(tid >> 6), lane = tid & 63, wr = wid >> 2, wc = wid & 3, fr = lane & 15, fq = lane >> 4;
    const int K = g.K, nt = K / BK;
    int RA[2], CA[2]; unsigned voffB[2];
#pragma unroll
    for (int i = 0; i < 2; ++i) { int R, C; stage_rc(tid * 16 + i * 8192, R, C); const int Rb = Epi::PERM ? ((R & ~31) + perm32(R & 31)) : R;
        RA[i] = R; CA[i] = C; voffB[i] = (unsigned)(Rb * K + C) * 2u; }
    const size_t kstep = (size_t)(BK * 2);
    const size_t hstep = (size_t)HALF * K * 2;
    const size_t tstep = 2 * hstep;
    const size_t akstep = A_HM ? (size_t)16384 * 128 : kstep, ahstep = A_HM ? (size_t)HALF * 128 : hstep;
#define PG8_ABASE(pm_) (A_HM ? ((size_t)((pm_) >> 6) * 16 * 16384 + (size_t)((pm_) & 63) * 256) * 128 : (size_t)(pm_) * tstep)
    const unsigned ldsw = (unsigned)wid * 1024u;
    const int aoff = lds_byte(wr * 64 + fr, fq * 8), boff = lds_byte(wc * 32 + fr, fq * 8);
#define PG8_SA(b, h) (((b) * 2 + (h)) * HTB)
#define PG8_SB(b, h) ((4 + (b) * 2 + (h)) * HTB)
#define PG8_STAGE(bufoff, gbase, voff) do { _Pragma("unroll") for (int _i = 0; _i < 2; ++_i) \
        __builtin_amdgcn_global_load_lds((const unsigned*)((const char*)(gbase) + (voff)[_i]), (LAS unsigned*)(lds + (bufoff) + ldsw + _i * 8192), 16, 0, 0); } while (0)
#define PG8_LDA(dst, b, h) do { _Pragma("unroll") for (int m = 0; m < 4; ++m) _Pragma("unroll") for (int k = 0; k < 2; ++k) dst[m][k] = *(const LAS bf16x8*)(lds + PG8_SA(b, h) + aoff + m * 2048 + k * 1024); } while (0)
#define PG8_LDB(dst, b, h) do { _Pragma("unroll") for (int n = 0; n < 2; ++n) _Pragma("unroll") for (int k = 0; k < 2; ++k) dst[n][k] = *(const LAS bf16x8*)(lds + PG8_SB(b, h) + boff + n * 2048 + k * 1024); } while (0)
#define PG8_MMA(ai, bj, At, Bt) do { __builtin_amdgcn_s_setprio(1); _Pragma("unroll") for (int m = 0; m < 4; ++m) _Pragma("unroll") for (int n = 0; n < 2; ++n) _Pragma("unroll") for (int k = 0; k < 2; ++k) \
        acc[ai][bj][m][n] = __builtin_amdgcn_mfma_f32_16x16x32_bf16(Bt[n][k], At[m][k], acc[ai][bj][m][n], 0, 0, 0); __builtin_amdgcn_s_setprio(0); } while (0)
#define PG8_WAIT_V(n) asm volatile("s_waitcnt vmcnt(" #n ")" ::: "memory")
#define PG8_WAIT_L(n) asm volatile("s_waitcnt lgkmcnt(" #n ")" ::: "memory")
#define PG8_BAR __builtin_amdgcn_s_barrier()
#define PG8_SCHED __builtin_amdgcn_sched_barrier(0)
#define PG8_AOFFS(dst, unit) do { _Pragma("unroll") for (int _h = 0; _h < 2; ++_h) _Pragma("unroll") for (int _i = 0; _i < 2; ++_i) { \
        const int _j = (unit).pm * BM + _h * HALF + RA[_i] - g.pst[(unit).e]; const int _src = (_j < g.cnt[(unit).e]) ? g.sparse[(unit).e * 32768 + _j] : NTOK; dst[_h][_i] = (unsigned)(_src * K + CA[_i]) * 2u; } } while (0)
    Unit cur, nxt; int ui = 0;
    if (!S.next(0, cur)) return;
    f32x4 acc[2][2][4][2];
#pragma unroll
    for (int a = 0; a < 2; ++a)
#pragma unroll
        for (int b = 0; b < 2; ++b)
#pragma unroll
            for (int m = 0; m < 4; ++m)
#pragma unroll
                for (int n = 0; n < 2; ++n) acc[a][b][m][n] = (f32x4){0.f, 0.f, 0.f, 0.f};
    bf16x8 At[4][2], B0[2][2], B1[2][2];
    unsigned voffA[2]; unsigned cAo[2][2], nAo[2][2];
#pragma unroll
    for (int i = 0; i < 2; ++i) voffA[i] = (unsigned)(RA[i] * (A_HM ? 64 : K) + CA[i]) * 2u;
    const char* cA = (const char*)g.A;
    if constexpr (GATHER) { PG8_AOFFS(cAo, cur); } else { cA += PG8_ABASE(cur.pm); }
    const char* cB = (const char*)g.Bt + (size_t)cur.e * g.b_estride + (size_t)cur.pn * tstep;
#define PG8_STAGE_A(bufoff, base, h, nx) do { if constexpr (GATHER) { _Pragma("unroll") for (int _i = 0; _i < 2; ++_i) { const unsigned _o = (nx) ? nAo[h][_i] : cAo[h][_i]; \
            __builtin_amdgcn_global_load_lds((const unsigned*)((const char*)(base) + _o), (LAS unsigned*)(lds + (bufoff) + ldsw + _i * 8192), 16, 0, 0); } } \
        else { PG8_STAGE(bufoff, (base) + (h) * ahstep, voffA); } } while (0)
    PG8_STAGE(PG8_SB(0, 0), cB, voffB); PG8_STAGE(PG8_SB(0, 1), cB + hstep, voffB); PG8_STAGE_A(PG8_SA(0, 0), cA, 0, false); PG8_STAGE_A(PG8_SA(0, 1), cA, 1, false);
    if (wr == 1) PG8_BAR;
    PG8_WAIT_V(2); PG8_BAR;
    PG8_STAGE(PG8_SB(1, 0), cB + kstep, voffB); PG8_STAGE_A(PG8_SA(1, 0), cA + akstep, 0, false); PG8_STAGE(PG8_SB(1, 1), cB + hstep + kstep, voffB);
    PG8_WAIT_V(6); PG8_BAR;
    for (;;) {
        const bool has_next = S.next(ui + 1, nxt);
        const char* nA = cA;
        if constexpr (GATHER) { if (has_next) { PG8_AOFFS(nAo, nxt); } else {
#pragma unroll
            for (int h = 0; h < 2; ++h)
#pragma unroll
                for (int i = 0; i < 2; ++i) nAo[h][i] = cAo[h][i]; } }
        else { if (has_next) nA = (const char*)g.A + PG8_ABASE(nxt.pm); }
        const char* nB = has_next ? (const char*)g.Bt + (size_t)nxt.e * g.b_estride + (size_t)nxt.pn * tstep : cB;
        for (int t = 0; t < nt; t += 2) {
            const bool last = (t == nt - 2);
            const char* a1 = cA + (size_t)(t + 1) * akstep;
            const char* a2 = last ? nA : cA + (size_t)(t + 2) * akstep; const char* b2 = last ? nB : cB + (size_t)(t + 2) * kstep;
            const char* a3 = a2 + akstep; const char* b3 = b2 + kstep;
            PG8_LDB(B0, 0, 0); PG8_LDB(B1, 0, 1); PG8_SCHED; PG8_LDA(At, 0, 0); PG8_STAGE_A(PG8_SA(1, 1), a1, 1, false);
            PG8_WAIT_V(8); PG8_WAIT_L(0); PG8_BAR; PG8_MMA(0, 0, At, B0); PG8_MMA(0, 1, At, B1); PG8_BAR; PG8_SCHED;
            PG8_LDA(At, 0, 1); PG8_STAGE(PG8_SB(0, 0), b2, voffB); PG8_STAGE(PG8_SB(0, 1), b2 + hstep, voffB); PG8_STAGE_A(PG8_SA(0, 0), a2, 0, last);
            PG8_WAIT_V(8); PG8_WAIT_L(0); PG8_BAR; PG8_MMA(1, 0, At, B0); PG8_MMA(1, 1, At, B1); PG8_BAR; PG8_SCHED;
            PG8_LDB(B0, 1, 0); PG8_LDB(B1, 1, 1); PG8_SCHED; PG8_LDA(At, 1, 0); PG8_STAGE_A(PG8_SA(0, 1), a2, 1, last);
            PG8_WAIT_V(8); PG8_WAIT_L(0); PG8_BAR; PG8_MMA(0, 0, At, B0); PG8_MMA(0, 1, At, B1); PG8_BAR; PG8_SCHED;
            PG8_LDA(At, 1, 1); PG8_STAGE(PG8_SB(1, 0), b3, voffB); PG8_STAGE(PG8_SB(1, 1), b3 + hstep, voffB); PG8_STAGE_A(PG8_SA(1, 0), a3, 0, last);
            PG8_WAIT_V(8); PG8_WAIT_L(0); PG8_BAR; PG8_MMA(1, 0, At, B0); PG8_MMA(1, 1, At, B1); PG8_BAR; PG8_SCHED;
        }
        if constexpr (ALIGN_EPI) { if (wr == 0) PG8_BAR; }
        E(acc, cur, wr, wc, fr, fq);
        if (!has_next) break;
#pragma unroll
        for (int a = 0; a < 2; ++a)
#pragma unroll
            for (int b = 0; b < 2; ++b)
#pragma unroll
                for (int m = 0; m < 4; ++m)
#pragma unroll
                    for (int n = 0; n < 2; ++n) acc[a][b][m][n] = (f32x4){0.f, 0.f, 0.f, 0.f};
        cur = nxt; cB = nB; cA = nA; ++ui;
        if constexpr (GATHER) {
#pragma unroll
        for (int h = 0; h < 2; ++h)
#pragma unroll
            for (int i = 0; i < 2; ++i) cAo[h][i] = nAo[h][i]; }
        if constexpr (ALIGN_EPI) { if (wr == 1) PG8_BAR; }
    }
    PG8_WAIT_V(0);
    if constexpr (!ALIGN_EPI) { if (wr == 0) PG8_BAR; }
    PG8_BAR;
#undef PG8_SA
#undef PG8_SB
#undef PG8_STAGE
#undef PG8_LDA
#undef PG8_LDB
#undef PG8_MMA
#undef PG8_WAIT_V
#undef PG8_WAIT_L
#undef PG8_BAR
#undef PG8_SCHED
#undef PG8_AOFFS
#undef PG8_STAGE_A
#undef PG8_ABASE
}


struct EpiQKV {
    static constexpr bool PERM = true;
    bf16_t* O; const float* rstd; const float* qg; const float* kg; float qscale;
    __device__ __forceinline__ void operator()(const f32x4 (&acc)[2][2][4][2], const Unit& u, int wr, int wc, int fr, int fq) const {
        const int part = u.pn >> 2, head = 4 * (u.pn & 3) + wc;
        f32x4 gv[2][2];
#pragma unroll
        for (int bj = 0; bj < 2; ++bj)
#pragma unroll
            for (int n = 0; n < 2; ++n) { const int dim = 32 * bj + 8 * fq + 4 * n;
                if (part == 0) gv[bj][n] = *(const f32x4*)(qg + dim) * qscale; else if (part == 1) gv[bj][n] = *(const f32x4*)(kg + dim); else gv[bj][n] = (f32x4){1.f, 1.f, 1.f, 1.f}; }
#pragma unroll
        for (int ai = 0; ai < 2; ++ai)
#pragma unroll
            for (int m = 0; m < 4; ++m) {
                const int row = u.pm * BM + ai * HALF + wr * 64 + m * 16 + fr; const float rs = rstd[row];
                f32x4 v[2][2]; float ss = 0.f;
#pragma unroll
                for (int bj = 0; bj < 2; ++bj)
#pragma unroll
                    for (int n = 0; n < 2; ++n) { v[bj][n] = acc[ai][bj][m][n] * rs; const f32x4 q = v[bj][n] * v[bj][n]; ss += (q[0] + q[1]) + (q[2] + q[3]); }
                float sc = 1.f;
                if (part < 2) { ss += __shfl_xor(ss, 16); ss += __shfl_xor(ss, 32); sc = 1.0f / sqrtf(ss * (1.0f / 64.0f) + EPS); }
                bf16_t* rowp = O + ((size_t)(part * 32 + (row / SEQ) * 16 + head) * SEQ + (row % SEQ)) * 64 + 8 * fq;
#pragma unroll
                for (int bj = 0; bj < 2; ++bj) { const f32x4 v0 = v[bj][0] * gv[bj][0] * sc, v1 = v[bj][1] * gv[bj][1] * sc;
                    u32x4 w; w.x = cvt_pk_bf16(v0[0], v0[1]); w.y = cvt_pk_bf16(v0[2], v0[3]); w.z = cvt_pk_bf16(v1[0], v1[1]); w.w = cvt_pk_bf16(v1[2], v1[3]);
                    *(u32x4*)(rowp + 32 * bj) = w; }
            }
    }
};
struct EpiBf16 {
    static constexpr bool PERM = true;
    bf16_t* O; int ldc; const float* rscale;
    __device__ __forceinline__ void operator()(const f32x4 (&acc)[2][2][4][2], const Unit& u, int wr, int wc, int fr, int fq) const {
        const int col0 = u.pn * BM + wc * 32 + 8 * fq;
#pragma unroll
        for (int ai = 0; ai < 2; ++ai)
#pragma unroll
            for (int m = 0; m < 4; ++m) { const int row = u.pm * BM + ai * HALF + wr * 64 + m * 16 + fr; const float rs = rscale ? rscale[row] : 1.f;
                bf16_t* rowp = O + (size_t)row * ldc + col0;
#pragma unroll
                for (int bj = 0; bj < 2; ++bj) { const f32x4 v0 = acc[ai][bj][m][0] * rs, v1 = acc[ai][bj][m][1] * rs;
                    u32x4 w; w.x = cvt_pk_bf16(v0[0], v0[1]); w.y = cvt_pk_bf16(v0[2], v0[3]); w.z = cvt_pk_bf16(v1[0], v1[1]); w.w = cvt_pk_bf16(v1[2], v1[3]);
                    *(u32x4*)(rowp + bj * HALF) = w; } }
    }
};
struct EpiResid {
    static constexpr bool PERM = false;
    const float* xin; float* out;
    __device__ __forceinline__ void operator()(const f32x4 (&acc)[2][2][4][2], const Unit& u, int wr, int wc, int fr, int fq) const {
        const int col0 = u.pn * BM + wc * 32 + 4 * fq;
#pragma unroll
        for (int ai = 0; ai < 2; ++ai)
#pragma unroll
            for (int m = 0; m < 4; ++m) { const size_t off = (size_t)(u.pm * BM + ai * HALF + wr * 64 + m * 16 + fr) * DM + col0;
#pragma unroll
                for (int bj = 0; bj < 2; ++bj)
#pragma unroll
                    for (int n = 0; n < 2; ++n) { const f32x4 b = *(const f32x4*)(xin + off + bj * HALF + n * 16); *(f32x4*)(out + off + bj * HALF + n * 16) = b + acc[ai][bj][m][n]; } }
    }
};
struct EpiResidB {
    static constexpr bool PERM = true;
    bf16_t* X;
    __device__ __forceinline__ void operator()(const f32x4 (&acc)[2][2][4][2], const Unit& u, int wr, int wc, int fr, int fq) const {
        const int col0 = u.pn * BM + wc * 32 + 8 * fq;
#pragma unroll
        for (int ai = 0; ai < 2; ++ai)
#pragma unroll
            for (int m = 0; m < 4; ++m) { bf16_t* rowp = X + (size_t)(u.pm * BM + ai * HALF + wr * 64 + m * 16 + fr) * DM + col0;
#pragma unroll
                for (int bj = 0; bj < 2; ++bj) { const u32x4 x = *(const u32x4*)(rowp + bj * HALF); const f32x4 a0 = acc[ai][bj][m][0], a1 = acc[ai][bj][m][1];
                    u32x4 w; w.x = cvt_pk_bf16(bflo(x.x) + a0[0], bfhi(x.x) + a0[1]); w.y = cvt_pk_bf16(bflo(x.y) + a0[2], bfhi(x.y) + a0[3]);
                    w.z = cvt_pk_bf16(bflo(x.z) + a1[0], bfhi(x.z) + a1[1]); w.w = cvt_pk_bf16(bflo(x.w) + a1[2], bfhi(x.w) + a1[3]);
                    *(u32x4*)(rowp + bj * HALF) = w; } }
    }
};
struct EpiGU {
    static constexpr bool PERM = true;
    bf16_t* O; const float* rstd; const int* sparse; const LAS int* pst; const LAS int* cnt;
    __device__ __forceinline__ void operator()(const f32x4 (&acc)[2][2][4][2], const Unit& u, int wr, int wc, int fr, int fq) const {
        const int col0 = u.pn * HALF + wc * 32 + 8 * fq;
#pragma unroll
        for (int ai = 0; ai < 2; ++ai)
#pragma unroll
            for (int m = 0; m < 4; ++m) { const int row = u.pm * BM + ai * HALF + wr * 64 + m * 16 + fr; const int jj = row - pst[u.e]; const float rs = (jj < cnt[u.e]) ? rstd[sparse[u.e * 32768 + jj]] : 0.f;
                float o[8];
#pragma unroll
                for (int n = 0; n < 2; ++n)
#pragma unroll
                    for (int i = 0; i < 4; ++i) { const float gg = acc[ai][0][m][n][i] * rs, uu = acc[ai][1][m][n][i] * rs;
                        o[n * 4 + i] = gg * fast_rcp(1.0f + fast_exp2(-gg * LOG2E)) * uu; }
                u32x4 w; w.x = cvt_pk_bf16(o[0], o[1]); w.y = cvt_pk_bf16(o[2], o[3]); w.z = cvt_pk_bf16(o[4], o[5]); w.w = cvt_pk_bf16(o[6], o[7]);
                *(u32x4*)(O + (size_t)row * FFE + col0) = w; }
    }
};
}

struct Frame {
    LAS unsigned char* lds;
    int tid, lane, wave, vcu, G;
};
struct Args { const float* in[20]; float* out; unsigned char* ws; int ph_lo, ph_hi; };
__device__ __forceinline__ Frame make_frame(LAS unsigned char* lds) {
    Frame F; int t = threadIdx.x; asm volatile("" : "+v"(t));
    F.lds = lds; F.tid = t; F.lane = t & 63; F.wave = __builtin_amdgcn_readfirstlane(t >> 6);
    F.G = gridDim.x; { const int bx = blockIdx.x; F.vcu = (F.G % 8 == 0) ? (bx % 8) * (F.G / 8) + bx / 8 : bx; }
    return F;
}

__device__ __forceinline__ bf16x8 ld_frag_lds(const LAS unsigned char* p) { return *(const LAS bf16x8*)p; }
__device__ __forceinline__ bf16x8 mk_frag(unsigned a, unsigned b, unsigned c, unsigned d) { u32x4 w = {a, b, c, d}; return __builtin_bit_cast(bf16x8, w); }
#define MFMA16(a, b, c) __builtin_amdgcn_mfma_f32_16x16x32_bf16(a, b, c, 0, 0, 0)

struct CvtDesc { const float* src; int ldsrc, k0, scol; const float* kscale; bf16_t* dst; int K, drow; };
__device__ __forceinline__ void cvt_load(const CvtDesc& d, int lane, f32x4 (&v)[8]) {
#pragma unroll
    for (int i = 0; i < 8; ++i) v[i] = __builtin_nontemporal_load((const GAS f32x4*)(d.src + (size_t)(d.k0 + 8 * i + (lane >> 3)) * d.ldsrc + d.scol + 4 * (lane & 7)));
}
__device__ __forceinline__ void cvt_finish(const CvtDesc& d, int lane, const f32x4 (&v)[8], LAS float* scr) {
#pragma unroll
    for (int i = 0; i < 8; ++i) { const int kk = 8 * i + (lane >> 3); const float s = d.kscale ? d.kscale[d.k0 + kk] : 1.f; LAS float* p = scr + kk * 33 + 4 * (lane & 7);
        p[0] = v[i][0] * s; p[1] = v[i][1] * s; p[2] = v[i][2] * s; p[3] = v[i][3] * s; }
    LDS_WAIT(); asm volatile("" ::: "memory");
    const int c = lane & 7;
#pragma unroll
    for (int j = 0; j < 4; ++j) { const int n = (lane >> 3) + 8 * j; const LAS float* s = scr + (8 * c) * 33 + n;
        u32x4 o; o.x = cvt_pk_bf16(s[0 * 33], s[1 * 33]); o.y = cvt_pk_bf16(s[2 * 33], s[3 * 33]); o.z = cvt_pk_bf16(s[4 * 33], s[5 * 33]); o.w = cvt_pk_bf16(s[6 * 33], s[7 * 33]);
        __builtin_nontemporal_store(o, (GAS u32x4*)(d.dst + (size_t)(d.drow + n) * d.K + d.k0 + 8 * c)); }
    LDS_WAIT(); asm volatile("" ::: "memory");
}
__device__ __forceinline__ void cvt_item(const float* src, int ldsrc, int k0, int scol, const float* kscale, bf16_t* dst, int K, int drow, LAS float* scr, int lane) {
    const CvtDesc d{src, ldsrc, k0, scol, kscale, dst, K, drow}; f32x4 v[8]; cvt_load(d, lane, v); cvt_finish(d, lane, v, scr);
}
constexpr int MOE_ITEMS = 64 * 16 * 32 + 64 * 8 * 32;
__device__ __forceinline__ CvtDesc cvt_moe_desc(const Args& a, int l, int it) {
    constexpr int I_GU = 64 * 16 * 32;
    unsigned char* ws = a.ws; CvtDesc d;
    if (it < I_GU) { const int e = it / (16 * 32), q = it % (16 * 32), kb = q / 32, nb = q % 32;
        const int pn = nb >> 3, bj = (nb >> 2) & 1, c32 = nb & 3; const int le = l * 64 + e;
        d.src = (bj ? a.in[18] : a.in[17]) + (size_t)le * DM * FFE; d.ldsrc = FFE; d.k0 = kb * 64; d.scol = 128 * pn + 32 * c32; d.kscale = a.in[2] + (size_t)l * DM;
        d.dst = (bf16_t*)(ws + WS_WGU) + (size_t)le * DM * DM; d.K = DM; d.drow = nb * 32; }
    else { const int r = it - I_GU; const int e = r / (8 * 32), q = r % (8 * 32), kb = q / 32, nb = q % 32; const int le = l * 64 + e;
        d.src = a.in[19] + (size_t)le * FFE * DM; d.ldsrc = DM; d.k0 = kb * 64; d.scol = nb * 32; d.kscale = nullptr;
        d.dst = (bf16_t*)(ws + WS_WD) + (size_t)le * DM * FFE; d.K = FFE; d.drow = nb * 32; }
    return d;
}

__device__ __forceinline__ void p0_weights(const Frame& F, const Args& a) {
    LAS float* scr = (LAS float*)(F.lds + F.wave * 16384);
    const int gw = F.vcu * 8 + F.wave, NGW = F.G * 8;
    unsigned char* ws = a.ws;
    constexpr int I_QKV = 2 * 16 * 96, I_O = 2 * 16 * 32, I_IN = 2 * 16 * 96, I_MO = 2 * 16 * 32;
    constexpr int NITEMS = I_QKV + I_O + I_IN + I_MO;
    for (int it = gw; it < NITEMS; it += NGW) {
        int r = it;
        if (r < I_QKV) { const int j = r / (16 * 96), q = r % (16 * 96), kb = q / 96, nb = q % 96;
            const int pn = nb >> 3, bj = (nb >> 2) & 1, wc = nb & 3, part = pn >> 2, head = 4 * (pn & 3) + wc;
            cvt_item(a.in[3] + (size_t)j * DM * 3072, 3072, kb * 64, part * 1024 + head * 64 + 32 * bj, a.in[1] + (size_t)(2 * j) * DM, (bf16_t*)(ws + WS_WQKV) + (size_t)j * 3072 * DM, DM, nb * 32, scr, F.lane); continue; }
        r -= I_QKV;
        if (r < I_O) { const int j = r / (16 * 32), q = r % (16 * 32), kb = q / 32, nb = q % 32;
            cvt_item(a.in[6] + (size_t)j * DM * DM, DM, kb * 64, nb * 32, nullptr, (bf16_t*)(ws + WS_WO) + (size_t)j * DM * DM, DM, nb * 32, scr, F.lane); continue; }
        r -= I_O;
        if (r < I_IN) { const int j = r / (16 * 96), q = r % (16 * 96), kb = q / 96, nb = q % 96;
            cvt_item(a.in[7] + (size_t)j * DM * 3080, 3080, kb * 64, nb * 32, a.in[1] + (size_t)(2 * j + 1) * DM, (bf16_t*)(ws + WS_WIN) + (size_t)j * 3072 * DM, DM, nb * 32, scr, F.lane); continue; }
        r -= I_IN;
        { const int j = r / (16 * 32), q = r % (16 * 32), kb = q / 32, nb = q % 32;
            cvt_item(a.in[12] + (size_t)j * DM * DM, DM, kb * 64, nb * 32, nullptr, (bf16_t*)(ws + WS_WMO) + (size_t)j * DM * DM, DM, nb * 32, scr, F.lane); }
    }
    {
        const int gt = F.vcu * 512 + F.tid, NT = F.G * 512;
        for (int i = gt; i < 4 * 80 * 1024; i += NT) { const int l = i / (80 * 1024), c = (i / 1024) % 80, k = i % 1024;
            float w = 0.f;
            if (c < 8) w = a.in[13][((size_t)l * DM + k) * 8 + c]; else if (c < 72) w = a.in[15][((size_t)l * DM + k) * 64 + (c - 8)];
            w *= a.in[2][l * DM + k];
            const unsigned hi = f2bf(w); const unsigned lo = f2bf(w - bf2f(hi));
            bf16_t* base = (bf16_t*)(ws + WS_WR) + (size_t)l * 2 * 80 * 1024;
            base[c * 1024 + k] = (bf16_t)hi; base[80 * 1024 + c * 1024 + k] = (bf16_t)lo; }
        for (int i = gt; i < 2 * 16 * 1024; i += NT) { const int j = i / (16 * 1024), c = (i / 1024) % 16, k = i % 1024;
            float w = 0.f; if (c < 8) w = a.in[7][((size_t)j * DM + k) * 3080 + 3072 + c] * a.in[1][(2 * j + 1) * DM + k];
            const unsigned hi = f2bf(w); const unsigned lo = f2bf(w - bf2f(hi));
            bf16_t* base = (bf16_t*)(ws + WS_WG) + (size_t)j * 2 * 16 * 1024;
            base[c * 1024 + k] = (bf16_t)hi; base[16 * 1024 + c * 1024 + k] = (bf16_t)lo; }
        if (F.vcu == 0) { for (int i = F.tid; i < DM / 2; i += 512) ((unsigned*)((bf16_t*)(ws + WS_XB) + (size_t)NTOK * DM))[i] = 0u;
            if (F.tid == 0) ((float*)(ws + SM_RSTD))[NTOK] = 0.f; }
    }
}

template <int MODE, int NT, bool WLO = false>
__device__ __forceinline__ void rowpass_wave(const Frame& F, const float* xsrc, float* xdst, bf16_t* xb, float* rstd_out,
                                             const bf16_t* yb, const int* tokp, const float* tokg, const int* toke, const LAS int* pst,
                                             const bf16_t* whi, const bf16_t* wlo, int tok0, f32x4 (&acc)[NT > 0 ? NT : 1], float& rstd_lane) {
    const int lane = F.lane, t = lane & 15, fq = lane >> 4, tok = tok0 + t;
    const float* xr = xsrc + (size_t)tok * DM + 8 * fq;
    bf16_t* xbr = xb + (size_t)tok * DM + 8 * fq;
    const bf16_t *y0 = nullptr, *y1 = nullptr; float g0 = 0.f, g1 = 0.f;
    if (MODE == 2) { const int p0 = pst[toke[2 * tok]] + tokp[2 * tok], p1 = pst[toke[2 * tok + 1]] + tokp[2 * tok + 1]; g0 = tokg[2 * tok]; g1 = tokg[2 * tok + 1];
        y0 = yb + (size_t)p0 * DM + 8 * fq; y1 = yb + (size_t)p1 * DM + 8 * fq; }
    float* xw = (MODE == 2) ? xdst + (size_t)tok * DM + 8 * fq : nullptr;
#pragma unroll
    for (int c = 0; c < (NT > 0 ? NT : 1); ++c) acc[c] = (f32x4){0.f, 0.f, 0.f, 0.f};
    float ss = 0.f;
#pragma unroll 4
    for (int s = 0; s < 32; ++s) {
        f32x4 a0 = __builtin_nontemporal_load((const GAS f32x4*)(xr + 32 * s)), a1 = __builtin_nontemporal_load((const GAS f32x4*)(xr + 32 * s + 4));
        if (MODE == 2) {
            const u32x4 w0 = *(const GAS u32x4*)(y0 + 32 * s), w1 = *(const GAS u32x4*)(y1 + 32 * s);
            a0[0] += g0 * bflo(w0.x) + g1 * bflo(w1.x); a0[1] += g0 * bfhi(w0.x) + g1 * bfhi(w1.x);
            a0[2] += g0 * bflo(w0.y) + g1 * bflo(w1.y); a0[3] += g0 * bfhi(w0.y) + g1 * bfhi(w1.y);
            a1[0] += g0 * bflo(w0.z) + g1 * bflo(w1.z); a1[1] += g0 * bfhi(w0.z) + g1 * bfhi(w1.z);
            a1[2] += g0 * bflo(w0.w) + g1 * bflo(w1.w); a1[3] += g0 * bfhi(w0.w) + g1 * bfhi(w1.w);
            *(GAS f32x4*)(xw + 32 * s) = a0; *(GAS f32x4*)(xw + 32 * s + 4) = a1;
        }
        ss += (a0[0] * a0[0] + a0[1] * a0[1]) + (a0[2] * a0[2] + a0[3] * a0[3]) + (a1[0] * a1[0] + a1[1] * a1[1]) + (a1[2] * a1[2] + a1[3] * a1[3]);
        u32x4 hi; hi.x = cvt_pk_bf16(a0[0], a0[1]); hi.y = cvt_pk_bf16(a0[2], a0[3]); hi.z = cvt_pk_bf16(a1[0], a1[1]); hi.w = cvt_pk_bf16(a1[2], a1[3]);
        *(GAS u32x4*)(xbr + 32 * s) = hi;
        if (NT > 0) {
            u32x4 lo;
            lo.x = cvt_pk_bf16(a0[0] - bflo(hi.x), a0[1] - bfhi(hi.x)); lo.y = cvt_pk_bf16(a0[2] - bflo(hi.y), a0[3] - bfhi(hi.y));
            lo.z = cvt_pk_bf16(a1[0] - bflo(hi.z), a1[1] - bfhi(hi.z)); lo.w = cvt_pk_bf16(a1[2] - bflo(hi.w), a1[3] - bfhi(hi.w));
            const bf16x8 Ah = __builtin_bit_cast(bf16x8, hi), Al = __builtin_bit_cast(bf16x8, lo);
#pragma unroll
            for (int c = 0; c < NT; ++c) {
                const bf16x8 Bh = *(const GAS bf16x8*)(whi + (size_t)(16 * c + t) * DM + 32 * s + 8 * fq);
                acc[c] = MFMA16(Ah, Bh, acc[c]); acc[c] = MFMA16(Al, Bh, acc[c]);
                if (WLO) { const bf16x8 Bl = *(const GAS bf16x8*)(wlo + (size_t)(16 * c + t) * DM + 32 * s + 8 * fq); acc[c] = MFMA16(Ah, Bl, acc[c]); }
            }
        }
    }
    ss += __shfl_xor(ss, 16); ss += __shfl_xor(ss, 32);
    rstd_lane = 1.0f / sqrtf(ss * (1.0f / DM) + EPS);
    if (fq == 0) rstd_out[tok] = rstd_lane;
}

__device__ __forceinline__ void phase_x0(const Frame& F, const Args& a) {
    f32x4 dummy[1]; float rs;
    for (int tb = F.vcu; tb < NTOK / 128; tb += F.G)
        rowpass_wave<0, 0>(F, a.in[0], nullptr, (bf16_t*)(a.ws + WS_XB), (float*)(a.ws + SM_RSTD), nullptr, nullptr, nullptr, nullptr, nullptr, nullptr, nullptr, tb * 128 + F.wave * 16, dummy, rs);
}


constexpr int RT_WB = 73728, RT_WBUF = 21760;
__device__ __forceinline__ void router_pass(const Frame& F, const bf16_t* xb, float* rstd_out, const bf16_t* whi, int tok0, f32x4 (&acc)[5], float& rstd_lane) {
    const int lane = F.lane, t = lane & 15, fq = lane >> 4, tok = tok0 + t;
    const bf16_t* xbr = xb + (size_t)tok * DM + 8 * fq;
    LAS unsigned char* WB = F.lds + RT_WB;
    u32x4 wr[3];
#define RT_LOAD(chunk) do { _Pragma("unroll") for (int i = 0; i < 3; ++i) { const int p = F.tid + 512 * i; if (p < 1280) wr[i] = *(const GAS u32x4*)(whi + (size_t)(p >> 4) * DM + (chunk) * 128 + (p & 15) * 8); } } while (0)
#define RT_STORE(buf) do { _Pragma("unroll") for (int i = 0; i < 3; ++i) { const int p = F.tid + 512 * i; if (p < 1280) *(LAS u32x4*)(WB + (buf) * RT_WBUF + (p >> 4) * 272 + (p & 15) * 16) = wr[i]; } } while (0)
    __syncthreads();
    RT_LOAD(0); RT_STORE(0);
    __syncthreads();
#pragma unroll
    for (int c = 0; c < 5; ++c) acc[c] = (f32x4){0.f, 0.f, 0.f, 0.f};
    float ss = 0.f;
    u32x4 xc[4], xn[4];
#pragma unroll
    for (int s4 = 0; s4 < 4; ++s4) xc[s4] = *(const GAS u32x4*)(xbr + 32 * s4);
    for (int chunk = 0; chunk < 8; ++chunk) {
        if (chunk + 1 < 8) { RT_LOAD(chunk + 1);
#pragma unroll
            for (int s4 = 0; s4 < 4; ++s4) xn[s4] = *(const GAS u32x4*)(xbr + 32 * ((chunk + 1) * 4 + s4)); }
        const LAS unsigned char* wb = WB + (chunk & 1) * RT_WBUF + t * 272 + fq * 16;
#pragma unroll
        for (int s4 = 0; s4 < 4; ++s4) {
            const u32x4 hi = xc[s4];
            { const float x0 = bflo(hi.x), x1 = bfhi(hi.x), x2 = bflo(hi.y), x3 = bfhi(hi.y), x4 = bflo(hi.z), x5 = bfhi(hi.z), x6 = bflo(hi.w), x7 = bfhi(hi.w);
              ss += (x0 * x0 + x1 * x1) + (x2 * x2 + x3 * x3) + (x4 * x4 + x5 * x5) + (x6 * x6 + x7 * x7); }
            const bf16x8 Ah = __builtin_bit_cast(bf16x8, hi);
#pragma unroll
            for (int c = 0; c < 5; ++c) { const bf16x8 Bh = *(const LAS bf16x8*)(wb + c * (16 * 272) + s4 * 64); acc[c] = MFMA16(Ah, Bh, acc[c]); } }
        if (chunk + 1 < 8) { RT_STORE((chunk + 1) & 1);
#pragma unroll
            for (int s4 = 0; s4 < 4; ++s4) xc[s4] = xn[s4]; }
        __syncthreads();
    }
#undef RT_LOAD
#undef RT_STORE
    ss += __shfl_xor(ss, 16); ss += __shfl_xor(ss, 32);
    rstd_lane = 1.0f / sqrtf(ss * (1.0f / DM) + EPS);
    if (fq == 0) rstd_out[tok] = rstd_lane;
}

__device__ __forceinline__ void phase_router(const Frame& F, const Args& a, int l, bool dry = false) {
    unsigned char* ws = a.ws;
    int* sparse = (int*)(ws + WS_QC);
    LAS float* lg = (LAS float*)(F.lds) + F.wave * (16 * 81);
    LAS float* rsl = (LAS float*)(F.lds + 65536) + F.wave * 16;
    LAS int* hist = (LAS int*)(F.lds + 70000);
    LAS int* bbase = (LAS int*)(F.lds + 70000 + 256);
    LAS int* a_e = (LAS int*)(F.lds + 71000);
    LAS int* a_r = (LAS int*)(F.lds + 72100);
    const bf16_t* whi = (const bf16_t*)(ws + WS_WR) + (size_t)l * 2 * 80 * 1024; const bf16_t* wlo = whi + 80 * 1024;
    unsigned* counts = (unsigned*)(ws + WS_CTL) + CW_CNT + l * 64 + (dry ? 4096 : 0);
    int* toke = (int*)(ws + SM_TOKE); float* tokg = (float*)(ws + SM_TOKG); int* tokp = (int*)(ws + SM_TOKP);
    const float* bg = a.in[14] + l * 8; const float* be = a.in[16] + l * 64;
    for (int tb = F.vcu; tb < NTOK / 128; tb += F.G) {
        __syncthreads();
        if (F.tid < 64) hist[F.tid] = 0;
        __syncthreads();
        f32x4 acc[5]; float rs;
        const int tok0 = tb * 128 + F.wave * 16;
        router_pass(F, (const bf16_t*)(ws + WS_XB), (float*)(ws + SM_RSTD), whi, tok0, acc, rs);
        const int t = F.lane & 15, fq = F.lane >> 4;
        if (fq == 0) rsl[t] = rs;
        LDS_WAIT();
#pragma unroll
        for (int c = 0; c < 5; ++c)
#pragma unroll
            for (int i = 0; i < 4; ++i) { const int tt = 4 * fq + i, col = 16 * c + t; const float bias = col < 8 ? bg[col] : (col < 72 ? be[col - 8] : 0.f);
                lg[tt * 81 + col] = acc[c][i] * rsl[tt] + bias; }
        LDS_WAIT();
        if (F.lane < 16) {
            const LAS float* L = lg + F.lane * 81;
            int grp = 0; float gm = L[0];
#pragma unroll
            for (int j = 1; j < 8; ++j) { const float v = L[j]; if (v > gm) { gm = v; grp = j; } }
            float den = 0.f;
#pragma unroll
            for (int j = 0; j < 8; ++j) den += __expf(L[j] - gm);
            const float pg = 1.0f / den;
            const LAS float* E = L + 8 + grp * 8;
            int i1 = 0; float v1 = E[0];
#pragma unroll
            for (int j = 1; j < 8; ++j) { const float v = E[j]; if (v > v1) { v1 = v; i1 = j; } }
            int i2 = (i1 == 0) ? 1 : 0; float v2 = -3.0e38f;
#pragma unroll
            for (int j = 0; j < 8; ++j) { const float v = E[j]; if (j != i1 && v > v2) { v2 = v; i2 = j; } }
            const float e2 = __expf(v2 - v1), s1 = 1.0f / (1.0f + e2);
            const int tok = tok0 + F.lane, e_a = grp * 8 + i1, e_b = grp * 8 + i2;
            toke[2 * tok] = e_a; toke[2 * tok + 1] = e_b; tokg[2 * tok] = pg * s1; tokg[2 * tok + 1] = pg * e2 * s1;
            const int la = (F.wave * 16 + F.lane) * 2;
            a_e[la] = e_a; a_e[la + 1] = e_b;
            a_r[la] = atomicAdd((int*)(hist + e_a), 1); a_r[la + 1] = atomicAdd((int*)(hist + e_b), 1);
        }
        __syncthreads();
        if (F.tid < 64) bbase[F.tid] = (int)atomicAdd(counts + F.tid, (unsigned)hist[F.tid]);
        __syncthreads();
        if (F.tid < 256) { const int tok = tb * 128 + (F.tid >> 1); const int e = a_e[F.tid], idx = bbase[e] + a_r[F.tid]; tokp[2 * tok + (F.tid & 1)] = idx; if (!dry) sparse[e * 32768 + idx] = tok; }
    }
}

__device__ __forceinline__ int moe_tables(const Frame& F, const unsigned* counts, LAS int* pst, LAS int* cnt) {
    __syncthreads();
    if (F.tid < 64) {
        const int c = (int)counts[F.tid]; const int pc = (c + 255) & ~255;
        int incl = pc;
#pragma unroll
        for (int o = 1; o < 64; o <<= 1) { const int t = __shfl_up(incl, o); if (F.lane >= o) incl += t; }
        const int start = incl - pc;
        cnt[F.tid] = c; pst[F.tid] = start; if (F.tid == 63) pst[64] = incl;
        for (int t = start >> 8; t < (incl >> 8); ++t) pst[256 + t] = F.tid;
    }
    __syncthreads();
    return pst[64] >> 8;
}
constexpr int MOE_TAB_OFF = 131072;
struct TokRec { int e0, e1, q0, q1; float g0, g1; };
__device__ __forceinline__ TokRec tok_rec(const int* toke, const int* tokp, const float* tokg, int tok) { TokRec r; r.e0 = toke[2 * tok]; r.e1 = toke[2 * tok + 1]; r.q0 = tokp[2 * tok]; r.q1 = tokp[2 * tok + 1]; r.g0 = tokg[2 * tok]; r.g1 = tokg[2 * tok + 1]; return r; }
template <bool GATES, bool FINAL>
__device__ __forceinline__ void combine_wave(const Frame& F, bf16_t* xb, float* rstd_out, float* fout, const bf16_t* yb, const TokRec tr, const LAS int* pst,
                                             const bf16_t* whi, const bf16_t* wlo, int tok0, f32x4& acc, float& rstd_lane) {
    const int lane = F.lane, t = lane & 15, fq = lane >> 4, tok = tok0 + t;
    bf16_t* xr = xb + (size_t)tok * DM + 8 * fq;
    const int p0 = pst[tr.e0] + tr.q0, p1 = pst[tr.e1] + tr.q1; const float g0 = tr.g0, g1 = tr.g1;
    const bf16_t* y0 = yb + (size_t)p0 * DM + 8 * fq; const bf16_t* y1 = yb + (size_t)p1 * DM + 8 * fq;
    float* fo = FINAL ? fout + (size_t)tok * DM + 8 * fq : nullptr;
    acc = (f32x4){0.f, 0.f, 0.f, 0.f};
    float ss = 0.f;
#pragma unroll 4
    for (int s = 0; s < 32; ++s) {
        const u32x4 x = *(const GAS u32x4*)(xr + 32 * s), w0 = *(const GAS u32x4*)(y0 + 32 * s), w1 = *(const GAS u32x4*)(y1 + 32 * s);
        float v[8];
        v[0] = bflo(x.x) + g0 * bflo(w0.x) + g1 * bflo(w1.x); v[1] = bfhi(x.x) + g0 * bfhi(w0.x) + g1 * bfhi(w1.x);
        v[2] = bflo(x.y) + g0 * bflo(w0.y) + g1 * bflo(w1.y); v[3] = bfhi(x.y) + g0 * bfhi(w0.y) + g1 * bfhi(w1.y);
        v[4] = bflo(x.z) + g0 * bflo(w0.z) + g1 * bflo(w1.z); v[5] = bfhi(x.z) + g0 * bfhi(w0.z) + g1 * bfhi(w1.z);
        v[6] = bflo(x.w) + g0 * bflo(w0.w) + g1 * bflo(w1.w); v[7] = bfhi(x.w) + g0 * bfhi(w0.w) + g1 * bfhi(w1.w);
        if (FINAL) { __builtin_nontemporal_store((f32x4){v[0], v[1], v[2], v[3]}, (GAS f32x4*)(fo + 32 * s)); __builtin_nontemporal_store((f32x4){v[4], v[5], v[6], v[7]}, (GAS f32x4*)(fo + 32 * s + 4)); }
        u32x4 hi; hi.x = cvt_pk_bf16(v[0], v[1]); hi.y = cvt_pk_bf16(v[2], v[3]); hi.z = cvt_pk_bf16(v[4], v[5]); hi.w = cvt_pk_bf16(v[6], v[7]);
        if (!FINAL) *(GAS u32x4*)(xr + 32 * s) = hi;
        { const float r0 = bflo(hi.x), r1 = bfhi(hi.x), r2 = bflo(hi.y), r3 = bfhi(hi.y), r4 = bflo(hi.z), r5 = bfhi(hi.z), r6 = bflo(hi.w), r7 = bfhi(hi.w);
          ss += (r0 * r0 + r1 * r1) + (r2 * r2 + r3 * r3) + (r4 * r4 + r5 * r5) + (r6 * r6 + r7 * r7); }
        if (GATES) { const bf16x8 Ah = __builtin_bit_cast(bf16x8, hi);
            const bf16x8 Bh = *(const GAS bf16x8*)(whi + (size_t)t * DM + 32 * s + 8 * fq), Bl = *(const GAS bf16x8*)(wlo + (size_t)t * DM + 32 * s + 8 * fq);
            acc = MFMA16(Ah, Bh, acc); acc = MFMA16(Ah, Bl, acc); }
    }
    ss += __shfl_xor(ss, 16); ss += __shfl_xor(ss, 32);
    rstd_lane = 1.0f / sqrtf(ss * (1.0f / DM) + EPS);
    if (!FINAL && fq == 0) rstd_out[tok] = rstd_lane;
}
template <bool FINAL>
__device__ __forceinline__ void combine_rows(const Frame& F, bf16_t* xb, float* rstd_out, float* fout, const bf16_t* yb, const int* toke, const int* tokp, const float* tokg, const LAS int* pst, int tok0) {
    const int lane = F.lane;
#pragma unroll 1
    for (int bt = 0; bt < 4; ++bt) {
        u32x4 xv[4][2], y0v[4][2], y1v[4][2]; float g0[4], g1[4];
#pragma unroll
        for (int t4 = 0; t4 < 4; ++t4) { const int tok = __builtin_amdgcn_readfirstlane(tok0 + 4 * bt + t4);
            const int p0 = __builtin_amdgcn_readfirstlane(pst[toke[2 * tok]] + tokp[2 * tok]), p1 = __builtin_amdgcn_readfirstlane(pst[toke[2 * tok + 1]] + tokp[2 * tok + 1]);
            g0[t4] = tokg[2 * tok]; g1[t4] = tokg[2 * tok + 1];
            const bf16_t* xr = xb + (size_t)tok * DM + 8 * lane; const bf16_t* r0 = yb + (size_t)p0 * DM + 8 * lane; const bf16_t* r1 = yb + (size_t)p1 * DM + 8 * lane;
#pragma unroll
            for (int j = 0; j < 2; ++j) { xv[t4][j] = *(const GAS u32x4*)(xr + 512 * j); y0v[t4][j] = *(const GAS u32x4*)(r0 + 512 * j); y1v[t4][j] = *(const GAS u32x4*)(r1 + 512 * j); } }
#pragma unroll
        for (int t4 = 0; t4 < 4; ++t4) { const int tok = tok0 + 4 * bt + t4; float ss = 0.f;
#pragma unroll
            for (int j = 0; j < 2; ++j) { const u32x4 x = xv[t4][j], w0 = y0v[t4][j], w1 = y1v[t4][j]; const float a0 = g0[t4], a1 = g1[t4];
                float v[8];
                v[0] = bflo(x.x) + a0 * bflo(w0.x) + a1 * bflo(w1.x); v[1] = bfhi(x.x) + a0 * bfhi(w0.x) + a1 * bfhi(w1.x);
                v[2] = bflo(x.y) + a0 * bflo(w0.y) + a1 * bflo(w1.y); v[3] = bfhi(x.y) + a0 * bfhi(w0.y) + a1 * bfhi(w1.y);
                v[4] = bflo(x.z) + a0 * bflo(w0.z) + a1 * bflo(w1.z); v[5] = bfhi(x.z) + a0 * bfhi(w0.z) + a1 * bfhi(w1.z);
                v[6] = bflo(x.w) + a0 * bflo(w0.w) + a1 * bflo(w1.w); v[7] = bfhi(x.w) + a0 * bfhi(w0.w) + a1 * bfhi(w1.w);
                if (FINAL) { float* fo = fout + (size_t)tok * DM + 512 * j + 8 * lane;
                    __builtin_nontemporal_store((f32x4){v[0], v[1], v[2], v[3]}, (GAS f32x4*)fo); __builtin_nontemporal_store((f32x4){v[4], v[5], v[6], v[7]}, (GAS f32x4*)(fo + 4)); }
                else { u32x4 hi; hi.x = cvt_pk_bf16(v[0], v[1]); hi.y = cvt_pk_bf16(v[2], v[3]); hi.z = cvt_pk_bf16(v[4], v[5]); hi.w = cvt_pk_bf16(v[6], v[7]);
                    *(GAS u32x4*)(xb + (size_t)tok * DM + 512 * j + 8 * lane) = hi;
                    const float r0 = bflo(hi.x), r1 = bfhi(hi.x), r2 = bflo(hi.y), r3 = bfhi(hi.y), r4 = bflo(hi.z), r5 = bfhi(hi.z), r6 = bflo(hi.w), r7 = bfhi(hi.w);
                    ss += (r0 * r0 + r1 * r1) + (r2 * r2 + r3 * r3) + (r4 * r4 + r5 * r5) + (r6 * r6 + r7 * r7); } }
            if (!FINAL) {
#pragma unroll
                for (int o = 1; o < 64; o <<= 1) ss += __shfl_xor(ss, o);
                if (lane == 0) rstd_out[tok] = 1.0f / sqrtf(ss * (1.0f / DM) + EPS); } }
    }
}
__device__ __forceinline__ void combine_rows_gates(const Frame& F, bf16_t* xb, float* rstd_out, float* gout, const bf16_t* yb, const int* toke, const int* tokp, const float* tokg, const LAS int* pst, int tok0,
                                                   const float* win  , const float* gain  ) {
    const int lane = F.lane;
    float wg[2][8][8];
#pragma unroll
    for (int j = 0; j < 2; ++j)
#pragma unroll
        for (int i = 0; i < 8; ++i) { const int k = 512 * j + 8 * lane + i; const float gk = gain[k]; const f32x4 a = *(const GAS f32x4*)(win + (size_t)k * 3080 + 3072), b = *(const GAS f32x4*)(win + (size_t)k * 3080 + 3076);
            wg[j][i][0] = a[0] * gk; wg[j][i][1] = a[1] * gk; wg[j][i][2] = a[2] * gk; wg[j][i][3] = a[3] * gk; wg[j][i][4] = b[0] * gk; wg[j][i][5] = b[1] * gk; wg[j][i][6] = b[2] * gk; wg[j][i][7] = b[3] * gk; }
#pragma unroll 1
    for (int bt = 0; bt < 8; ++bt) {
        u32x4 xv[2][2], y0v[2][2], y1v[2][2]; float g0[2], g1[2];
#pragma unroll
        for (int t2 = 0; t2 < 2; ++t2) { const int tok = __builtin_amdgcn_readfirstlane(tok0 + 2 * bt + t2);
            const int p0 = __builtin_amdgcn_readfirstlane(pst[toke[2 * tok]] + tokp[2 * tok]), p1 = __builtin_amdgcn_readfirstlane(pst[toke[2 * tok + 1]] + tokp[2 * tok + 1]);
            g0[t2] = tokg[2 * tok]; g1[t2] = tokg[2 * tok + 1];
            const bf16_t* xr = xb + (size_t)tok * DM + 8 * lane; const bf16_t* r0 = yb + (size_t)p0 * DM + 8 * lane; const bf16_t* r1 = yb + (size_t)p1 * DM + 8 * lane;
#pragma unroll
            for (int j = 0; j < 2; ++j) { xv[t2][j] = *(const GAS u32x4*)(xr + 512 * j); y0v[t2][j] = *(const GAS u32x4*)(r0 + 512 * j); y1v[t2][j] = *(const GAS u32x4*)(r1 + 512 * j); } }
#pragma unroll
        for (int t2 = 0; t2 < 2; ++t2) { const int tok = tok0 + 2 * bt + t2; float ss = 0.f, gs[8];
#pragma unroll
            for (int c = 0; c < 8; ++c) gs[c] = 0.f;
#pragma unroll
            for (int j = 0; j < 2; ++j) { const u32x4 x = xv[t2][j], w0 = y0v[t2][j], w1 = y1v[t2][j]; const float a0 = g0[t2], a1 = g1[t2];
                float v[8];
                v[0] = bflo(x.x) + a0 * bflo(w0.x) + a1 * bflo(w1.x); v[1] = bfhi(x.x) + a0 * bfhi(w0.x) + a1 * bfhi(w1.x);
                v[2] = bflo(x.y) + a0 * bflo(w0.y) + a1 * bflo(w1.y); v[3] = bfhi(x.y) + a0 * bfhi(w0.y) + a1 * bfhi(w1.y);
                v[4] = bflo(x.z) + a0 * bflo(w0.z) + a1 * bflo(w1.z); v[5] = bfhi(x.z) + a0 * bfhi(w0.z) + a1 * bfhi(w1.z);
                v[6] = bflo(x.w) + a0 * bflo(w0.w) + a1 * bflo(w1.w); v[7] = bfhi(x.w) + a0 * bfhi(w0.w) + a1 * bfhi(w1.w);
                u32x4 hi; hi.x = cvt_pk_bf16(v[0], v[1]); hi.y = cvt_pk_bf16(v[2], v[3]); hi.z = cvt_pk_bf16(v[4], v[5]); hi.w = cvt_pk_bf16(v[6], v[7]);
                *(GAS u32x4*)(xb + (size_t)tok * DM + 512 * j + 8 * lane) = hi;
                const float r[8] = {bflo(hi.x), bfhi(hi.x), bflo(hi.y), bfhi(hi.y), bflo(hi.z), bfhi(hi.z), bflo(hi.w), bfhi(hi.w)};
#pragma unroll
                for (int i = 0; i < 8; ++i) { ss += r[i] * r[i];
#pragma unroll
                    for (int c = 0; c < 8; ++c) gs[c] += r[i] * wg[j][i][c]; } }
#pragma unroll
            for (int o = 1; o < 64; o <<= 1) { ss += __shfl_xor(ss, o);
#pragma unroll
                for (int c = 0; c < 8; ++c) gs[c] += __shfl_xor(gs[c], o); }
            const float rs = 1.0f / sqrtf(ss * (1.0f / DM) + EPS);
            if (lane == 0) rstd_out[tok] = rs;
            if (lane < 8) { float gv = gs[0];
#pragma unroll
                for (int c = 1; c < 8; ++c) gv = (lane == c) ? gs[c] : gv;
                gout[(size_t)tok * 8 + lane] = gv * rs; } }
    }
}
__device__ __forceinline__ void phase_combine(const Frame& F, const Args& a, int l) {
    unsigned char* ws = a.ws;
    const bool gates = (l + 1 < NLAYER) && ((l + 1) & 1);
    const int j = (l + 1) >> 1;
    const bf16_t* whi = (const bf16_t*)(ws + WS_WG) + (size_t)j * 2 * 16 * 1024; const bf16_t* wlo = whi + 16 * 1024;
    float* gout = (float*)(ws + SM_GATES);
    LAS float* rsl = (LAS float*)(F.lds) + F.wave * 16;
    LAS int* pst = (LAS int*)(F.lds + MOE_TAB_OFF); LAS int* cnt = (LAS int*)(F.lds + MOE_TAB_OFF + 512);
    const int* tokp = (const int*)(ws + SM_TOKP); const float* tokg = (const float*)(ws + SM_TOKG); const int* toke = (const int*)(ws + SM_TOKE);
    TokRec tr = tok_rec(toke, tokp, tokg, F.vcu * 128 + F.wave * 16 + (F.lane & 15));
    (void)moe_tables(F, (const unsigned*)(ws + WS_CTL) + CW_CNT + l * 64, pst, cnt);
    bf16_t* xb = (bf16_t*)(ws + WS_XB); float* rstd = (float*)(ws + SM_RSTD); const bf16_t* yb = (const bf16_t*)(ws + WS_YB);
    for (int tb = F.vcu; tb < NTOK / 128; tb += F.G) {
        f32x4 acc; float rs; const int tok0 = tb * 128 + F.wave * 16;
        if (tb != F.vcu) tr = tok_rec(toke, tokp, tokg, tok0 + (F.lane & 15));
        if (l + 1 == NLAYER) combine_rows<true>(F, xb, rstd, a.out, yb, toke, tokp, tokg, pst, tok0);
        else if (gates) { combine_rows_gates(F, xb, rstd, gout, yb, toke, tokp, tokg, pst, tok0, a.in[7] + (size_t)j * DM * 3080, a.in[1] + (size_t)(2 * j + 1) * DM);
        } else combine_rows<false>(F, xb, rstd, nullptr, yb, toke, tokp, tokg, pst, tok0);
    }
}

constexpr int ATT_KB = 0, ATT_VT = 36864;
struct AttnRegs { u32x4 k[2]; u32x4 v0, v1; bf16x8 q0, q1; };
struct AttnStep { int d, b, h, r, blk; bool prime; };
__device__ __forceinline__ void attn_fetch(const Frame& F, const bf16_t* QKV, const AttnStep& u, AttnRegs& R) {
    const int tid = F.tid, fr = F.lane & 15, fq = F.lane >> 4; const bool valid = u.blk >= 0; const int s0 = u.blk * 128;
#pragma unroll
    for (int i = 0; i < 2; ++i) { const int id = tid + 512 * i, row = id >> 3, ch = id & 7;
        R.k[i] = (u32x4){0u, 0u, 0u, 0u};
        if (valid) R.k[i] = *(const GAS u32x4*)(QKV + ((size_t)(32 + u.b * 16 + u.h) * SEQ + (s0 + row) * u.d + u.r) * 64 + 8 * ch); }
    { const int pair = tid >> 3, ch = tid & 7;
        R.v0 = (u32x4){0u, 0u, 0u, 0u}; R.v1 = (u32x4){0u, 0u, 0u, 0u};
        if (valid) { const bf16_t* p = QKV + ((size_t)(64 + u.b * 16 + u.h) * SEQ + (s0 + 2 * pair) * u.d + u.r) * 64 + 8 * ch; R.v0 = *(const GAS u32x4*)p; R.v1 = *(const GAS u32x4*)(p + (size_t)u.d * 64); } }
    if (!u.prime) { const size_t qrow = (size_t)(u.b * 16 + u.h) * SEQ + (s0 + 16 * F.wave + fr) * u.d + u.r;
        R.q0 = *(const GAS bf16x8*)(QKV + qrow * 64 + 8 * fq); R.q1 = *(const GAS bf16x8*)(QKV + qrow * 64 + 32 + 8 * fq); }
}
__device__ __forceinline__ void attn_stage(const Frame& F, const AttnRegs& R, int slot) {
    LAS unsigned char* Kb = F.lds + ATT_KB; LAS unsigned* VT = (LAS unsigned*)(F.lds + ATT_VT);
#pragma unroll
    for (int i = 0; i < 2; ++i) { const int id = F.tid + 512 * i, row = id >> 3, ch = id & 7; *(LAS u32x4*)(Kb + (slot * 128 + row) * 144 + ch * 16) = R.k[i]; }
    { const int pair = F.tid >> 3, ch = F.tid & 7; const u32x4 v0 = R.v0, v1 = R.v1;
        LAS unsigned* o = VT + (8 * ch) * 129 + slot * 64 + pair;
        o[0 * 129] = (v0.x & 0xffffu) | (v1.x << 16); o[1 * 129] = (v0.x >> 16) | (v1.x & 0xffff0000u);
        o[2 * 129] = (v0.y & 0xffffu) | (v1.y << 16); o[3 * 129] = (v0.y >> 16) | (v1.y & 0xffff0000u);
        o[4 * 129] = (v0.z & 0xffffu) | (v1.z << 16); o[5 * 129] = (v0.z >> 16) | (v1.z & 0xffff0000u);
        o[6 * 129] = (v0.w & 0xffffu) | (v1.w << 16); o[7 * 129] = (v0.w >> 16) | (v1.w & 0xffff0000u); }
}
template <int MODE, bool FIRST>
__device__ __forceinline__ void attn_compute(const Frame& F, const AttnStep& u, const int par, const bf16x8 Q0, const bf16x8 Q1, float off2, bf16_t* part_out, float* l_out, bf16_t* OB, const bf16_t* PP1, const bf16_t* PP2, const float* PL1, const float* PL2) {
    const int lane = F.lane, w = F.wave, fr = lane & 15, fq = lane >> 4;
    const int si0 = u.blk * 128;
    const LAS unsigned char* Kb = F.lds + ATT_KB; const LAS unsigned* VT = (const LAS unsigned*)(F.lds + ATT_VT);
    const int iq = 16 * w + fr; const size_t qrow = (size_t)(u.b * SEQ + (si0 + iq) * u.d + u.r), hrow = (size_t)(u.b * 16 + u.h) * SEQ + (si0 + iq) * u.d + u.r;
    f32x4 O[4];
#pragma unroll
    for (int dt = 0; dt < 4; ++dt) O[dt] = (f32x4){0.f, 0.f, 0.f, 0.f};
    float lsum = 0.f;
#pragma unroll
    for (int up = 0; up < 5; ++up) {
        unsigned pk[4];
#pragma unroll
        for (int hh = 0; hh < 2; ++hh) {
            const int tt = 2 * up + hh;
            if (tt < 9) {
                const int kt = w + tt;
                const int prow = ((kt < 8) ? (par ^ 1) : par) * 128 + 16 * (kt & 7);
                const LAS unsigned char* kp = Kb + (prow + fr) * 144 + fq * 16;
                f32x4 s = (f32x4){0.f, 0.f, 0.f, 0.f};
                s = MFMA16(ld_frag_lds(kp), Q0, s); s = MFMA16(ld_frag_lds(kp + 64), Q1, s);
                float p[4];
                if (FIRST || tt == 0 || tt == 8) {
#pragma unroll
                    for (int i = 0; i < 4; ++i) { const int jk = 16 * kt + 4 * fq + i; const bool ok = (jk >= iq) && (jk <= iq + 128) && (!FIRST || jk >= 128);
                        p[i] = ok ? fast_exp2(s[i] - off2) : 0.f; }
                } else {
#pragma unroll
                    for (int i = 0; i < 4; ++i) p[i] = fast_exp2(s[i] - off2);
                }
                lsum += (p[0] + p[1]) + (p[2] + p[3]);
                pk[2 * hh] = cvt_pk_bf16(p[0], p[1]); pk[2 * hh + 1] = cvt_pk_bf16(p[2], p[3]);
            } else { pk[2 * hh] = 0u; pk[2 * hh + 1] = 0u; }
        }
        const bf16x8 Pf = mk_frag(pk[0], pk[1], pk[2], pk[3]);
        const int kt0 = w + 2 * up, kt1 = (2 * up + 1 < 9) ? kt0 + 1 : kt0;
        const int pb0 = ((kt0 < 8) ? (par ^ 1) : par) * 64 + 8 * (kt0 & 7), pb1 = ((kt1 < 8) ? (par ^ 1) : par) * 64 + 8 * (kt1 & 7);
#pragma unroll
        for (int dt = 0; dt < 4; ++dt) { const LAS unsigned* vp = VT + (16 * dt + fr) * 129 + 2 * fq;
            const bf16x8 V = mk_frag(vp[pb0], vp[pb0 + 1], vp[pb1], vp[pb1 + 1]);
            O[dt] = MFMA16(V, Pf, O[dt]); }
    }
    lsum += __shfl_xor(lsum, 16); lsum += __shfl_xor(lsum, 32);
    if (MODE == 0) {
        bf16_t* o = part_out + hrow * 64 + 4 * fq;
#pragma unroll
        for (int dt = 0; dt < 4; ++dt) { u32x2 wv; wv.x = cvt_pk_bf16(O[dt][0], O[dt][1]); wv.y = cvt_pk_bf16(O[dt][2], O[dt][3]); *(GAS u32x2*)(o + 16 * dt) = wv; }
        if (fq == 0) l_out[hrow] = lsum;
    } else {
        const float inv = 1.0f / (lsum + PL1[hrow] + PL2[hrow]);
        bf16_t* o = OB + hrow * 64 + 4 * fq;
#pragma unroll
        for (int dt = 0; dt < 4; ++dt) { const u32x2 x1 = *(const GAS u32x2*)(PP1 + hrow * 64 + 4 * fq + 16 * dt), x2 = *(const GAS u32x2*)(PP2 + hrow * 64 + 4 * fq + 16 * dt);
            const float o0 = (O[dt][0] + bflo(x1.x) + bflo(x2.x)) * inv, o1 = (O[dt][1] + bfhi(x1.x) + bfhi(x2.x)) * inv;
            const float o2 = (O[dt][2] + bflo(x1.y) + bflo(x2.y)) * inv, o3 = (O[dt][3] + bfhi(x1.y) + bfhi(x2.y)) * inv;
            u32x2 wv; wv.x = cvt_pk_bf16(o0, o1); wv.y = cvt_pk_bf16(o2, o3); *(GAS u32x2*)(o + 16 * dt) = wv; }
    }
}
__device__ __forceinline__ float attn_off2(const float* qg, const float* kg) {
    const int i = threadIdx.x & 63; float mx = fabsf(qg[i] * kg[i]);
#pragma unroll
    for (int o = 1; o < 64; o <<= 1) mx = fmaxf(mx, __shfl_xor(mx, o));
    return 8.0f * mx * LOG2E * 1.02f;
}
template <int MODE>
__device__ __forceinline__ AttnStep attn_step(int s, int vcu, int& br) {
    const int xcd = vcu >> 5, jb = vcu & 31; AttnStep u; int bhl, nblk0, o;
    if (MODE == 0) {
        if (s < 18) { const int ci = 2 * jb + (s >= 9 ? 1 : 0); o = s >= 9 ? s - 9 : s; u.d = 16; bhl = ci >> 4; u.r = ci & 15; nblk0 = 0; br = 0; }
        else { o = s - 18; u.d = 4; bhl = jb >> 3; u.r = (jb & 7) >> 1; nblk0 = 16 * (jb & 1); br = 1; }
    } else { o = s; u.d = 1; bhl = jb >> 3; u.r = 0; nblk0 = 16 * (jb & 7); br = 0; }
    const int bh = xcd + 8 * bhl; u.b = bh >> 4; u.h = bh & 15; u.blk = nblk0 + o - 1; u.prime = (o == 0);
    return u;
}
template <int MODE>
__device__ __forceinline__ void phase_attn(const Frame& F, const Args& a, int j) {
    unsigned char* ws = a.ws; const bf16_t* QKV = (const bf16_t*)(ws + WS_QKV);
    const float off2 = attn_off2(a.in[4] + j * 64, a.in[5] + j * 64);
    constexpr int NSTEP = (MODE == 0) ? 35 : 17;
    if (F.G != 256) return;
    AttnRegs R; R.q0 = (bf16x8){0, 0, 0, 0, 0, 0, 0, 0}; R.q1 = R.q0; int br = 0, ucount = 0;
    AttnStep st = attn_step<MODE>(0, F.vcu, br);
    attn_fetch(F, QKV, st, R);
    const bf16_t* P1 = (const bf16_t*)(ws + WS_P1); const bf16_t* P2 = (const bf16_t*)(ws + WS_P2); const float* L1 = (const float*)(ws + SM_L1); const float* L2 = (const float*)(ws + SM_L2);
    for (int s = 0; s < NSTEP; ++s) {
        __syncthreads();
        attn_stage(F, R, s & 1);
        const bf16x8 Q0 = R.q0, Q1 = R.q1;
        const AttnStep cur = st; const int cbr = br;
        if (s + 1 < NSTEP) { st = attn_step<MODE>(s + 1, F.vcu, br); attn_fetch(F, QKV, st, R); }
        __syncthreads();
        if (cur.prime) continue;
        const int slot = (MODE == 0 ? 0 : 32) + ucount; ++ucount; const int cl = 2 * j + (slot >= 24 ? 1 : 0); const int cit = (F.vcu * 8 + F.wave) + 2048 * (slot % 24);
        const bool do_cvt = (slot < 48) && (cit < MOE_ITEMS);
        CvtDesc cd = cvt_moe_desc(a, cl, do_cvt ? cit : 0); f32x4 cv[8];
        if (do_cvt) cvt_load(cd, F.lane, cv);
        if (cur.blk == 0) attn_compute<MODE, true>(F, cur, s & 1, Q0, Q1, off2, (bf16_t*)(ws + (cbr == 0 ? WS_P1 : WS_P2)), (float*)(ws + (cbr == 0 ? SM_L1 : SM_L2)), (bf16_t*)(ws + WS_OB), P1, P2, L1, L2);
        else attn_compute<MODE, false>(F, cur, s & 1, Q0, Q1, off2, (bf16_t*)(ws + (cbr == 0 ? WS_P1 : WS_P2)), (float*)(ws + (cbr == 0 ? SM_L1 : SM_L2)), (bf16_t*)(ws + WS_OB), P1, P2, L1, L2);
        if (do_cvt) cvt_finish(cd, F.lane, cv, (LAS float*)(F.lds + 71680 + F.wave * 8448));
    }
}
__device__ __forceinline__ void phase_attn_a(const Frame& F, const Args& a, int j) { phase_attn<0>(F, a, j); }
__device__ __forceinline__ void phase_attn_b(const Frame& F, const Args& a, int j) { phase_attn<1>(F, a, j); }

__device__ __forceinline__ float log_sigmoid(float x) { return fminf(x, 0.f) - __logf(1.0f + __expf(-fabsf(x))); }
__device__ __forceinline__ float wave_incl_scan_add(float v, int lane) {
#pragma unroll
    for (int o = 1; o < 64; o <<= 1) { const float t = __shfl_up(v, o); if (lane >= o) v += t; }
    return v;
}
__device__ __forceinline__ float wave_incl_scan_max(float v, int lane) {
#pragma unroll
    for (int o = 1; o < 64; o <<= 1) { const float t = __shfl_up(v, o); if (lane >= o) v = fmaxf(v, t); }
    return v;
}
__device__ __forceinline__ float wave_max(float v) {
#pragma unroll
    for (int o = 1; o < 64; o <<= 1) v = fmaxf(v, __shfl_xor(v, o));
    return v;
}
constexpr int B2_KWT = 0, B2_VT = 18432, B2_WS = 52224, B2_RAW = 56320, B2_OUT = 91904;
__device__ __forceinline__ int vt_col(int dv, int pair) { return (pair + (dv >> 5)) & 31; }
__device__ __forceinline__ void mlstm_fetch_v(const Frame& F, const bf16_t* QKV, int n0, int h, u32x4 (&v0)[2], u32x4 (&v1)[2]) {
#pragma unroll
    for (int i = 0; i < 2; ++i) { const int id = F.tid + 512 * i, ch = id & 31, pair = id >> 5;
        const bf16_t* p = QKV + (size_t)(n0 + 2 * pair) * 3072 + 1024 + h * 256 + 8 * ch;
        v0[i] = *(const GAS u32x4*)p; v1[i] = *(const GAS u32x4*)(p + 3072); }
}
__device__ __forceinline__ void mlstm_write_vT(const Frame& F, const u32x4 (&v0a)[2], const u32x4 (&v1a)[2], LAS unsigned* VT) {
#pragma unroll
    for (int i = 0; i < 2; ++i) { const int id = F.tid + 512 * i, ch = id & 31, pair = id >> 5; const u32x4 v0 = v0a[i], v1 = v1a[i];
        LAS unsigned* o = VT + (8 * ch) * 33 + ((pair + (ch >> 2)) & 31);
        o[0 * 33] = (v0.x & 0xffffu) | (v1.x << 16); o[1 * 33] = (v0.x >> 16) | (v1.x & 0xffff0000u);
        o[2 * 33] = (v0.y & 0xffffu) | (v1.y << 16); o[3 * 33] = (v0.y >> 16) | (v1.y & 0xffff0000u);
        o[4 * 33] = (v0.z & 0xffffu) | (v1.z << 16); o[5 * 33] = (v0.z >> 16) | (v1.z & 0xffff0000u);
        o[6 * 33] = (v0.w & 0xffffu) | (v1.w << 16); o[7 * 33] = (v0.w >> 16) | (v1.w & 0xffff0000u); }
}
__device__ __forceinline__ void mlstm_stage_vT(const Frame& F, const bf16_t* QKV, int n0, int h, LAS unsigned* VT) {
    u32x4 v0[2], v1[2]; mlstm_fetch_v(F, QKV, n0, h, v0, v1); mlstm_write_vT(F, v0, v1, VT);
}
__device__ __forceinline__ void phase_mlstm_local(const Frame& F, const Args& a, int j) {
    unsigned char* ws = a.ws; const bf16_t* QKV = (const bf16_t*)(ws + WS_QKV);
    const float* gates = (const float*)(ws + SM_GATES); const float* gb = a.in[10] + j * 8;
    const float* cw = a.in[8] + (size_t)j * 4 * 1024; const float* cb = a.in[9] + j * 1024;
    bf16_t* QC = (bf16_t*)(ws + WS_QC); bf16_t* KC = (bf16_t*)(ws + WS_KC);
    bf16_t* DC = (bf16_t*)(ws + WS_DC); float* DN = (float*)(ws + SM_DN); float* MLOC = (float*)(ws + SM_MLOC); float* BL = (float*)(ws + SM_BL);
    LAS unsigned char* KwT = F.lds + B2_KWT; LAS unsigned* VT = (LAS unsigned*)(F.lds + B2_VT); LAS float* wsm = (LAS float*)(F.lds + B2_WS);
    if (F.vcu >= 256) return;
    const int bh = F.vcu >> 5, sc = F.vcu & 31, b = bh >> 2, h = bh & 3, us = bh * 32 + sc;
    f32x4 Dacc[2][8], an = (f32x4){0.f, 0.f, 0.f, 0.f};
#pragma unroll
    for (int bt = 0; bt < 2; ++bt)
#pragma unroll
        for (int at = 0; at < 8; ++at) Dacc[bt][at] = (f32x4){0.f, 0.f, 0.f, 0.f};
    float mq = -__builtin_inff(), blsum = 0.f;
    LAS float* G2 = (LAS float*)(F.lds + B2_WS + 512);
    { const int w_ = F.wave, lane_ = F.lane; const int n0w = b * SEQ + (sc * 8 + w_) * 64;
        const float ipre = DBGG(gates[(size_t)(n0w + lane_) * 8 + h]) + gb[h]; const float fpre = DBGG(gates[(size_t)(n0w + lane_) * 8 + 4 + h]) + gb[4 + h];
        const float bs = wave_incl_scan_add(log_sigmoid(fpre), lane_); const float bL = __shfl(bs, 63);
        const float gs = bL - bs + ipre; const float ml = wave_max(gs);
        G2[w_ * 64 + lane_] = __expf(gs - ml);
        if (lane_ == 0) { G2[512 + 2 * w_] = bL; G2[512 + 2 * w_ + 1] = ml; } }
    u32x4 Rv0[2], Rv1[2], Rr[5];
    LAS unsigned char* raw = F.lds + B2_RAW;
#define B2_FETCH(FR, c_) do { _Pragma("unroll") for (int i = 0; i < 5; ++i) { const int p = FR.tid + 512 * i, r = p >> 5, hf = (p >> 4) & 1, c16 = p & 15; const int pos = (c_) * 64 - 3 + r; \
            Rr[i] = (u32x4){0u, 0u, 0u, 0u}; if (p < 67 * 32 && pos >= 0) Rr[i] = *(const GAS u32x4*)(QKV + (size_t)(b * SEQ + pos) * 3072 + hf * 512 + h * 128 + 8 * c16); } } while (0)
    B2_FETCH(F, sc * 8); mlstm_fetch_v(F, QKV, b * SEQ + sc * 8 * 64, h, Rv0, Rv1);
    LAS float* cwl = (LAS float*)(F.lds + 126720);
    for (int idx = F.tid; idx < 1280; idx += 512) { const int isk = idx / 640, jr = (idx % 640) >> 7, cc = idx & 127; cwl[idx] = (jr < 4) ? cw[jr * 1024 + isk * 512 + h * 128 + cc] : cb[isk * 512 + h * 128 + cc]; }
    for (int jc = 0; jc < 8; ++jc) {
        const Frame Fi = make_frame(F.lds);
        const int lane = Fi.lane, fr = lane & 15, fq = lane >> 4, w = Fi.wave;
        const int c = sc * 8 + jc, n0 = b * SEQ + c * 64;
        __syncthreads();
        if (Fi.tid < 64) { const int s = Fi.tid; const float bL = G2[512 + 2 * jc], ml = G2[512 + 2 * jc + 1];
            const float mn = fmaxf(bL + mq, ml); const float aa = __expf(bL + mq - mn), bb = __expf(ml - mn);
            wsm[s] = G2[jc * 64 + s] * bb;
            if (s == 0) wsm[64] = aa;
            mq = mn; blsum += bL; }
        mlstm_write_vT(Fi, Rv0, Rv1, VT);
#pragma unroll
        for (int i = 0; i < 5; ++i) { const int p = Fi.tid + 512 * i, r = p >> 5, hf = (p >> 4) & 1, c16 = p & 15; if (p < 67 * 32) *(LAS u32x4*)(raw + r * 528 + hf * 256 + c16 * 16) = Rr[i]; }
        if (jc + 1 < 8) { mlstm_fetch_v(Fi, QKV, b * SEQ + (c + 1) * 64, h, Rv0, Rv1); B2_FETCH(Fi, c + 1); }
        __syncthreads();
#pragma unroll
        for (int i = 0; i < 4; ++i) { const int id = Fi.tid + 512 * i, s = id & 63, ch = (id >> 6) & 15, isk = id >> 10;
            const int col = (isk ? 512 : 0) + h * 128 + 8 * ch;
            float accv[8];
#pragma unroll
            for (int e = 0; e < 8; ++e) accv[e] = cwl[(isk * 5 + 4) * 128 + 8 * ch + e];
#pragma unroll
            for (int jj = 0; jj < 4; ++jj) { const u32x4 x = *(const LAS u32x4*)(raw + (s + jj) * 528 + isk * 256 + ch * 16); const LAS float* wj = cwl + (isk * 5 + jj) * 128 + 8 * ch;
                accv[0] += wj[0] * bflo(x.x); accv[1] += wj[1] * bfhi(x.x); accv[2] += wj[2] * bflo(x.y); accv[3] += wj[3] * bfhi(x.y);
                accv[4] += wj[4] * bflo(x.z); accv[5] += wj[5] * bfhi(x.z); accv[6] += wj[6] * bflo(x.w); accv[7] += wj[7] * bfhi(x.w); }
            const float scq = isk ? 0.08838834764831845f : 1.0f;
#pragma unroll
            for (int e = 0; e < 8; ++e) { const float v = accv[e]; accv[e] = v * fast_rcp(1.0f + __expf(-v)) * scq; }
            u32x4 o; o.x = cvt_pk_bf16(accv[0], accv[1]); o.y = cvt_pk_bf16(accv[2], accv[3]); o.z = cvt_pk_bf16(accv[4], accv[5]); o.w = cvt_pk_bf16(accv[6], accv[7]);
            *(LAS u32x4*)(F.lds + B2_OUT + isk * 17408 + s * 272 + ch * 16) = o;
            if (isk) { const float wv = wsm[s];
#pragma unroll
                for (int e = 0; e < 8; ++e) *(LAS bf16_t*)(KwT + (8 * ch + e) * 144 + 2 * s) = (bf16_t)f2bf(accv[e] * wv); } }
        __syncthreads();
#pragma unroll
        for (int i = 0; i < 4; ++i) { const int id = Fi.tid + 512 * i, c16 = id & 15, s = (id >> 4) & 63, isk = id >> 10;
            *(GAS u32x4*)((isk ? KC : QC) + ((size_t)(b * 4 + h) * SEQ + c * 64 + s) * 128 + 8 * c16) = *(const LAS u32x4*)(F.lds + B2_OUT + isk * 17408 + s * 272 + c16 * 16); }
        const float aa = wsm[64];
        bf16x8 Bv[2][2];
#pragma unroll
        for (int bt = 0; bt < 2; ++bt)
#pragma unroll
            for (int kk = 0; kk < 2; ++kk) { const int dvr = 16 * (2 * w + bt) + fr; const LAS unsigned* vp = VT + dvr * 33; const int p0 = 4 * fq + 16 * kk; Bv[bt][kk] = mk_frag(vp[vt_col(dvr, p0)], vp[vt_col(dvr, p0 + 1)], vp[vt_col(dvr, p0 + 2)], vp[vt_col(dvr, p0 + 3)]); }
        an *= aa;
#pragma unroll
        for (int at = 0; at < 8; ++at) {
            const LAS unsigned char* kp = KwT + (16 * at + fr) * 144 + 16 * fq;
            const bf16x8 A0 = ld_frag_lds(kp), A1 = ld_frag_lds(kp + 64);
#pragma unroll
            for (int bt = 0; bt < 2; ++bt) { f32x4 d = Dacc[bt][at] * aa; d = MFMA16(A0, Bv[bt][0], d); d = MFMA16(A1, Bv[bt][1], d); Dacc[bt][at] = d; }
            if (at == w) {
                const bf16x8 ones = mk_frag(0x3f803f80u, 0x3f803f80u, 0x3f803f80u, 0x3f803f80u);
                an = MFMA16(A0, ones, an); an = MFMA16(A1, ones, an); }
        }
    }
    { const int lane = F.lane, fr = lane & 15, fq = lane >> 4, w = F.wave;
        bf16_t* dcu = DC + (size_t)us * 32768;
#pragma unroll
        for (int bt = 0; bt < 2; ++bt)
#pragma unroll
            for (int at = 0; at < 8; ++at) { const f32x4 d = Dacc[bt][at]; u32x2 wv; wv.x = cvt_pk_bf16(d[0], d[1]); wv.y = cvt_pk_bf16(d[2], d[3]);
                *(GAS u32x2*)(dcu + (size_t)(16 * (2 * w + bt) + fr) * 128 + 16 * at + 4 * fq) = wv; }
        if (fr == 0) *(GAS f32x4*)(DN + (size_t)us * 128 + 16 * w + 4 * fq) = an;
        if (F.tid == 0) { MLOC[us] = mq; BL[us] = blsum; } }
#undef B2_FETCH
}
__device__ __forceinline__ void phase_mlstm_scan(const Frame& F, const Args& a) {
    unsigned char* ws = a.ws;
    if (F.vcu >= 256 || F.tid >= 256) return;
    const int bh = F.vcu >> 5, part = F.vcu & 31; const size_t eoff = (size_t)part * 1024 + F.tid * 4;
    const bf16_t* DC = (const bf16_t*)(ws + WS_DC); bf16_t* CS = (bf16_t*)(ws + WS_CS);
    const float* DN = (const float*)(ws + SM_DN); float* NS = (float*)(ws + SM_NS);
    const float* MLOC = (const float*)(ws + SM_MLOC); const float* BL = (const float*)(ws + SM_BL); float* MPREV = (float*)(ws + SM_MPREV);
    const bool doN = (part == 0) && (F.tid < 128);
    float st[4] = {0.f, 0.f, 0.f, 0.f}, nst = 0.f, m = 0.f;
    u32x2 dcA[8], dcB[8]; float blA[8], mlA[8], dnA[8], blB[8], mlB[8], dnB[8];
#define B3_LOAD(dc, bl, ml, dn, c0) do { _Pragma("unroll") for (int i = 0; i < 8; ++i) { const int u = bh * 32 + (c0) + i; dc[i] = *(const GAS u32x2*)(DC + (size_t)u * 32768 + eoff); bl[i] = BL[u]; ml[i] = MLOC[u]; dn[i] = doN ? DN[(size_t)u * 128 + F.tid] : 0.f; } } while (0)
#define B3_STEP(dc, bl, ml, dn, c0) do { _Pragma("unroll") for (int i = 0; i < 8; ++i) { const int u = bh * 32 + (c0) + i; \
            u32x2 o; o.x = cvt_pk_bf16(st[0], st[1]); o.y = cvt_pk_bf16(st[2], st[3]); \
            *(GAS u32x2*)(CS + (size_t)u * 32768 + eoff) = o; \
            if (doN) NS[(size_t)u * 128 + F.tid] = nst; \
            if (part == 0 && F.tid == 0) MPREV[u] = m; \
            const float mn = fmaxf(bl[i] + m, ml[i]); const float aa = __expf(bl[i] + m - mn), bb = __expf(ml[i] - mn); \
            st[0] = aa * st[0] + bb * bflo(dc[i].x); st[1] = aa * st[1] + bb * bfhi(dc[i].x); st[2] = aa * st[2] + bb * bflo(dc[i].y); st[3] = aa * st[3] + bb * bfhi(dc[i].y); \
            nst = aa * nst + bb * dn[i]; m = mn; } } while (0)
    B3_LOAD(dcA, blA, mlA, dnA, 0);
    for (int c0 = 0; c0 < 32; c0 += 16) {
        B3_LOAD(dcB, blB, mlB, dnB, c0 + 8);
        B3_STEP(dcA, blA, mlA, dnA, c0);
        if (c0 + 16 < 32) B3_LOAD(dcA, blA, mlA, dnA, c0 + 16);
        B3_STEP(dcB, blB, mlB, dnB, c0 + 8);
    }
#undef B3_LOAD
#undef B3_STEP
}
constexpr int B4_QS = 0, B4_KS = 17408, B4_VT = 34816, B4_SS = 68608, B4_SC = 77824, B4_KWT = 86016, B4_G = 104448, B4_RED = 112768;
__device__ __forceinline__ void phase_mlstm_out(const Frame& F, const Args& a, int j) {
    unsigned char* ws = a.ws; const bf16_t* QKV = (const bf16_t*)(ws + WS_QKV);
    const float* gates = (const float*)(ws + SM_GATES); const float* gb = a.in[10] + j * 8; const float* hg = a.in[11] + (size_t)j * 1024;
    const bf16_t* QC = (const bf16_t*)(ws + WS_QC); const bf16_t* KC = (const bf16_t*)(ws + WS_KC);
    const bf16_t* CS = (const bf16_t*)(ws + WS_CS); const float* NS = (const float*)(ws + SM_NS); const float* MPREV = (const float*)(ws + SM_MPREV);
    bf16_t* OB = (bf16_t*)(ws + WS_OB);
    LAS unsigned char* Qs = F.lds + B4_QS; LAS unsigned char* Ks = F.lds + B4_KS; LAS unsigned* VT = (LAS unsigned*)(F.lds + B4_VT); LAS unsigned char* Ss = F.lds + B4_SS; LAS unsigned char* KwT = F.lds + B4_KWT;
    LAS float* us = (LAS float*)(F.lds + B4_SC); LAS float* Ms = us + 64; LAS float* wint = us + 128; LAS float* eneg = us + 192; LAS float* npv = us + 256; LAS float* den = us + 384  ; LAS float* qn = us + 640  ; LAS float* hss = us + 1152  ;
    LAS float* wk = us + 1664  ; LAS float* scal = us + 1728;
    const int lane = F.lane, fr = lane & 15, fq = lane >> 4, w = F.wave;
    if (F.vcu >= 256) return;
    const int bh = F.vcu >> 5, sc = F.vcu & 31, b = bh >> 2, h = bh & 3;
    const int us0 = bh * 32 + sc;
    f32x4 Cst[2][8];
#pragma unroll
    for (int bt = 0; bt < 2; ++bt)
#pragma unroll
        for (int at = 0; at < 8; ++at) { const u32x2 x = *(const GAS u32x2*)(CS + (size_t)us0 * 32768 + (size_t)(16 * (2 * w + bt) + fr) * 128 + 16 * at + 4 * fq);
            Cst[bt][at] = (f32x4){bflo(x.x), bfhi(x.x), bflo(x.y), bfhi(x.y)}; }
    float mcur = MPREV[us0];
    LAS float* G4 = (LAS float*)(F.lds + B4_G);
    { const int n0w = b * SEQ + (sc * 8 + w) * 64;
        const float ipre = DBGG(gates[(size_t)(n0w + lane) * 8 + h]) + gb[h]; const float fpre = DBGG(gates[(size_t)(n0w + lane) * 8 + 4 + h]) + gb[4 + h];
        const float bs = wave_incl_scan_add(log_sigmoid(fpre), lane); const float uu = ipre - bs; const float pm = wave_incl_scan_max(uu, lane);
        const float bL = __shfl(bs, 63); const float gs = bL - bs + ipre; const float ml = wave_max(gs);
        G4[(w * 4 + 0) * 64 + lane] = bs; G4[(w * 4 + 1) * 64 + lane] = uu; G4[(w * 4 + 2) * 64 + lane] = pm; G4[(w * 4 + 3) * 64 + lane] = __expf(gs - ml);
        if (lane == 0) { G4[2048 + 2 * w] = bL; G4[2048 + 2 * w + 1] = ml; } }
    if (F.tid >= 64 && F.tid < 192) npv[F.tid - 64] = NS[(size_t)us0 * 128 + F.tid - 64];
    u32x4 Rqk[4], Rv0[2], Rv1[2];
#define B4_FETCH(FR, c_) do { const int n0_ = b * SEQ + (c_) * 64; \
        _Pragma("unroll") for (int i = 0; i < 4; ++i) { const int id = FR.tid + 512 * i, ch = id & 15, s = (id >> 4) & 63, isk = id >> 10; \
            Rqk[i] = *(const GAS u32x4*)((isk ? KC : QC) + ((size_t)(b * 4 + h) * SEQ + (c_) * 64 + s) * 128 + 8 * ch); } \
        mlstm_fetch_v(FR, QKV, n0_, h, Rv0, Rv1); } while (0)
    B4_FETCH(F, sc * 8);
    for (int jc = 0; jc < 8; ++jc) {
        const Frame Fi = make_frame(F.lds);
        const int lane = Fi.lane, fr = lane & 15, fq = lane >> 4, w = Fi.wave;
        const int c = sc * 8 + jc, n0 = b * SEQ + c * 64;
        __syncthreads();
        if (Fi.tid < 64) { const int s = Fi.tid; const float bs = G4[(jc * 4 + 0) * 64 + s], uu = G4[(jc * 4 + 1) * 64 + s], pm = G4[(jc * 4 + 2) * 64 + s];
            const float mp = mcur; const float M = fmaxf(mp, pm);
            us[s] = uu; Ms[s] = M; wint[s] = __expf(mp - M); eneg[s] = __expf(-(bs + M));
            const float bL = G4[2048 + 2 * jc], ml = G4[2048 + 2 * jc + 1];
            const float mn = fmaxf(bL + mp, ml); const float aa = __expf(bL + mp - mn), bb = __expf(ml - mn);
            wk[s] = G4[(jc * 4 + 3) * 64 + s] * bb;
            if (s == 0) scal[0] = aa;
            mcur = mn; }
#pragma unroll
        for (int i = 0; i < 4; ++i) { const int id = Fi.tid + 512 * i, ch = id & 15, s = (id >> 4) & 63, isk = id >> 10;
            *(LAS u32x4*)((isk ? Ks : Qs) + s * 272 + ch * 16) = Rqk[i]; }
        mlstm_write_vT(Fi, Rv0, Rv1, VT);
        if (jc + 1 < 8) B4_FETCH(Fi, c + 1);
        __syncthreads();
        u32x2 ogv[4][2]; f32x4 hgv[2];
#pragma unroll
        for (int dv = 0; dv < 2; ++dv) { const int col = h * 256 + 16 * (2 * w + dv) + 4 * fq; hgv[dv] = *(const GAS f32x4*)(hg + col);
#pragma unroll
            for (int tt = 0; tt < 4; ++tt) ogv[tt][dv] = *(const GAS u32x2*)(QKV + (size_t)(n0 + 16 * tt + fr) * 3072 + 2048 + col); }
#pragma unroll
        for (int i = 0; i < 2; ++i) { const int id = Fi.tid + 512 * i, s = id & 63, ch = id >> 6; const u32x4 kx = *(const LAS u32x4*)(Ks + s * 272 + ch * 16); const float wv = wk[s];
            LAS unsigned char* o = KwT + (8 * ch) * 144 + 2 * s;
            *(LAS bf16_t*)(o + 0 * 144) = (bf16_t)f2bf(bflo(kx.x) * wv); *(LAS bf16_t*)(o + 1 * 144) = (bf16_t)f2bf(bfhi(kx.x) * wv);
            *(LAS bf16_t*)(o + 2 * 144) = (bf16_t)f2bf(bflo(kx.y) * wv); *(LAS bf16_t*)(o + 3 * 144) = (bf16_t)f2bf(bfhi(kx.y) * wv);
            *(LAS bf16_t*)(o + 4 * 144) = (bf16_t)f2bf(bflo(kx.z) * wv); *(LAS bf16_t*)(o + 5 * 144) = (bf16_t)f2bf(bfhi(kx.z) * wv);
            *(LAS bf16_t*)(o + 6 * 144) = (bf16_t)f2bf(bflo(kx.w) * wv); *(LAS bf16_t*)(o + 7 * 144) = (bf16_t)f2bf(bfhi(kx.w) * wv); }
#pragma unroll
        for (int q2 = 0; q2 < 2; ++q2) { const int idx = 2 * w + q2, st = idx >> 2, tt = idx & 3;
            f32x4 sacc = (f32x4){0.f, 0.f, 0.f, 0.f};
            if (st <= tt) {
#pragma unroll
                for (int kk = 0; kk < 4; ++kk) sacc = MFMA16(ld_frag_lds(Ks + (16 * st + fr) * 272 + 16 * fq + 64 * kk), ld_frag_lds(Qs + (16 * tt + fr) * 272 + 16 * fq + 64 * kk), sacc);
            }
            const int t = 16 * tt + fr; const float Mt = Ms[t]; float p[4], rsum = 0.f;
#pragma unroll
            for (int i = 0; i < 4; ++i) { const int s = 16 * st + 4 * fq + i; p[i] = (s <= t) ? sacc[i] * __expf(us[s] - Mt) : 0.f; rsum += p[i]; }
            u32x2 wv; wv.x = cvt_pk_bf16(p[0], p[1]); wv.y = cvt_pk_bf16(p[2], p[3]);
            *(LAS u32x2*)(Ss + t * 144 + (16 * st + 4 * fq) * 2) = wv;
            rsum += __shfl_xor(rsum, 16); rsum += __shfl_xor(rsum, 32);
            if (fq == 0) den[st * 64 + t] = rsum; }
        { const int t = Fi.tid & 63, pp = Fi.tid >> 6; const u32x4 qa = *(const LAS u32x4*)(Qs + t * 272 + 32 * pp), qb = *(const LAS u32x4*)(Qs + t * 272 + 32 * pp + 16);
            const f32x4 n0v = *(const LAS f32x4*)(npv + 16 * pp), n1v = *(const LAS f32x4*)(npv + 16 * pp + 4), n2v = *(const LAS f32x4*)(npv + 16 * pp + 8), n3v = *(const LAS f32x4*)(npv + 16 * pp + 12);
            float sacc = 0.f;
            sacc += bflo(qa.x) * n0v[0]; sacc += bfhi(qa.x) * n0v[1]; sacc += bflo(qa.y) * n0v[2]; sacc += bfhi(qa.y) * n0v[3];
            sacc += bflo(qa.z) * n1v[0]; sacc += bfhi(qa.z) * n1v[1]; sacc += bflo(qa.w) * n1v[2]; sacc += bfhi(qa.w) * n1v[3];
            sacc += bflo(qb.x) * n2v[0]; sacc += bfhi(qb.x) * n2v[1]; sacc += bflo(qb.y) * n2v[2]; sacc += bfhi(qb.y) * n2v[3];
            sacc += bflo(qb.z) * n3v[0]; sacc += bfhi(qb.z) * n3v[1]; sacc += bflo(qb.w) * n3v[2]; sacc += bfhi(qb.w) * n3v[3];
            qn[pp * 64 + t] = sacc; }
        __syncthreads();
        f32x4 acc[2][4];
#pragma unroll
        for (int dv = 0; dv < 2; ++dv)
#pragma unroll
            for (int tt = 0; tt < 4; ++tt) acc[dv][tt] = (f32x4){0.f, 0.f, 0.f, 0.f};
#pragma unroll
        for (int kk = 0; kk < 4; ++kk) {
            bf16x8 Bq[4];
#pragma unroll
            for (int tt = 0; tt < 4; ++tt) { const LAS unsigned char* qp = Qs + (16 * tt + fr) * 272 + 64 * kk + 8 * fq; const u32x2 lo = *(const LAS u32x2*)qp, hi = *(const LAS u32x2*)(qp + 32); Bq[tt] = mk_frag(lo.x, lo.y, hi.x, hi.y); }
#pragma unroll
            for (int dv = 0; dv < 2; ++dv) { const f32x4 c0 = Cst[dv][2 * kk], c1 = Cst[dv][2 * kk + 1];
                const bf16x8 Ac = mk_frag(cvt_pk_bf16(c0[0], c0[1]), cvt_pk_bf16(c0[2], c0[3]), cvt_pk_bf16(c1[0], c1[1]), cvt_pk_bf16(c1[2], c1[3]));
#pragma unroll
                for (int tt = 0; tt < 4; ++tt) acc[dv][tt] = MFMA16(Ac, Bq[tt], acc[dv][tt]); }
            __builtin_amdgcn_sched_barrier(0);
        }
#pragma unroll
        for (int tt = 0; tt < 4; ++tt) { const float wi = wint[16 * tt + fr];
#pragma unroll
            for (int dv = 0; dv < 2; ++dv) acc[dv][tt] *= wi; }
#pragma unroll
        for (int kk = 0; kk < 2; ++kk) {
            bf16x8 Bs[4], Avk[2];
#pragma unroll
            for (int dv = 0; dv < 2; ++dv) { const int dvr = 16 * (2 * w + dv) + fr; const LAS unsigned* vp = VT + dvr * 33; const int p0 = 4 * fq + 16 * kk; Avk[dv] = mk_frag(vp[vt_col(dvr, p0)], vp[vt_col(dvr, p0 + 1)], vp[vt_col(dvr, p0 + 2)], vp[vt_col(dvr, p0 + 3)]); }
#pragma unroll
            for (int tt = 0; tt < 4; ++tt) Bs[tt] = ld_frag_lds(Ss + (16 * tt + fr) * 144 + 16 * fq + 64 * kk);
#pragma unroll
            for (int dv = 0; dv < 2; ++dv)
#pragma unroll
                for (int tt = 0; tt < 4; ++tt) acc[dv][tt] = MFMA16(Avk[dv], Bs[tt], acc[dv][tt]);
            __builtin_amdgcn_sched_barrier(0);
        }
        LAS float* redw = (LAS float*)(F.lds + B4_RED) + w * 64;
        { const int t = lane; const float qnt = ((qn[t] + qn[64 + t]) + (qn[128 + t] + qn[192 + t])) + ((qn[256 + t] + qn[320 + t]) + (qn[384 + t] + qn[448 + t]));
            const float dn = ((den[t] + den[64 + t]) + (den[128 + t] + den[192 + t])) + wint[t] * qnt; redw[t] = 1.0f / fmaxf(fabsf(dn), eneg[t]); }
        LDS_WAIT(); asm volatile("" ::: "memory");
#pragma unroll
        for (int tt = 0; tt < 4; ++tt) { const int t = 16 * tt + fr; const float inv = redw[t];
            float q = 0.f;
#pragma unroll
            for (int dv = 0; dv < 2; ++dv) { acc[dv][tt] *= inv; const f32x4 v = acc[dv][tt] * acc[dv][tt]; q += (v[0] + v[1]) + (v[2] + v[3]); }
            q += __shfl_xor(q, 16); q += __shfl_xor(q, 32);
            if (fq == 0) hss[w * 64 + t] = q; }
        __syncthreads();
        { const int t = lane; const float hs = ((hss[t] + hss[64 + t]) + (hss[128 + t] + hss[192 + t])) + ((hss[256 + t] + hss[320 + t]) + (hss[384 + t] + hss[448 + t]));
            redw[t] = 1.0f / sqrtf(hs * (1.0f / 256.0f) + EPS); }
        LDS_WAIT(); asm volatile("" ::: "memory");
#pragma unroll
        for (int tt = 0; tt < 4; ++tt) { const int t = 16 * tt + fr; const float rst = redw[t];
#pragma unroll
            for (int dv = 0; dv < 2; ++dv) { const int col = h * 256 + 16 * (2 * w + dv) + 4 * fq;
                const u32x2 og = ogv[tt][dv]; const f32x4 g4 = hgv[dv];
                const float o0 = acc[dv][tt][0] * rst * g4[0] * fast_rcp(1.0f + __expf(-bflo(og.x))), o1 = acc[dv][tt][1] * rst * g4[1] * fast_rcp(1.0f + __expf(-bfhi(og.x)));
                const float o2 = acc[dv][tt][2] * rst * g4[2] * fast_rcp(1.0f + __expf(-bflo(og.y))), o3 = acc[dv][tt][3] * rst * g4[3] * fast_rcp(1.0f + __expf(-bfhi(og.y)));
                u32x2 wv; wv.x = cvt_pk_bf16(o0, o1); wv.y = cvt_pk_bf16(o2, o3);
                *(GAS u32x2*)(OB + (size_t)(n0 + t) * DM + col) = wv; } }
        { const float aa = scal[0];
            bf16x8 Avk[2][2];
#pragma unroll
            for (int kk = 0; kk < 2; ++kk)
#pragma unroll
                for (int dv = 0; dv < 2; ++dv) { const int dvr = 16 * (2 * w + dv) + fr; const LAS unsigned* vp = VT + dvr * 33; const int p0 = 4 * fq + 16 * kk; Avk[kk][dv] = mk_frag(vp[vt_col(dvr, p0)], vp[vt_col(dvr, p0 + 1)], vp[vt_col(dvr, p0 + 2)], vp[vt_col(dvr, p0 + 3)]); }
#pragma unroll
            for (int bt = 0; bt < 2; ++bt)
#pragma unroll
                for (int at = 0; at < 8; ++at) Cst[bt][at] *= aa;
#pragma unroll
            for (int at = 0; at < 8; ++at) { const LAS unsigned char* kp = KwT + (16 * at + fr) * 144 + 16 * fq; const bf16x8 A0 = ld_frag_lds(kp), A1 = ld_frag_lds(kp + 64);
#pragma unroll
                for (int bt = 0; bt < 2; ++bt) { Cst[bt][at] = MFMA16(A0, Avk[0][bt], Cst[bt][at]); Cst[bt][at] = MFMA16(A1, Avk[1][bt], Cst[bt][at]); } }
            if (Fi.tid >= 64 && Fi.tid < 192) { const int dk = Fi.tid - 64; const LAS unsigned char* kr = KwT + dk * 144; float sum = 0.f;
#pragma unroll
                for (int q8 = 0; q8 < 8; ++q8) { const u32x4 x = *(const LAS u32x4*)(kr + 16 * q8); sum += ((bflo(x.x) + bfhi(x.x)) + (bflo(x.y) + bfhi(x.y))) + ((bflo(x.z) + bfhi(x.z)) + (bflo(x.w) + bfhi(x.w))); }
                npv[dk] = aa * npv[dk] + sum; } }
    }
#undef B4_FETCH
}


#ifdef PROBE_BUF
__device__ __forceinline__ void probe_scan(const Frame& F, const Args& a) {
    unsigned* ctl = (unsigned*)(a.ws + WS_CTL);
    unsigned bad = 0; float ms = 0.f;
    for (size_t i = (size_t)F.vcu * 512 + F.tid; i < (size_t)(PROBE_N); i += (size_t)F.G * 512) {
        float v;
        if (PROBE_KIND == 0) v = bf2f(((const bf16_t*)(a.ws + PROBE_BUF))[i]); else v = ((const float*)(a.ws + PROBE_BUF))[i];
        if (fabsf(v) < 1e30f) ms += v * v; else ++bad;
    }
    if (PROBE_STAT == 2) { bad = 0; ms = 0.f;
        for (int u = F.vcu * 8 + F.wave; u < (int)((PROBE_N) / 32768); u += F.G * 8) { unsigned b2 = 0;
            for (int i = F.lane; i < 32768; i += 64) { const float v = bf2f(((const bf16_t*)(a.ws + PROBE_BUF))[(size_t)u * 32768 + i]); if (!(fabsf(v) < 1e30f)) b2 = 1; }
            b2 = __any(b2) ? 1u : 0u; if (F.lane == 0) bad += b2 * 32768u; } }
    atomicAdd(ctl + 20000, bad); atomicAdd((float*)(ctl + 20064), ms);
}
__device__ __forceinline__ void probe_fill(const Frame& F, const Args& a) {
    const unsigned* ctl = (const unsigned*)(a.ws + WS_CTL);
    const float f = (float)ctl[20000] / (float)(PROBE_N), msq = ((const float*)ctl)[20064] / (float)(PROBE_N);
    const float c = sqrtf(PROBE_STAT != 1 ? 10.0f * f : msq);
    for (size_t i = (size_t)F.vcu * 512 + F.tid; i < (size_t)NTOK * DM; i += (size_t)F.G * 512) a.out[i] = c;
}
#endif
constexpr int NPHASE = 1 + NLAYER * 10;

typedef const __attribute__((address_space(4))) Args* KArgsPtr;
__device__ __forceinline__ Args opaque_args() {
#if defined(__HIP_DEVICE_COMPILE__)
    KArgsPtr p = (KArgsPtr)__builtin_amdgcn_kernarg_segment_ptr(); asm volatile("" : "+s"(p)); return *p;
#else
    return Args{};
#endif
}
#define SITE() const Frame FP = make_frame(lds); const Args A = opaque_args(); unsigned char* const ws = A.ws; (void)ws
__global__ void __launch_bounds__(512, 2) mk_fwd(Args args) {
    extern __shared__ __attribute__((aligned(16))) unsigned char lds_raw[];
    LAS unsigned char* const lds = (LAS unsigned char*)lds_raw;
    volatile LAS unsigned* MISC = (volatile LAS unsigned*)(lds + MISC_OFF);
    if (threadIdx.x < 32) MISC[threadIdx.x] = 0u;
    __syncthreads();
    const int lo = args.ph_lo, hi = args.ph_hi;
    XcdBarrier bar; bar.bar = (unsigned*)(args.ws + WS_CTL) + CW_BAR; bar.x = 0; bar.st = nullptr;
    if (hi - lo > 1) bar = xcd_barrier_post((unsigned*)(args.ws + WS_CTL) + CW_BAR, MISC + 8);
#define IN(k) (lo <= (k) && (k) < hi)
#ifdef XBAR_EXTRA
#define SEAM(k) do { if (IN(k) && IN((k) + 1)) { xcd_barrier(bar); xcd_barrier(bar); } } while (0)
#else
#define SEAM(k) do { if (IN(k) && IN((k) + 1)) xcd_barrier(bar); } while (0)
#endif
    if (PHON(0) && IN(0)) for (int rep_ = 0; rep_ < NREP(0); ++rep_) { SITE(); p0_weights(FP, A); phase_x0(FP, A); }
    SEAM(0);
    for (int l = 0; l < NLAYER; ++l) {
        const int pb = 1 + l * 10, j = l >> 1;
        if ((l & 1) == 0) {
            if (PHON(1) && IN(pb)) for (int rep_ = 0; rep_ < NREP(1); ++rep_) { SITE(); pg8::Gemm g{(const bf16_t*)(ws + WS_XB), (const bf16_t*)(ws + WS_WQKV) + (size_t)j * 3072 * DM, DM, 0, nullptr, nullptr, nullptr};
                pg8::StaticOrder S; S.init(NTOK / 256, 12, FP.G, (int)blockIdx.x, nullptr);
                pg8::EpiQKV E{(bf16_t*)(ws + WS_QKV), (const float*)(ws + SM_RSTD), A.in[4] + j * 64, A.in[5] + j * 64, 0.125f * LOG2E};
                pg8::gemm_phase<pg8::EpiQKV, true, false>(lds, FP.tid, g, S, E); }
            SEAM(pb);
            if (PHON(2) && IN(pb + 1)) for (int rep_ = 0; rep_ < NREP(2); ++rep_) { SITE(); phase_attn_a(FP, A, j); }
            SEAM(pb + 1);
            if (PHON(3) && IN(pb + 2)) for (int rep_ = 0; rep_ < NREP(3); ++rep_) { SITE(); phase_attn_b(FP, A, j); }
            if (IN(pb + 2) && IN(pb + 4)) xcd_barrier(bar);
            if (PHON(4) && IN(pb + 4)) { SITE(); pg8::Gemm g{(const bf16_t*)(ws + WS_OB), (const bf16_t*)(ws + WS_WO) + (size_t)j * DM * DM, DM, 0, nullptr, nullptr, nullptr};
                pg8::StaticOrder S; S.init(NTOK / 256, 4, FP.G, (int)blockIdx.x, nullptr);
                pg8::EpiResidB E{(bf16_t*)(ws + WS_XB)};
                pg8::gemm_phase<pg8::EpiResidB, true, false, true>(lds, FP.tid, g, S, E); }
            SEAM(pb + 4);
        } else {
            if (PHON(5) && IN(pb)) for (int rep_ = 0; rep_ < NREP(5); ++rep_) { SITE(); pg8::Gemm g{(const bf16_t*)(ws + WS_XB), (const bf16_t*)(ws + WS_WIN) + (size_t)j * 3072 * DM, DM, 0, nullptr, nullptr, nullptr};
                pg8::StaticOrder S; S.init(NTOK / 256, 12, FP.G, (int)blockIdx.x, nullptr);
                pg8::EpiBf16 E{(bf16_t*)(ws + WS_QKV), 3072, (const float*)(ws + SM_RSTD)};
                pg8::gemm_phase<pg8::EpiBf16, true, false>(lds, FP.tid, g, S, E); }
            SEAM(pb);
            if (PHON(6) && IN(pb + 1)) for (int rep_ = 0; rep_ < NREP(6); ++rep_) { SITE(); phase_mlstm_local(FP, A, j); }
            SEAM(pb + 1);
            if (PHON(7) && IN(pb + 2)) for (int rep_ = 0; rep_ < NREP(7); ++rep_) { SITE(); phase_mlstm_scan(FP, A); }
            SEAM(pb + 2);
            if (PHON(8) && IN(pb + 3)) for (int rep_ = 0; rep_ < NREP(8); ++rep_) { SITE(); phase_mlstm_out(FP, A, j); }
            SEAM(pb + 3);
            if (PHON(9) && IN(pb + 4)) { SITE(); pg8::Gemm g{(const bf16_t*)(ws + WS_OB), (const bf16_t*)(ws + WS_WMO) + (size_t)j * DM * DM, DM, 0, nullptr, nullptr, nullptr};
                pg8::StaticOrder S; S.init(NTOK / 256, 4, FP.G, (int)blockIdx.x, nullptr);
                pg8::EpiResidB E{(bf16_t*)(ws + WS_XB)};
                pg8::gemm_phase<pg8::EpiResidB, true, false>(lds, FP.tid, g, S, E); }
            SEAM(pb + 4);
        }
        if (PHON(10) && IN(pb + 5)) for (int rep_ = 0; rep_ < NREP(10); ++rep_) { SITE(); phase_router(FP, A, l, rep_ + 1 < NREP(10)); }
        if (IN(pb + 5) && IN(pb + 7)) xcd_barrier(bar);
        if (PHON(12) && IN(pb + 7)) for (int rep_ = 0; rep_ < NREP(12); ++rep_) { SITE();
            LAS int* pst = (LAS int*)(lds + MOE_TAB_OFF); LAS int* cnt = (LAS int*)(lds + MOE_TAB_OFF + 512);
            const int ntiles = __builtin_amdgcn_readfirstlane(moe_tables(FP, (const unsigned*)(ws + WS_CTL) + CW_CNT + l * 64, pst, cnt));
            pg8::Gemm g{(const bf16_t*)(ws + WS_XB), (const bf16_t*)(ws + WS_WGU) + (size_t)l * 64 * DM * DM, DM, (size_t)DM * DM * 2, (const int*)(ws + WS_QC), pst, cnt};
            pg8::StaticOrder S; S.init(ntiles, 4, FP.G, (int)blockIdx.x, pst);
            pg8::EpiGU E{(bf16_t*)(ws + WS_ACT), (const float*)(ws + SM_RSTD), (const int*)(ws + WS_QC), pst, cnt};
            pg8::gemm_phase<pg8::EpiGU, true, true>(lds, FP.tid, g, S, E); }
        SEAM(pb + 7);
        if (PHON(13) && IN(pb + 8)) for (int rep_ = 0; rep_ < NREP(13); ++rep_) { SITE();
            LAS int* pst = (LAS int*)(lds + MOE_TAB_OFF); LAS int* cnt = (LAS int*)(lds + MOE_TAB_OFF + 512);
            const int ntiles = __builtin_amdgcn_readfirstlane(moe_tables(FP, (const unsigned*)(ws + WS_CTL) + CW_CNT + l * 64, pst, cnt));
            pg8::Gemm g{(const bf16_t*)(ws + WS_ACT), (const bf16_t*)(ws + WS_WD) + (size_t)l * 64 * DM * FFE, FFE, (size_t)DM * FFE * 2, nullptr, pst, cnt};
            pg8::StaticOrder S; S.init(ntiles, 4, FP.G, (int)blockIdx.x, pst);
            pg8::EpiBf16 E{(bf16_t*)(ws + WS_YB), DM, nullptr};
            pg8::gemm_phase<pg8::EpiBf16, true, false>(lds, FP.tid, g, S, E); }
        SEAM(pb + 8);
        if (PHON(14) && IN(pb + 9)) { SITE(); phase_combine(FP, A, l); }
        SEAM(pb + 9);
    }
#ifdef PROBE_BUF
    if (IN(NPHASE)) { SITE(); probe_scan(FP, A); }
    if (IN(NPHASE + 1)) { SITE(); probe_fill(FP, A); }
#endif
#undef IN
#undef SEAM
}

extern "C" void kernel_launch(void* const* d_in, const int* in_sizes, int n_in, void* d_out, int out_size, void* d_ws, size_t ws_size, hipStream_t stream) {
    static int grid = 0;
    if (grid == 0) {
        if (n_in != 20 || out_size != NTOK * DM || ws_size < WS_END) { fprintf(stderr, "kernel_launch: unexpected shapes (n_in %d, out %d, ws %zu < %zu); nothing launched\n", n_in, out_size, ws_size, (size_t)WS_END); grid = -1; return; }
        int dev = 0, cus = 0, per_cu = 0;
        if (hipGetDevice(&dev) != hipSuccess || hipDeviceGetAttribute(&cus, hipDeviceAttributeMultiprocessorCount, dev) != hipSuccess) { grid = -1; return; }
        if (hipFuncSetAttribute((const void*)mk_fwd, hipFuncAttributeMaxDynamicSharedMemorySize, LDS_BYTES) != hipSuccess) { fprintf(stderr, "kernel_launch: hipFuncSetAttribute failed\n"); grid = -1; return; }
        if (hipOccupancyMaxActiveBlocksPerMultiprocessor(&per_cu, (const void*)mk_fwd, 512, LDS_BYTES) != hipSuccess || per_cu < 1) { fprintf(stderr, "kernel_launch: occupancy query says %d\n", per_cu); }
        (void)hipGetLastError();
        grid = cus;
        if (grid != 256) { fprintf(stderr, "kernel_launch: built for a 256-CU device, found %d CUs; nothing launched\n", cus); grid = -1; return; }
    }
    if (grid < 0) return;
    if (hipMemsetAsync((char*)d_ws + WS_CTL, 0, CTL_ZERO_BYTES, stream) != hipSuccess) return;
    Args a{};
    for (int i = 0; i < 20; ++i) a.in[i] = (const float*)d_in[i];
    a.out = (float*)d_out; a.ws = (unsigned char*)d_ws;
#if MK_ONE_LAUNCH
    a.ph_lo = 0; a.ph_hi = NPHASE;
    hipLaunchKernelGGL(mk_fwd, dim3(grid), dim3(512), LDS_BYTES, stream, a);
#else
    int np = NPHASE;
#ifdef PROBE_BUF
    np += 2;
#endif
    for (int p = 0; p < np; ++p) { a.ph_lo = p; a.ph_hi = p + 1; hipLaunchKernelGGL(mk_fwd, dim3(grid), dim3(512), LDS_BYTES, stream, a); }
#endif
}
```

```cpp
#include <hip/hip_runtime.h>
#include <cstdio>
#include <cstdint>

#ifndef MK_ONE_LAUNCH
#define MK_ONE_LAUNCH 1
#endif

#ifndef PHMASK
#define PHMASK 0xFFFFFFFFu
#endif
#define PHON(n) ((PHMASK >> (n)) & 1u)
#ifndef REPMASK
#define REPMASK 0u
#endif
#define NREP(n) (1 + (int)((REPMASK >> (n)) & 1u))
#ifdef DBG_NOGATES
#define DBGG(x) 0.0f
#else
#define DBGG(x) (x)
#endif

#define LAS __attribute__((address_space(3)))
#define GAS __attribute__((address_space(1)))
typedef unsigned short bf16_t;
typedef short bf16x8 __attribute__((ext_vector_type(8)));
typedef float f32x4 __attribute__((ext_vector_type(4)));
typedef float f32x2 __attribute__((ext_vector_type(2)));
typedef unsigned u32x4 __attribute__((ext_vector_type(4)));
typedef unsigned u32x2 __attribute__((ext_vector_type(2)));

constexpr int NTOK = 32768, SEQ = 16384, DM = 1024, NLAYER = 4;
constexpr int NEXP = 64, FFE = 512;
constexpr int PMAX = 81920;
constexpr float EPS = 1e-6f;
constexpr float LOG2E = 1.4426950408889634f;

constexpr size_t MiB = 1u << 20;
constexpr size_t WS_CTL = 0, CTL_ZERO_BYTES = 1 * MiB;
constexpr size_t WS_WQKV = 2 * MiB, WS_WO = 14 * MiB, WS_WIN = 18 * MiB, WS_WMO = 30 * MiB, WS_WR = 34 * MiB, WS_WG = 36 * MiB;
constexpr size_t WS_SMALL = 37 * MiB;
constexpr size_t SM_RSTD = WS_SMALL, SM_GATES = WS_SMALL + 256 * 1024, SM_TOKE = WS_SMALL + 1280 * 1024, SM_TOKG = WS_SMALL + 1536 * 1024,
                 SM_TOKP = WS_SMALL + 1792 * 1024, SM_ROWTOK = WS_SMALL + 2 * MiB, SM_TILEEXP = WS_SMALL + 2 * MiB + 512 * 1024,
                 SM_MLOC = WS_SMALL + 2 * MiB + 768 * 1024, SM_BL = SM_MLOC + 8192, SM_MPREV = SM_MLOC + 16384,
                 SM_DN = WS_SMALL + 3 * MiB, SM_NS = WS_SMALL + 4 * MiB, SM_L1 = WS_SMALL + 5 * MiB, SM_L2 = WS_SMALL + 7 * MiB;
constexpr size_t WS_WGU = 64 * MiB, WS_WD = 576 * MiB, WS_XB = 832 * MiB, WS_QKV = 898 * MiB, WS_OB = 1090 * MiB,
                 WS_P1 = 1170 * MiB, WS_P2 = 1234 * MiB, WS_CS = 1298 * MiB, WS_QC = 1426 * MiB, WS_KC = 1458 * MiB, WS_END = 1490 * MiB;
constexpr size_t WS_YB = WS_QKV, WS_ACT = WS_OB, WS_DC = WS_P1;
constexpr int CW_BAR = 4096, CW_CNT = 16384;

constexpr int LDS_BYTES = 147456;
constexpr int MISC_OFF = 147456 - 512;

__device__ __forceinline__ unsigned f2bf(float f) { unsigned u = __builtin_bit_cast(unsigned, f); return (u + 0x7fffu + ((u >> 16) & 1u)) >> 16; }
__device__ __forceinline__ float bf2f(unsigned h) { return __builtin_bit_cast(float, h << 16); }
typedef __bf16 bf16x2_t __attribute__((ext_vector_type(2)));
__device__ __forceinline__ unsigned cvt_pk_bf16(float lo, float hi) { f32x2 v = {lo, hi}; bf16x2_t r = __builtin_convertvector(v, bf16x2_t); return __builtin_bit_cast(unsigned, r); }
__device__ __forceinline__ float bflo(unsigned w) { return __builtin_bit_cast(float, w << 16); }
__device__ __forceinline__ float bfhi(unsigned w) { return __builtin_bit_cast(float, w & 0xffff0000u); }
__device__ __forceinline__ float fast_exp2(float x) { return __builtin_amdgcn_exp2f(x); }
__device__ __forceinline__ float fast_rcp(float x) { return __builtin_amdgcn_rcpf(x); }
#define LDS_WAIT() asm volatile("s_waitcnt lgkmcnt(0)" ::: "memory")
#define VM_WAIT() asm volatile("s_waitcnt vmcnt(0)" ::: "memory")

#define XB_TMO      128
#define XB_XCNT(j)  (256  + 64 * (j))
#define XB_XSUB(j)  (1280 + 64 * (j))
#define XB_XGEN(j)  (2304 + 64 * (j))
#define XB_TOP      3328
#define XB_TOPGEN   3392
#define XCD_BAR_WORDS 3456
#define XB_SPIN_CAP (1u << 18)
__device__ __forceinline__ unsigned xb_ld(unsigned* p)              { return __hip_atomic_load(p, __ATOMIC_RELAXED, __HIP_MEMORY_SCOPE_AGENT); }
__device__ __forceinline__ unsigned xb_add(unsigned* p, unsigned v) { return __hip_atomic_fetch_add(p, v, __ATOMIC_RELAXED, __HIP_MEMORY_SCOPE_AGENT); }
__device__ __forceinline__ unsigned xb_xcc_id() { return (unsigned)__builtin_amdgcn_s_getreg((3 << 11) | 20) & 0xFu; }
#define XB_SPIN(cond, bar) do { unsigned _sp = 0; while (cond) { __builtin_amdgcn_s_sleep(1); \
    if ((++_sp & 255u) == 0u) { if (xb_ld(&(bar)[XB_TMO])) break; if (_sp > XB_SPIN_CAP) { atomicAdd(&(bar)[XB_TMO], 1u); break; } } } } while (0)
struct XcdBarrier { unsigned* bar; unsigned x; volatile LAS unsigned* st; };
__device__ __forceinline__ XcdBarrier xcd_barrier_post(unsigned* bar, volatile LAS unsigned* st) {
    XcdBarrier b; b.bar = bar; b.x = xb_xcc_id(); b.st = st;
    if (threadIdx.x == 0) (void)xb_add(&bar[XB_XCNT(b.x)], 1u);
    return b;
}
__device__ __forceinline__ void xcd_barrier_complete(unsigned* bar, unsigned x, unsigned& nloc, unsigned& nx) {
    const unsigned G = gridDim.x * gridDim.y * gridDim.z;
    unsigned sum, cnt, mine, sp = 0u;
    for (;;) {
        sum = 0u; cnt = 0u; mine = 0u;
#pragma unroll
        for (unsigned j = 0; j < 16; ++j) { const unsigned c = xb_ld(&bar[XB_XCNT(j)]); sum += c; cnt += (c > 0u) ? 1u : 0u; mine = (j == x) ? c : mine; }
        if (sum == G) break;
        __builtin_amdgcn_s_sleep(1);
        if ((++sp & 255u) == 0u) { if (xb_ld(&bar[XB_TMO])) break; if (sp > XB_SPIN_CAP) { atomicAdd(&bar[XB_TMO], 1u); break; } }
    }
    nloc = mine > 0u ? mine : 1u; nx = cnt > 0u ? cnt : 1u;
}
__device__ __forceinline__ void xcd_barrier(const XcdBarrier& b) {
    asm volatile("s_waitcnt vmcnt(0)" ::: "memory");
    __syncthreads();
    if (threadIdx.x == 0) {
        unsigned* bar = b.bar;
        __builtin_amdgcn_s_waitcnt(0);
        unsigned nloc = b.st[0], nx = b.st[1];
        if (nloc == 0u) { xcd_barrier_complete(bar, b.x, nloc, nx); b.st[0] = nloc; b.st[1] = nx; }
        const unsigned old = xb_add(&bar[XB_XSUB(b.x)], 1u);
        const unsigned gen = old / nloc;
        if (old + 1u == (gen + 1u) * nloc) {
            __builtin_amdgcn_fence(__ATOMIC_RELEASE, "agent");
            asm volatile("s_waitcnt vmcnt(0)" ::: "memory");
            const unsigned og = xb_add(&bar[XB_TOP], 1u);
            const unsigned tg = og / nx;
            if (og + 1u == (tg + 1u) * nx) xb_add(&bar[XB_TOPGEN], 1u);
            else XB_SPIN(xb_ld(&bar[XB_TOPGEN]) == tg, bar);
            __builtin_amdgcn_fence(__ATOMIC_ACQUIRE, "agent");
            xb_add(&bar[XB_XGEN(b.x)], 1u);
            asm volatile("s_waitcnt vmcnt(0)" ::: "memory");
        } else {
            XB_SPIN(xb_ld(&bar[XB_XGEN(b.x)]) == gen, bar);
            __builtin_amdgcn_fence(__ATOMIC_ACQUIRE, "agent");
            asm volatile("s_waitcnt vmcnt(0)" ::: "memory");
        }
    }
    __syncthreads();
}

namespace pg8 {
constexpr int BM = 256, BK = 64, HALF = 128, HTB = HALF * BK * 2, STAGE_BYTES = 8 * HTB, NXCD = 8, WGM = 8;
__host__ __device__ __forceinline__ int lds_byte(int r, int c) { const int st = (r >> 4) * 2 + (c >> 5), rr = r & 15, cc = c & 31, ob = rr * 64 + cc * 2; return st * 1024 + (ob ^ (((ob >> 9) & 1) << 5)); }
__host__ __device__ __forceinline__ void stage_rc(int b, int& R, int& C) { const int st = b / 1024, sb = b % 1024, swz = sb ^ (((sb >> 9) & 1) << 5); R = (st >> 1) * 16 + swz / 64; C = (st & 1) * 32 + (swz % 64) / 2; }
__host__ __device__ __forceinline__ int perm32(int rho) { const int n = rho >> 4, i = rho & 15; return 8 * (i >> 2) + 4 * n + (i & 3); }

struct Unit { int pm, pn, e; };
struct Gemm { const bf16_t* A; const bf16_t* Bt; int K; size_t b_estride; const int* sparse; const LAS int* pst; const LAS int* cnt; };

struct StaticOrder {
    int nM, nN, nwg, G, c; const LAS int* pst;
    __device__ void init(int nM_, int nN_, int G_, int c_, const LAS int* pst_) { nM = nM_; nN = nN_; nwg = nM * nN; G = G_; c = c_; pst = pst_; }
    __device__ bool next(int i, Unit& u) const {
        const long L = (long)i * G + c; if (L >= nwg) return false;
        int wgid = (int)L; { const int q = nwg / NXCD, r = nwg % NXCD, xcd = wgid % NXCD, off = wgid / NXCD; wgid = (xcd < r ? xcd * (q + 1) : r * (q + 1) + (xcd - r) * q) + off; }
        const int nig = WGM * nN, gid = wgid / nig, fm = gid * WGM, gsz = (nM - fm) < WGM ? (nM - fm) : WGM;
        u.pm = fm + ((wgid % nig) % gsz); u.pn = (wgid % nig) / gsz;
        u.e = pst ? __builtin_amdgcn_readfirstlane(pst[256 + u.pm]) : 0;
        return true;
    }
};

template <class Epi, bool ALIGN_EPI, bool GATHER, bool A_HM = false>
__device__ __forceinline__ void gemm_phase(LAS unsigned char* lds, const int tid, const Gemm g, const StaticOrder& S, const Epi& E) {
    const int wid = __builtin_amdgcn_readfirstlane(tid >> 6), lane = tid & 63, wr = wid >> 2, wc = wid & 3, fr = lane & 15, fq = lane >> 4;
    const int K = g.K, nt = K / BK;
    int RA[2], CA[2]; unsigned voffB[2];
#pragma unroll
    for (int i = 0; i < 2; ++i) { int R, C; stage_rc(tid * 16 + i * 8192, R, C); const int Rb = Epi::PERM ? ((R & ~31) + perm32(R & 31)) : R;
        RA[i] = R; CA[i] = C; voffB[i] = (unsigned)(Rb * K + C) * 2u; }
    const size_t kstep = (size_t)(BK * 2);
    const size_t hstep = (size_t)HALF * K * 2;
    const size_t tstep = 2 * hstep;
    const size_t akstep = A_HM ? (size_t)16384 * 128 : kstep, ahstep = A_HM ? (size_t)HALF * 128 : hstep;
#define PG8_ABASE(pm_) (A_HM ? ((size_t)((pm_) >> 6) * 16 * 16384 + (size_t)((pm_) & 63) * 256) * 128 : (size_t)(pm_) * tstep)
    const unsigned ldsw = (unsigned)wid * 1024u;
    const int aoff = lds_byte(wr * 64 + fr, fq * 8), boff = lds_byte(wc * 32 + fr, fq * 8);
#define PG8_SA(b, h) (((b) * 2 + (h)) * HTB)
#define PG8_SB(b, h) ((4 + (b) * 2 + (h)) * HTB)
#define PG8_STAGE(bufoff, gbase, voff) do { _Pragma("unroll") for (int _i = 0; _i < 2; ++_i) \
        __builtin_amdgcn_global_load_lds((const unsigned*)((const char*)(gbase) + (voff)[_i]), (LAS unsigned*)(lds + (bufoff) + ldsw + _i * 8192), 16, 0, 0); } while (0)
#define PG8_LDA(dst, b, h) do { _Pragma("unroll") for (int m = 0; m < 4; ++m) _Pragma("unroll") for (int k = 0; k < 2; ++k) dst[m][k] = *(const LAS bf16x8*)(lds + PG8_SA(b, h) + aoff + m * 2048 + k * 1024); } while (0)
#define PG8_LDB(dst, b, h) do { _Pragma("unroll") for (int n = 0; n < 2; ++n) _Pragma("unroll") for (int k = 0; k < 2; ++k) dst[n][k] = *(const LAS bf16x8*)(lds + PG8_SB(b, h) + boff + n * 2048 + k * 1024); } while (0)
#define PG8_MMA(ai, bj, At, Bt) do { __builtin_amdgcn_s_setprio(1); _Pragma("unroll") for (int m = 0; m < 4; ++m) _Pragma("unroll") for (int n = 0; n < 2; ++n) _Pragma("unroll") for (int k = 0; k < 2; ++k) \
        acc[ai][bj][m][n] = __builtin_amdgcn_mfma_f32_16x16x32_bf16(Bt[n][k], At[m][k], acc[ai][bj][m][n], 0, 0, 0); __builtin_amdgcn_s_setprio(0); } while (0)
#define PG8_WAIT_V(n) asm volatile("s_waitcnt vmcnt(" #n ")" ::: "memory")
#define PG8_WAIT_L(n) asm volatile("s_waitcnt lgkmcnt(" #n ")" ::: "memory")
#define PG8_BAR __builtin_amdgcn_s_barrier()
#define PG8_SCHED __builtin_amdgcn_sched_barrier(0)
#define PG8_AOFFS(dst, unit) do { _Pragma("unroll") for (int _h = 0; _h < 2; ++_h) _Pragma("unroll") for (int _i = 0; _i < 2; ++_i) { \
        const int _j = (unit).pm * BM + _h * HALF + RA[_i] - g.pst[(unit).e]; const int _src = (_j < g.cnt[(unit).e]) ? g.sparse[(unit).e * 32768 + _j] : NTOK; dst[_h][_i] = (unsigned)(_src * K + CA[_i]) * 2u; } } while (0)
    Unit cur, nxt; int ui = 0;
    if (!S.next(0, cur)) return;
    f32x4 acc[2][2][4][2];
#pragma unroll
    for (int a = 0; a < 2; ++a)
#pragma unroll
        for (int b = 0; b < 2; ++b)
#pragma unroll
            for (int m = 0; m < 4; ++m)
#pragma unroll
                for (int n = 0; n < 2; ++n) acc[a][b][m][n] = (f32x4){0.f, 0.f, 0.f, 0.f};
    bf16x8 At[4][2], B0[2][2], B1[2][2];
    unsigned voffA[2]; unsigned cAo[2][2], nAo[2][2];
#pragma unroll
    for (int i = 0; i < 2; ++i) voffA[i] = (unsigned)(RA[i] * (A_HM ? 64 : K) + CA[i]) * 2u;
    const char* cA = (const char*)g.A;
    if constexpr (GATHER) { PG8_AOFFS(cAo, cur); } else { cA += PG8_ABASE(cur.pm); }
    const char* cB = (const char*)g.Bt + (size_t)cur.e * g.b_estride + (size_t)cur.pn * tstep;
#define PG8_STAGE_A(bufoff, base, h, nx) do { if constexpr (GATHER) { _Pragma("unroll") for (int _i = 0; _i < 2; ++_i) { const unsigned _o = (nx) ? nAo[h][_i] : cAo[h][_i]; \
            __builtin_amdgcn_global_load_lds((const unsigned*)((const char*)(base) + _o), (LAS unsigned*)(lds + (bufoff) + ldsw + _i * 8192), 16, 0, 0); } } \
        else { PG8_STAGE(bufoff, (base) + (h) * ahstep, voffA); } } while (0)
    PG8_STAGE(PG8_SB(0, 0), cB, voffB); PG8_STAGE(PG8_SB(0, 1), cB + hstep, voffB); PG8_STAGE_A(PG8_SA(0, 0), cA, 0, false); PG8_STAGE_A(PG8_SA(0, 1), cA, 1, false);
    if (wr == 1) PG8_BAR;
    PG8_WAIT_V(2); PG8_BAR;
    PG8_STAGE(PG8_SB(1, 0), cB + kstep, voffB); PG8_STAGE_A(PG8_SA(1, 0), cA + akstep, 0, false); PG8_STAGE(PG8_SB(1, 1), cB + hstep + kstep, voffB);
    PG8_WAIT_V(6); PG8_BAR;
    for (;;) {
        const bool has_next = S.next(ui + 1, nxt);
        const char* nA = cA;
        if constexpr (GATHER) { if (has_next) { PG8_AOFFS(nAo, nxt); } else {
#pragma unroll
            for (int h = 0; h < 2; ++h)
#pragma unroll
                for (int i = 0; i < 2; ++i) nAo[h][i] = cAo[h][i]; } }
        else { if (has_next) nA = (const char*)g.A + PG8_ABASE(nxt.pm); }
        const char* nB = has_next ? (const char*)g.Bt + (size_t)nxt.e * g.b_estride + (size_t)nxt.pn * tstep : cB;
        for (int t = 0; t < nt; t += 2) {
            const bool last = (t == nt - 2);
            const char* a1 = cA + (size_t)(t + 1) * akstep;
            const char* a2 = last ? nA : cA + (size_t)(t + 2) * akstep; const char* b2 = last ? nB : cB + (size_t)(t + 2) * kstep;
            const char* a3 = a2 + akstep; const char* b3 = b2 + kstep;
            PG8_LDB(B0, 0, 0); PG8_LDB(B1, 0, 1); PG8_SCHED; PG8_LDA(At, 0, 0); PG8_STAGE_A(PG8_SA(1, 1), a1, 1, false);
            PG8_WAIT_V(8); PG8_WAIT_L(0); PG8_BAR; PG8_MMA(0, 0, At, B0); PG8_MMA(0, 1, At, B1); PG8_BAR; PG8_SCHED;
            PG8_LDA(At, 0, 1); PG8_STAGE(PG8_SB(0, 0), b2, voffB); PG8_STAGE(PG8_SB(0, 1), b2 + hstep, voffB); PG8_STAGE_A(PG8_SA(0, 0), a2, 0, last);
            PG8_WAIT_V(8); PG8_WAIT_L(0); PG8_BAR; PG8_MMA(1, 0, At, B0); PG8_MMA(1, 1, At, B1); PG8_BAR; PG8_SCHED;
            PG8_LDB(B0, 1, 0); PG8_LDB(B1, 1, 1); PG8_SCHED; PG8_LDA(At, 1, 0); PG8_STAGE_A(PG8_SA(0, 1), a2, 1, last);
            PG8_WAIT_V(8); PG8_WAIT_L(0); PG8_BAR; PG8_MMA(0, 0, At, B0); PG8_MMA(0, 1, At, B1); PG8_BAR; PG8_SCHED;
            PG8_LDA(At, 1, 1); PG8_STAGE(PG8_SB(1, 0), b3, voffB); PG8_STAGE(PG8_SB(1, 1), b3 + hstep, voffB); PG8_STAGE_A(PG8_SA(1, 0), a3, 0, last);
            PG8_WAIT_V(8); PG8_WAIT_L(0); PG8_BAR; PG8_MMA(1, 0, At, B0); PG8_MMA(1, 1, At, B1); PG8_BAR; PG8_SCHED;
        }
        if constexpr (ALIGN_EPI) { if (wr == 0) PG8_BAR; }
        E(acc, cur, wr, wc, fr, fq);
        if (!has_next) break;
#pragma unroll
        for (int a = 0; a < 2; ++a)
#pragma unroll
            for (int b = 0; b < 2; ++b)
#pragma unroll
                for (int m = 0; m < 4; ++m)
#pragma unroll
                    for (int n = 0; n < 2; ++n) acc[a][b][m][n] = (f32x4){0.f, 0.f, 0.f, 0.f};
        cur = nxt; cB = nB; cA = nA; ++ui;
        if constexpr (GATHER) {
#pragma unroll
        for (int h = 0; h < 2; ++h)
#pragma unroll
            for (int i = 0; i < 2; ++i) cAo[h][i] = nAo[h][i]; }
        if constexpr (ALIGN_EPI) { if (wr == 1) PG8_BAR; }
    }
    PG8_WAIT_V(0);
    if constexpr (!ALIGN_EPI) { if (wr == 0) PG8_BAR; }
    PG8_BAR;
#undef PG8_SA
#undef PG8_SB
#undef PG8_STAGE
#undef PG8_LDA
#undef PG8_LDB
#undef PG8_MMA
#undef PG8_WAIT_V
#undef PG8_WAIT_L
#undef PG8_BAR
#undef PG8_SCHED
#undef PG8_AOFFS
#undef PG8_STAGE_A
#undef PG8_ABASE
}


struct EpiQKV {
    static constexpr bool PERM = true;
    bf16_t* O; const float* rstd; const float* qg; const float* kg; float qscale;
    __device__ __forceinline__ void operator()(const f32x4 (&acc)[2][2][4][2], const Unit& u, int wr, int wc, int fr, int fq) const {
        const int part = u.pn >> 2, head = 4 * (u.pn & 3) + wc;
        f32x4 gv[2][2];
#pragma unroll
        for (int bj = 0; bj < 2; ++bj)
#pragma unroll
            for (int n = 0; n < 2; ++n) { const int dim = 32 * bj + 8 * fq + 4 * n;
                if (part == 0) gv[bj][n] = *(const f32x4*)(qg + dim) * qscale; else if (part == 1) gv[bj][n] = *(const f32x4*)(kg + dim); else gv[bj][n] = (f32x4){1.f, 1.f, 1.f, 1.f}; }
#pragma unroll
        for (int ai = 0; ai < 2; ++ai)
#pragma unroll
            for (int m = 0; m < 4; ++m) {
                const int row = u.pm * BM + ai * HALF + wr * 64 + m * 16 + fr; const float rs = rstd[row];
                f32x4 v[2][2]; float ss = 0.f;
#pragma unroll
                for (int bj = 0; bj < 2; ++bj)
#pragma unroll
                    for (int n = 0; n < 2; ++n) { v[bj][n] = acc[ai][bj][m][n] * rs; const f32x4 q = v[bj][n] * v[bj][n]; ss += (q[0] + q[1]) + (q[2] + q[3]); }
                float sc = 1.f;
                if (part < 2) { ss += __shfl_xor(ss, 16); ss += __shfl_xor(ss, 32); sc = 1.0f / sqrtf(ss * (1.0f / 64.0f) + EPS); }
                bf16_t* rowp = O + ((size_t)(part * 32 + (row / SEQ) * 16 + head) * SEQ + (row % SEQ)) * 64 + 8 * fq;
#pragma unroll
                for (int bj = 0; bj < 2; ++bj) { const f32x4 v0 = v[bj][0] * gv[bj][0] * sc, v1 = v[bj][1] * gv[bj][1] * sc;
                    u32x4 w; w.x = cvt_pk_bf16(v0[0], v0[1]); w.y = cvt_pk_bf16(v0[2], v0[3]); w.z = cvt_pk_bf16(v1[0], v1[1]); w.w = cvt_pk_bf16(v1[2], v1[3]);
                    *(u32x4*)(rowp + 32 * bj) = w; }
            }
    }
};
struct EpiBf16 {
    static constexpr bool PERM = true;
    bf16_t* O; int ldc; const float* rscale;
    __device__ __forceinline__ void operator()(const f32x4 (&acc)[2][2][4][2], const Unit& u, int wr, int wc, int fr, int fq) const {
        const int col0 = u.pn * BM + wc * 32 + 8 * fq;
#pragma unroll
        for (int ai = 0; ai < 2; ++ai)
#pragma unroll
            for (int m = 0; m < 4; ++m) { const int row = u.pm * BM + ai * HALF + wr * 64 + m * 16 + fr; const float rs = rscale ? rscale[row] : 1.f;
                bf16_t* rowp = O + (size_t)row * ldc + col0;
#pragma unroll
                for (int bj = 0; bj < 2; ++bj) { const f32x4 v0 = acc[ai][bj][m][0] * rs, v1 = acc[ai][bj][m][1] * rs;
                    u32x4 w; w.x = cvt_pk_bf16(v0[0], v0[1]); w.y = cvt_pk_bf16(v0[2], v0[3]); w.z = cvt_pk_bf16(v1[0], v1[1]); w.w = cvt_pk_bf16(v1[2], v1[3]);
                    *(u32x4*)(rowp + bj * HALF) = w; } }
    }
};
struct EpiResid {
    static constexpr bool PERM = false;
    const float* xin; float* out;
    __device__ __forceinline__ void operator()(const f32x4 (&acc)[2][2][4][2], const Unit& u, int wr, int wc, int fr, int fq) const {
        const int col0 = u.pn * BM + wc * 32 + 4 * fq;
#pragma unroll
        for (int ai = 0; ai < 2; ++ai)
#pragma unroll
            for (int m = 0; m < 4; ++m) { const size_t off = (size_t)(u.pm * BM + ai * HALF + wr * 64 + m * 16 + fr) * DM + col0;
#pragma unroll
                for (int bj = 0; bj < 2; ++bj)
#pragma unroll
                    for (int n = 0; n < 2; ++n) { const f32x4 b = *(const f32x4*)(xin + off + bj * HALF + n * 16); *(f32x4*)(out + off + bj * HALF + n * 16) = b + acc[ai][bj][m][n]; } }
    }
};
struct EpiResidB {
    static constexpr bool PERM = true;
    bf16_t* X;
    __device__ __forceinline__ void operator()(const f32x4 (&acc)[2][2][4][2], const Unit& u, int wr, int wc, int fr, int fq) const {
        const int col0 = u.pn * BM + wc * 32 + 8 * fq;
#pragma unroll
        for (int ai = 0; ai < 2; ++ai)
#pragma unroll
            for (int m = 0; m < 4; ++m) { bf16_t* rowp = X + (size_t)(u.pm * BM + ai * HALF + wr * 64 + m * 16 + fr) * DM + col0;
#pragma unroll
                for (int bj = 0; bj < 2; ++bj) { const u32x4 x = *(const u32x4*)(rowp + bj * HALF); const f32x4 a0 = acc[ai][bj][m][0], a1 = acc[ai][bj][m][1];
                    u32x4 w; w.x = cvt_pk_bf16(bflo(x.x) + a0[0], bfhi(x.x) + a0[1]); w.y = cvt_pk_bf16(bflo(x.y) + a0[2], bfhi(x.y) + a0[3]);
                    w.z = cvt_pk_bf16(bflo(x.z) + a1[0], bfhi(x.z) + a1[1]); w.w = cvt_pk_bf16(bflo(x.w) + a1[2], bfhi(x.w) + a1[3]);
                    *(u32x4*)(rowp + bj * HALF) = w; } }
    }
};
struct EpiGU {
    static constexpr bool PERM = true;
    bf16_t* O; const float* rstd; const int* sparse; const LAS int* pst; const LAS int* cnt;
    __device__ __forceinline__ void operator()(const f32x4 (&acc)[2][2][4][2], const Unit& u, int wr, int wc, int fr, int fq) const {
        const int col0 = u.pn * HALF + wc * 32 + 8 * fq;
#pragma unroll
        for (int ai = 0; ai < 2; ++ai)
#pragma unroll
            for (int m = 0; m < 4; ++m) { const int row = u.pm * BM + ai * HALF + wr * 64 + m * 16 + fr; const int jj = row - pst[u.e]; const float rs = (jj < cnt[u.e]) ? rstd[sparse[u.e * 32768 + jj]] : 0.f;
                float o[8];
#pragma unroll
                for (int n = 0; n < 2; ++n)
#pragma unroll
                    for (int i = 0; i < 4; ++i) { const float gg = acc[ai][0][m][n][i] * rs, uu = acc[ai][1][m][n][i] * rs;
                        o[n * 4 + i] = gg * fast_rcp(1.0f + fast_exp2(-gg * LOG2E)) * uu; }
                u32x4 w; w.x = cvt_pk_bf16(o[0], o[1]); w.y = cvt_pk_bf16(o[2], o[3]); w.z = cvt_pk_bf16(o[4], o[5]); w.w = cvt_pk_bf16(o[6], o[7]);
                *(u32x4*)(O + (size_t)row * FFE + col0) = w; }
    }
};
}

struct Frame {
    LAS unsigned char* lds;
    int tid, lane, wave, vcu, G;
};
struct Args { const float* in[20]; float* out; unsigned char* ws; int ph_lo, ph_hi; };
__device__ __forceinline__ Frame make_frame(LAS unsigned char* lds) {
    Frame F; int t = threadIdx.x; asm volatile("" : "+v"(t));
    F.lds = lds; F.tid = t; F.lane = t & 63; F.wave = __builtin_amdgcn_readfirstlane(t >> 6);
    F.G = gridDim.x; { const int bx = blockIdx.x; F.vcu = (F.G % 8 == 0) ? (bx % 8) * (F.G / 8) + bx / 8 : bx; }
    return F;
}

__device__ __forceinline__ bf16x8 ld_frag_lds(const LAS unsigned char* p) { return *(const LAS bf16x8*)p; }
__device__ __forceinline__ bf16x8 mk_frag(unsigned a, unsigned b, unsigned c, unsigned d) { u32x4 w = {a, b, c, d}; return __builtin_bit_cast(bf16x8, w); }
#define MFMA16(a, b, c) __builtin_amdgcn_mfma_f32_16x16x32_bf16(a, b, c, 0, 0, 0)

struct CvtDesc { const float* src; int ldsrc, k0, scol; const float* kscale; bf16_t* dst; int K, drow; };
__device__ __forceinline__ void cvt_load(const CvtDesc& d, int lane, f32x4 (&v)[8]) {
#pragma unroll
    for (int i = 0; i < 8; ++i) v[i] = __builtin_nontemporal_load((const GAS f32x4*)(d.src + (size_t)(d.k0 + 8 * i + (lane >> 3)) * d.ldsrc + d.scol + 4 * (lane & 7)));
}
__device__ __forceinline__ void cvt_finish(const CvtDesc& d, int lane, const f32x4 (&v)[8], LAS float* scr) {
    const int c = lane & 7;
    f32x4 ga = (f32x4){1.f, 1.f, 1.f, 1.f}, gb = ga;
    if (d.kscale) { ga = *(const GAS f32x4*)(d.kscale + d.k0 + 8 * c); gb = *(const GAS f32x4*)(d.kscale + d.k0 + 8 * c + 4); }
#pragma unroll
    for (int i = 0; i < 8; ++i) { const int kk = 8 * i + (lane >> 3); LAS float* p = scr + kk * 33 + 4 * (lane & 7);
        p[0] = v[i][0]; p[1] = v[i][1]; p[2] = v[i][2]; p[3] = v[i][3]; }
    LDS_WAIT(); asm volatile("" ::: "memory");
#pragma unroll
    for (int j = 0; j < 4; ++j) { const int n = (lane >> 3) + 8 * j; const LAS float* s = scr + (8 * c) * 33 + n;
        u32x4 o; o.x = cvt_pk_bf16(s[0 * 33] * ga[0], s[1 * 33] * ga[1]); o.y = cvt_pk_bf16(s[2 * 33] * ga[2], s[3 * 33] * ga[3]); o.z = cvt_pk_bf16(s[4 * 33] * gb[0], s[5 * 33] * gb[1]); o.w = cvt_pk_bf16(s[6 * 33] * gb[2], s[7 * 33] * gb[3]);
        __builtin_nontemporal_store(o, (GAS u32x4*)(d.dst + (size_t)(d.drow + n) * d.K + d.k0 + 8 * c)); }
    LDS_WAIT(); asm volatile("" ::: "memory");
}
__device__ __forceinline__ void cvt_item(const float* src, int ldsrc, int k0, int scol, const float* kscale, bf16_t* dst, int K, int drow, LAS float* scr, int lane) {
    const CvtDesc d{src, ldsrc, k0, scol, kscale, dst, K, drow}; f32x4 v[8]; cvt_load(d, lane, v); cvt_finish(d, lane, v, scr);
}
constexpr int MOE_ITEMS = 64 * 16 * 32 + 64 * 8 * 32;
__device__ __forceinline__ CvtDesc cvt_moe_desc(const Args& a, int l, int it) {
    constexpr int I_GU = 64 * 16 * 32;
    unsigned char* ws = a.ws; CvtDesc d;
    if (it < I_GU) { const int e = it / (16 * 32), q = it % (16 * 32), kb = q / 32, nb = q % 32;
        const int pn = nb >> 3, bj = (nb >> 2) & 1, c32 = nb & 3; const int le = l * 64 + e;
        d.src = (bj ? a.in[18] : a.in[17]) + (size_t)le * DM * FFE; d.ldsrc = FFE; d.k0 = kb * 64; d.scol = 128 * pn + 32 * c32; d.kscale = a.in[2] + (size_t)l * DM;
        d.dst = (bf16_t*)(ws + WS_WGU) + (size_t)le * DM * DM; d.K = DM; d.drow = nb * 32; }
    else { const int r = it - I_GU; const int e = r / (8 * 32), q = r % (8 * 32), kb = q / 32, nb = q % 32; const int le = l * 64 + e;
        d.src = a.in[19] + (size_t)le * FFE * DM; d.ldsrc = DM; d.k0 = kb * 64; d.scol = nb * 32; d.kscale = nullptr;
        d.dst = (bf16_t*)(ws + WS_WD) + (size_t)le * DM * FFE; d.K = FFE; d.drow = nb * 32; }
    return d;
}

__device__ __forceinline__ void p0_weights(const Frame& F, const Args& a) {
    LAS float* scr = (LAS float*)(F.lds + F.wave * 16384);
    const int gw = F.vcu * 8 + F.wave, NGW = F.G * 8;
    unsigned char* ws = a.ws;
    constexpr int I_QKV = 2 * 16 * 96, I_O = 2 * 16 * 32, I_IN = 2 * 16 * 96, I_MO = 2 * 16 * 32;
    constexpr int NITEMS = I_QKV + I_O + I_IN + I_MO;
    for (int it = gw; it < NITEMS; it += NGW) {
        int r = it;
        if (r < I_QKV) { const int j = r / (16 * 96), q = r % (16 * 96), kb = q / 96, nb = q % 96;
            const int pn = nb >> 3, bj = (nb >> 2) & 1, wc = nb & 3, part = pn >> 2, head = 4 * (pn & 3) + wc;
            cvt_item(a.in[3] + (size_t)j * DM * 3072, 3072, kb * 64, part * 1024 + head * 64 + 32 * bj, a.in[1] + (size_t)(2 * j) * DM, (bf16_t*)(ws + WS_WQKV) + (size_t)j * 3072 * DM, DM, nb * 32, scr, F.lane); continue; }
        r -= I_QKV;
        if (r < I_O) { const int j = r / (16 * 32), q = r % (16 * 32), kb = q / 32, nb = q % 32;
            cvt_item(a.in[6] + (size_t)j * DM * DM, DM, kb * 64, nb * 32, nullptr, (bf16_t*)(ws + WS_WO) + (size_t)j * DM * DM, DM, nb * 32, scr, F.lane); continue; }
        r -= I_O;
        if (r < I_IN) { const int j = r / (16 * 96), q = r % (16 * 96), kb = q / 96, nb = q % 96;
            cvt_item(a.in[7] + (size_t)j * DM * 3080, 3080, kb * 64, nb * 32, a.in[1] + (size_t)(2 * j + 1) * DM, (bf16_t*)(ws + WS_WIN) + (size_t)j * 3072 * DM, DM, nb * 32, scr, F.lane); continue; }
        r -= I_IN;
        { const int j = r / (16 * 32), q = r % (16 * 32), kb = q / 32, nb = q % 32;
            cvt_item(a.in[12] + (size_t)j * DM * DM, DM, kb * 64, nb * 32, nullptr, (bf16_t*)(ws + WS_WMO) + (size_t)j * DM * DM, DM, nb * 32, scr, F.lane); }
    }
    {
        const int gt = F.vcu * 512 + F.tid, NT = F.G * 512;
        for (int i = gt; i < 4 * 80 * 1024; i += NT) { const int l = i / (80 * 1024), c = (i / 1024) % 80, k = i % 1024;
            float w = 0.f;
            if (c < 8) w = a.in[13][((size_t)l * DM + k) * 8 + c]; else if (c < 72) w = a.in[15][((size_t)l * DM + k) * 64 + (c - 8)];
            w *= a.in[2][l * DM + k];
            const unsigned hi = f2bf(w); const unsigned lo = f2bf(w - bf2f(hi));
            bf16_t* base = (bf16_t*)(ws + WS_WR) + (size_t)l * 2 * 80 * 1024;
            base[c * 1024 + k] = (bf16_t)hi; base[80 * 1024 + c * 1024 + k] = (bf16_t)lo; }
        for (int i = gt; i < 2 * 16 * 1024; i += NT) { const int j = i / (16 * 1024), c = (i / 1024) % 16, k = i % 1024;
            float w = 0.f; if (c < 8) w = a.in[7][((size_t)j * DM + k) * 3080 + 3072 + c] * a.in[1][(2 * j + 1) * DM + k];
            const unsigned hi = f2bf(w); const unsigned lo = f2bf(w - bf2f(hi));
            bf16_t* base = (bf16_t*)(ws + WS_WG) + (size_t)j * 2 * 16 * 1024;
            base[c * 1024 + k] = (bf16_t)hi; base[16 * 1024 + c * 1024 + k] = (bf16_t)lo; }
        if (F.vcu == 0) { for (int i = F.tid; i < DM / 2; i += 512) ((unsigned*)((bf16_t*)(ws + WS_XB) + (size_t)NTOK * DM))[i] = 0u;
            if (F.tid == 0) ((float*)(ws + SM_RSTD))[NTOK] = 0.f; }
    }
}

template <int MODE, int NT, bool WLO = false>
__device__ __forceinline__ void rowpass_wave(const Frame& F, const float* xsrc, float* xdst, bf16_t* xb, float* rstd_out,
                                             const bf16_t* yb, const int* tokp, const float* tokg, const int* toke, const LAS int* pst,
                                             const bf16_t* whi, const bf16_t* wlo, int tok0, f32x4 (&acc)[NT > 0 ? NT : 1], float& rstd_lane) {
    const int lane = F.lane, t = lane & 15, fq = lane >> 4, tok = tok0 + t;
    const float* xr = xsrc + (size_t)tok * DM + 8 * fq;
    bf16_t* xbr = xb + (size_t)tok * DM + 8 * fq;
    const bf16_t *y0 = nullptr, *y1 = nullptr; float g0 = 0.f, g1 = 0.f;
    if (MODE == 2) { const int p0 = pst[toke[2 * tok]] + tokp[2 * tok], p1 = pst[toke[2 * tok + 1]] + tokp[2 * tok + 1]; g0 = tokg[2 * tok]; g1 = tokg[2 * tok + 1];
        y0 = yb + (size_t)p0 * DM + 8 * fq; y1 = yb + (size_t)p1 * DM + 8 * fq; }
    float* xw = (MODE == 2) ? xdst + (size_t)tok * DM + 8 * fq : nullptr;
#pragma unroll
    for (int c = 0; c < (NT > 0 ? NT : 1); ++c) acc[c] = (f32x4){0.f, 0.f, 0.f, 0.f};
    float ss = 0.f;
#pragma unroll 4
    for (int s = 0; s < 32; ++s) {
        f32x4 a0 = __builtin_nontemporal_load((const GAS f32x4*)(xr + 32 * s)), a1 = __builtin_nontemporal_load((const GAS f32x4*)(xr + 32 * s + 4));
        if (MODE == 2) {
            const u32x4 w0 = *(const GAS u32x4*)(y0 + 32 * s), w1 = *(const GAS u32x4*)(y1 + 32 * s);
            a0[0] += g0 * bflo(w0.x) + g1 * bflo(w1.x); a0[1] += g0 * bfhi(w0.x) + g1 * bfhi(w1.x);
            a0[2] += g0 * bflo(w0.y) + g1 * bflo(w1.y); a0[3] += g0 * bfhi(w0.y) + g1 * bfhi(w1.y);
            a1[0] += g0 * bflo(w0.z) + g1 * bflo(w1.z); a1[1] += g0 * bfhi(w0.z) + g1 * bfhi(w1.z);
            a1[2] += g0 * bflo(w0.w) + g1 * bflo(w1.w); a1[3] += g0 * bfhi(w0.w) + g1 * bfhi(w1.w);
            *(GAS f32x4*)(xw + 32 * s) = a0; *(GAS f32x4*)(xw + 32 * s + 4) = a1;
        }
        ss += (a0[0] * a0[0] + a0[1] * a0[1]) + (a0[2] * a0[2] + a0[3] * a0[3]) + (a1[0] * a1[0] + a1[1] * a1[1]) + (a1[2] * a1[2] + a1[3] * a1[3]);
        u32x4 hi; hi.x = cvt_pk_bf16(a0[0], a0[1]); hi.y = cvt_pk_bf16(a0[2], a0[3]); hi.z = cvt_pk_bf16(a1[0], a1[1]); hi.w = cvt_pk_bf16(a1[2], a1[3]);
        *(GAS u32x4*)(xbr + 32 * s) = hi;
        if (NT > 0) {
            u32x4 lo;
            lo.x = cvt_pk_bf16(a0[0] - bflo(hi.x), a0[1] - bfhi(hi.x)); lo.y = cvt_pk_bf16(a0[2] - bflo(hi.y), a0[3] - bfhi(hi.y));
            lo.z = cvt_pk_bf16(a1[0] - bflo(hi.z), a1[1] - bfhi(hi.z)); lo.w = cvt_pk_bf16(a1[2] - bflo(hi.w), a1[3] - bfhi(hi.w));
            const bf16x8 Ah = __builtin_bit_cast(bf16x8, hi), Al = __builtin_bit_cast(bf16x8, lo);
#pragma unroll
            for (int c = 0; c < NT; ++c) {
                const bf16x8 Bh = *(const GAS bf16x8*)(whi + (size_t)(16 * c + t) * DM + 32 * s + 8 * fq);
                acc[c] = MFMA16(Ah, Bh, acc[c]); acc[c] = MFMA16(Al, Bh, acc[c]);
                if (WLO) { const bf16x8 Bl = *(const GAS bf16x8*)(wlo + (size_t)(16 * c + t) * DM + 32 * s + 8 * fq); acc[c] = MFMA16(Ah, Bl, acc[c]); }
            }
        }
    }
    ss += __shfl_xor(ss, 16); ss += __shfl_xor(ss, 32);
    rstd_lane = 1.0f / sqrtf(ss * (1.0f / DM) + EPS);
    if (fq == 0) rstd_out[tok] = rstd_lane;
}

__device__ __forceinline__ void phase_x0(const Frame& F, const Args& a) {
    f32x4 dummy[1]; float rs;
    for (int tb = F.vcu; tb < NTOK / 128; tb += F.G)
        rowpass_wave<0, 0>(F, a.in[0], nullptr, (bf16_t*)(a.ws + WS_XB), (float*)(a.ws + SM_RSTD), nullptr, nullptr, nullptr, nullptr, nullptr, nullptr, nullptr, tb * 128 + F.wave * 16, dummy, rs);
}


constexpr int RT_WB = 73728, RT_WBUF = 21760;
__device__ __forceinline__ void router_pass(const Frame& F, const bf16_t* xb, float* rstd_out, const bf16_t* whi, int tok0, f32x4 (&acc)[5], float& rstd_lane) {
    const int lane = F.lane, t = lane & 15, fq = lane >> 4, tok = tok0 + t;
    const bf16_t* xbr = xb + (size_t)tok * DM + 8 * fq;
    LAS unsigned char* WB = F.lds + RT_WB;
    u32x4 wr[3];
#define RT_LOAD(chunk) do { _Pragma("unroll") for (int i = 0; i < 3; ++i) { const int p = F.tid + 512 * i; if (p < 1280) wr[i] = *(const GAS u32x4*)(whi + (size_t)(p >> 4) * DM + (chunk) * 128 + (p & 15) * 8); } } while (0)
#define RT_STORE(buf) do { _Pragma("unroll") for (int i = 0; i < 3; ++i) { const int p = F.tid + 512 * i; if (p < 1280) *(LAS u32x4*)(WB + (buf) * RT_WBUF + (p >> 4) * 272 + (p & 15) * 16) = wr[i]; } } while (0)
    __syncthreads();
    RT_LOAD(0); RT_STORE(0);
    __syncthreads();
#pragma unroll
    for (int c = 0; c < 5; ++c) acc[c] = (f32x4){0.f, 0.f, 0.f, 0.f};
    float ss = 0.f;
    u32x4 xc[4], xn[4];
#pragma unroll
    for (int s4 = 0; s4 < 4; ++s4) xc[s4] = *(const GAS u32x4*)(xbr + 32 * s4);
    for (int chunk = 0; chunk < 8; ++chunk) {
        if (chunk + 1 < 8) { RT_LOAD(chunk + 1);
#pragma unroll
            for (int s4 = 0; s4 < 4; ++s4) xn[s4] = *(const GAS u32x4*)(xbr + 32 * ((chunk + 1) * 4 + s4)); }
        const LAS unsigned char* wb = WB + (chunk & 1) * RT_WBUF + t * 272 + fq * 16;
#pragma unroll
        for (int s4 = 0; s4 < 4; ++s4) {
            const u32x4 hi = xc[s4];
            { const float x0 = bflo(hi.x), x1 = bfhi(hi.x), x2 = bflo(hi.y), x3 = bfhi(hi.y), x4 = bflo(hi.z), x5 = bfhi(hi.z), x6 = bflo(hi.w), x7 = bfhi(hi.w);
              ss += (x0 * x0 + x1 * x1) + (x2 * x2 + x3 * x3) + (x4 * x4 + x5 * x5) + (x6 * x6 + x7 * x7); }
            const bf16x8 Ah = __builtin_bit_cast(bf16x8, hi);
#pragma unroll
            for (int c = 0; c < 5; ++c) { const bf16x8 Bh = *(const LAS bf16x8*)(wb + c * (16 * 272) + s4 * 64); acc[c] = MFMA16(Ah, Bh, acc[c]); } }
        if (chunk + 1 < 8) { RT_STORE((chunk + 1) & 1);
#pragma unroll
            for (int s4 = 0; s4 < 4; ++s4) xc[s4] = xn[s4]; }
        __syncthreads();
    }
#undef RT_LOAD
#undef RT_STORE
    ss += __shfl_xor(ss, 16); ss += __shfl_xor(ss, 32);
    rstd_lane = 1.0f / sqrtf(ss * (1.0f / DM) + EPS);
    if (fq == 0) rstd_out[tok] = rstd_lane;
}

__device__ __forceinline__ void phase_router(const Frame& F, const Args& a, int l, bool dry = false) {
    unsigned char* ws = a.ws;
    int* sparse = (int*)(ws + WS_QC);
    LAS float* lg = (LAS float*)(F.lds) + F.wave * (16 * 81);
    LAS float* rsl = (LAS float*)(F.lds + 65536) + F.wave * 16;
    LAS int* hist = (LAS int*)(F.lds + 70000);
    LAS int* bbase = (LAS int*)(F.lds + 70000 + 256);
    LAS int* a_e = (LAS int*)(F.lds + 71000);
    LAS int* a_r = (LAS int*)(F.lds + 72100);
    const bf16_t* whi = (const bf16_t*)(ws + WS_WR) + (size_t)l * 2 * 80 * 1024; const bf16_t* wlo = whi + 80 * 1024;
    unsigned* counts = (unsigned*)(ws + WS_CTL) + CW_CNT + l * 64 + (dry ? 4096 : 0);
    int* toke = (int*)(ws + SM_TOKE); float* tokg = (float*)(ws + SM_TOKG); int* tokp = (int*)(ws + SM_TOKP);
    const float* bg = a.in[14] + l * 8; const float* be = a.in[16] + l * 64;
    for (int tb = F.vcu; tb < NTOK / 128; tb += F.G) {
        __syncthreads();
        if (F.tid < 64) hist[F.tid] = 0;
        __syncthreads();
        f32x4 acc[5]; float rs;
        const int tok0 = tb * 128 + F.wave * 16;
        router_pass(F, (const bf16_t*)(ws + WS_XB), (float*)(ws + SM_RSTD), whi, tok0, acc, rs);
        const int t = F.lane & 15, fq = F.lane >> 4;
        if (fq == 0) rsl[t] = rs;
        LDS_WAIT();
#pragma unroll
        for (int c = 0; c < 5; ++c)
#pragma unroll
            for (int i = 0; i < 4; ++i) { const int tt = 4 * fq + i, col = 16 * c + t; const float bias = col < 8 ? bg[col] : (col < 72 ? be[col - 8] : 0.f);
                lg[tt * 81 + col] = acc[c][i] * rsl[tt] + bias; }
        LDS_WAIT();
        if (F.lane < 16) {
            const LAS float* L = lg + F.lane * 81;
            int grp = 0; float gm = L[0];
#pragma unroll
            for (int j = 1; j < 8; ++j) { const float v = L[j]; if (v > gm) { gm = v; grp = j; } }
            float den = 0.f;
#pragma unroll
            for (int j = 0; j < 8; ++j) den += __expf(L[j] - gm);
            const float pg = 1.0f / den;
            const LAS float* E = L + 8 + grp * 8;
            int i1 = 0; float v1 = E[0];
#pragma unroll
            for (int j = 1; j < 8; ++j) { const float v = E[j]; if (v > v1) { v1 = v; i1 = j; } }
            int i2 = (i1 == 0) ? 1 : 0; float v2 = -3.0e38f;
#pragma unroll
            for (int j = 0; j < 8; ++j) { const float v = E[j]; if (j != i1 && v > v2) { v2 = v; i2 = j; } }
            const float e2 = __expf(v2 - v1), s1 = 1.0f / (1.0f + e2);
            const int tok = tok0 + F.lane, e_a = grp * 8 + i1, e_b = grp * 8 + i2;
            toke[2 * tok] = e_a; toke[2 * tok + 1] = e_b; tokg[2 * tok] = pg * s1; tokg[2 * tok + 1] = pg * e2 * s1;
            const int la = (F.wave * 16 + F.lane) * 2;
            a_e[la] = e_a; a_e[la + 1] = e_b;
            a_r[la] = atomicAdd((int*)(hist + e_a), 1); a_r[la + 1] = atomicAdd((int*)(hist + e_b), 1);
        }
        __syncthreads();
        if (F.tid < 64) bbase[F.tid] = (int)atomicAdd(counts + F.tid, (unsigned)hist[F.tid]);
        __syncthreads();
        if (F.tid < 256) { const int tok = tb * 128 + (F.tid >> 1); const int e = a_e[F.tid], idx = bbase[e] + a_r[F.tid]; tokp[2 * tok + (F.tid & 1)] = idx; if (!dry) sparse[e * 32768 + idx] = tok; }
    }
}

__device__ __forceinline__ int moe_tables(const Frame& F, const unsigned* counts, LAS int* pst, LAS int* cnt) {
    __syncthreads();
    if (F.tid < 64) {
        const int c = (int)counts[F.tid]; const int pc = (c + 255) & ~255;
        int incl = pc;
#pragma unroll
        for (int o = 1; o < 64; o <<= 1) { const int t = __shfl_up(incl, o); if (F.lane >= o) incl += t; }
        const int start = incl - pc;
        cnt[F.tid] = c; pst[F.tid] = start; if (F.tid == 63) pst[64] = incl;
        for (int t = start >> 8; t < (incl >> 8); ++t) pst[256 + t] = F.tid;
    }
    __syncthreads();
    return pst[64] >> 8;
}
constexpr int MOE_TAB_OFF = 131072;
struct TokRec { int e0, e1, q0, q1; float g0, g1; };
__device__ __forceinline__ TokRec tok_rec(const int* toke, const int* tokp, const float* tokg, int tok) { TokRec r; r.e0 = toke[2 * tok]; r.e1 = toke[2 * tok + 1]; r.q0 = tokp[2 * tok]; r.q1 = tokp[2 * tok + 1]; r.g0 = tokg[2 * tok]; r.g1 = tokg[2 * tok + 1]; return r; }
template <bool GATES, bool FINAL>
__device__ __forceinline__ void combine_wave(const Frame& F, bf16_t* xb, float* rstd_out, float* fout, const bf16_t* yb, const TokRec tr, const LAS int* pst,
                                             const bf16_t* whi, const bf16_t* wlo, int tok0, f32x4& acc, float& rstd_lane) {
    const int lane = F.lane, t = lane & 15, fq = lane >> 4, tok = tok0 + t;
    bf16_t* xr = xb + (size_t)tok * DM + 8 * fq;
    const int p0 = pst[tr.e0] + tr.q0, p1 = pst[tr.e1] + tr.q1; const float g0 = tr.g0, g1 = tr.g1;
    const bf16_t* y0 = yb + (size_t)p0 * DM + 8 * fq; const bf16_t* y1 = yb + (size_t)p1 * DM + 8 * fq;
    float* fo = FINAL ? fout + (size_t)tok * DM + 8 * fq : nullptr;
    acc = (f32x4){0.f, 0.f, 0.f, 0.f};
    float ss = 0.f;
#pragma unroll 4
    for (int s = 0; s < 32; ++s) {
        const u32x4 x = *(const GAS u32x4*)(xr + 32 * s), w0 = *(const GAS u32x4*)(y0 + 32 * s), w1 = *(const GAS u32x4*)(y1 + 32 * s);
        float v[8];
        v[0] = bflo(x.x) + g0 * bflo(w0.x) + g1 * bflo(w1.x); v[1] = bfhi(x.x) + g0 * bfhi(w0.x) + g1 * bfhi(w1.x);
        v[2] = bflo(x.y) + g0 * bflo(w0.y) + g1 * bflo(w1.y); v[3] = bfhi(x.y) + g0 * bfhi(w0.y) + g1 * bfhi(w1.y);
        v[4] = bflo(x.z) + g0 * bflo(w0.z) + g1 * bflo(w1.z); v[5] = bfhi(x.z) + g0 * bfhi(w0.z) + g1 * bfhi(w1.z);
        v[6] = bflo(x.w) + g0 * bflo(w0.w) + g1 * bflo(w1.w); v[7] = bfhi(x.w) + g0 * bfhi(w0.w) + g1 * bfhi(w1.w);
        if (FINAL) { __builtin_nontemporal_store((f32x4){v[0], v[1], v[2], v[3]}, (GAS f32x4*)(fo + 32 * s)); __builtin_nontemporal_store((f32x4){v[4], v[5], v[6], v[7]}, (GAS f32x4*)(fo + 32 * s + 4)); }
        u32x4 hi; hi.x = cvt_pk_bf16(v[0], v[1]); hi.y = cvt_pk_bf16(v[2], v[3]); hi.z = cvt_pk_bf16(v[4], v[5]); hi.w = cvt_pk_bf16(v[6], v[7]);
        if (!FINAL) *(GAS u32x4*)(xr + 32 * s) = hi;
        { const float r0 = bflo(hi.x), r1 = bfhi(hi.x), r2 = bflo(hi.y), r3 = bfhi(hi.y), r4 = bflo(hi.z), r5 = bfhi(hi.z), r6 = bflo(hi.w), r7 = bfhi(hi.w);
          ss += (r0 * r0 + r1 * r1) + (r2 * r2 + r3 * r3) + (r4 * r4 + r5 * r5) + (r6 * r6 + r7 * r7); }
        if (GATES) { const bf16x8 Ah = __builtin_bit_cast(bf16x8, hi);
            const bf16x8 Bh = *(const GAS bf16x8*)(whi + (size_t)t * DM + 32 * s + 8 * fq), Bl = *(const GAS bf16x8*)(wlo + (size_t)t * DM + 32 * s + 8 * fq);
            acc = MFMA16(Ah, Bh, acc); acc = MFMA16(Ah, Bl, acc); }
    }
    ss += __shfl_xor(ss, 16); ss += __shfl_xor(ss, 32);
    rstd_lane = 1.0f / sqrtf(ss * (1.0f / DM) + EPS);
    if (!FINAL && fq == 0) rstd_out[tok] = rstd_lane;
}
template <bool FINAL>
__device__ __forceinline__ void combine_rows(const Frame& F, bf16_t* xb, float* rstd_out, float* fout, const bf16_t* yb, const int* toke, const int* tokp, const float* tokg, const LAS int* pst, int tok0) {
    const int lane = F.lane;
#pragma unroll 1
    for (int bt = 0; bt < 4; ++bt) {
        u32x4 xv[4][2], y0v[4][2], y1v[4][2]; float g0[4], g1[4];
#pragma unroll
        for (int t4 = 0; t4 < 4; ++t4) { const int tok = __builtin_amdgcn_readfirstlane(tok0 + 4 * bt + t4);
            const int p0 = __builtin_amdgcn_readfirstlane(pst[toke[2 * tok]] + tokp[2 * tok]), p1 = __builtin_amdgcn_readfirstlane(pst[toke[2 * tok + 1]] + tokp[2 * tok + 1]);
            g0[t4] = tokg[2 * tok]; g1[t4] = tokg[2 * tok + 1];
            const bf16_t* xr = xb + (size_t)tok * DM + 8 * lane; const bf16_t* r0 = yb + (size_t)p0 * DM + 8 * lane; const bf16_t* r1 = yb + (size_t)p1 * DM + 8 * lane;
#pragma unroll
            for (int j = 0; j < 2; ++j) { xv[t4][j] = *(const GAS u32x4*)(xr + 512 * j); y0v[t4][j] = *(const GAS u32x4*)(r0 + 512 * j); y1v[t4][j] = *(const GAS u32x4*)(r1 + 512 * j); } }
#pragma unroll
        for (int t4 = 0; t4 < 4; ++t4) { const int tok = tok0 + 4 * bt + t4; float ss = 0.f;
#pragma unroll
            for (int j = 0; j < 2; ++j) { const u32x4 x = xv[t4][j], w0 = y0v[t4][j], w1 = y1v[t4][j]; const float a0 = g0[t4], a1 = g1[t4];
                float v[8];
                v[0] = bflo(x.x) + a0 * bflo(w0.x) + a1 * bflo(w1.x); v[1] = bfhi(x.x) + a0 * bfhi(w0.x) + a1 * bfhi(w1.x);
                v[2] = bflo(x.y) + a0 * bflo(w0.y) + a1 * bflo(w1.y); v[3] = bfhi(x.y) + a0 * bfhi(w0.y) + a1 * bfhi(w1.y);
                v[4] = bflo(x.z) + a0 * bflo(w0.z) + a1 * bflo(w1.z); v[5] = bfhi(x.z) + a0 * bfhi(w0.z) + a1 * bfhi(w1.z);
                v[6] = bflo(x.w) + a0 * bflo(w0.w) + a1 * bflo(w1.w); v[7] = bfhi(x.w) + a0 * bfhi(w0.w) + a1 * bfhi(w1.w);
                if (FINAL) { float* fo = fout + (size_t)tok * DM + 512 * j + 8 * lane;
                    __builtin_nontemporal_store((f32x4){v[0], v[1], v[2], v[3]}, (GAS f32x4*)fo); __builtin_nontemporal_store((f32x4){v[4], v[5], v[6], v[7]}, (GAS f32x4*)(fo + 4)); }
                else { u32x4 hi; hi.x = cvt_pk_bf16(v[0], v[1]); hi.y = cvt_pk_bf16(v[2], v[3]); hi.z = cvt_pk_bf16(v[4], v[5]); hi.w = cvt_pk_bf16(v[6], v[7]);
                    *(GAS u32x4*)(xb + (size_t)tok * DM + 512 * j + 8 * lane) = hi;
                    const float r0 = bflo(hi.x), r1 = bfhi(hi.x), r2 = bflo(hi.y), r3 = bfhi(hi.y), r4 = bflo(hi.z), r5 = bfhi(hi.z), r6 = bflo(hi.w), r7 = bfhi(hi.w);
                    ss += (r0 * r0 + r1 * r1) + (r2 * r2 + r3 * r3) + (r4 * r4 + r5 * r5) + (r6 * r6 + r7 * r7); } }
            if (!FINAL) {
#pragma unroll
                for (int o = 1; o < 64; o <<= 1) ss += __shfl_xor(ss, o);
                if (lane == 0) rstd_out[tok] = 1.0f / sqrtf(ss * (1.0f / DM) + EPS); } }
    }
}
__device__ __forceinline__ void combine_rows_gates(const Frame& F, bf16_t* xb, float* rstd_out, float* gout, const bf16_t* yb, const int* toke, const int* tokp, const float* tokg, const LAS int* pst, int tok0,
                                                   const float* win  , const float* gain  ) {
    const int lane = F.lane;
    float wg[2][8][8];
#pragma unroll
    for (int j = 0; j < 2; ++j)
#pragma unroll
        for (int i = 0; i < 8; ++i) { const int k = 512 * j + 8 * lane + i; const float gk = gain[k]; const f32x4 a = *(const GAS f32x4*)(win + (size_t)k * 3080 + 3072), b = *(const GAS f32x4*)(win + (size_t)k * 3080 + 3076);
            wg[j][i][0] = a[0] * gk; wg[j][i][1] = a[1] * gk; wg[j][i][2] = a[2] * gk; wg[j][i][3] = a[3] * gk; wg[j][i][4] = b[0] * gk; wg[j][i][5] = b[1] * gk; wg[j][i][6] = b[2] * gk; wg[j][i][7] = b[3] * gk; }
#pragma unroll 1
    for (int bt = 0; bt < 8; ++bt) {
        u32x4 xv[2][2], y0v[2][2], y1v[2][2]; float g0[2], g1[2];
#pragma unroll
        for (int t2 = 0; t2 < 2; ++t2) { const int tok = __builtin_amdgcn_readfirstlane(tok0 + 2 * bt + t2);
            const int p0 = __builtin_amdgcn_readfirstlane(pst[toke[2 * tok]] + tokp[2 * tok]), p1 = __builtin_amdgcn_readfirstlane(pst[toke[2 * tok + 1]] + tokp[2 * tok + 1]);
            g0[t2] = tokg[2 * tok]; g1[t2] = tokg[2 * tok + 1];
            const bf16_t* xr = xb + (size_t)tok * DM + 8 * lane; const bf16_t* r0 = yb + (size_t)p0 * DM + 8 * lane; const bf16_t* r1 = yb + (size_t)p1 * DM + 8 * lane;
#pragma unroll
            for (int j = 0; j < 2; ++j) { xv[t2][j] = *(const GAS u32x4*)(xr + 512 * j); y0v[t2][j] = *(const GAS u32x4*)(r0 + 512 * j); y1v[t2][j] = *(const GAS u32x4*)(r1 + 512 * j); } }
#pragma unroll
        for (int t2 = 0; t2 < 2; ++t2) { const int tok = tok0 + 2 * bt + t2; float ss = 0.f, gs[8];
#pragma unroll
            for (int c = 0; c < 8; ++c) gs[c] = 0.f;
#pragma unroll
            for (int j = 0; j < 2; ++j) { const u32x4 x = xv[t2][j], w0 = y0v[t2][j], w1 = y1v[t2][j]; const float a0 = g0[t2], a1 = g1[t2];
                float v[8];
                v[0] = bflo(x.x) + a0 * bflo(w0.x) + a1 * bflo(w1.x); v[1] = bfhi(x.x) + a0 * bfhi(w0.x) + a1 * bfhi(w1.x);
                v[2] = bflo(x.y) + a0 * bflo(w0.y) + a1 * bflo(w1.y); v[3] = bfhi(x.y) + a0 * bfhi(w0.y) + a1 * bfhi(w1.y);
                v[4] = bflo(x.z) + a0 * bflo(w0.z) + a1 * bflo(w1.z); v[5] = bfhi(x.z) + a0 * bfhi(w0.z) + a1 * bfhi(w1.z);
                v[6] = bflo(x.w) + a0 * bflo(w0.w) + a1 * bflo(w1.w); v[7] = bfhi(x.w) + a0 * bfhi(w0.w) + a1 * bfhi(w1.w);
                u32x4 hi; hi.x = cvt_pk_bf16(v[0], v[1]); hi.y = cvt_pk_bf16(v[2], v[3]); hi.z = cvt_pk_bf16(v[4], v[5]); hi.w = cvt_pk_bf16(v[6], v[7]);
                *(GAS u32x4*)(xb + (size_t)tok * DM + 512 * j + 8 * lane) = hi;
                const float r[8] = {bflo(hi.x), bfhi(hi.x), bflo(hi.y), bfhi(hi.y), bflo(hi.z), bfhi(hi.z), bflo(hi.w), bfhi(hi.w)};
#pragma unroll
                for (int i = 0; i < 8; ++i) { ss += r[i] * r[i];
#pragma unroll
                    for (int c = 0; c < 8; ++c) gs[c] += r[i] * wg[j][i][c]; } }
#pragma unroll
            for (int o = 1; o < 64; o <<= 1) { ss += __shfl_xor(ss, o);
#pragma unroll
                for (int c = 0; c < 8; ++c) gs[c] += __shfl_xor(gs[c], o); }
            const float rs = 1.0f / sqrtf(ss * (1.0f / DM) + EPS);
            if (lane == 0) rstd_out[tok] = rs;
            if (lane < 8) { float gv = gs[0];
#pragma unroll
                for (int c = 1; c < 8; ++c) gv = (lane == c) ? gs[c] : gv;
                gout[(size_t)tok * 8 + lane] = gv * rs; } }
    }
}
__device__ __forceinline__ void phase_combine(const Frame& F, const Args& a, int l) {
    unsigned char* ws = a.ws;
    const bool gates = (l + 1 < NLAYER) && ((l + 1) & 1);
    const int j = (l + 1) >> 1;
    const bf16_t* whi = (const bf16_t*)(ws + WS_WG) + (size_t)j * 2 * 16 * 1024; const bf16_t* wlo = whi + 16 * 1024;
    float* gout = (float*)(ws + SM_GATES);
    LAS float* rsl = (LAS float*)(F.lds) + F.wave * 16;
    LAS int* pst = (LAS int*)(F.lds + MOE_TAB_OFF); LAS int* cnt = (LAS int*)(F.lds + MOE_TAB_OFF + 512);
    const int* tokp = (const int*)(ws + SM_TOKP); const float* tokg = (const float*)(ws + SM_TOKG); const int* toke = (const int*)(ws + SM_TOKE);
    TokRec tr = tok_rec(toke, tokp, tokg, F.vcu * 128 + F.wave * 16 + (F.lane & 15));
    (void)moe_tables(F, (const unsigned*)(ws + WS_CTL) + CW_CNT + l * 64, pst, cnt);
    bf16_t* xb = (bf16_t*)(ws + WS_XB); float* rstd = (float*)(ws + SM_RSTD); const bf16_t* yb = (const bf16_t*)(ws + WS_YB);
    for (int tb = F.vcu; tb < NTOK / 128; tb += F.G) {
        f32x4 acc; float rs; const int tok0 = tb * 128 + F.wave * 16;
        if (tb != F.vcu) tr = tok_rec(toke, tokp, tokg, tok0 + (F.lane & 15));
        if (l + 1 == NLAYER) combine_rows<true>(F, xb, rstd, a.out, yb, toke, tokp, tokg, pst, tok0);
        else if (gates) { combine_rows_gates(F, xb, rstd, gout, yb, toke, tokp, tokg, pst, tok0, a.in[7] + (size_t)j * DM * 3080, a.in[1] + (size_t)(2 * j + 1) * DM);
        } else combine_rows<false>(F, xb, rstd, nullptr, yb, toke, tokp, tokg, pst, tok0);
    }
}

constexpr int ATT_KB = 0, ATT_VT = 36864;
struct AttnRegs { u32x4 k[2]; u32x4 v0, v1; bf16x8 q0, q1; };
struct AttnStep { int d, b, h, r, blk; bool prime; };
__device__ __forceinline__ void attn_fetch(const Frame& F, const bf16_t* QKV, const AttnStep& u, AttnRegs& R) {
    const int tid = F.tid, fr = F.lane & 15, fq = F.lane >> 4; const bool valid = u.blk >= 0; const int s0 = u.blk * 128;
#pragma unroll
    for (int i = 0; i < 2; ++i) { const int id = tid + 512 * i, row = id >> 3, ch = id & 7;
        R.k[i] = (u32x4){0u, 0u, 0u, 0u};
        if (valid) R.k[i] = *(const GAS u32x4*)(QKV + ((size_t)(32 + u.b * 16 + u.h) * SEQ + (s0 + row) * u.d + u.r) * 64 + 8 * ch); }
    { const int pair = tid >> 3, ch = tid & 7;
        R.v0 = (u32x4){0u, 0u, 0u, 0u}; R.v1 = (u32x4){0u, 0u, 0u, 0u};
        if (valid) { const bf16_t* p = QKV + ((size_t)(64 + u.b * 16 + u.h) * SEQ + (s0 + 2 * pair) * u.d + u.r) * 64 + 8 * ch; R.v0 = *(const GAS u32x4*)p; R.v1 = *(const GAS u32x4*)(p + (size_t)u.d * 64); } }
    if (!u.prime) { const size_t qrow = (size_t)(u.b * 16 + u.h) * SEQ + (s0 + 16 * F.wave + fr) * u.d + u.r;
        R.q0 = *(const GAS bf16x8*)(QKV + qrow * 64 + 8 * fq); R.q1 = *(const GAS bf16x8*)(QKV + qrow * 64 + 32 + 8 * fq); }
}
__device__ __forceinline__ void attn_stage(const Frame& F, const AttnRegs& R, int slot) {
    LAS unsigned char* Kb = F.lds + ATT_KB; LAS unsigned* VT = (LAS unsigned*)(F.lds + ATT_VT);
#pragma unroll
    for (int i = 0; i < 2; ++i) { const int id = F.tid + 512 * i, row = id >> 3, ch = id & 7; *(LAS u32x4*)(Kb + (slot * 128 + row) * 144 + ch * 16) = R.k[i]; }
    { const int pair = F.tid >> 3, ch = F.tid & 7; const u32x4 v0 = R.v0, v1 = R.v1;
        LAS unsigned* o = VT + (8 * ch) * 129 + slot * 64 + pair;
        o[0 * 129] = (v0.x & 0xffffu) | (v1.x << 16); o[1 * 129] = (v0.x >> 16) | (v1.x & 0xffff0000u);
        o[2 * 129] = (v0.y & 0xffffu) | (v1.y << 16); o[3 * 129] = (v0.y >> 16) | (v1.y & 0xffff0000u);
        o[4 * 129] = (v0.z & 0xffffu) | (v1.z << 16); o[5 * 129] = (v0.z >> 16) | (v1.z & 0xffff0000u);
        o[6 * 129] = (v0.w & 0xffffu) | (v1.w << 16); o[7 * 129] = (v0.w >> 16) | (v1.w & 0xffff0000u); }
}
template <int MODE, bool FIRST>
__device__ __forceinline__ void attn_compute(const Frame& F, const AttnStep& u, const int par, const bf16x8 Q0, const bf16x8 Q1, float off2, bf16_t* part_out, float* l_out, bf16_t* OB, const bf16_t* PP1, const bf16_t* PP2, const float* PL1, const float* PL2) {
    const int lane = F.lane, w = F.wave, fr = lane & 15, fq = lane >> 4;
    const int si0 = u.blk * 128;
    const LAS unsigned char* Kb = F.lds + ATT_KB; const LAS unsigned* VT = (const LAS unsigned*)(F.lds + ATT_VT);
    const int iq = 16 * w + fr; const size_t qrow = (size_t)(u.b * SEQ + (si0 + iq) * u.d + u.r), hrow = (size_t)(u.b * 16 + u.h) * SEQ + (si0 + iq) * u.d + u.r;
    f32x4 O[4];
#pragma unroll
    for (int dt = 0; dt < 4; ++dt) O[dt] = (f32x4){0.f, 0.f, 0.f, 0.f};
    float lsum = 0.f;
#pragma unroll
    for (int up = 0; up < 5; ++up) {
        unsigned pk[4];
#pragma unroll
        for (int hh = 0; hh < 2; ++hh) {
            const int tt = 2 * up + hh;
            if (tt < 9) {
                const int kt = w + tt;
                const int prow = ((kt < 8) ? (par ^ 1) : par) * 128 + 16 * (kt & 7);
                const LAS unsigned char* kp = Kb + (prow + fr) * 144 + fq * 16;
                f32x4 s = (f32x4){0.f, 0.f, 0.f, 0.f};
                s = MFMA16(ld_frag_lds(kp), Q0, s); s = MFMA16(ld_frag_lds(kp + 64), Q1, s);
                float p[4];
                if (FIRST || tt == 0 || tt == 8) {
#pragma unroll
                    for (int i = 0; i < 4; ++i) { const int jk = 16 * kt + 4 * fq + i; const bool ok = (jk >= iq) && (jk <= iq + 128) && (!FIRST || jk >= 128);
                        p[i] = ok ? fast_exp2(s[i] - off2) : 0.f; }
                } else {
#pragma unroll
                    for (int i = 0; i < 4; ++i) p[i] = fast_exp2(s[i] - off2);
                }
                lsum += (p[0] + p[1]) + (p[2] + p[3]);
                pk[2 * hh] = cvt_pk_bf16(p[0], p[1]); pk[2 * hh + 1] = cvt_pk_bf16(p[2], p[3]);
            } else { pk[2 * hh] = 0u; pk[2 * hh + 1] = 0u; }
        }
        const bf16x8 Pf = mk_frag(pk[0], pk[1], pk[2], pk[3]);
        const int kt0 = w + 2 * up, kt1 = (2 * up + 1 < 9) ? kt0 + 1 : kt0;
        const int pb0 = ((kt0 < 8) ? (par ^ 1) : par) * 64 + 8 * (kt0 & 7), pb1 = ((kt1 < 8) ? (par ^ 1) : par) * 64 + 8 * (kt1 & 7);
#pragma unroll
        for (int dt = 0; dt < 4; ++dt) { const LAS unsigned* vp = VT + (16 * dt + fr) * 129 + 2 * fq;
            const bf16x8 V = mk_frag(vp[pb0], vp[pb0 + 1], vp[pb1], vp[pb1 + 1]);
            O[dt] = MFMA16(V, Pf, O[dt]); }
    }
    lsum += __shfl_xor(lsum, 16); lsum += __shfl_xor(lsum, 32);
    if (MODE == 0) {
        bf16_t* o = part_out + hrow * 64 + 4 * fq;
#pragma unroll
        for (int dt = 0; dt < 4; ++dt) { u32x2 wv; wv.x = cvt_pk_bf16(O[dt][0], O[dt][1]); wv.y = cvt_pk_bf16(O[dt][2], O[dt][3]); *(GAS u32x2*)(o + 16 * dt) = wv; }
        if (fq == 0) l_out[hrow] = lsum;
    } else {
        const float inv = 1.0f / (lsum + PL1[hrow] + PL2[hrow]);
        bf16_t* o = OB + hrow * 64 + 4 * fq;
#pragma unroll
        for (int dt = 0; dt < 4; ++dt) { const u32x2 x1 = *(const GAS u32x2*)(PP1 + hrow * 64 + 4 * fq + 16 * dt), x2 = *(const GAS u32x2*)(PP2 + hrow * 64 + 4 * fq + 16 * dt);
            const float o0 = (O[dt][0] + bflo(x1.x) + bflo(x2.x)) * inv, o1 = (O[dt][1] + bfhi(x1.x) + bfhi(x2.x)) * inv;
            const float o2 = (O[dt][2] + bflo(x1.y) + bflo(x2.y)) * inv, o3 = (O[dt][3] + bfhi(x1.y) + bfhi(x2.y)) * inv;
            u32x2 wv; wv.x = cvt_pk_bf16(o0, o1); wv.y = cvt_pk_bf16(o2, o3); *(GAS u32x2*)(o + 16 * dt) = wv; }
    }
}
__device__ __forceinline__ float attn_off2(const float* qg, const float* kg) {
    const int i = threadIdx.x & 63; float mx = fabsf(qg[i] * kg[i]);
#pragma unroll
    for (int o = 1; o < 64; o <<= 1) mx = fmaxf(mx, __shfl_xor(mx, o));
    return 8.0f * mx * LOG2E * 1.02f;
}
template <int MODE>
__device__ __forceinline__ AttnStep attn_step(int s, int vcu, int& br) {
    const int xcd = vcu >> 5, jb = vcu & 31; AttnStep u; int bhl, nblk0, o;
    if (MODE == 0) {
        if (s < 18) { const int ci = 2 * jb + (s >= 9 ? 1 : 0); o = s >= 9 ? s - 9 : s; u.d = 16; bhl = ci >> 4; u.r = ci & 15; nblk0 = 0; br = 0; }
        else { o = s - 18; u.d = 4; bhl = jb >> 3; u.r = (jb & 7) >> 1; nblk0 = 16 * (jb & 1); br = 1; }
    } else { o = s; u.d = 1; bhl = jb >> 3; u.r = 0; nblk0 = 16 * (jb & 7); br = 0; }
    const int bh = xcd + 8 * bhl; u.b = bh >> 4; u.h = bh & 15; u.blk = nblk0 + o - 1; u.prime = (o == 0);
    return u;
}
template <int MODE>
__device__ __forceinline__ void phase_attn(const Frame& F, const Args& a, int j) {
    unsigned char* ws = a.ws; const bf16_t* QKV = (const bf16_t*)(ws + WS_QKV);
    const float off2 = attn_off2(a.in[4] + j * 64, a.in[5] + j * 64);
    constexpr int NSTEP = (MODE == 0) ? 35 : 17;
    if (F.G != 256) return;
    AttnRegs R; R.q0 = (bf16x8){0, 0, 0, 0, 0, 0, 0, 0}; R.q1 = R.q0; int br = 0, ucount = 0;
    AttnStep st = attn_step<MODE>(0, F.vcu, br);
    attn_fetch(F, QKV, st, R);
    const bf16_t* P1 = (const bf16_t*)(ws + WS_P1); const bf16_t* P2 = (const bf16_t*)(ws + WS_P2); const float* L1 = (const float*)(ws + SM_L1); const float* L2 = (const float*)(ws + SM_L2);
    for (int s = 0; s < NSTEP; ++s) {
        __syncthreads();
        attn_stage(F, R, s & 1);
        const bf16x8 Q0 = R.q0, Q1 = R.q1;
        const AttnStep cur = st; const int cbr = br;
        if (s + 1 < NSTEP) { st = attn_step<MODE>(s + 1, F.vcu, br); attn_fetch(F, QKV, st, R); }
        __syncthreads();
        if (cur.prime) continue;
        const int slot = (MODE == 0 ? 0 : 32) + ucount; ++ucount; const int cl = 2 * j + (slot >= 24 ? 1 : 0); const int cit = (F.vcu * 8 + F.wave) + 2048 * (slot % 24);
        const bool do_cvt = (slot < 48) && (cit < MOE_ITEMS);
        CvtDesc cd = cvt_moe_desc(a, cl, do_cvt ? cit : 0); f32x4 cv[8];
        if (do_cvt) cvt_load(cd, F.lane, cv);
        if (cur.blk == 0) attn_compute<MODE, true>(F, cur, s & 1, Q0, Q1, off2, (bf16_t*)(ws + (cbr == 0 ? WS_P1 : WS_P2)), (float*)(ws + (cbr == 0 ? SM_L1 : SM_L2)), (bf16_t*)(ws + WS_OB), P1, P2, L1, L2);
        else attn_compute<MODE, false>(F, cur, s & 1, Q0, Q1, off2, (bf16_t*)(ws + (cbr == 0 ? WS_P1 : WS_P2)), (float*)(ws + (cbr == 0 ? SM_L1 : SM_L2)), (bf16_t*)(ws + WS_OB), P1, P2, L1, L2);
        if (do_cvt) cvt_finish(cd, F.lane, cv, (LAS float*)(F.lds + 71680 + F.wave * 8448));
    }
}
__device__ __forceinline__ void phase_attn_a(const Frame& F, const Args& a, int j) { phase_attn<0>(F, a, j); }
__device__ __forceinline__ void phase_attn_b(const Frame& F, const Args& a, int j) { phase_attn<1>(F, a, j); }

__device__ __forceinline__ float log_sigmoid(float x) { return fminf(x, 0.f) - __logf(1.0f + __expf(-fabsf(x))); }
__device__ __forceinline__ float wave_incl_scan_add(float v, int lane) {
#pragma unroll
    for (int o = 1; o < 64; o <<= 1) { const float t = __shfl_up(v, o); if (lane >= o) v += t; }
    return v;
}
__device__ __forceinline__ float wave_incl_scan_max(float v, int lane) {
#pragma unroll
    for (int o = 1; o < 64; o <<= 1) { const float t = __shfl_up(v, o); if (lane >= o) v = fmaxf(v, t); }
    return v;
}
__device__ __forceinline__ float wave_max(float v) {
#pragma unroll
    for (int o = 1; o < 64; o <<= 1) v = fmaxf(v, __shfl_xor(v, o));
    return v;
}
constexpr int B2_KWT = 0, B2_VT = 18432, B2_WS = 52224, B2_RAW = 56320, B2_OUT = 91904;
__device__ __forceinline__ int vt_col(int dv, int pair) { return (pair + (dv >> 5)) & 31; }
__device__ __forceinline__ void mlstm_fetch_v(const Frame& F, const bf16_t* QKV, int n0, int h, u32x4 (&v0)[2], u32x4 (&v1)[2]) {
#pragma unroll
    for (int i = 0; i < 2; ++i) { const int id = F.tid + 512 * i, ch = id & 31, pair = id >> 5;
        const bf16_t* p = QKV + (size_t)(n0 + 2 * pair) * 3072 + 1024 + h * 256 + 8 * ch;
        v0[i] = *(const GAS u32x4*)p; v1[i] = *(const GAS u32x4*)(p + 3072); }
}
__device__ __forceinline__ void mlstm_write_vT(const Frame& F, const u32x4 (&v0a)[2], const u32x4 (&v1a)[2], LAS unsigned* VT) {
#pragma unroll
    for (int i = 0; i < 2; ++i) { const int id = F.tid + 512 * i, ch = id & 31, pair = id >> 5; const u32x4 v0 = v0a[i], v1 = v1a[i];
        LAS unsigned* o = VT + (8 * ch) * 33 + ((pair + (ch >> 2)) & 31);
        o[0 * 33] = (v0.x & 0xffffu) | (v1.x << 16); o[1 * 33] = (v0.x >> 16) | (v1.x & 0xffff0000u);
        o[2 * 33] = (v0.y & 0xffffu) | (v1.y << 16); o[3 * 33] = (v0.y >> 16) | (v1.y & 0xffff0000u);
        o[4 * 33] = (v0.z & 0xffffu) | (v1.z << 16); o[5 * 33] = (v0.z >> 16) | (v1.z & 0xffff0000u);
        o[6 * 33] = (v0.w & 0xffffu) | (v1.w << 16); o[7 * 33] = (v0.w >> 16) | (v1.w & 0xffff0000u); }
}
__device__ __forceinline__ void mlstm_stage_vT(const Frame& F, const bf16_t* QKV, int n0, int h, LAS unsigned* VT) {
    u32x4 v0[2], v1[2]; mlstm_fetch_v(F, QKV, n0, h, v0, v1); mlstm_write_vT(F, v0, v1, VT);
}
__device__ __forceinline__ void phase_mlstm_local(const Frame& F, const Args& a, int j) {
    unsigned char* ws = a.ws; const bf16_t* QKV = (const bf16_t*)(ws + WS_QKV);
    const float* gates = (const float*)(ws + SM_GATES); const float* gb = a.in[10] + j * 8;
    const float* cw = a.in[8] + (size_t)j * 4 * 1024; const float* cb = a.in[9] + j * 1024;
    bf16_t* QC = (bf16_t*)(ws + WS_QC); bf16_t* KC = (bf16_t*)(ws + WS_KC);
    bf16_t* DC = (bf16_t*)(ws + WS_DC); float* DN = (float*)(ws + SM_DN); float* MLOC = (float*)(ws + SM_MLOC); float* BL = (float*)(ws + SM_BL);
    LAS unsigned char* KwT = F.lds + B2_KWT; LAS unsigned* VT = (LAS unsigned*)(F.lds + B2_VT); LAS float* wsm = (LAS float*)(F.lds + B2_WS);
    if (F.vcu >= 256) return;
    const int bh = F.vcu >> 5, sc = F.vcu & 31, b = bh >> 2, h = bh & 3, us = bh * 32 + sc;
    f32x4 Dacc[2][8], an = (f32x4){0.f, 0.f, 0.f, 0.f};
#pragma unroll
    for (int bt = 0; bt < 2; ++bt)
#pragma unroll
        for (int at = 0; at < 8; ++at) Dacc[bt][at] = (f32x4){0.f, 0.f, 0.f, 0.f};
    float mq = -__builtin_inff(), blsum = 0.f;
    LAS float* G2 = (LAS float*)(F.lds + B2_WS + 512);
    { const int w_ = F.wave, lane_ = F.lane; const int n0w = b * SEQ + (sc * 8 + w_) * 64;
        const float ipre = DBGG(gates[(size_t)(n0w + lane_) * 8 + h]) + gb[h]; const float fpre = DBGG(gates[(size_t)(n0w + lane_) * 8 + 4 + h]) + gb[4 + h];
        const float bs = wave_incl_scan_add(log_sigmoid(fpre), lane_); const float bL = __shfl(bs, 63);
        const float gs = bL - bs + ipre; const float ml = wave_max(gs);
        G2[w_ * 64 + lane_] = __expf(gs - ml);
        if (lane_ == 0) { G2[512 + 2 * w_] = bL; G2[512 + 2 * w_ + 1] = ml; } }
    u32x4 Rv0[2], Rv1[2], Rr[5];
    LAS unsigned char* raw = F.lds + B2_RAW;
#define B2_FETCH(FR, c_) do { _Pragma("unroll") for (int i = 0; i < 5; ++i) { const int p = FR.tid + 512 * i, r = p >> 5, hf = (p >> 4) & 1, c16 = p & 15; const int pos = (c_) * 64 - 3 + r; \
            Rr[i] = (u32x4){0u, 0u, 0u, 0u}; if (p < 67 * 32 && pos >= 0) Rr[i] = *(const GAS u32x4*)(QKV + (size_t)(b * SEQ + pos) * 3072 + hf * 512 + h * 128 + 8 * c16); } } while (0)
    B2_FETCH(F, sc * 8); mlstm_fetch_v(F, QKV, b * SEQ + sc * 8 * 64, h, Rv0, Rv1);
    LAS float* cwl = (LAS float*)(F.lds + 126720);
    for (int idx = F.tid; idx < 1280; idx += 512) { const int isk = idx / 640, jr = (idx % 640) >> 7, cc = idx & 127; cwl[idx] = (jr < 4) ? cw[jr * 1024 + isk * 512 + h * 128 + cc] : cb[isk * 512 + h * 128 + cc]; }
    for (int jc = 0; jc < 8; ++jc) {
        const Frame Fi = make_frame(F.lds);
        const int lane = Fi.lane, fr = lane & 15, fq = lane >> 4, w = Fi.wave;
        const int c = sc * 8 + jc, n0 = b * SEQ + c * 64;
        __syncthreads();
        if (Fi.tid < 64) { const int s = Fi.tid; const float bL = G2[512 + 2 * jc], ml = G2[512 + 2 * jc + 1];
            const float mn = fmaxf(bL + mq, ml); const float aa = __expf(bL + mq - mn), bb = __expf(ml - mn);
            wsm[s] = G2[jc * 64 + s] * bb;
            if (s == 0) wsm[64] = aa;
            mq = mn; blsum += bL; }
        mlstm_write_vT(Fi, Rv0, Rv1, VT);
#pragma unroll
        for (int i = 0; i < 5; ++i) { const int p = Fi.tid + 512 * i, r = p >> 5, hf = (p >> 4) & 1, c16 = p & 15; if (p < 67 * 32) *(LAS u32x4*)(raw + r * 528 + hf * 256 + c16 * 16) = Rr[i]; }
        if (jc + 1 < 8) { mlstm_fetch_v(Fi, QKV, b * SEQ + (c + 1) * 64, h, Rv0, Rv1); B2_FETCH(Fi, c + 1); }
        __syncthreads();
#pragma unroll
        for (int i = 0; i < 4; ++i) { const int id = Fi.tid + 512 * i, s = id & 63, ch = (id >> 6) & 15, isk = id >> 10;
            const int col = (isk ? 512 : 0) + h * 128 + 8 * ch;
            float accv[8];
#pragma unroll
            for (int e = 0; e < 8; ++e) accv[e] = cwl[(isk * 5 + 4) * 128 + 8 * ch + e];
#pragma unroll
            for (int jj = 0; jj < 4; ++jj) { const u32x4 x = *(const LAS u32x4*)(raw + (s + jj) * 528 + isk * 256 + ch * 16); const LAS float* wj = cwl + (isk * 5 + jj) * 128 + 8 * ch;
                accv[0] += wj[0] * bflo(x.x); accv[1] += wj[1] * bfhi(x.x); accv[2] += wj[2] * bflo(x.y); accv[3] += wj[3] * bfhi(x.y);
                accv[4] += wj[4] * bflo(x.z); accv[5] += wj[5] * bfhi(x.z); accv[6] += wj[6] * bflo(x.w); accv[7] += wj[7] * bfhi(x.w); }
            const float scq = isk ? 0.08838834764831845f : 1.0f;
#pragma unroll
            for (int e = 0; e < 8; ++e) { const float v = accv[e]; accv[e] = v * fast_rcp(1.0f + __expf(-v)) * scq; }
            u32x4 o; o.x = cvt_pk_bf16(accv[0], accv[1]); o.y = cvt_pk_bf16(accv[2], accv[3]); o.z = cvt_pk_bf16(accv[4], accv[5]); o.w = cvt_pk_bf16(accv[6], accv[7]);
            *(LAS u32x4*)(F.lds + B2_OUT + isk * 17408 + s * 272 + ch * 16) = o;
            if (isk) { const float wv = wsm[s];
#pragma unroll
                for (int e = 0; e < 8; ++e) *(LAS bf16_t*)(KwT + (8 * ch + e) * 144 + 2 * s) = (bf16_t)f2bf(accv[e] * wv); } }
        __syncthreads();
#pragma unroll
        for (int i = 0; i < 4; ++i) { const int id = Fi.tid + 512 * i, c16 = id & 15, s = (id >> 4) & 63, isk = id >> 10;
            *(GAS u32x4*)((isk ? KC : QC) + ((size_t)(b * 4 + h) * SEQ + c * 64 + s) * 128 + 8 * c16) = *(const LAS u32x4*)(F.lds + B2_OUT + isk * 17408 + s * 272 + c16 * 16); }
        const float aa = wsm[64];
        bf16x8 Bv[2][2];
#pragma unroll
        for (int bt = 0; bt < 2; ++bt)
#pragma unroll
            for (int kk = 0; kk < 2; ++kk) { const int dvr = 16 * (2 * w + bt) + fr; const LAS unsigned* vp = VT + dvr * 33; const int p0 = 4 * fq + 16 * kk; Bv[bt][kk] = mk_frag(vp[vt_col(dvr, p0)], vp[vt_col(dvr, p0 + 1)], vp[vt_col(dvr, p0 + 2)], vp[vt_col(dvr, p0 + 3)]); }
        an *= aa;
#pragma unroll
        for (int at = 0; at < 8; ++at) {
            const LAS unsigned char* kp = KwT + (16 * at + fr) * 144 + 16 * fq;
            const bf16x8 A0 = ld_frag_lds(kp), A1 = ld_frag_lds(kp + 64);
#pragma unroll
            for (int bt = 0; bt < 2; ++bt) { f32x4 d = Dacc[bt][at] * aa; d = MFMA16(A0, Bv[bt][0], d); d = MFMA16(A1, Bv[bt][1], d); Dacc[bt][at] = d; }
            if (at == w) {
                const bf16x8 ones = mk_frag(0x3f803f80u, 0x3f803f80u, 0x3f803f80u, 0x3f803f80u);
                an = MFMA16(A0, ones, an); an = MFMA16(A1, ones, an); }
        }
    }
    { const int lane = F.lane, fr = lane & 15, fq = lane >> 4, w = F.wave;
        bf16_t* dcu = DC + (size_t)us * 32768;
#pragma unroll
        for (int bt = 0; bt < 2; ++bt)
#pragma unroll
            for (int at = 0; at < 8; ++at) { const f32x4 d = Dacc[bt][at]; u32x2 wv; wv.x = cvt_pk_bf16(d[0], d[1]); wv.y = cvt_pk_bf16(d[2], d[3]);
                *(GAS u32x2*)(dcu + (size_t)(16 * (2 * w + bt) + fr) * 128 + 16 * at + 4 * fq) = wv; }
        if (fr == 0) *(GAS f32x4*)(DN + (size_t)us * 128 + 16 * w + 4 * fq) = an;
        if (F.tid == 0) { MLOC[us] = mq; BL[us] = blsum; } }
#undef B2_FETCH
}
__device__ __forceinline__ void phase_mlstm_scan(const Frame& F, const Args& a) {
    unsigned char* ws = a.ws;
    if (F.vcu >= 256 || F.tid >= 256) return;
    const int bh = F.vcu >> 5, part = F.vcu & 31; const size_t eoff = (size_t)part * 1024 + F.tid * 4;
    const bf16_t* DC = (const bf16_t*)(ws + WS_DC); bf16_t* CS = (bf16_t*)(ws + WS_CS);
    const float* DN = (const float*)(ws + SM_DN); float* NS = (float*)(ws + SM_NS);
    const float* MLOC = (const float*)(ws + SM_MLOC); const float* BL = (const float*)(ws + SM_BL); float* MPREV = (float*)(ws + SM_MPREV);
    const bool doN = (part == 0) && (F.tid < 128);
    float st[4] = {0.f, 0.f, 0.f, 0.f}, nst = 0.f, m = 0.f;
    u32x2 dcA[8], dcB[8]; float blA[8], mlA[8], dnA[8], blB[8], mlB[8], dnB[8];
#define B3_LOAD(dc, bl, ml, dn, c0) do { _Pragma("unroll") for (int i = 0; i < 8; ++i) { const int u = bh * 32 + (c0) + i; dc[i] = *(const GAS u32x2*)(DC + (size_t)u * 32768 + eoff); bl[i] = BL[u]; ml[i] = MLOC[u]; dn[i] = doN ? DN[(size_t)u * 128 + F.tid] : 0.f; } } while (0)
#define B3_STEP(dc, bl, ml, dn, c0) do { _Pragma("unroll") for (int i = 0; i < 8; ++i) { const int u = bh * 32 + (c0) + i; \
            u32x2 o; o.x = cvt_pk_bf16(st[0], st[1]); o.y = cvt_pk_bf16(st[2], st[3]); \
            *(GAS u32x2*)(CS + (size_t)u * 32768 + eoff) = o; \
            if (doN) NS[(size_t)u * 128 + F.tid] = nst; \
            if (part == 0 && F.tid == 0) MPREV[u] = m; \
            const float mn = fmaxf(bl[i] + m, ml[i]); const float aa = __expf(bl[i] + m - mn), bb = __expf(ml[i] - mn); \
            st[0] = aa * st[0] + bb * bflo(dc[i].x); st[1] = aa * st[1] + bb * bfhi(dc[i].x); st[2] = aa * st[2] + bb * bflo(dc[i].y); st[3] = aa * st[3] + bb * bfhi(dc[i].y); \
            nst = aa * nst + bb * dn[i]; m = mn; } } while (0)
    B3_LOAD(dcA, blA, mlA, dnA, 0);
    for (int c0 = 0; c0 < 32; c0 += 16) {
        B3_LOAD(dcB, blB, mlB, dnB, c0 + 8);
        B3_STEP(dcA, blA, mlA, dnA, c0);
        if (c0 + 16 < 32) B3_LOAD(dcA, blA, mlA, dnA, c0 + 16);
        B3_STEP(dcB, blB, mlB, dnB, c0 + 8);
    }
#undef B3_LOAD
#undef B3_STEP
}
constexpr int B4_QS = 0, B4_KS = 17408, B4_VT = 34816, B4_SS = 68608, B4_SC = 77824, B4_KWT = 86016, B4_G = 104448, B4_RED = 112768;
__device__ __forceinline__ void phase_mlstm_out(const Frame& F, const Args& a, int j) {
    unsigned char* ws = a.ws; const bf16_t* QKV = (const bf16_t*)(ws + WS_QKV);
    const float* gates = (const float*)(ws + SM_GATES); const float* gb = a.in[10] + j * 8; const float* hg = a.in[11] + (size_t)j * 1024;
    const bf16_t* QC = (const bf16_t*)(ws + WS_QC); const bf16_t* KC = (const bf16_t*)(ws + WS_KC);
    const bf16_t* CS = (const bf16_t*)(ws + WS_CS); const float* NS = (const float*)(ws + SM_NS); const float* MPREV = (const float*)(ws + SM_MPREV);
    bf16_t* OB = (bf16_t*)(ws + WS_OB);
    LAS unsigned char* Qs = F.lds + B4_QS; LAS unsigned char* Ks = F.lds + B4_KS; LAS unsigned* VT = (LAS unsigned*)(F.lds + B4_VT); LAS unsigned char* Ss = F.lds + B4_SS; LAS unsigned char* KwT = F.lds + B4_KWT;
    LAS float* us = (LAS float*)(F.lds + B4_SC); LAS float* Ms = us + 64; LAS float* wint = us + 128; LAS float* eneg = us + 192; LAS float* npv = us + 256; LAS float* den = us + 384  ; LAS float* qn = us + 640  ; LAS float* hss = us + 1152  ;
    LAS float* wk = us + 1664  ; LAS float* scal = us + 1728;
    const int lane = F.lane, fr = lane & 15, fq = lane >> 4, w = F.wave;
    if (F.vcu >= 256) return;
    const int bh = F.vcu >> 5, sc = F.vcu & 31, b = bh >> 2, h = bh & 3;
    const int us0 = bh * 32 + sc;
    f32x4 Cst[2][8];
#pragma unroll
    for (int bt = 0; bt < 2; ++bt)
#pragma unroll
        for (int at = 0; at < 8; ++at) { const u32x2 x = *(const GAS u32x2*)(CS + (size_t)us0 * 32768 + (size_t)(16 * (2 * w + bt) + fr) * 128 + 16 * at + 4 * fq);
            Cst[bt][at] = (f32x4){bflo(x.x), bfhi(x.x), bflo(x.y), bfhi(x.y)}; }
    float mcur = MPREV[us0];
    LAS float* G4 = (LAS float*)(F.lds + B4_G);
    { const int n0w = b * SEQ + (sc * 8 + w) * 64;
        const float ipre = DBGG(gates[(size_t)(n0w + lane) * 8 + h]) + gb[h]; const float fpre = DBGG(gates[(size_t)(n0w + lane) * 8 + 4 + h]) + gb[4 + h];
        const float bs = wave_incl_scan_add(log_sigmoid(fpre), lane); const float uu = ipre - bs; const float pm = wave_incl_scan_max(uu, lane);
        const float bL = __shfl(bs, 63); const float gs = bL - bs + ipre; const float ml = wave_max(gs);
        G4[(w * 4 + 0) * 64 + lane] = bs; G4[(w * 4 + 1) * 64 + lane] = uu; G4[(w * 4 + 2) * 64 + lane] = pm; G4[(w * 4 + 3) * 64 + lane] = __expf(gs - ml);
        if (lane == 0) { G4[2048 + 2 * w] = bL; G4[2048 + 2 * w + 1] = ml; } }
    if (F.tid >= 64 && F.tid < 192) npv[F.tid - 64] = NS[(size_t)us0 * 128 + F.tid - 64];
    u32x4 Rqk[4], Rv0[2], Rv1[2];
#define B4_FETCH(FR, c_) do { const int n0_ = b * SEQ + (c_) * 64; \
        _Pragma("unroll") for (int i = 0; i < 4; ++i) { const int id = FR.tid + 512 * i, ch = id & 15, s = (id >> 4) & 63, isk = id >> 10; \
            Rqk[i] = *(const GAS u32x4*)((isk ? KC : QC) + ((size_t)(b * 4 + h) * SEQ + (c_) * 64 + s) * 128 + 8 * ch); } \
        mlstm_fetch_v(FR, QKV, n0_, h, Rv0, Rv1); } while (0)
    B4_FETCH(F, sc * 8);
    for (int jc = 0; jc < 8; ++jc) {
        const Frame Fi = make_frame(F.lds);
        const int lane = Fi.lane, fr = lane & 15, fq = lane >> 4, w = Fi.wave;
        const int c = sc * 8 + jc, n0 = b * SEQ + c * 64;
        __syncthreads();
        if (Fi.tid < 64) { const int s = Fi.tid; const float bs = G4[(jc * 4 + 0) * 64 + s], uu = G4[(jc * 4 + 1) * 64 + s], pm = G4[(jc * 4 + 2) * 64 + s];
            const float mp = mcur; const float M = fmaxf(mp, pm);
            us[s] = uu; Ms[s] = M; wint[s] = __expf(mp - M); eneg[s] = __expf(-(bs + M));
            const float bL = G4[2048 + 2 * jc], ml = G4[2048 + 2 * jc + 1];
            const float mn = fmaxf(bL + mp, ml); const float aa = __expf(bL + mp - mn), bb = __expf(ml - mn);
            wk[s] = G4[(jc * 4 + 3) * 64 + s] * bb;
            if (s == 0) scal[0] = aa;
            mcur = mn; }
#pragma unroll
        for (int i = 0; i < 4; ++i) { const int id = Fi.tid + 512 * i, ch = id & 15, s = (id >> 4) & 63, isk = id >> 10;
            *(LAS u32x4*)((isk ? Ks : Qs) + s * 272 + ch * 16) = Rqk[i]; }
        mlstm_write_vT(Fi, Rv0, Rv1, VT);
        if (jc + 1 < 8) B4_FETCH(Fi, c + 1);
        __syncthreads();
        u32x2 ogv[4][2]; f32x4 hgv[2];
#pragma unroll
        for (int dv = 0; dv < 2; ++dv) { const int col = h * 256 + 16 * (2 * w + dv) + 4 * fq; hgv[dv] = *(const GAS f32x4*)(hg + col);
#pragma unroll
            for (int tt = 0; tt < 4; ++tt) ogv[tt][dv] = *(const GAS u32x2*)(QKV + (size_t)(n0 + 16 * tt + fr) * 3072 + 2048 + col); }
#pragma unroll
        for (int i = 0; i < 2; ++i) { const int id = Fi.tid + 512 * i, s = id & 63, ch = id >> 6; const u32x4 kx = *(const LAS u32x4*)(Ks + s * 272 + ch * 16); const float wv = wk[s];
            LAS unsigned char* o = KwT + (8 * ch) * 144 + 2 * s;
            *(LAS bf16_t*)(o + 0 * 144) = (bf16_t)f2bf(bflo(kx.x) * wv); *(LAS bf16_t*)(o + 1 * 144) = (bf16_t)f2bf(bfhi(kx.x) * wv);
            *(LAS bf16_t*)(o + 2 * 144) = (bf16_t)f2bf(bflo(kx.y) * wv); *(LAS bf16_t*)(o + 3 * 144) = (bf16_t)f2bf(bfhi(kx.y) * wv);
            *(LAS bf16_t*)(o + 4 * 144) = (bf16_t)f2bf(bflo(kx.z) * wv); *(LAS bf16_t*)(o + 5 * 144) = (bf16_t)f2bf(bfhi(kx.z) * wv);
            *(LAS bf16_t*)(o + 6 * 144) = (bf16_t)f2bf(bflo(kx.w) * wv); *(LAS bf16_t*)(o + 7 * 144) = (bf16_t)f2bf(bfhi(kx.w) * wv); }
#pragma unroll
        for (int q2 = 0; q2 < 2; ++q2) { const int idx = 2 * w + q2, st = idx >> 2, tt = idx & 3;
            f32x4 sacc = (f32x4){0.f, 0.f, 0.f, 0.f};
            if (st <= tt) {
#pragma unroll
                for (int kk = 0; kk < 4; ++kk) sacc = MFMA16(ld_frag_lds(Ks + (16 * st + fr) * 272 + 16 * fq + 64 * kk), ld_frag_lds(Qs + (16 * tt + fr) * 272 + 16 * fq + 64 * kk), sacc);
            }
            const int t = 16 * tt + fr; const float Mt = Ms[t]; float p[4], rsum = 0.f;
#pragma unroll
            for (int i = 0; i < 4; ++i) { const int s = 16 * st + 4 * fq + i; p[i] = (s <= t) ? sacc[i] * __expf(us[s] - Mt) : 0.f; rsum += p[i]; }
            u32x2 wv; wv.x = cvt_pk_bf16(p[0], p[1]); wv.y = cvt_pk_bf16(p[2], p[3]);
            *(LAS u32x2*)(Ss + t * 144 + (16 * st + 4 * fq) * 2) = wv;
            rsum += __shfl_xor(rsum, 16); rsum += __shfl_xor(rsum, 32);
            if (fq == 0) den[st * 64 + t] = rsum; }
        { const int t = Fi.tid & 63, pp = Fi.tid >> 6; const u32x4 qa = *(const LAS u32x4*)(Qs + t * 272 + 32 * pp), qb = *(const LAS u32x4*)(Qs + t * 272 + 32 * pp + 16);
            const f32x4 n0v = *(const LAS f32x4*)(npv + 16 * pp), n1v = *(const LAS f32x4*)(npv + 16 * pp + 4), n2v = *(const LAS f32x4*)(npv + 16 * pp + 8), n3v = *(const LAS f32x4*)(npv + 16 * pp + 12);
            float sacc = 0.f;
            sacc += bflo(qa.x) * n0v[0]; sacc += bfhi(qa.x) * n0v[1]; sacc += bflo(qa.y) * n0v[2]; sacc += bfhi(qa.y) * n0v[3];
            sacc += bflo(qa.z) * n1v[0]; sacc += bfhi(qa.z) * n1v[1]; sacc += bflo(qa.w) * n1v[2]; sacc += bfhi(qa.w) * n1v[3];
            sacc += bflo(qb.x) * n2v[0]; sacc += bfhi(qb.x) * n2v[1]; sacc += bflo(qb.y) * n2v[2]; sacc += bfhi(qb.y) * n2v[3];
            sacc += bflo(qb.z) * n3v[0]; sacc += bfhi(qb.z) * n3v[1]; sacc += bflo(qb.w) * n3v[2]; sacc += bfhi(qb.w) * n3v[3];
            qn[pp * 64 + t] = sacc; }
        __syncthreads();
        f32x4 acc[2][4];
#pragma unroll
        for (int dv = 0; dv < 2; ++dv)
#pragma unroll
            for (int tt = 0; tt < 4; ++tt) acc[dv][tt] = (f32x4){0.f, 0.f, 0.f, 0.f};
#pragma unroll
        for (int kk = 0; kk < 4; ++kk) {
            bf16x8 Bq[4];
#pragma unroll
            for (int tt = 0; tt < 4; ++tt) { const LAS unsigned char* qp = Qs + (16 * tt + fr) * 272 + 64 * kk + 8 * fq; const u32x2 lo = *(const LAS u32x2*)qp, hi = *(const LAS u32x2*)(qp + 32); Bq[tt] = mk_frag(lo.x, lo.y, hi.x, hi.y); }
#pragma unroll
            for (int dv = 0; dv < 2; ++dv) { const f32x4 c0 = Cst[dv][2 * kk], c1 = Cst[dv][2 * kk + 1];
                const bf16x8 Ac = mk_frag(cvt_pk_bf16(c0[0], c0[1]), cvt_pk_bf16(c0[2], c0[3]), cvt_pk_bf16(c1[0], c1[1]), cvt_pk_bf16(c1[2], c1[3]));
#pragma unroll
                for (int tt = 0; tt < 4; ++tt) acc[dv][tt] = MFMA16(Ac, Bq[tt], acc[dv][tt]); }
            __builtin_amdgcn_sched_barrier(0);
        }
#pragma unroll
        for (int tt = 0; tt < 4; ++tt) { const float wi = wint[16 * tt + fr];
#pragma unroll
            for (int dv = 0; dv < 2; ++dv) acc[dv][tt] *= wi; }
#pragma unroll
        for (int kk = 0; kk < 2; ++kk) {
            bf16x8 Bs[4], Avk[2];
#pragma unroll
            for (int dv = 0; dv < 2; ++dv) { const int dvr = 16 * (2 * w + dv) + fr; const LAS unsigned* vp = VT + dvr * 33; const int p0 = 4 * fq + 16 * kk; Avk[dv] = mk_frag(vp[vt_col(dvr, p0)], vp[vt_col(dvr, p0 + 1)], vp[vt_col(dvr, p0 + 2)], vp[vt_col(dvr, p0 + 3)]); }
#pragma unroll
            for (int tt = 0; tt < 4; ++tt) Bs[tt] = ld_frag_lds(Ss + (16 * tt + fr) * 144 + 16 * fq + 64 * kk);
#pragma unroll
            for (int dv = 0; dv < 2; ++dv)
#pragma unroll
                for (int tt = 0; tt < 4; ++tt) acc[dv][tt] = MFMA16(Avk[dv], Bs[tt], acc[dv][tt]);
            __builtin_amdgcn_sched_barrier(0);
        }
        LAS float* redw = (LAS float*)(F.lds + B4_RED) + w * 64;
        { const int t = lane; const float qnt = ((qn[t] + qn[64 + t]) + (qn[128 + t] + qn[192 + t])) + ((qn[256 + t] + qn[320 + t]) + (qn[384 + t] + qn[448 + t]));
            const float dn = ((den[t] + den[64 + t]) + (den[128 + t] + den[192 + t])) + wint[t] * qnt; redw[t] = 1.0f / fmaxf(fabsf(dn), eneg[t]); }
        LDS_WAIT(); asm volatile("" ::: "memory");
#pragma unroll
        for (int tt = 0; tt < 4; ++tt) { const int t = 16 * tt + fr; const float inv = redw[t];
            float q = 0.f;
#pragma unroll
            for (int dv = 0; dv < 2; ++dv) { acc[dv][tt] *= inv; const f32x4 v = acc[dv][tt] * acc[dv][tt]; q += (v[0] + v[1]) + (v[2] + v[3]); }
            q += __shfl_xor(q, 16); q += __shfl_xor(q, 32);
            if (fq == 0) hss[w * 64 + t] = q; }
        __syncthreads();
        { const int t = lane; const float hs = ((hss[t] + hss[64 + t]) + (hss[128 + t] + hss[192 + t])) + ((hss[256 + t] + hss[320 + t]) + (hss[384 + t] + hss[448 + t]));
            redw[t] = 1.0f / sqrtf(hs * (1.0f / 256.0f) + EPS); }
        LDS_WAIT(); asm volatile("" ::: "memory");
#pragma unroll
        for (int tt = 0; tt < 4; ++tt) { const int t = 16 * tt + fr; const float rst = redw[t];
#pragma unroll
            for (int dv = 0; dv < 2; ++dv) { const int col = h * 256 + 16 * (2 * w + dv) + 4 * fq;
                const u32x2 og = ogv[tt][dv]; const f32x4 g4 = hgv[dv];
                const float o0 = acc[dv][tt][0] * rst * g4[0] * fast_rcp(1.0f + __expf(-bflo(og.x))), o1 = acc[dv][tt][1] * rst * g4[1] * fast_rcp(1.0f + __expf(-bfhi(og.x)));
                const float o2 = acc[dv][tt][2] * rst * g4[2] * fast_rcp(1.0f + __expf(-bflo(og.y))), o3 = acc[dv][tt][3] * rst * g4[3] * fast_rcp(1.0f + __expf(-bfhi(og.y)));
                u32x2 wv; wv.x = cvt_pk_bf16(o0, o1); wv.y = cvt_pk_bf16(o2, o3);
                *(GAS u32x2*)(OB + (size_t)(n0 + t) * DM + col) = wv; } }
        { const float aa = scal[0];
            bf16x8 Avk[2][2];
#pragma unroll
            for (int kk = 0; kk < 2; ++kk)
#pragma unroll
                for (int dv = 0; dv < 2; ++dv) { const int dvr = 16 * (2 * w + dv) + fr; const LAS unsigned* vp = VT + dvr * 33; const int p0 = 4 * fq + 16 * kk; Avk[kk][dv] = mk_frag(vp[vt_col(dvr, p0)], vp[vt_col(dvr, p0 + 1)], vp[vt_col(dvr, p0 + 2)], vp[vt_col(dvr, p0 + 3)]); }
#pragma unroll
            for (int bt = 0; bt < 2; ++bt)
#pragma unroll
                for (int at = 0; at < 8; ++at) Cst[bt][at] *= aa;
#pragma unroll
            for (int at = 0; at < 8; ++at) { const LAS unsigned char* kp = KwT + (16 * at + fr) * 144 + 16 * fq; const bf16x8 A0 = ld_frag_lds(kp), A1 = ld_frag_lds(kp + 64);
#pragma unroll
                for (int bt = 0; bt < 2; ++bt) { Cst[bt][at] = MFMA16(A0, Avk[0][bt], Cst[bt][at]); Cst[bt][at] = MFMA16(A1, Avk[1][bt], Cst[bt][at]); } }
            if (Fi.tid >= 64 && Fi.tid < 192) { const int dk = Fi.tid - 64; const LAS unsigned char* kr = KwT + dk * 144; float sum = 0.f;
#pragma unroll
                for (int q8 = 0; q8 < 8; ++q8) { const u32x4 x = *(const LAS u32x4*)(kr + 16 * q8); sum += ((bflo(x.x) + bfhi(x.x)) + (bflo(x.y) + bfhi(x.y))) + ((bflo(x.z) + bfhi(x.z)) + (bflo(x.w) + bfhi(x.w))); }
                npv[dk] = aa * npv[dk] + sum; } }
    }
#undef B4_FETCH
}


#ifdef PROBE_BUF
__device__ __forceinline__ void probe_scan(const Frame& F, const Args& a) {
    unsigned* ctl = (unsigned*)(a.ws + WS_CTL);
    unsigned bad = 0; float ms = 0.f;
    for (size_t i = (size_t)F.vcu * 512 + F.tid; i < (size_t)(PROBE_N); i += (size_t)F.G * 512) {
        float v;
        if (PROBE_KIND == 0) v = bf2f(((const bf16_t*)(a.ws + PROBE_BUF))[i]); else v = ((const float*)(a.ws + PROBE_BUF))[i];
        if (fabsf(v) < 1e30f) ms += v * v; else ++bad;
    }
    if (PROBE_STAT == 2) { bad = 0; ms = 0.f;
        for (int u = F.vcu * 8 + F.wave; u < (int)((PROBE_N) / 32768); u += F.G * 8) { unsigned b2 = 0;
            for (int i = F.lane; i < 32768; i += 64) { const float v = bf2f(((const bf16_t*)(a.ws + PROBE_BUF))[(size_t)u * 32768 + i]); if (!(fabsf(v) < 1e30f)) b2 = 1; }
            b2 = __any(b2) ? 1u : 0u; if (F.lane == 0) bad += b2 * 32768u; } }
    atomicAdd(ctl + 20000, bad); atomicAdd((float*)(ctl + 20064), ms);
}
__device__ __forceinline__ void probe_fill(const Frame& F, const Args& a) {
    const unsigned* ctl = (const unsigned*)(a.ws + WS_CTL);
    const float f = (float)ctl[20000] / (float)(PROBE_N), msq = ((const float*)ctl)[20064] / (float)(PROBE_N);
    const float c = sqrtf(PROBE_STAT != 1 ? 10.0f * f : msq);
    for (size_t i = (size_t)F.vcu * 512 + F.tid; i < (size_t)NTOK * DM; i += (size_t)F.G * 512) a.out[i] = c;
}
#endif
constexpr int NPHASE = 1 + NLAYER * 10;

typedef const __attribute__((address_space(4))) Args* KArgsPtr;
__device__ __forceinline__ Args opaque_args() {
#if defined(__HIP_DEVICE_COMPILE__)
    KArgsPtr p = (KArgsPtr)__builtin_amdgcn_kernarg_segment_ptr(); asm volatile("" : "+s"(p)); return *p;
#else
    return Args{};
#endif
}
#define SITE() const Frame FP = make_frame(lds); const Args A = opaque_args(); unsigned char* const ws = A.ws; (void)ws
__global__ void __launch_bounds__(512, 2) mk_fwd(Args args) {
    extern __shared__ __attribute__((aligned(16))) unsigned char lds_raw[];
    LAS unsigned char* const lds = (LAS unsigned char*)lds_raw;
    volatile LAS unsigned* MISC = (volatile LAS unsigned*)(lds + MISC_OFF);
    if (threadIdx.x < 32) MISC[threadIdx.x] = 0u;
    __syncthreads();
    const int lo = args.ph_lo, hi = args.ph_hi;
    XcdBarrier bar; bar.bar = (unsigned*)(args.ws + WS_CTL) + CW_BAR; bar.x = 0; bar.st = nullptr;
    if (hi - lo > 1) bar = xcd_barrier_post((unsigned*)(args.ws + WS_CTL) + CW_BAR, MISC + 8);
#define IN(k) (lo <= (k) && (k) < hi)
#ifdef XBAR_EXTRA
#define SEAM(k) do { if (IN(k) && IN((k) + 1)) { xcd_barrier(bar); xcd_barrier(bar); } } while (0)
#else
#define SEAM(k) do { if (IN(k) && IN((k) + 1)) xcd_barrier(bar); } while (0)
#endif
    if (PHON(0) && IN(0)) for (int rep_ = 0; rep_ < NREP(0); ++rep_) { SITE(); p0_weights(FP, A); phase_x0(FP, A); }
    SEAM(0);
    for (int l = 0; l < NLAYER; ++l) {
        const int pb = 1 + l * 10, j = l >> 1;
        if ((l & 1) == 0) {
            if (PHON(1) && IN(pb)) for (int rep_ = 0; rep_ < NREP(1); ++rep_) { SITE(); pg8::Gemm g{(const bf16_t*)(ws + WS_XB), (const bf16_t*)(ws + WS_WQKV) + (size_t)j * 3072 * DM, DM, 0, nullptr, nullptr, nullptr};
                pg8::StaticOrder S; S.init(NTOK / 256, 12, FP.G, (int)blockIdx.x, nullptr);
                pg8::EpiQKV E{(bf16_t*)(ws + WS_QKV), (const float*)(ws + SM_RSTD), A.in[4] + j * 64, A.in[5] + j * 64, 0.125f * LOG2E};
                pg8::gemm_phase<pg8::EpiQKV, true, false>(lds, FP.tid, g, S, E); }
            SEAM(pb);
            if (PHON(2) && IN(pb + 1)) for (int rep_ = 0; rep_ < NREP(2); ++rep_) { SITE(); phase_attn_a(FP, A, j); }
            SEAM(pb + 1);
            if (PHON(3) && IN(pb + 2)) for (int rep_ = 0; rep_ < NREP(3); ++rep_) { SITE(); phase_attn_b(FP, A, j); }
            if (IN(pb + 2) && IN(pb + 4)) xcd_barrier(bar);
            if (PHON(4) && IN(pb + 4)) { SITE(); pg8::Gemm g{(const bf16_t*)(ws + WS_OB), (const bf16_t*)(ws + WS_WO) + (size_t)j * DM * DM, DM, 0, nullptr, nullptr, nullptr};
                pg8::StaticOrder S; S.init(NTOK / 256, 4, FP.G, (int)blockIdx.x, nullptr);
                pg8::EpiResidB E{(bf16_t*)(ws + WS_XB)};
                pg8::gemm_phase<pg8::EpiResidB, true, false, true>(lds, FP.tid, g, S, E); }
            SEAM(pb + 4);
        } else {
            if (PHON(5) && IN(pb)) for (int rep_ = 0; rep_ < NREP(5); ++rep_) { SITE(); pg8::Gemm g{(const bf16_t*)(ws + WS_XB), (const bf16_t*)(ws + WS_WIN) + (size_t)j * 3072 * DM, DM, 0, nullptr, nullptr, nullptr};
                pg8::StaticOrder S; S.init(NTOK / 256, 12, FP.G, (int)blockIdx.x, nullptr);
                pg8::EpiBf16 E{(bf16_t*)(ws + WS_QKV), 3072, (const float*)(ws + SM_RSTD)};
                pg8::gemm_phase<pg8::EpiBf16, true, false>(lds, FP.tid, g, S, E); }
            SEAM(pb);
            if (PHON(6) && IN(pb + 1)) for (int rep_ = 0; rep_ < NREP(6); ++rep_) { SITE(); phase_mlstm_local(FP, A, j); }
            SEAM(pb + 1);
            if (PHON(7) && IN(pb + 2)) for (int rep_ = 0; rep_ < NREP(7); ++rep_) { SITE(); phase_mlstm_scan(FP, A); }
            SEAM(pb + 2);
            if (PHON(8) && IN(pb + 3)) for (int rep_ = 0; rep_ < NREP(8); ++rep_) { SITE(); phase_mlstm_out(FP, A, j); }
            SEAM(pb + 3);
            if (PHON(9) && IN(pb + 4)) { SITE(); pg8::Gemm g{(const bf16_t*)(ws + WS_OB), (const bf16_t*)(ws + WS_WMO) + (size_t)j * DM * DM, DM, 0, nullptr, nullptr, nullptr};
                pg8::StaticOrder S; S.init(NTOK / 256, 4, FP.G, (int)blockIdx.x, nullptr);
                pg8::EpiResidB E{(bf16_t*)(ws + WS_XB)};
                pg8::gemm_phase<pg8::EpiResidB, true, false>(lds, FP.tid, g, S, E); }
            SEAM(pb + 4);
        }
        if (PHON(10) && IN(pb + 5)) for (int rep_ = 0; rep_ < NREP(10); ++rep_) { SITE(); phase_router(FP, A, l, rep_ + 1 < NREP(10)); }
        if (IN(pb + 5) && IN(pb + 7)) xcd_barrier(bar);
        if (PHON(12) && IN(pb + 7)) for (int rep_ = 0; rep_ < NREP(12); ++rep_) { SITE();
            LAS int* pst = (LAS int*)(lds + MOE_TAB_OFF); LAS int* cnt = (LAS int*)(lds + MOE_TAB_OFF + 512);
            const int ntiles = __builtin_amdgcn_readfirstlane(moe_tables(FP, (const unsigned*)(ws + WS_CTL) + CW_CNT + l * 64, pst, cnt));
            pg8::Gemm g{(const bf16_t*)(ws + WS_XB), (const bf16_t*)(ws + WS_WGU) + (size_t)l * 64 * DM * DM, DM, (size_t)DM * DM * 2, (const int*)(ws + WS_QC), pst, cnt};
            pg8::StaticOrder S; S.init(ntiles, 4, FP.G, (int)blockIdx.x, pst);
            pg8::EpiGU E{(bf16_t*)(ws + WS_ACT), (const float*)(ws + SM_RSTD), (const int*)(ws + WS_QC), pst, cnt};
            pg8::gemm_phase<pg8::EpiGU, true, true>(lds, FP.tid, g, S, E); }
        SEAM(pb + 7);
        if (PHON(13) && IN(pb + 8)) for (int rep_ = 0; rep_ < NREP(13); ++rep_) { SITE();
            LAS int* pst = (LAS int*)(lds + MOE_TAB_OFF); LAS int* cnt = (LAS int*)(lds + MOE_TAB_OFF + 512);
            const int ntiles = __builtin_amdgcn_readfirstlane(moe_tables(FP, (const unsigned*)(ws + WS_CTL) + CW_CNT + l * 64, pst, cnt));
            pg8::Gemm g{(const bf16_t*)(ws + WS_ACT), (const bf16_t*)(ws + WS_WD) + (size_t)l * 64 * DM * FFE, FFE, (size_t)DM * FFE * 2, nullptr, pst, cnt};
            pg8::StaticOrder S; S.init(ntiles, 4, FP.G, (int)blockIdx.x, pst);
            pg8::EpiBf16 E{(bf16_t*)(ws + WS_YB), DM, nullptr};
            pg8::gemm_phase<pg8::EpiBf16, true, false>(lds, FP.tid, g, S, E); }
        SEAM(pb + 8);
        if (PHON(14) && IN(pb + 9)) { SITE(); phase_combine(FP, A, l); }
        SEAM(pb + 9);
    }
#ifdef PROBE_BUF
    if (IN(NPHASE)) { SITE(); probe_scan(FP, A); }
    if (IN(NPHASE + 1)) { SITE(); probe_fill(FP, A); }
#endif
#undef IN
#undef SEAM
}

extern "C" void kernel_launch(void* const* d_in, const int* in_sizes, int n_in, void* d_out, int out_size, void* d_ws, size_t ws_size, hipStream_t stream) {
    static int grid = 0;
    if (grid == 0) {
        if (n_in != 20 || out_size != NTOK * DM || ws_size < WS_END) { fprintf(stderr, "kernel_launch: unexpected shapes (n_in %d, out %d, ws %zu < %zu); nothing launched\n", n_in, out_size, ws_size, (size_t)WS_END); grid = -1; return; }
        int dev = 0, cus = 0, per_cu = 0;
        if (hipGetDevice(&dev) != hipSuccess || hipDeviceGetAttribute(&cus, hipDeviceAttributeMultiprocessorCount, dev) != hipSuccess) { grid = -1; return; }
        if (hipFuncSetAttribute((const void*)mk_fwd, hipFuncAttributeMaxDynamicSharedMemorySize, LDS_BYTES) != hipSuccess) { fprintf(stderr, "kernel_launch: hipFuncSetAttribute failed\n"); grid = -1; return; }
        if (hipOccupancyMaxActiveBlocksPerMultiprocessor(&per_cu, (const void*)mk_fwd, 512, LDS_BYTES) != hipSuccess || per_cu < 1) { fprintf(stderr, "kernel_launch: occupancy query says %d\n", per_cu); }
        (void)hipGetLastError();
        grid = cus;
        if (grid != 256) { fprintf(stderr, "kernel_launch: built for a 256-CU device, found %d CUs; nothing launched\n", cus); grid = -1; return; }
    }
    if (grid < 0) return;
    if (hipMemsetAsync((char*)d_ws + WS_CTL, 0, CTL_ZERO_BYTES, stream) != hipSuccess) return;
    Args a{};
    for (int i = 0; i < 20; ++i) a.in[i] = (const float*)d_in[i];
    a.out = (float*)d_out; a.ws = (unsigned char*)d_ws;
#if MK_ONE_LAUNCH
    a.ph_lo = 0; a.ph_hi = NPHASE;
    hipLaunchKernelGGL(mk_fwd, dim3(grid), dim3(512), LDS_BYTES, stream, a);
#else
    int np = NPHASE;
#ifdef PROBE_BUF
    np += 2;
#endif
    for (int p = 0; p < np; ++p) { a.ph_lo = p; a.ph_hi = p + 1; hipLaunchKernelGGL(mk_fwd, dim3(grid), dim3(512), LDS_BYTES, stream, a); }
#endif
}
```
